# Optimizing an MI355X kernel written in HIP

```python
import jax
import jax.numpy as jnp
from jax import lax
import numpy as np

D_MODEL = 1024
BATCH = 8
SEQ = 4096
DEPTH = 2

GRID_W = 64
CTX_LEN = 256
N_MOD = 6
D_MIX = D_MODEL
EPS = 1e-6
ML_H = 4
ML_DH = 64
ML_W = ML_H * ML_DH
ML_CHUNK = 64
ML_CONV = 3
NA_H = 6
NA_DH = 64
NA_W = NA_H * NA_DH
NA_WR = 8
NA_WC = 16
MLA_H = 6
MLA_NOPE = 64
MLA_ROPE = 32
MLA_V = 64
MLA_W = MLA_H * MLA_V
Q_LORA = 512
KV_LORA = 256
ATT_BLOCK = 128
ROPE_THETA = 10000.0
ML_COLS = 4 * ML_W + 4 * ML_H
NA_COLS = 3 * NA_W
MLA_COLS = Q_LORA + KV_LORA + MLA_ROPE
OFF_NA = ML_COLS
OFF_MLA = OFF_NA + NA_COLS
N_IN = OFF_MLA + MLA_COLS
D_FF = 2816
N_EXPERTS = 8
TOP_K = 2
D_FF_EXPERT = 2816
MOE_BLOCK = 256
N_DENSE = (DEPTH + 1) // 2
N_MOE = DEPTH // 2
F32 = jnp.float32

kernel_name = "hybrid_mlstm_natten_mla_moe_dit"


def rmsnorm(x, w):
    xf = x.astype(F32)
    y = xf * lax.rsqrt(jnp.mean(xf * xf, axis=-1, keepdims=True) + EPS) * w.astype(F32)
    return y.astype(x.dtype)


def modulate(h, shift, scale):
    return h * (1.0 + scale) + shift


def short_conv(x, w):
    k_w = w.shape[0]
    left = k_w // 2
    t_ = x.shape[1]
    xp = jnp.pad(x, ((0, 0), (left, k_w - 1 - left), (0, 0)))
    acc = xp[:, 0:t_] * w[0]
    for j in range(1, k_w):
        acc = acc + xp[:, j:j + t_] * w[j]
    return acc


def axial_rope_angles(t_):
    t = jnp.arange(t_, dtype=jnp.int32)
    row = (t // GRID_W).astype(F32)
    col = (t % GRID_W).astype(F32)
    half = MLA_ROPE // 2
    inv = ROPE_THETA ** (-jnp.arange(0, half, 2, dtype=F32) / half)
    return row[:, None] * inv, col[:, None] * inv


def _rot(x, ang):
    m = x.shape[-1] // 2
    x1, x2 = x[..., :m], x[..., m:]
    cs, sn = jnp.cos(ang), jnp.sin(ang)
    return jnp.concatenate([x1 * cs - x2 * sn, x2 * cs + x1 * sn], axis=-1)


def apply_axial_rope(x, ang_r, ang_c):
    xf = x.astype(F32)
    half = x.shape[-1] // 2
    return jnp.concatenate([_rot(xf[..., :half], ang_r), _rot(xf[..., half:], ang_c)], axis=-1).astype(x.dtype)


def softmax_attend(q, k, v):
    s = jnp.einsum('bhqd,bhkd->bhqk', q, k).astype(F32)
    return jnp.einsum('bhqk,bhkd->bhqd', jax.nn.softmax(s, axis=-1).astype(v.dtype), v)


def mlstm_chunkwise(q, k, v, li, lf, state, with_out):
    b_, h_, t_, dh = q.shape
    nc = t_ // ML_CHUNK
    qc = q.reshape(b_, h_, nc, ML_CHUNK, dh)
    kc = k.reshape(b_, h_, nc, ML_CHUNK, dh)
    vc = v.reshape(b_, h_, nc, ML_CHUNK, dh)
    lic = li.reshape(b_, h_, nc, ML_CHUNK)
    bcum = jnp.cumsum(lf.reshape(b_, h_, nc, ML_CHUNK), axis=-1)
    g = bcum[..., -1]
    a = g[..., None] - bcum + lic
    m_loc = jnp.max(a, axis=-1)
    w = jnp.exp(a - m_loc[..., None])
    c_loc = jnp.einsum('bhnl,bhnld,bhnle->bhnde', w, vc, kc)
    n_loc = jnp.einsum('bhnl,bhnle->bhne', w, kc)

    def step(carry, inp):
        c_st, n_st, m_st = carry
        g_j, c_j, n_j, m_j = inp
        m_new = jnp.maximum(g_j + m_st, m_j)
        w_old = jnp.exp(g_j + m_st - m_new)
        w_new = jnp.exp(m_j - m_new)
        c_nx = w_old[..., None, None] * c_st + w_new[..., None, None] * c_j
        n_nx = w_old[..., None] * n_st + w_new[..., None] * n_j
        return (c_nx, n_nx, m_new), carry

    xs = (jnp.moveaxis(g, 2, 0), jnp.moveaxis(c_loc, 2, 0), jnp.moveaxis(n_loc, 2, 0), jnp.moveaxis(m_loc, 2, 0))
    final, entering = lax.scan(step, state, xs)
    if not with_out:
        return None, final
    c_in = jnp.moveaxis(entering[0], 0, 2)
    n_in = jnp.moveaxis(entering[1], 0, 2)
    m_in = jnp.moveaxis(entering[2], 0, 2)
    inter = bcum + m_in[..., None]
    causal = jnp.tril(jnp.ones((ML_CHUNK, ML_CHUNK), dtype=bool))
    dmat = jnp.where(causal, bcum[..., :, None] - bcum[..., None, :] + lic[..., None, :], -jnp.inf)
    m_t = jnp.maximum(inter, jnp.max(dmat, axis=-1))
    s = jnp.einsum('bhntd,bhnsd->bhnts', qc, kc) * jnp.exp(dmat - m_t[..., None])
    w_inter = jnp.exp(inter - m_t)
    num = jnp.einsum('bhnts,bhnsd->bhntd', s, vc) + w_inter[..., None] * jnp.einsum('bhnde,bhnte->bhntd', c_in, qc)
    den = jnp.sum(s, axis=-1) + w_inter * jnp.einsum('bhne,bhnte->bhnt', n_in, qc)
    h = num / jnp.maximum(jnp.abs(den), jnp.exp(-m_t))[..., None]
    return h.reshape(b_, h_, t_, dh), final


def mlstm_prep(p, conv_w, ig_b, fg_b):
    b_, t_, _ = p.shape
    qk = jax.nn.silu(short_conv(p[..., :2 * ML_W], conv_w))

    def heads(a):
        return a.reshape(b_, t_, ML_H, ML_DH).transpose(0, 2, 1, 3).astype(F32)

    q = heads(qk[..., :ML_W])
    k = heads(qk[..., ML_W:]) * (ML_DH ** -0.5)
    v = heads(p[..., 2 * ML_W:3 * ML_W])
    o = p[..., 3 * ML_W:4 * ML_W]
    gates = p[..., 4 * ML_W:].astype(F32).reshape(b_, t_, 2, 2, ML_H)
    li = (gates[:, :, 0] + ig_b.astype(F32)).transpose(2, 0, 3, 1)
    lf = jax.nn.log_sigmoid(gates[:, :, 1] + fg_b.astype(F32)).transpose(2, 0, 3, 1)
    return q, k, v, o, li, lf


def mlstm_out(h, o, norm_w):
    b_, h_, t_, dh = h.shape
    ht = h.transpose(0, 2, 1, 3)
    hn = ht * lax.rsqrt(jnp.mean(ht * ht, axis=-1, keepdims=True) + EPS) * norm_w.astype(F32).reshape(h_, dh)
    return (hn.reshape(b_, t_, h_ * dh) * jax.nn.sigmoid(o.astype(F32))).astype(o.dtype)


def mlstm_mixer(p, pc, conv_w, ig_b, fg_b, norm_w, with_ctx_out):
    q, k, v, o, li, lf = mlstm_prep(p, conv_w, ig_b, fg_b)
    qc, kc, vc, oc, lic, lfc = mlstm_prep(pc, conv_w, ig_b, fg_b)
    b_, h_, _, dh = q.shape
    zero = (jnp.zeros((b_, h_, dh, dh), F32), jnp.zeros((b_, h_, dh), F32), jnp.full((b_, h_), -jnp.inf, F32))
    h_lat = []
    h_ctx = []
    for d in range(2):
        fl = (lambda z: jnp.flip(z, axis=2)) if d == 1 else (lambda z: z)
        hc_d, st = mlstm_chunkwise(fl(qc), fl(kc), fl(vc), fl(lic[d]), fl(lfc[d]), zero, with_ctx_out)
        h_d, _ = mlstm_chunkwise(fl(q), fl(k), fl(v), fl(li[d]), fl(lf[d]), st, True)
        h_lat.append(fl(h_d))
        if with_ctx_out:
            h_ctx.append(fl(hc_d))
    out = mlstm_out(h_lat[0] + h_lat[1], o, norm_w)
    if not with_ctx_out:
        return out, None
    return out, mlstm_out(h_ctx[0] + h_ctx[1], oc, norm_w)


def na_mixer(p, pc, rpb, with_ctx_out):
    b_, t_, _ = p.shape
    rows = t_ // GRID_W
    wr = min(NA_WR, rows)
    nband = wr * GRID_W
    scale = NA_DH ** -0.5

    def heads(a):
        return a.reshape(a.shape[0], a.shape[1], NA_H, NA_DH).transpose(0, 2, 1, 3)

    q = heads(p[..., :NA_W]) * scale
    k = heads(p[..., NA_W:2 * NA_W])
    v = heads(p[..., 2 * NA_W:])
    qc = heads(pc[..., :NA_W]) * scale
    kc = heads(pc[..., NA_W:2 * NA_W])
    vc = heads(pc[..., 2 * NA_W:])
    kg = k.reshape(b_, NA_H, rows, GRID_W, NA_DH)
    vg = v.reshape(b_, NA_H, rows, GRID_W, NA_DH)
    qg = jnp.moveaxis(q.reshape(b_, NA_H, rows, GRID_W, NA_DH), 2, 0)
    col = jnp.arange(GRID_W)
    c0 = jnp.clip(col - NA_WC // 2, 0, GRID_W - NA_WC)
    col_mask = (col[None, :] >= c0[:, None]) & (col[None, :] < c0[:, None] + NA_WC)
    col_idx = jnp.clip(col[None, :] - col[:, None], 1 - NA_WC, NA_WC - 1) + NA_WC - 1
    rpb_cols = rpb.astype(F32)[:, :, col_idx]

    def row_block(args):
        r, q_r = args
        r0 = jnp.clip(r - wr // 2, 0, rows - wr)
        k_b = lax.dynamic_slice_in_dim(kg, r0, wr, axis=2)
        v_b = lax.dynamic_slice_in_dim(vg, r0, wr, axis=2)
        bias = rpb_cols[:, r0 + jnp.arange(wr) - r + NA_WR - 1].transpose(0, 2, 1, 3)
        s = jnp.einsum('bhqd,bhrkd->bhqrk', q_r, k_b).astype(F32) + bias
        s = jnp.where(col_mask[:, None, :], s, -jnp.inf).reshape(b_, NA_H, GRID_W, nband)
        s_c = jnp.einsum('bhqd,bhcd->bhqc', q_r, kc).astype(F32)
        pr = jax.nn.softmax(jnp.concatenate([s, s_c], axis=-1), axis=-1).astype(v.dtype)
        o_b = jnp.einsum('bhqrk,bhrkd->bhqd', pr[..., :nband].reshape(b_, NA_H, GRID_W, wr, GRID_W), v_b)
        return o_b + jnp.einsum('bhqc,bhcd->bhqd', pr[..., nband:], vc)

    og = lax.map(row_block, (jnp.arange(rows), qg))
    out = og.transpose(1, 0, 3, 2, 4).reshape(b_, t_, NA_W)
    if not with_ctx_out:
        return out, None
    oc = softmax_attend(qc, kc, vc).transpose(0, 2, 1, 3).reshape(b_, pc.shape[1], NA_W)
    return out, oc


def mla_mixer(p, pc, q_norm_w, kv_norm_w, w_uq, w_ukv, ang_r, ang_c, with_ctx_out):
    scale = (MLA_NOPE + MLA_ROPE) ** -0.5

    def project(a, rotate):
        b_, t_, _ = a.shape
        cq = rmsnorm(a[..., :Q_LORA], q_norm_w)
        ckv = rmsnorm(a[..., Q_LORA:Q_LORA + KV_LORA], kv_norm_w)
        kr = a[..., Q_LORA + KV_LORA:]
        qf = (cq @ w_uq).reshape(b_, t_, MLA_H, MLA_NOPE + MLA_ROPE)
        kv = (ckv @ w_ukv).reshape(b_, t_, MLA_H, MLA_NOPE + MLA_V)
        qn, qr = qf[..., :MLA_NOPE], qf[..., MLA_NOPE:]
        kn, vv = kv[..., :MLA_NOPE], kv[..., MLA_NOPE:]
        if rotate:
            qr = apply_axial_rope(qr, ang_r[:, None], ang_c[:, None])
            kr = apply_axial_rope(kr, ang_r, ang_c)
        return (qn.transpose(0, 2, 1, 3) * scale, qr.transpose(0, 2, 1, 3) * scale,
                kn.transpose(0, 2, 1, 3), kr, vv.transpose(0, 2, 1, 3))

    qn, qr, kn, kr, v = project(p, True)
    qnc, qrc, knc, krc, vc = project(pc, False)
    b_, h_, t_, _ = qn.shape
    nb = t_ // ATT_BLOCK

    def blocks(z):
        return jnp.moveaxis(z.reshape(b_, h_, nb, ATT_BLOCK, z.shape[-1]), 2, 0)

    def attend(args):
        qn_b, qr_b = args
        s_l = jnp.einsum('bhqd,bhkd->bhqk', qn_b, kn) + jnp.einsum('bhqr,bkr->bhqk', qr_b, kr)
        s_c = jnp.einsum('bhqd,bhkd->bhqk', qn_b, knc) + jnp.einsum('bhqr,bkr->bhqk', qr_b, krc)
        pr = jax.nn.softmax(jnp.concatenate([s_l, s_c], axis=-1).astype(F32), axis=-1).astype(v.dtype)
        return jnp.einsum('bhqk,bhkd->bhqd', pr[..., :t_], v) + jnp.einsum('bhqk,bhkd->bhqd', pr[..., t_:], vc)

    og = lax.map(attend, (blocks(qn), blocks(qr)))
    out = og.transpose(1, 0, 3, 2, 4).reshape(b_, t_, MLA_W)
    if not with_ctx_out:
        return out, None
    s = (jnp.einsum('bhqd,bhkd->bhqk', qnc, knc) + jnp.einsum('bhqr,bkr->bhqk', qrc, krc)).astype(F32)
    oc = jnp.einsum('bhqk,bhkd->bhqd', jax.nn.softmax(s, axis=-1).astype(vc.dtype), vc)
    return out, oc.transpose(0, 2, 1, 3).reshape(b_, pc.shape[1], MLA_W)


def swiglu(x, w1, w3, w2):
    return (jax.nn.silu(x @ w1) * (x @ w3)) @ w2


def moe_ffn(x, router_w, w1, w3, w2):
    n_tok, d_ = x.shape
    logits = (x @ router_w).astype(F32)
    top_val, top_idx = lax.top_k(logits, TOP_K)
    gates = jax.nn.softmax(top_val, axis=-1)
    n_asg = n_tok * TOP_K
    e_flat = top_idx.reshape(n_asg)
    g_flat = gates.reshape(n_asg)
    tok_flat = jnp.arange(n_asg, dtype=jnp.int32) // TOP_K
    order = jnp.argsort(e_flat)
    e_s, tok_s, g_s = e_flat[order], tok_flat[order], g_flat[order]
    counts = jnp.zeros((N_EXPERTS,), jnp.int32).at[e_flat].add(1)
    padded = (counts + MOE_BLOCK - 1) // MOE_BLOCK * MOE_BLOCK
    pad_end = jnp.cumsum(padded)
    pad_start = pad_end - padded
    start = jnp.cumsum(counts) - counts
    dest = pad_start[e_s] + jnp.arange(n_asg, dtype=jnp.int32) - start[e_s]
    n_blocks = -(-n_asg // MOE_BLOCK) + N_EXPERTS
    n_rows = n_blocks * MOE_BLOCK
    buf_tok = jnp.full((n_rows,), n_tok, jnp.int32).at[dest].set(tok_s)
    buf_gate = jnp.zeros((n_rows,), F32).at[dest].set(g_s)
    blk_expert = jnp.minimum(jnp.searchsorted(pad_end, jnp.arange(n_blocks) * MOE_BLOCK, side='right'), N_EXPERTS - 1)
    x_pad = jnp.concatenate([x, jnp.zeros((1, d_), x.dtype)], axis=0)
    xb = x_pad[buf_tok].reshape(n_blocks, MOE_BLOCK, d_)

    def expert_block(args):
        xb_i, e = args
        return swiglu(xb_i, w1[e], w3[e], w2[e])

    yb = lax.map(expert_block, (xb, blk_expert)).reshape(n_rows, d_)
    y = jax.ops.segment_sum(yb * buf_gate[:, None].astype(yb.dtype), buf_tok, num_segments=n_tok + 1)
    return y[:n_tok]


def setup_inputs(seed: int = 0) -> dict:
    key = jax.random.key(seed)
    ks = list(jax.random.split(key, 32))
    d_ = D_MODEL

    def nrm(i, shape, scale):
        return jax.random.normal(ks[i], shape, F32) * scale

    return {
        'x': nrm(0, (BATCH, SEQ, d_), 1.0),
        'c': nrm(1, (BATCH, d_), 1.0),
        'ctx': nrm(2, (BATCH, CTX_LEN, d_), 1.0),
        'c_ctx': nrm(3, (d_,), 1.0),
        'ada_w': nrm(4, (DEPTH, d_, N_MOD * d_), 0.5 * d_ ** -0.5),
        'ada_b': nrm(5, (DEPTH, N_MOD * d_), 0.01),
        'norm1_w': 1.0 + nrm(6, (DEPTH, d_), 0.02),
        'norm2_w': 1.0 + nrm(7, (DEPTH, d_), 0.02),
        'w_in': nrm(8, (DEPTH, d_, N_IN), d_ ** -0.5),
        'w_out': nrm(9, (DEPTH, D_MIX, d_), D_MIX ** -0.5),
        'mlstm_conv_w': nrm(10, (DEPTH, ML_CONV, 2 * ML_W), ML_CONV ** -0.5),
        'mlstm_ig_b': nrm(11, (DEPTH, 2, ML_H), 0.1),
        'mlstm_fg_b': jnp.linspace(3.0, 6.0, ML_H, dtype=F32) + nrm(12, (DEPTH, 2, ML_H), 0.1),
        'mlstm_norm_w': 1.0 + nrm(13, (DEPTH, ML_W), 0.02),
        'na_rpb': nrm(14, (DEPTH, NA_H, 2 * NA_WR - 1, 2 * NA_WC - 1), 0.1),
        'mla_q_norm_w': 1.0 + nrm(15, (DEPTH, Q_LORA), 0.02),
        'mla_kv_norm_w': 1.0 + nrm(16, (DEPTH, KV_LORA), 0.02),
        'mla_w_uq': nrm(17, (DEPTH, Q_LORA, MLA_H * (MLA_NOPE + MLA_ROPE)), Q_LORA ** -0.5),
        'mla_w_ukv': nrm(18, (DEPTH, KV_LORA, MLA_H * (MLA_NOPE + MLA_V)), KV_LORA ** -0.5),
        'ffn_w1': nrm(19, (N_DENSE, d_, D_FF), d_ ** -0.5),
        'ffn_w3': nrm(20, (N_DENSE, d_, D_FF), d_ ** -0.5),
        'ffn_w2': nrm(21, (N_DENSE, D_FF, d_), D_FF ** -0.5),
        'moe_router_w': nrm(22, (N_MOE, d_, N_EXPERTS), d_ ** -0.5),
        'moe_w1': nrm(23, (N_MOE, N_EXPERTS, d_, D_FF_EXPERT), d_ ** -0.5),
        'moe_w3': nrm(24, (N_MOE, N_EXPERTS, d_, D_FF_EXPERT), d_ ** -0.5),
        'moe_w2': nrm(25, (N_MOE, N_EXPERTS, D_FF_EXPERT, d_), D_FF_EXPERT ** -0.5),
        'final_norm_w': 1.0 + nrm(26, (d_,), 0.02),
    }


def reference(x, c, ctx, c_ctx, ada_w, ada_b, norm1_w, norm2_w, w_in, w_out,
              mlstm_conv_w, mlstm_ig_b, mlstm_fg_b, mlstm_norm_w, na_rpb,
              mla_q_norm_w, mla_kv_norm_w, mla_w_uq, mla_w_ukv,
              ffn_w1, ffn_w3, ffn_w2, moe_router_w, moe_w1, moe_w3, moe_w2, final_norm_w):
    b_, t_, d_ = x.shape
    n_ctx = ctx.shape[1]
    ang_r, ang_c = axial_rope_angles(t_)
    xc = ctx
    sc_lat = jax.nn.silu(c)
    sc_ctx = jax.nn.silu(c_ctx)
    for l in range(DEPTH):
        last = l == DEPTH - 1
        mod = (sc_lat @ ada_w[l] + ada_b[l]).reshape(b_, N_MOD, 1, d_)
        modc = (sc_ctx @ ada_w[l] + ada_b[l]).reshape(N_MOD, d_)
        p = modulate(rmsnorm(x, norm1_w[l]), mod[:, 0], mod[:, 1]) @ w_in[l]
        pc = modulate(rmsnorm(xc, norm1_w[l]), modc[0], modc[1]) @ w_in[l]
        ml, mlc = mlstm_mixer(p[..., :OFF_NA], pc[..., :OFF_NA], mlstm_conv_w[l], mlstm_ig_b[l], mlstm_fg_b[l],
                              mlstm_norm_w[l], not last)
        na, nac = na_mixer(p[..., OFF_NA:OFF_MLA], pc[..., OFF_NA:OFF_MLA], na_rpb[l], not last)
        mla, mlac = mla_mixer(p[..., OFF_MLA:], pc[..., OFF_MLA:], mla_q_norm_w[l], mla_kv_norm_w[l],
                              mla_w_uq[l], mla_w_ukv[l], ang_r, ang_c, not last)
        x = x + mod[:, 2] * (jnp.concatenate([ml, na, mla], axis=-1) @ w_out[l]).astype(x.dtype)
        if not last:
            xc = xc + modc[2] * (jnp.concatenate([mlc, nac, mlac], axis=-1) @ w_out[l]).astype(xc.dtype)
        h = modulate(rmsnorm(x, norm2_w[l]), mod[:, 3], mod[:, 4])
        j = l // 2
        if l % 2 == 0:
            x = x + mod[:, 5] * swiglu(h, ffn_w1[j], ffn_w3[j], ffn_w2[j])
            if not last:
                hc = modulate(rmsnorm(xc, norm2_w[l]), modc[3], modc[4])
                xc = xc + modc[5] * swiglu(hc, ffn_w1[j], ffn_w3[j], ffn_w2[j])
        else:
            if last:
                y = moe_ffn(h.reshape(b_ * t_, d_), moe_router_w[j], moe_w1[j], moe_w3[j], moe_w2[j])
            else:
                hc = modulate(rmsnorm(xc, norm2_w[l]), modc[3], modc[4])
                tok = jnp.concatenate([h.reshape(b_ * t_, d_), hc.reshape(b_ * n_ctx, d_)], axis=0)
                y_all = moe_ffn(tok, moe_router_w[j], moe_w1[j], moe_w3[j], moe_w2[j])
                y = y_all[:b_ * t_]
                xc = xc + modc[5] * y_all[b_ * t_:].reshape(b_, n_ctx, d_).astype(xc.dtype)
            x = x + mod[:, 5] * y.reshape(b_, t_, d_).astype(x.dtype)
    return rmsnorm(x, final_norm_w)
```

```cpp
#include <hip/hip_runtime.h>
#include <stdint.h>
#include <stdio.h>

#ifndef MK_MULTI
#define MK_MULTI 0
#endif

#define LAS __attribute__((address_space(3)))
#define GAS __attribute__((address_space(1)))
typedef unsigned short bf16_t;
typedef short bf16x8 __attribute__((ext_vector_type(8)));
typedef short s16x4 __attribute__((ext_vector_type(4)));
typedef float f32x2 __attribute__((ext_vector_type(2)));
typedef float f32x4 __attribute__((ext_vector_type(4)));
typedef float f32x16 __attribute__((ext_vector_type(16)));
typedef unsigned u32x2 __attribute__((ext_vector_type(2)));
typedef unsigned u32x4 __attribute__((ext_vector_type(4)));
typedef __bf16 bf16x2_t __attribute__((ext_vector_type(2)));

constexpr int NB = 8, T = 4096, D = 1024, NC = 256;
constexpr int ML = NB * T, MC = NB * NC, M = ML + MC;
constexpr int NP = 3072;
constexpr int PC_QL = 0, PC_KVL = 512, PC_MQ = 768, PC_MK = 1024, PC_MV = 1280, PC_MO = 1536, PC_NQ = 1792, PC_NK = 2176, PC_NV = 2560, PC_KR = 2944, PC_GT = 2976;
constexpr int NQM = 576, NKVM = 768;
constexpr int DFF = 2816, NEXP = 8;
constexpr int NCHK = 68;
constexpr float LOG2E = 1.4426950408889634f;
constexpr float EPS = 1e-6f;

constexpr size_t MiB = 1u << 20;
constexpr size_t WS_CTL = 0, CTL_ZERO_BYTES = 1 * MiB;
constexpr size_t WS_SMALL = 1 * MiB;
constexpr size_t SM_MOD = WS_SMALL;
constexpr size_t SM_ROPE = SM_MOD + 2 * 9 * 6144 * 4;
constexpr size_t SM_STATS = WS_SMALL + 1 * MiB;
constexpr size_t SM_NLOC = WS_SMALL + 5 * MiB;
constexpr size_t SM_NIN = WS_SMALL + 7 * MiB;
constexpr size_t SM_MG = WS_SMALL + 9 * MiB;
constexpr size_t SM_MIN = SM_MG + 256 * 1024;
constexpr size_t SM_TOK = WS_SMALL + 10 * MiB;
constexpr size_t SM_TOKG = SM_TOK + (size_t)ML * 16;
constexpr size_t SM_WGCNT = WS_SMALL + 11 * MiB;
constexpr size_t SM_ROWTOK = SM_WGCNT + 64 * 1024;
constexpr size_t SM_ROWGATE = SM_ROWTOK + (size_t)2 * M * 4;
constexpr size_t SM_TILEEXP = SM_ROWGATE + (size_t)2 * M * 4;
constexpr size_t WS_WSMALL = 17 * MiB;
constexpr size_t W_IN = WS_WSMALL;
constexpr size_t W_OUT = W_IN + (size_t)2 * 3072 * 1024 * 2;
constexpr size_t W_UQ = W_OUT + (size_t)2 * 1024 * 1024 * 2;
constexpr size_t W_UKV = W_UQ + (size_t)2 * 768 * 512 * 2;
constexpr size_t W_F13 = W_UKV + (size_t)2 * 768 * 256 * 2;
constexpr size_t W_F2 = W_F13 + (size_t)5632 * 1024 * 2;
constexpr size_t WS_XC = 52 * MiB;
constexpr size_t WS_H = 60 * MiB;
constexpr size_t WS_P = 128 * MiB;
constexpr size_t WS_QM = 332 * MiB;
constexpr size_t WS_KVM = 371 * MiB;
constexpr size_t WS_CIN = 422 * MiB;
constexpr size_t WS_END_MIX = 456 * MiB;
constexpr size_t WS_WMOE = 17 * MiB;
constexpr size_t WMOE_E = (size_t)5632 * 1024 * 2 + (size_t)1024 * 2816 * 2;
constexpr size_t WS_U = 149 * MiB;
constexpr size_t WS_ASORT = 336 * MiB;
constexpr size_t WS_PBY = 472 * MiB;
constexpr size_t WS_END = 516 * MiB;
constexpr size_t WS_PBF = WS_QM;
constexpr size_t WS_PBW = WS_KVM;
static_assert(W_F2 + (size_t)1024 * 2816 * 2 <= WS_XC, "weights");
static_assert(WS_H + (size_t)M * 1024 * 2 <= WS_P && WS_P + (size_t)M * NP * 2 <= WS_QM && WS_QM + (size_t)M * NQM * 2 <= WS_KVM && WS_KVM + (size_t)M * NKVM * 2 <= WS_CIN, "map");
static_assert(WS_CIN + (size_t)2 * 8 * 4 * NCHK * 4096 * 2 <= WS_END_MIX, "map2");
static_assert(WS_WMOE + 8 * WMOE_E <= WS_U && WS_U + (size_t)M * DFF * 2 <= WS_ASORT && WS_ASORT + (size_t)2 * M * 1024 * 2 <= WS_PBY && WS_PBY + (size_t)11 * 7 * 256 * 1024 * 2 <= WS_END, "map3");
static_assert((size_t)2 * 8 * 4 * NCHK * 4096 * 4 <= (size_t)M * 1024 * 2, "C_LOC overlays BUF_H");
static_assert(SM_TILEEXP + 4096 <= WS_WSMALL && SM_TOKG + (size_t)ML * 8 <= SM_WGCNT && SM_STATS + (size_t)M * 24 * 4 <= SM_NLOC, "small map");

constexpr int CW_BAR = 4096;
constexpr int CW_QUEUE = 8192;
constexpr int CW_REDO2 = 8192 + 2048;
constexpr int CW_REDO = 8192 + 256;

constexpr int LDS_BYTES = 155648;
constexpr int LDS_MISC = 155648 - 256;

#define LDS_WAIT() asm volatile("s_waitcnt lgkmcnt(0)" ::: "memory")
#define VM_WAIT() asm volatile("s_waitcnt vmcnt(0)" ::: "memory")
__device__ __forceinline__ float bf2f(unsigned v) { return __uint_as_float(v << 16); }
__device__ __forceinline__ unsigned pk2(float lo, float hi) { f32x2 v = {lo, hi}; bf16x2_t b = __builtin_convertvector(v, bf16x2_t); return __builtin_bit_cast(unsigned, b); }
__device__ __forceinline__ void unpack8(const u32x4 w, float* f) {
    f[0] = __uint_as_float(w.x << 16); f[1] = __uint_as_float(w.x & 0xffff0000u); f[2] = __uint_as_float(w.y << 16); f[3] = __uint_as_float(w.y & 0xffff0000u);
    f[4] = __uint_as_float(w.z << 16); f[5] = __uint_as_float(w.z & 0xffff0000u); f[6] = __uint_as_float(w.w << 16); f[7] = __uint_as_float(w.w & 0xffff0000u);
}
__device__ __forceinline__ u32x4 pack8(const float* f) { u32x4 w; w.x = pk2(f[0], f[1]); w.y = pk2(f[2], f[3]); w.z = pk2(f[4], f[5]); w.w = pk2(f[6], f[7]); return w; }
__device__ __forceinline__ float wave_sum(float v) {
#pragma unroll
    for (int o = 1; o < 64; o <<= 1) v += __shfl_xor(v, o);
    return v;
}
__device__ __forceinline__ float wave_max(float v) {
#pragma unroll
    for (int o = 1; o < 64; o <<= 1) v = fmaxf(v, __shfl_xor(v, o));
    return v;
}
__device__ __forceinline__ float fexp2(float x) { return __builtin_amdgcn_exp2f(x); }
__device__ __forceinline__ float fexp(float x) { return __builtin_amdgcn_exp2f(x * LOG2E); }
__device__ __forceinline__ float frcp(float x) { return __builtin_amdgcn_rcpf(x); }
__device__ __forceinline__ float silu_f(float x) { return x * frcp(1.0f + fexp(-x)); }
__device__ __forceinline__ float sigmoid_f(float x) { return frcp(1.0f + fexp(-x)); }
__device__ __forceinline__ int fresh_lane() { int l; asm volatile("v_mbcnt_lo_u32_b32 %0, -1, 0\n\tv_mbcnt_hi_u32_b32 %0, -1, %0" : "=v"(l)); return l; }
__device__ __forceinline__ float xhalf(float v) { return __shfl_xor(v, 32); }
__device__ __forceinline__ float half_max(float v) { auto rr = __builtin_amdgcn_permlane32_swap(__float_as_uint(v), __float_as_uint(v), false, false); return fmaxf(__uint_as_float(rr[0]), __uint_as_float(rr[1])); }
__device__ __forceinline__ float half_sum(float v) { auto rr = __builtin_amdgcn_permlane32_swap(__float_as_uint(v), __float_as_uint(v), false, false); return __uint_as_float(rr[0]) + __uint_as_float(rr[1]); }

namespace pg8 {
constexpr int BM = 256, BK = 64, HALF = 128, HTB = HALF * BK * 2, STAGE_BYTES = 8 * HTB, NXCD = 8, WGM = 8;
__host__ __device__ __forceinline__ int lds_byte(int r, int c) { const int st = (r >> 4) * 2 + (c >> 5), rr = r & 15, cc = c & 31, ob = rr * 64 + cc * 2; return st * 1024 + (ob ^ (((ob >> 9) & 1) << 5)); }
__host__ __device__ __forceinline__ void stage_rc(int b, int& R, int& C) { const int st = b / 1024, sb = b % 1024, swz = sb ^ (((sb >> 9) & 1) << 5); R = (st >> 1) * 16 + swz / 64; C = (st & 1) * 32 + (swz % 64) / 2; }
__host__ __device__ __forceinline__ int perm32(int rho) { const int n = rho >> 4, i = rho & 15; return 8 * (i >> 2) + 4 * n + (i & 3); }

struct Unit { int pm, pn, kb, ke, part; };
struct Gemm { const bf16_t* A; int lda; const bf16_t* Bt; int K; };

struct StaticOrder {
    int nM, nN, nwg, G, c, nt;
    __device__ void init(int nM_, int nN_, int G_, int c_, int K_) { nM = nM_; nN = nN_; nwg = nM * nN; G = G_; c = c_; nt = K_ / BK; }
    __device__ __forceinline__ void tile_of(int L, Unit& u) const {
        int wgid = L; { const int q = nwg / NXCD, r = nwg % NXCD, xcd = wgid % NXCD, off = wgid / NXCD; wgid = (xcd < r ? xcd * (q + 1) : r * (q + 1) + (xcd - r) * q) + off; }
        const int nig = WGM * nN, gid = wgid / nig, fm = gid * WGM, gsz = (nM - fm) < WGM ? (nM - fm) : WGM;
        u.pm = fm + ((wgid % nig) % gsz); u.pn = (wgid % nig) / gsz;
    }
    __device__ bool next(int i, Unit& u) const {
        const long L = (long)i * G + c; if (L >= nwg) return false;
        tile_of((int)L, u); u.kb = 0; u.ke = nt; u.part = -1; return true;
    }
    __device__ __forceinline__ const char* a_base(const Gemm& g, const Unit& u) const { return (const char*)g.A + (size_t)u.pm * 256 * g.lda * 2 + (size_t)u.kb * (BK * 2); }
    __device__ __forceinline__ const char* b_base(const Gemm& g, const Unit& u) const { return (const char*)g.Bt + (size_t)u.pn * 256 * g.K * 2 + (size_t)u.kb * (BK * 2); }
};
struct GroupedOrder : StaticOrder {
    const int* tile_exp; size_t estride;
    __device__ __forceinline__ const char* b_base(const Gemm& g, const Unit& u) const { return (const char*)g.Bt + (size_t)tile_exp[u.pm] * estride + (size_t)u.pn * 256 * g.K * 2 + (size_t)u.kb * (BK * 2); }
};
template <class Base> struct TailSplit : Base {
    int nMain, nTail, S;
    __device__ void init_ts(int nMain_, int nTail_, int S_) { nMain = nMain_; nTail = nTail_ < 0 ? 0 : nTail_; S = S_; this->nM = nMain; this->nwg = nMain * this->nN; }
    __device__ bool next(int i, Unit& u) const {
        const long L = (long)i * this->G + this->c;
        if (L < this->nwg) { this->tile_of((int)L, u); u.kb = 0; u.ke = this->nt; u.part = -1; return true; }
        const long j = L - this->nwg; const int ntu = nTail * this->nN;
        if (j >= (long)ntu * S) return false;
        const int t = (int)(j % ntu), p = (int)(j / ntu), np = this->nt / 2;
        u.pm = nMain + t / this->nN; u.pn = t % this->nN; u.kb = 2 * (p * np / S); u.ke = 2 * ((p + 1) * np / S); u.part = p; return true;
    }
};

__device__ __forceinline__ unsigned cvt_pk_bf16(float lo, float hi) { unsigned r; asm volatile("v_cvt_pk_bf16_f32 %0, %1, %2" : "=v"(r) : "v"(lo), "v"(hi)); return r; }

template <class Epi, class Sched, bool ALIGN_EPI, bool GATHER = false>
__device__ __forceinline__ void gemm_phase(LAS unsigned char* lds, const Gemm g, const Sched& S, const Epi& E, const int wid0, const int* rowsrc = nullptr) {
    const int lane = fresh_lane(), wid = wid0, tid = wid * 64 + lane,
    wr = wid >> 2, wc = wid & 3, fr = lane & 15, fq = lane >> 4;
    const int K = g.K;
    unsigned vA[2][2], vN[2][2], voffB[2]; int sR[2], sC[2];
#pragma unroll
    for (int i = 0; i < 2; ++i) { int R, C; stage_rc(tid * 16 + i * 8192, R, C); const int Rb = Epi::PERM ? ((R & ~31) + perm32(R & 31)) : R; sR[i] = R; sC[i] = C;
        vA[0][i] = (unsigned)(R * g.lda + C) * 2u; vA[1][i] = (unsigned)((R + HALF) * g.lda + C) * 2u; vN[0][i] = vA[0][i]; vN[1][i] = vA[1][i]; voffB[i] = (unsigned)(Rb * K + C) * 2u; }
    const size_t kstep = (size_t)(BK * 2);
    const size_t hsB = (size_t)HALF * K * 2;
    LAS const int* rtab = (LAS const int*)(lds + STAGE_BYTES);
    if constexpr (GATHER) { Unit uu; for (int i = 0; S.next(i, uu); ++i) { if (tid < 256) ((LAS int*)(lds + STAGE_BYTES))[i * 256 + tid] = rowsrc[uu.pm * 256 + tid]; }
        asm volatile("s_waitcnt vmcnt(0) lgkmcnt(0)" ::: "memory"); __builtin_amdgcn_s_barrier(); asm volatile("" ::: "memory"); }
    auto gather_off = [&](int ui_, unsigned (&v)[2][2]) {
#pragma unroll
        for (int h = 0; h < 2; ++h)
#pragma unroll
            for (int i = 0; i < 2; ++i) v[h][i] = ((unsigned)rtab[ui_ * 256 + h * HALF + sR[i]] * (unsigned)g.lda + (unsigned)sC[i]) * 2u; };
    const unsigned ldsw = (unsigned)wid * 1024u;
    const int aoff = lds_byte(wr * 64 + fr, fq * 8), boff = lds_byte(wc * 32 + fr, fq * 8);
#define PG8_SA(b, h) (((b) * 2 + (h)) * HTB)
#define PG8_SB(b, h) ((4 + (b) * 2 + (h)) * HTB)
#define PG8_STAGE(bufoff, gbase, voff) do { _Pragma("unroll") for (int _i = 0; _i < 2; ++_i) \
        __builtin_amdgcn_global_load_lds((const unsigned*)((const char*)(gbase) + (voff)[_i]), (LAS unsigned*)(lds + (bufoff) + ldsw + _i * 8192), 16, 0, 0); } while (0)
#define PG8_STAGE_A(bufoff, gbase, h, nx) do { _Pragma("unroll") for (int _i = 0; _i < 2; ++_i) { const unsigned _o = (GATHER && (nx)) ? vN[h][_i] : vA[h][_i]; \
        __builtin_amdgcn_global_load_lds((const unsigned*)((const char*)(gbase) + _o), (LAS unsigned*)(lds + (bufoff) + ldsw + _i * 8192), 16, 0, 0); } } while (0)
#define PG8_LDA(dst, b, h) do { _Pragma("unroll") for (int m = 0; m < 4; ++m) _Pragma("unroll") for (int k = 0; k < 2; ++k) dst[m][k] = *(const LAS bf16x8*)(lds + PG8_SA(b, h) + aoff + m * 2048 + k * 1024); } while (0)
#define PG8_LDB(dst, b, h) do { _Pragma("unroll") for (int n = 0; n < 2; ++n) _Pragma("unroll") for (int k = 0; k < 2; ++k) dst[n][k] = *(const LAS bf16x8*)(lds + PG8_SB(b, h) + boff + n * 2048 + k * 1024); } while (0)
#define PG8_MMA(ai, bj, At, Bt) do { __builtin_amdgcn_s_setprio(1); _Pragma("unroll") for (int m = 0; m < 4; ++m) _Pragma("unroll") for (int n = 0; n < 2; ++n) _Pragma("unroll") for (int k = 0; k < 2; ++k) \
        acc[ai][bj][m][n] = __builtin_amdgcn_mfma_f32_16x16x32_bf16(Bt[n][k], At[m][k], acc[ai][bj][m][n], 0, 0, 0); __builtin_amdgcn_s_setprio(0); } while (0)
#define PG8_WAIT_V(n) asm volatile("s_waitcnt vmcnt(" #n ")" ::: "memory")
#define PG8_WAIT_L(n) asm volatile("s_waitcnt lgkmcnt(" #n ")" ::: "memory")
#define PG8_BAR __builtin_amdgcn_s_barrier()
#define PG8_SCHED __builtin_amdgcn_sched_barrier(0)
    Unit cur, nxt; int ui = 0;
    if (!S.next(0, cur)) return;
    f32x4 acc[2][2][4][2];
#pragma unroll
    for (int a = 0; a < 2; ++a)
#pragma unroll
        for (int b = 0; b < 2; ++b)
#pragma unroll
            for (int m = 0; m < 4; ++m)
#pragma unroll
                for (int n = 0; n < 2; ++n) acc[a][b][m][n] = (f32x4){0.f, 0.f, 0.f, 0.f};
    bf16x8 At[4][2], B0[2][2], B1[2][2];
    const char* cA = GATHER ? (const char*)g.A + (size_t)cur.kb * kstep : S.a_base(g, cur); const char* cB = S.b_base(g, cur);
    if constexpr (GATHER) gather_off(0, vA);
    PG8_STAGE(PG8_SB(0, 0), cB, voffB); PG8_STAGE(PG8_SB(0, 1), cB + hsB, voffB); PG8_STAGE_A(PG8_SA(0, 0), cA, 0, false); PG8_STAGE_A(PG8_SA(0, 1), cA, 1, false);
    if (wr == 1) PG8_BAR;
    PG8_WAIT_V(2); PG8_BAR;
    PG8_STAGE(PG8_SB(1, 0), cB + kstep, voffB); PG8_STAGE_A(PG8_SA(1, 0), cA + kstep, 0, false); PG8_STAGE(PG8_SB(1, 1), cB + hsB + kstep, voffB);
    PG8_WAIT_V(6); PG8_BAR;
    for (;;) {
        const bool has_next = S.next(ui + 1, nxt);
        const char* nA = has_next ? (GATHER ? (const char*)g.A + (size_t)nxt.kb * kstep : S.a_base(g, nxt)) : cA; const char* nB = has_next ? S.b_base(g, nxt) : cB;
        if constexpr (GATHER) { if (has_next) gather_off(ui + 1, vN); else {
#pragma unroll
            for (int h = 0; h < 2; ++h) { vN[h][0] = vA[h][0]; vN[h][1] = vA[h][1]; } } }
        const int ntc = cur.ke - cur.kb;
#pragma unroll 1
        for (int t = 0; t < ntc; t += 2) {
            const bool last = (t == ntc - 2);
            const char* a1 = cA + (size_t)(t + 1) * kstep;
            const char* a2 = last ? nA : cA + (size_t)(t + 2) * kstep; const char* b2 = last ? nB : cB + (size_t)(t + 2) * kstep;
            const char* a3 = a2 + kstep; const char* b3 = b2 + kstep;
            PG8_LDB(B0, 0, 0); PG8_LDB(B1, 0, 1); PG8_SCHED; PG8_LDA(At, 0, 0); PG8_STAGE_A(PG8_SA(1, 1), a1, 1, false);
            PG8_WAIT_V(8); PG8_WAIT_L(0); PG8_BAR; PG8_MMA(0, 0, At, B0); PG8_MMA(0, 1, At, B1); PG8_BAR; PG8_SCHED;
            PG8_LDA(At, 0, 1); PG8_STAGE(PG8_SB(0, 0), b2, voffB); PG8_STAGE(PG8_SB(0, 1), b2 + hsB, voffB); PG8_STAGE_A(PG8_SA(0, 0), a2, 0, last);
            PG8_WAIT_V(8); PG8_WAIT_L(0); PG8_BAR; PG8_MMA(1, 0, At, B0); PG8_MMA(1, 1, At, B1); PG8_BAR; PG8_SCHED;
            PG8_LDB(B0, 1, 0); PG8_LDB(B1, 1, 1); PG8_SCHED; PG8_LDA(At, 1, 0); PG8_STAGE_A(PG8_SA(0, 1), a2, 1, last);
            PG8_WAIT_V(8); PG8_WAIT_L(0); PG8_BAR; PG8_MMA(0, 0, At, B0); PG8_MMA(0, 1, At, B1); PG8_BAR; PG8_SCHED;
            PG8_LDA(At, 1, 1); PG8_STAGE(PG8_SB(1, 0), b3, voffB); PG8_STAGE(PG8_SB(1, 1), b3 + hsB, voffB); PG8_STAGE_A(PG8_SA(1, 0), a3, 0, last);
            PG8_WAIT_V(8); PG8_WAIT_L(0); PG8_BAR; PG8_MMA(1, 0, At, B0); PG8_MMA(1, 1, At, B1); PG8_BAR; PG8_SCHED;
        }
        if constexpr (ALIGN_EPI) { if (wr == 0) PG8_BAR; }
        E(acc, cur, wr, wc, fr, fq);
        if (!has_next) break;
#pragma unroll
        for (int a = 0; a < 2; ++a)
#pragma unroll
            for (int b = 0; b < 2; ++b)
#pragma unroll
                for (int m = 0; m < 4; ++m)
#pragma unroll
                    for (int n = 0; n < 2; ++n) acc[a][b][m][n] = (f32x4){0.f, 0.f, 0.f, 0.f};
        cur = nxt; cA = nA; cB = nB; ++ui;
        if constexpr (GATHER) {
#pragma unroll
            for (int h = 0; h < 2; ++h) { vA[h][0] = vN[h][0]; vA[h][1] = vN[h][1]; } }
        if constexpr (ALIGN_EPI) { if (wr == 1) PG8_BAR; }
    }
    PG8_WAIT_V(0);
    if constexpr (!ALIGN_EPI) { if (wr == 0) PG8_BAR; }
    PG8_BAR;
#undef PG8_STAGE_A
#undef PG8_SA
#undef PG8_SB
#undef PG8_STAGE
#undef PG8_LDA
#undef PG8_LDB
#undef PG8_MMA
#undef PG8_WAIT_V
#undef PG8_WAIT_L
#undef PG8_BAR
#undef PG8_SCHED
}

typedef const f32x4 (&AccRef)[2][2][4][2];

__device__ __forceinline__ void rope8(f32x4& v0, f32x4& v1, int fq, int tpos, const float* tab) {
    const int pos = (fq < 2) ? (tpos >> 6) : (tpos & 63);
    const f32x4 c0 = *(const f32x4*)(tab + pos * 8), c1 = *(const f32x4*)(tab + pos * 8 + 4), s0 = *(const f32x4*)(tab + 512 + pos * 8), s1 = *(const f32x4*)(tab + 512 + pos * 8 + 4);
    f32x4 p0, p1;
#pragma unroll
    for (int j = 0; j < 4; ++j) { p0[j] = __shfl_xor(v0[j], 16); p1[j] = __shfl_xor(v1[j], 16); }
    const float sg = (fq & 1) ? 1.f : -1.f;
    v0 = v0 * c0 + sg * (p0 * s0); v1 = v1 * c1 + sg * (p1 * s1);
}

struct EpiP {
    static constexpr bool PERM = true;
    bf16_t* P; float* stats; const float* rope;
    __device__ __forceinline__ void operator()(AccRef acc, const Unit& u, int wr, int wc, int fr, int fq) const {
        const int row0 = u.pm * BM + wr * 64 + fr, col0 = u.pn * BM + wc * 32 + 8 * fq;
        const bool do_stats = u.pn < 3, do_rope = (u.pn == 11) && (wc == 0) && (u.pm < ML / 256);
#pragma unroll
        for (int ai = 0; ai < 2; ++ai)
#pragma unroll
            for (int m = 0; m < 4; ++m) { const int row = row0 + ai * HALF + m * 16; bf16_t* rowp = P + (size_t)row * NP + col0;
#pragma unroll
                for (int bj = 0; bj < 2; ++bj) { f32x4 v0 = acc[ai][bj][m][0], v1 = acc[ai][bj][m][1];
                    if (do_stats) { float ss = (v0[0] * v0[0] + v0[1] * v0[1]) + (v0[2] * v0[2] + v0[3] * v0[3]) + (v1[0] * v1[0] + v1[1] * v1[1]) + (v1[2] * v1[2] + v1[3] * v1[3]);
                        ss += __shfl_xor(ss, 16); ss += __shfl_xor(ss, 32);
                        if (fq == 0) stats[(size_t)row * 24 + u.pn * 8 + bj * 4 + wc] = ss; }
                    if (bj == 1 && do_rope) rope8(v0, v1, fq, row & (T - 1), rope);
                    u32x4 w; w.x = cvt_pk_bf16(v0[0], v0[1]); w.y = cvt_pk_bf16(v0[2], v0[3]); w.z = cvt_pk_bf16(v1[0], v1[1]); w.w = cvt_pk_bf16(v1[2], v1[3]);
                    *(u32x4*)(rowp + bj * HALF) = w; } }
    }
};
template <bool ROPE> struct EpiRS {
    static constexpr bool PERM = true;
    bf16_t* O; int ldc, ncols, rope_c0; const float* stats; int part0, nparts; float invk; const float* rope;
    __device__ __forceinline__ void operator()(AccRef acc, const Unit& u, int wr, int wc, int fr, int fq) const {
        const int row0 = u.pm * BM + wr * 64 + fr, col0 = u.pn * BM + wc * 32 + 8 * fq;
        const int npl = nparts >> 2;
#pragma unroll
        for (int ai = 0; ai < 2; ++ai)
#pragma unroll
            for (int m = 0; m < 4; ++m) { const int row = row0 + ai * HALF + m * 16; bf16_t* rowp = O + (size_t)row * ldc + col0;
                const float* sp = stats + (size_t)row * 24 + part0 + fq * npl; float ss = sp[0] + sp[1]; if (npl == 4) ss += sp[2] + sp[3];
                ss += __shfl_xor(ss, 16); ss += __shfl_xor(ss, 32);
                const float rs = 1.0f / sqrtf(ss * invk + EPS);
#pragma unroll
                for (int bj = 0; bj < 2; ++bj) { const int c = col0 + bj * HALF; f32x4 v0 = acc[ai][bj][m][0] * rs, v1 = acc[ai][bj][m][1] * rs;
                    if (ROPE) { const int cb = u.pn * BM + bj * HALF + wc * 32;
                        if (cb >= rope_c0 && cb < ncols && u.pm < ML / 256) rope8(v0, v1, fq, row & (T - 1), rope); }
                    if (c < ncols) { u32x4 w; w.x = cvt_pk_bf16(v0[0], v0[1]); w.y = cvt_pk_bf16(v0[2], v0[3]); w.z = cvt_pk_bf16(v1[0], v1[1]); w.w = cvt_pk_bf16(v1[2], v1[3]);
                        *(u32x4*)(rowp + bj * HALF) = w; } } }
    }
};
struct EpiDelta {
    static constexpr bool PERM = true;
    bf16_t* O; const float* gate; int gstride;
    bf16_t* Op; size_t pstride; int prow0;
    __device__ __forceinline__ void operator()(AccRef acc, const Unit& u, int wr, int wc, int fr, int fq) const {
        const int row0 = u.pm * BM + wr * 64 + fr - (u.part >= 0 ? prow0 : 0), col0 = u.pn * BM + wc * 32 + 8 * fq;
        bf16_t* const Ob = u.part >= 0 ? Op + (size_t)u.part * pstride : O;
        f32x4 gv[2][2];
#pragma unroll
        for (int bj = 0; bj < 2; ++bj)
#pragma unroll
            for (int n = 0; n < 2; ++n) gv[bj][n] = gate ? *(const f32x4*)(gate + (size_t)(u.pm < ML / 256 ? (u.pm >> 4) : 8) * gstride + col0 + bj * HALF + 4 * n) : (f32x4){1.f, 1.f, 1.f, 1.f};
#pragma unroll
        for (int ai = 0; ai < 2; ++ai)
#pragma unroll
            for (int m = 0; m < 4; ++m) { bf16_t* rowp = Ob + (size_t)(row0 + ai * HALF + m * 16) * D + col0;
#pragma unroll
                for (int bj = 0; bj < 2; ++bj) { const f32x4 v0 = acc[ai][bj][m][0] * gv[bj][0], v1 = acc[ai][bj][m][1] * gv[bj][1];
                    u32x4 w; w.x = cvt_pk_bf16(v0[0], v0[1]); w.y = cvt_pk_bf16(v0[2], v0[3]); w.z = cvt_pk_bf16(v1[0], v1[1]); w.w = cvt_pk_bf16(v1[2], v1[3]);
                    *(u32x4*)(rowp + bj * HALF) = w; } }
    }
};
struct EpiRes2 {
    static constexpr bool PERM = false;
    const float* xin; float* xout; const float* gate; int gstride; bf16_t* Op; size_t pstride; int prow0;
    __device__ __forceinline__ void operator()(AccRef acc, const Unit& u, int wr, int wc, int fr, int fq) const {
        const int row0 = u.pm * BM + wr * 64 + fr, col0 = u.pn * BM + wc * 32 + 4 * fq;
        const float* gp = gate + (size_t)(u.pm < ML / 256 ? (u.pm >> 4) : 8) * gstride + col0;
        f32x4 gv[2][2];
#pragma unroll
        for (int bj = 0; bj < 2; ++bj)
#pragma unroll
            for (int n = 0; n < 2; ++n) gv[bj][n] = *(const f32x4*)(gp + bj * HALF + n * 16);
        if (u.part < 0) {
#pragma unroll
            for (int ai = 0; ai < 2; ++ai)
#pragma unroll
                for (int m = 0; m < 4; ++m) { const size_t off = (size_t)(row0 + ai * HALF + m * 16) * D + col0;
#pragma unroll
                    for (int bj = 0; bj < 2; ++bj)
#pragma unroll
                        for (int n = 0; n < 2; ++n) { const f32x4 xv = *(const f32x4*)(xin + off + bj * HALF + n * 16); *(f32x4*)(xout + off + bj * HALF + n * 16) = xv + gv[bj][n] * acc[ai][bj][m][n]; } }
        } else { bf16_t* ob = Op + (size_t)u.part * pstride;
#pragma unroll
            for (int ai = 0; ai < 2; ++ai)
#pragma unroll
                for (int m = 0; m < 4; ++m) { const size_t off = (size_t)(row0 - prow0 + ai * HALF + m * 16) * D + col0;
#pragma unroll
                    for (int bj = 0; bj < 2; ++bj)
#pragma unroll
                        for (int n = 0; n < 2; ++n) { const f32x4 y = gv[bj][n] * acc[ai][bj][m][n]; u32x2 w; w.x = cvt_pk_bf16(y[0], y[1]); w.y = cvt_pk_bf16(y[2], y[3]); *(u32x2*)(ob + off + bj * HALF + n * 16) = w; } }
        }
    }
};
struct EpiSwiglu {
    static constexpr bool PERM = true;
    bf16_t* U; int ldc;
    __device__ __forceinline__ void operator()(AccRef acc, const Unit& u, int wr, int wc, int fr, int fq) const {
        const int row0 = u.pm * BM + wr * 64 + fr, col0 = u.pn * 128 + wc * 32 + 8 * fq;
#pragma unroll
        for (int ai = 0; ai < 2; ++ai)
#pragma unroll
            for (int m = 0; m < 4; ++m) { bf16_t* rowp = U + (size_t)(row0 + ai * HALF + m * 16) * ldc + col0; float o[8];
#pragma unroll
                for (int n = 0; n < 2; ++n)
#pragma unroll
                    for (int j = 0; j < 4; ++j) { const float a = acc[ai][0][m][n][j], b = acc[ai][1][m][n][j]; o[n * 4 + j] = silu_f(a) * b; }
                u32x4 w; w.x = cvt_pk_bf16(o[0], o[1]); w.y = cvt_pk_bf16(o[2], o[3]); w.z = cvt_pk_bf16(o[4], o[5]); w.w = cvt_pk_bf16(o[6], o[7]);
                *(u32x4*)rowp = w; }
    }
};
}

namespace att {
constexpr int VSLOT = 8192, NSLOT = 3;
constexpr int OFF_K = 0;
constexpr int OFF_V = NSLOT * 12 * 1024;
constexpr int OFF_WS = OFF_V + NSLOT * VSLOT;
constexpr int OFF_OST = OFF_WS + 8 * 512;
constexpr int OFF_BIAS = OFF_OST + 8 * 4096;
constexpr int LDS_END = OFF_BIAS + 640 * 4;
__device__ __forceinline__ int crow(int r, int hi) { return (r & 3) + 8 * (r >> 2) + 4 * hi; }
__device__ __forceinline__ void glds16(const void* gsrc, unsigned lds_dst) { unsigned keep;
    asm volatile("s_mov_b32 %0, m0\n\ts_mov_b32 m0, %2\n\ts_nop 0\n\tglobal_load_lds_dwordx4 %1, off\n\ts_mov_b32 m0, %0" : "=&s"(keep) : "v"(gsrc), "s"(lds_dst) : "memory"); }
__device__ __forceinline__ void glds16s(const void* sbase, unsigned voff, unsigned lds_dst) { unsigned keep;
    asm volatile("s_mov_b32 %0, m0\n\ts_mov_b32 m0, %3\n\ts_nop 0\n\tglobal_load_lds_dwordx4 %1, %2\n\ts_mov_b32 m0, %0" : "=&s"(keep) : "v"(voff), "s"(sbase), "s"(lds_dst) : "memory"); }
__device__ __forceinline__ s16x4 vtr(LAS const char* p) { typedef short v4i16_t __attribute__((ext_vector_type(4)));
    return __builtin_bit_cast(s16x4, __builtin_amdgcn_ds_read_tr16_b64_v4i16((LAS v4i16_t*)p)); }

struct Unit {
    const bf16_t* qn; int ldq;
    const bf16_t* qr; int ldqr;
    const bf16_t* kn; int ldk;
    const bf16_t* kr; int ldkr;
    const bf16_t* v; int ldv;
    bf16_t* o; int ldo;
    int na, rowa, rowc;
    int rg, rlo;
};

template <int NCH, bool NA, bool FAST = false>
__device__ __forceinline__ bool attn_unit(LAS char* lds, const Unit& U, const int wid0) {
    const int lane = fresh_lane(), r32 = lane & 31, hi = lane >> 5, wid = wid0, tid = wid * 64 + lane; (void)tid;
    constexpr int KSLOT = NCH * 1024;
    const unsigned lds0 = (unsigned)(uintptr_t)lds;
    LAS float* wsf = (LAS float*)(lds + OFF_WS) + wid * 128;
    const int NT = U.na + 4;
    bf16x8 qf[NCH / 2];
    { const bf16_t* qp = U.qn + (size_t)(wid * 32 + r32) * U.ldq + hi * 8;
#pragma unroll
      for (int d0 = 0; d0 < 4; ++d0) qf[d0] = *(const bf16x8*)(qp + d0 * 16);
      if constexpr (NCH == 12) { const bf16_t* qp2 = U.qr + (size_t)(wid * 32 + r32) * U.ldqr + hi * 8;
#pragma unroll
          for (int d0 = 0; d0 < 2; ++d0) qf[4 + d0] = *(const bf16x8*)(qp2 + d0 * 16); } }
#pragma unroll
    for (int d0 = 0; d0 < NCH / 2; ++d0) asm volatile("" : "+v"(qf[d0]));
    VM_WAIT();
    auto tile_row = [&](int it) -> int { return it < U.na ? U.rowa + 64 * it : U.rowc + 64 * (it - U.na); };
    auto dma = [&](int it, int slot) {
        const int row = tile_row(it);
        glds16(U.v + (size_t)(row + 16 * (wid & 3) + (lane >> 2)) * U.ldv + (wid >> 2) * 32 + (lane & 3) * 8, (unsigned)__builtin_amdgcn_readfirstlane(lds0 + OFF_V + slot * VSLOT + wid * 1024));
        glds16(U.kn + (size_t)(row + lane) * U.ldk + wid * 8, (unsigned)__builtin_amdgcn_readfirstlane(lds0 + OFF_K + slot * KSLOT + wid * 1024));
        if constexpr (NCH == 12) glds16(U.kr + (size_t)(row + lane) * U.ldkr + (wid & 3) * 8, (unsigned)__builtin_amdgcn_readfirstlane(lds0 + OFF_K + slot * KSLOT + (8 + (wid & 3)) * 1024));
    };
    constexpr int NPER = (NCH == 12) ? 3 : 2;
    dma(0, 0); dma(1, 1);
    float mrun = -INFINITY, lrun = 0.f; f32x16 o[2]; o[0] = f32x16{}; o[1] = f32x16{};
    f32x16 lacc = f32x16{}; const bf16x8 ones = (bf16x8){0x3f80, 0x3f80, 0x3f80, 0x3f80, 0x3f80, 0x3f80, 0x3f80, 0x3f80};
    const int grow = NA ? 4 * U.rg + (wid >> 1) : 0, qc = 32 * (wid & 1) + r32;
    const int r0w = NA ? min(max(grow - 4, 0), 56) : 0, c0w = min(max(qc - 8, 0), 48);
    LAS const float* btab = (LAS const float*)(lds + OFF_BIAS);
    const int vaddr = ((lane >> 4) & 1) * 32 + (lane & 3) * 8 + (4 * hi + ((lane & 15) >> 2)) * 64;
    int slot = 0;
    for (int it = 0; it < NT; ++it) {
        if (it + 1 < NT) { if constexpr (NPER == 3) asm volatile("s_waitcnt vmcnt(3)" ::: "memory"); else asm volatile("s_waitcnt vmcnt(2)" ::: "memory"); }
        else asm volatile("s_waitcnt vmcnt(0)" ::: "memory");
        asm volatile("s_barrier" ::: "memory");
        if (it + 2 < NT) { const int s2 = slot >= 1 ? slot - 1 : 2; dma(it + 2, s2); }
        bool active = true; int dr = 0;
        if constexpr (NA) { if (it < U.na) { const int krow = U.rlo + it; active = (krow >= r0w) && (krow < r0w + 8); dr = krow - grow + 7; } }
        if (active) {
            LAS const char* ks = lds + OFF_K + slot * KSLOT + r32 * 16; LAS const char* vs = lds + OFF_V + slot * VSLOT + vaddr;
            f32x16 p0 = f32x16{}, p1 = f32x16{};
            { bf16x8 kf0[NCH / 2], kf1[NCH / 2];
#pragma unroll
              for (int d0 = 0; d0 < NCH / 2; ++d0) { kf0[d0] = *(const LAS bf16x8*)(ks + (2 * d0 + hi) * 1024); kf1[d0] = *(const LAS bf16x8*)(ks + (2 * d0 + hi) * 1024 + 512); }
              __builtin_amdgcn_sched_barrier(0);
#pragma unroll
              for (int d0 = 0; d0 < NCH / 2; ++d0) { p0 = __builtin_amdgcn_mfma_f32_32x32x16_bf16(kf0[d0], qf[d0], p0, 0, 0, 0); p1 = __builtin_amdgcn_mfma_f32_32x32x16_bf16(kf1[d0], qf[d0], p1, 0, 0, 0); } }
            if constexpr (NA) { if (it < U.na) {
                LAS const float* bt = btab + 64 + dr * 31 + 15 - qc;
#pragma unroll
                for (int r = 0; r < 16; ++r) { const int kc = crow(r, hi);
                    p0[r] = ((unsigned)(kc - c0w) < 16u) ? p0[r] + bt[kc] : -INFINITY;
                    p1[r] = ((unsigned)(kc + 32 - c0w) < 16u) ? p1[r] + bt[kc + 32] : -INFINITY; } } }
            if constexpr (FAST) {
#pragma unroll
                for (int r = 0; r < 16; ++r) { p0[r] = fexp2(p0[r]); p1[r] = fexp2(p1[r]); }
            } else {
            float mx = fmaxf(p0[0], p1[0]);
#pragma unroll
            for (int r = 1; r < 16; ++r) mx = fmaxf(mx, fmaxf(p0[r], p1[r]));
            mx = half_max(mx);
            const float mnew = fmaxf(mrun, mx);
            if (__any(mnew > mrun)) {
                const float alpha = fexp2(mrun - mnew);
                lrun *= alpha; if (hi == 0) wsf[r32] = alpha; LDS_WAIT();
#pragma unroll
                for (int r = 0; r < 16; ++r) { const float a = wsf[crow(r, hi)]; o[0][r] *= a; o[1][r] *= a; }
                mrun = mnew;
            }
            float ls = 0.f;
#pragma unroll
            for (int r = 0; r < 16; ++r) { p0[r] = fexp2(p0[r] - mrun); p1[r] = fexp2(p1[r] - mrun); ls += p0[r] + p1[r]; }
            lrun += ls;
            }
            u32x4 pw[4];
#pragma unroll
            for (int j = 0; j < 4; ++j) { pw[0][j] = pk2(p0[2 * j], p0[2 * j + 1]); pw[1][j] = pk2(p0[8 + 2 * j], p0[9 + 2 * j]); pw[2][j] = pk2(p1[2 * j], p1[2 * j + 1]); pw[3][j] = pk2(p1[8 + 2 * j], p1[9 + 2 * j]); }
#pragma unroll
            for (int k = 0; k < 4; ++k)
#pragma unroll
                for (int db = 0; db < 2; ++db) { const s16x4 lo = vtr(vs + db * 4096 + k * 1024), h4 = vtr(vs + db * 4096 + k * 1024 + 512);
                    const bf16x8 vf = (bf16x8){lo[0], lo[1], lo[2], lo[3], h4[0], h4[1], h4[2], h4[3]};
                    o[db] = __builtin_amdgcn_mfma_f32_32x32x16_bf16(__builtin_bit_cast(bf16x8, pw[k]), vf, o[db], 0, 0, 0);
                    if (FAST && db == 1) lacc = __builtin_amdgcn_mfma_f32_32x32x16_bf16(__builtin_bit_cast(bf16x8, pw[k]), ones, lacc, 0, 0, 0); }
        }
        slot = slot == 2 ? 0 : slot + 1;
    }
    LAS bf16_t* stg = (LAS bf16_t*)(lds + OFF_OST) + wid * 2048;
    if constexpr (FAST) {
        bool bad = false;
#pragma unroll
        for (int r = 0; r < 16; ++r) bad |= !(lacc[r] > 1e-30f && lacc[r] < 1e30f);
        LAS int* gf = (LAS int*)(lds + OFF_OST);
        asm volatile("s_waitcnt lgkmcnt(0)\n\ts_barrier" ::: "memory");
        const int ab = __any(bad) ? 1 : 0; if (lane == 0) gf[wid] = ab;
        asm volatile("s_waitcnt lgkmcnt(0)\n\ts_barrier" ::: "memory");
        int anyb = 0;
#pragma unroll
        for (int w = 0; w < 8; ++w) anyb |= gf[w];
        asm volatile("s_waitcnt lgkmcnt(0)\n\ts_barrier" ::: "memory");
        if (__builtin_amdgcn_readfirstlane(anyb)) return false;
#pragma unroll
        for (int r = 0; r < 16; ++r) { const int orow = crow(r, hi); const float il = frcp(lacc[r]);
#pragma unroll
            for (int db = 0; db < 2; ++db) stg[orow * 64 + db * 32 + r32] = (bf16_t)(pk2(o[db][r] * il, 0.f) & 0xffffu); }
    } else {
        lrun = half_sum(lrun);
        if (hi == 0) wsf[32 + r32] = frcp(lrun); LDS_WAIT();
#pragma unroll
        for (int r = 0; r < 16; ++r) { const int orow = crow(r, hi); const float il = wsf[32 + orow];
#pragma unroll
            for (int db = 0; db < 2; ++db) stg[orow * 64 + db * 32 + r32] = (bf16_t)(pk2(o[db][r] * il, 0.f) & 0xffffu); }
    }
    LDS_WAIT();
    bf16_t* Ow = U.o + (size_t)(wid * 32) * U.ldo;
#pragma unroll
    for (int i = 0; i < 4; ++i) { const int row = i * 8 + (lane >> 3), ch = lane & 7; const u32x4 v = *(const LAS u32x4*)(stg + row * 64 + ch * 8); *(u32x4*)(Ow + (size_t)row * U.ldo + ch * 8) = v; }
    asm volatile("s_waitcnt lgkmcnt(0)\n\ts_barrier" ::: "memory");
    return true;
}

__device__ __forceinline__ float rowmax32(const f32x16& p0, const f32x16& p1) {
    float a = __builtin_fmaxf(__builtin_fmaxf(p0[0], p0[1]), p1[0]), b = __builtin_fmaxf(__builtin_fmaxf(p0[2], p0[3]), p1[1]); a = __builtin_fmaxf(__builtin_fmaxf(a, p1[2]), p1[3]);
#pragma unroll
    for (int r = 4; r < 16; r += 4) { a = __builtin_fmaxf(__builtin_fmaxf(a, p0[r]), p0[r + 1]); b = __builtin_fmaxf(__builtin_fmaxf(b, p0[r + 2]), p0[r + 3]); a = __builtin_fmaxf(__builtin_fmaxf(a, p1[r]), p1[r + 1]); b = __builtin_fmaxf(__builtin_fmaxf(b, p1[r + 2]), p1[r + 3]); }
    const float m = __builtin_fmaxf(a, b); return half_max(m);
}
__device__ __forceinline__ void softmax_step(f32x16& p0, f32x16& p1, float& mref, float& lrun, f32x16 (&o)[2], LAS float* wsf, int r32, int hi, bool first, float thr) {
    const float mx = rowmax32(p0, p1);
    if (first || __any(mx > mref + thr)) {
        const float mnew = first ? mx : __builtin_fmaxf(mx, mref);
        if (!first) { const float alpha = fexp2(mref - mnew); lrun *= alpha; if (hi == 0) wsf[r32] = alpha; LDS_WAIT();
#pragma unroll
            for (int r = 0; r < 16; ++r) { const float a = wsf[crow(r, hi)]; o[0][r] *= a; o[1][r] *= a; } }
        mref = mnew;
    }
    float ls = 0.f;
#pragma unroll
    for (int r = 0; r < 16; ++r) { p0[r] = fexp2(p0[r] - mref); p1[r] = fexp2(p1[r] - mref); ls += p0[r] + p1[r]; }
    lrun += ls;
}
__device__ __forceinline__ bool attn_unit64(LAS char* lds, const Unit& U, const int wid0) {
    constexpr int NCH = 12, KSLOT = NCH * 1024;
    const int lane = fresh_lane(), r32 = lane & 31, hi = lane >> 5, wid = wid0;
    const unsigned lds0 = (unsigned)(uintptr_t)lds;
    LAS float* wsf = (LAS float*)(lds + OFF_WS) + wid * 128;
    const int NT = U.na + 4;
    bf16x8 qf[2][6];
#pragma unroll
    for (int qb = 0; qb < 2; ++qb) { const bf16_t* qp = U.qn + (size_t)(wid * 64 + qb * 32 + r32) * U.ldq + hi * 8; const bf16_t* qp2 = U.qr + (size_t)(wid * 64 + qb * 32 + r32) * U.ldqr + hi * 8;
#pragma unroll
        for (int d0 = 0; d0 < 4; ++d0) qf[qb][d0] = *(const bf16x8*)(qp + d0 * 16);
#pragma unroll
        for (int d0 = 0; d0 < 2; ++d0) qf[qb][4 + d0] = *(const bf16x8*)(qp2 + d0 * 16); }
#pragma unroll
    for (int qb = 0; qb < 2; ++qb)
#pragma unroll
        for (int d0 = 0; d0 < 6; ++d0) asm volatile("" : "+v"(qf[qb][d0]));
    VM_WAIT();
    auto tile_row = [&](int it) -> int { return it < U.na ? U.rowa + 64 * it : U.rowc + 64 * (it - U.na); };
    const unsigned offKn = (unsigned)(lane * U.ldk + wid * 8) * 2u, offKr = (unsigned)(lane * U.ldkr + (wid & 3) * 8) * 2u;
    const unsigned offV = (unsigned)((16 * (wid & 3) + (lane >> 2)) * U.ldv + (wid >> 2) * 32 + (lane & 3) * 8) * 2u;
    auto dma = [&](int it, int slot) {
        const int row = tile_row(it);
        glds16s((const char*)U.v + (size_t)row * U.ldv * 2, offV, (unsigned)__builtin_amdgcn_readfirstlane(lds0 + OFF_V + slot * VSLOT + wid * 1024));
        glds16s((const char*)U.kn + (size_t)row * U.ldk * 2, offKn, (unsigned)__builtin_amdgcn_readfirstlane(lds0 + OFF_K + slot * KSLOT + wid * 1024));
        glds16s((const char*)U.kr + (size_t)row * U.ldkr * 2, offKr, (unsigned)__builtin_amdgcn_readfirstlane(lds0 + OFF_K + slot * KSLOT + (8 + (wid & 3)) * 1024));
    };
    dma(0, 0); dma(1, 1);
    f32x16 lAcc = f32x16{}, lBcc = f32x16{};
    const bf16x8 ones = (bf16x8){0x3f80, 0x3f80, 0x3f80, 0x3f80, 0x3f80, 0x3f80, 0x3f80, 0x3f80}; f32x16 oA[2], oB[2]; oA[0] = f32x16{}; oA[1] = f32x16{}; oB[0] = f32x16{}; oB[1] = f32x16{};
    const int vaddr = ((lane >> 4) & 1) * 32 + (lane & 3) * 8 + (4 * hi + ((lane & 15) >> 2)) * 64;
    int slot = 0;
    for (int it = 0; it < NT; ++it) {
        if (it + 1 < NT) asm volatile("s_waitcnt vmcnt(3)" ::: "memory"); else asm volatile("s_waitcnt vmcnt(0)" ::: "memory");
        asm volatile("s_barrier" ::: "memory");
        if (it + 2 < NT) { const int s2 = slot >= 1 ? slot - 1 : 2; dma(it + 2, s2); }
        LAS const char* ks = lds + OFF_K + slot * KSLOT + r32 * 16; LAS const char* vs = lds + OFF_V + slot * VSLOT + vaddr;
        f32x16 pA0 = f32x16{}, pA1 = f32x16{}, pB0 = f32x16{}, pB1 = f32x16{};
        { bf16x8 a0 = *(const LAS bf16x8*)(ks + hi * 1024), a1 = *(const LAS bf16x8*)(ks + hi * 1024 + 512);
#pragma unroll
          for (int d0 = 0; d0 < 6; ++d0) {
            bf16x8 n0 = a0, n1 = a1;
            if (d0 < 5) { n0 = *(const LAS bf16x8*)(ks + (2 * d0 + 2 + hi) * 1024); n1 = *(const LAS bf16x8*)(ks + (2 * d0 + 2 + hi) * 1024 + 512); }
            __builtin_amdgcn_sched_barrier(0);
            pA0 = __builtin_amdgcn_mfma_f32_32x32x16_bf16(a0, qf[0][d0], pA0, 0, 0, 0); pA1 = __builtin_amdgcn_mfma_f32_32x32x16_bf16(a1, qf[0][d0], pA1, 0, 0, 0);
            pB0 = __builtin_amdgcn_mfma_f32_32x32x16_bf16(a0, qf[1][d0], pB0, 0, 0, 0); pB1 = __builtin_amdgcn_mfma_f32_32x32x16_bf16(a1, qf[1][d0], pB1, 0, 0, 0);
            __builtin_amdgcn_sched_barrier(0);
            a0 = n0; a1 = n1; } }
        __builtin_amdgcn_sched_barrier(0);
        { _Pragma("unroll") for (int r = 0; r < 16; ++r) { pA0[r] = fexp2(pA0[r]); pA1[r] = fexp2(pA1[r]); } }
        u32x4 pwA[4];
#pragma unroll
        for (int j = 0; j < 4; ++j) { pwA[0][j] = pk2(pA0[2 * j], pA0[2 * j + 1]); pwA[1][j] = pk2(pA0[8 + 2 * j], pA0[9 + 2 * j]); pwA[2][j] = pk2(pA1[2 * j], pA1[2 * j + 1]); pwA[3][j] = pk2(pA1[8 + 2 * j], pA1[9 + 2 * j]); }
        __builtin_amdgcn_sched_barrier(0);
        { _Pragma("unroll") for (int r = 0; r < 16; ++r) { pB0[r] = fexp2(pB0[r]); pB1[r] = fexp2(pB1[r]); } }
        u32x4 pwB[4];
#pragma unroll
        for (int j = 0; j < 4; ++j) { pwB[0][j] = pk2(pB0[2 * j], pB0[2 * j + 1]); pwB[1][j] = pk2(pB0[8 + 2 * j], pB0[9 + 2 * j]); pwB[2][j] = pk2(pB1[2 * j], pB1[2 * j + 1]); pwB[3][j] = pk2(pB1[8 + 2 * j], pB1[9 + 2 * j]); }
        __builtin_amdgcn_sched_barrier(0);
#pragma unroll
        for (int k = 0; k < 4; ++k)
#pragma unroll
            for (int db = 0; db < 2; ++db) { const s16x4 lo = vtr(vs + db * 4096 + k * 1024), h4 = vtr(vs + db * 4096 + k * 1024 + 512);
                const bf16x8 vf = (bf16x8){lo[0], lo[1], lo[2], lo[3], h4[0], h4[1], h4[2], h4[3]};
                oA[db] = __builtin_amdgcn_mfma_f32_32x32x16_bf16(__builtin_bit_cast(bf16x8, pwA[k]), vf, oA[db], 0, 0, 0);
                oB[db] = __builtin_amdgcn_mfma_f32_32x32x16_bf16(__builtin_bit_cast(bf16x8, pwB[k]), vf, oB[db], 0, 0, 0);
                if (db == 1) { lAcc = __builtin_amdgcn_mfma_f32_32x32x16_bf16(__builtin_bit_cast(bf16x8, pwA[k]), ones, lAcc, 0, 0, 0); lBcc = __builtin_amdgcn_mfma_f32_32x32x16_bf16(__builtin_bit_cast(bf16x8, pwB[k]), ones, lBcc, 0, 0, 0); } }
        slot = slot == 2 ? 0 : slot + 1;
    }
    {
        bool bad = false;
#pragma unroll
        for (int r = 0; r < 16; ++r) bad |= !(lAcc[r] > 1e-30f && lAcc[r] < 1e30f && lBcc[r] > 1e-30f && lBcc[r] < 1e30f);
        LAS int* gf = (LAS int*)(lds + OFF_OST);
        asm volatile("s_waitcnt lgkmcnt(0)\n\ts_barrier" ::: "memory");
        const int ab = __any(bad) ? 1 : 0; if (lane == 0) gf[wid] = ab;
        asm volatile("s_waitcnt lgkmcnt(0)\n\ts_barrier" ::: "memory");
        int anyb = 0;
#pragma unroll
        for (int w = 0; w < 8; ++w) anyb |= gf[w];
        asm volatile("s_waitcnt lgkmcnt(0)\n\ts_barrier" ::: "memory");
        if (__builtin_amdgcn_readfirstlane(anyb)) return false;
    }
    LAS bf16_t* stg = (LAS bf16_t*)(lds + OFF_OST) + wid * 2048;
#pragma unroll
    for (int qb = 0; qb < 2; ++qb) {
        LDS_WAIT();
#pragma unroll
        for (int r = 0; r < 16; ++r) { const int orow = crow(r, hi); const float il = frcp(qb == 0 ? lAcc[r] : lBcc[r]);
#pragma unroll
            for (int db = 0; db < 2; ++db) stg[orow * 64 + db * 32 + r32] = (bf16_t)(pk2((qb == 0 ? oA[db][r] : oB[db][r]) * il, 0.f) & 0xffffu); }
        LDS_WAIT();
        bf16_t* Ow = U.o + (size_t)(wid * 64 + qb * 32) * U.ldo;
#pragma unroll
        for (int i = 0; i < 4; ++i) { const int row = i * 8 + (lane >> 3), ch = lane & 7; const u32x4 v = *(const LAS u32x4*)(stg + row * 64 + ch * 8); *(u32x4*)(Ow + (size_t)row * U.ldo + ch * 8) = v; }
    }
    asm volatile("s_waitcnt lgkmcnt(0)\n\ts_barrier" ::: "memory");
    return true;
}
}

namespace ml {
constexpr int WAVE_LDS = 19328;
constexpr int OFF_VT = 0, OFF_KT = 8192, OFF_TB = 16384;
constexpr int TB_CS = 0, TB_BT = 128, TB_EM = 256, TB_NI = 384, TB_HD = 512, TB_QW = 544;
__device__ __forceinline__ int crow(int r, int hi) { return (r & 3) + 8 * (r >> 2) + 4 * hi; }
__device__ __forceinline__ int chunk_row(int b, int j) { return j < 4 ? ML + b * NC + j * 64 : b * T + (j - 4) * 64; }
__device__ __forceinline__ float prefix_sum(float v, int lane) {
#pragma unroll
    for (int o = 1; o < 64; o <<= 1) { const float t = __shfl_up(v, o); if (lane >= o) v += t; }
    return v;
}
__device__ __forceinline__ float prefix_max(float v, int lane) {
#pragma unroll
    for (int o = 1; o < 64; o <<= 1) { const float t = __shfl_up(v, o); if (lane >= o) v = fmaxf(v, t); }
    return v;
}
__device__ __forceinline__ float suffix_max(float v, int lane) {
#pragma unroll
    for (int o = 1; o < 64; o <<= 1) { const float t = __shfl_down(v, o); if (lane + o < 64) v = fmaxf(v, t); }
    return v;
}
struct Gates { float li[2], bcum[2], g[2]; };
__device__ __forceinline__ void load_gates(const bf16_t* P, int row, int h, const float* igb, const float* fgb, Gates& G, int lane) {
    const bf16_t* gp = P + (size_t)row * NP + PC_GT;
#pragma unroll
    for (int d = 0; d < 2; ++d) {
        const float gi = bf2f(gp[d * 4 + h]) + igb[d * 4 + h], gf = bf2f(gp[8 + d * 4 + h]) + fgb[d * 4 + h];
        const float lf = fminf(gf, 0.f) - log1pf(expf(-fabsf(gf)));
        const float ps = prefix_sum(lf, lane), tot = __shfl(ps, 63);
        G.li[d] = gi; G.g[d] = tot; G.bcum[d] = d == 0 ? ps : tot - ps + lf;
    }
}
__device__ __forceinline__ bf16x8 trfrag(LAS const char* tile, int blk, int ks, int lane) {
    const int hi = lane >> 5, q = (lane & 15) >> 2; LAS const char* p = tile + blk * 4096 + (16 * ks + 8 * hi + q) * 64 + ((lane >> 4) & 1) * 32 + (lane & 3) * 8;
    const s16x4 lo = att::vtr(p), h4 = att::vtr(p + 256);
    return (bf16x8){lo[0], lo[1], lo[2], lo[3], h4[0], h4[1], h4[2], h4[3]};
}
__device__ __forceinline__ void load_vtile(LAS char* vt, const bf16_t* P, int rowbase, int col, int lane) {
#pragma unroll
    for (int i = 0; i < 8; ++i) { const int t = i * 8 + (lane >> 3), c = lane & 7;
        const u32x4 w = *(const u32x4*)(P + (size_t)(rowbase + t) * NP + col + 8 * c); *(LAS u32x4*)(vt + (c >> 2) * 4096 + t * 64 + (c & 3) * 16) = w; }
}
__device__ __forceinline__ void conv8(const bf16_t* P, int row, int col, int pos, int len, const float* w0, const float* w1, const float* w2, float* y) {
    const bf16_t* p = P + (size_t)row * NP + col; float x0[8], x1[8], x2[8];
    unpack8(*(const u32x4*)p, x1);
    if (pos > 0) unpack8(*(const u32x4*)(p - NP), x0); else { for (int e = 0; e < 8; ++e) x0[e] = 0.f; }
    if (pos < len - 1) unpack8(*(const u32x4*)(p + NP), x2); else { for (int e = 0; e < 8; ++e) x2[e] = 0.f; }
#pragma unroll
    for (int e = 0; e < 8; ++e) y[e] = silu_f(x0[e] * w0[e] + x1[e] * w1[e] + x2[e] * w2[e]);
}

__device__ __forceinline__ void chunk_state_unit(LAS char* wl, int b, int h, int j, const bf16_t* P, const float* convw, const float* igb, const float* fgb,
                                                 float* CLOC, float* NLOC, float* MG, int lane) {
    const int r32 = lane & 31, hi = lane >> 5;
    const int rowbase = chunk_row(b, j), len = j < 4 ? NC : T, pos0 = j < 4 ? j * 64 : (j - 4) * 64;
    LAS float* tb = (LAS float*)(wl + OFF_TB);
    Gates G; load_gates(P, rowbase + lane, h, igb, fgb, G, lane);
    float mloc[2];
#pragma unroll
    for (int d = 0; d < 2; ++d) { const float a = G.g[d] - G.bcum[d] + G.li[d]; mloc[d] = wave_max(a); tb[d * 64 + lane] = fexp(a - mloc[d]); }
    { const int c = lane & 7; float w0[8], w1[8], w2[8]; const float* cw = convw + 256 + h * 64 + 8 * c;
#pragma unroll
      for (int e = 0; e < 8; ++e) { w0[e] = cw[e]; w1[e] = cw[512 + e]; w2[e] = cw[1024 + e]; }
#pragma unroll 2
      for (int i = 0; i < 8; ++i) { const int t = i * 8 + (lane >> 3); float y[8]; conv8(P, rowbase + t, PC_MK + h * 64 + 8 * c, pos0 + t, len, w0, w1, w2, y);
#pragma unroll
          for (int e = 0; e < 8; ++e) y[e] *= 0.125f;
          *(LAS u32x4*)(wl + OFF_KT + (c >> 2) * 4096 + t * 64 + (c & 3) * 16) = pack8(y); } }
    u32x4 vraw[8];
#pragma unroll
    for (int i = 0; i < 8; ++i) { const int t = i * 8 + (lane >> 3), c = lane & 7; vraw[i] = *(const u32x4*)(P + (size_t)(rowbase + t) * NP + PC_MV + h * 64 + 8 * c); }
    LDS_WAIT();
#pragma unroll 1
    for (int d = 0; d < 2; ++d) {
        LDS_WAIT();
        { const int c = lane & 7;
#pragma unroll
          for (int i = 0; i < 8; ++i) { const int t = i * 8 + (lane >> 3); const float w = tb[d * 64 + t]; float y[8]; unpack8(vraw[i], y);
#pragma unroll
              for (int e = 0; e < 8; ++e) y[e] *= w;
              *(LAS u32x4*)(wl + OFF_VT + (c >> 2) * 4096 + t * 64 + (c & 3) * 16) = pack8(y); } }
        LDS_WAIT();
        const size_t sidx = ((size_t)((d * NB + b) * 4 + h) * NCHK + j);
        float* cl = CLOC + sidx * 4096;
#pragma unroll
        for (int db = 0; db < 2; ++db) { bf16x8 af[4];
#pragma unroll
            for (int ks = 0; ks < 4; ++ks) af[ks] = trfrag(wl + OFF_VT, db, ks, lane);
#pragma unroll
            for (int dkb = 0; dkb < 2; ++dkb) { f32x16 acc = f32x16{};
#pragma unroll
                for (int ks = 0; ks < 4; ++ks) acc = __builtin_amdgcn_mfma_f32_32x32x16_bf16(af[ks], trfrag(wl + OFF_KT, dkb, ks, lane), acc, 0, 0, 0);
#pragma unroll
                for (int i = 0; i < 16; ++i) cl[(32 * db + crow(i, hi)) * 64 + 32 * dkb + r32] = acc[i]; } }
        { float sacc = 0.f; LAS const bf16_t* kt = (LAS const bf16_t*)(wl + OFF_KT + (lane >> 5) * 4096 + (lane & 31) * 2);
#pragma unroll 8
          for (int t = 0; t < 64; ++t) sacc += bf2f(kt[t * 32]) * tb[d * 64 + t];
          NLOC[sidx * 64 + lane] = sacc; }
        if (lane == 0) { MG[sidx * 2] = d == 0 ? mloc[0] : mloc[1]; MG[sidx * 2 + 1] = d == 0 ? G.g[0] : G.g[1]; }
    }
    LDS_WAIT();
}

__device__ __forceinline__ int step_chunk(int d, int s) { return d == 0 ? s : (s < 4 ? 3 - s : 71 - s); }
__device__ __forceinline__ void scan_item(LAS char* lds, const int wid0, int item, const float* CLOC, const float* NLOC, const float* MG, bf16_t* CIN, float* NIN, float* MIN_) {
    const int tid = wid0 * 64 + fresh_lane(); const int dbh = item >> 2, qd = item & 3, d = dbh >> 5;
    LAS float* mg = (LAS float*)lds; LAS float* wo = mg + 2 * NCHK; LAS float* wn = wo + NCHK;
    __syncthreads();
    if (tid < 2 * NCHK) mg[tid] = MG[(size_t)dbh * NCHK * 2 + tid];
    __syncthreads();
    if (tid == 0) { float m = -INFINITY;
        for (int s = 0; s < NCHK; ++s) { const int j = step_chunk(d, s); const float mj = mg[2 * j], gj = mg[2 * j + 1];
            if (qd == 0) MIN_[(size_t)dbh * NCHK + j] = m;
            const float mn = fmaxf(gj + m, mj); wo[s] = fexp(gj + m - mn); wn[s] = fexp(mj - mn); m = mn; } }
    __syncthreads();
    const float* cl = CLOC + (size_t)dbh * NCHK * 4096; bf16_t* ci = CIN + (size_t)dbh * NCHK * 4096;
    const int e0 = qd * 1024 + tid, e1 = e0 + 512;
    float s0 = 0.f, s1 = 0.f;
#pragma unroll 4
    for (int s = 0; s < NCHK; ++s) { const int j = step_chunk(d, s); const float c0 = cl[(size_t)j * 4096 + e0], c1 = cl[(size_t)j * 4096 + e1];
        ci[(size_t)j * 4096 + e0] = (bf16_t)(pk2(s0, 0.f) & 0xffffu); ci[(size_t)j * 4096 + e1] = (bf16_t)(pk2(s1, 0.f) & 0xffffu);
        s0 = wo[s] * s0 + wn[s] * c0; s1 = wo[s] * s1 + wn[s] * c1; }
    if (tid < 16) { const int e = qd * 16 + tid; float sn = 0.f; const float* nl = NLOC + (size_t)dbh * NCHK * 64; float* ni = NIN + (size_t)dbh * NCHK * 64;
        for (int s = 0; s < NCHK; ++s) { const int j = step_chunk(d, s); const float c = nl[j * 64 + e]; ni[j * 64 + e] = sn; sn = wo[s] * sn + wn[s] * c; } }
}

__device__ __forceinline__ void out_unit(LAS char* wl, int b, int h, int j, const bf16_t* P, const float* convw, const float* igb, const float* fgb, const float* normw,
                                         const bf16_t* CIN, const float* NIN, const float* MIN_, bf16_t* MIX, int lane) {
    const int r32_ = lane & 31, hi_ = lane >> 5;
    const int rowbase = chunk_row(b, j), len = j < 4 ? NC : T, pos0 = j < 4 ? j * 64 : (j - 4) * 64;
    LAS float* tb = (LAS float*)(wl + OFF_TB);
    float min_d[2];
    { Gates G; load_gates(P, rowbase + lane, h, igb, fgb, G, lane);
#pragma unroll
      for (int d = 0; d < 2; ++d) { const float cs = G.li[d] - G.bcum[d]; const float pm = d == 0 ? prefix_max(cs, lane) : suffix_max(cs, lane);
          const size_t sidx = ((size_t)((d * NB + b) * 4 + h) * NCHK + j);
          const float mi = MIN_[sidx]; min_d[d] = mi;
          const float mt = G.bcum[d] + fmaxf(mi, pm);
          tb[TB_CS + d * 64 + lane] = cs; tb[TB_BT + d * 64 + lane] = G.bcum[d] - mt; tb[TB_EM + d * 64 + lane] = fexp(-mt); tb[TB_NI + d * 64 + lane] = NIN[sidx * 64 + lane]; } }
#pragma unroll
    for (int k = 0; k < 3; ++k) tb[TB_QW + k * 64 + lane] = convw[k * 512 + h * 64 + lane];
    load_vtile(wl + OFF_VT, P, rowbase, PC_MV + h * 64, lane);
    { const int c = lane & 7; float w0[8], w1[8], w2[8]; const float* cw = convw + 256 + h * 64 + 8 * c;
#pragma unroll
      for (int e = 0; e < 8; ++e) { w0[e] = cw[e]; w1[e] = cw[512 + e]; w2[e] = cw[1024 + e]; }
#pragma unroll 2
      for (int i = 0; i < 8; ++i) { const int t = i * 8 + (lane >> 3); float y[8]; conv8(P, rowbase + t, PC_MK + h * 64 + 8 * c, pos0 + t, len, w0, w1, w2, y);
#pragma unroll
          for (int e = 0; e < 8; ++e) y[e] *= 0.125f;
          *(LAS u32x4*)(wl + OFF_KT + c * 1024 + t * 16) = pack8(y); } }
    LDS_WAIT();
#pragma unroll 1
    for (int tbk = 0; tbk < 2; ++tbk) {
        int r32 = r32_, hi = hi_; asm volatile("" : "+v"(r32), "+v"(hi));
        const int t = 32 * tbk + r32;
        const int vaddr = ((lane >> 4) & 1) * 32 + (lane & 3) * 8 + (4 * hi + ((lane & 15) >> 2)) * 64;
        u32x4 qf[4];
#pragma unroll
        for (int d0 = 0; d0 < 4; ++d0) { const int c = 2 * d0 + hi; float w0[8], w1[8], w2[8], y[8];
#pragma unroll
            for (int e = 0; e < 8; ++e) { w0[e] = tb[TB_QW + 8 * c + e]; w1[e] = tb[TB_QW + 64 + 8 * c + e]; w2[e] = tb[TB_QW + 128 + 8 * c + e]; }
            conv8(P, rowbase + t, PC_MQ + h * 64 + 8 * c, pos0 + t, len, w0, w1, w2, y); qf[d0] = pack8(y); }
        f32x16 hs[2]; hs[0] = f32x16{}; hs[1] = f32x16{};
#pragma unroll 1
        for (int d = 0; d < 2; ++d) {
            const size_t sidx = ((size_t)((d * NB + b) * 4 + h) * NCHK + j);
            const float mi = d == 0 ? min_d[0] : min_d[1];
            const float bt = tb[TB_BT + d * 64 + t], em = tb[TB_EM + d * 64 + t];
            const float wi = (mi == -INFINITY) ? 0.f : fexp(bt + mi);
            f32x16 p[2];
#pragma unroll
            for (int sb = 0; sb < 2; ++sb) { p[sb] = f32x16{};
#pragma unroll
                for (int d0 = 0; d0 < 4; ++d0) { const bf16x8 kfr = *(const LAS bf16x8*)(wl + OFF_KT + (2 * d0 + hi) * 1024 + (32 * sb + r32) * 16);
                    p[sb] = __builtin_amdgcn_mfma_f32_32x32x16_bf16(kfr, __builtin_bit_cast(bf16x8, qf[d0]), p[sb], 0, 0, 0); } }
            float ds = 0.f;
#pragma unroll
            for (int sb = 0; sb < 2; ++sb)
#pragma unroll
                for (int i = 0; i < 16; ++i) { const int s_ = 32 * sb + crow(i, hi); const bool valid = d == 0 ? (s_ <= t) : (s_ >= t);
                    const float w = valid ? fexp(bt + tb[TB_CS + d * 64 + s_]) : 0.f; p[sb][i] *= w; ds += p[sb][i]; }
            ds = half_sum(ds);
            float qn = 0.f; u32x4 qw[4];
#pragma unroll
            for (int d0 = 0; d0 < 4; ++d0) { float y[8]; unpack8(qf[d0], y);
#pragma unroll
                for (int e = 0; e < 8; ++e) { qn += y[e] * tb[TB_NI + d * 64 + 16 * d0 + 8 * hi + e]; y[e] *= wi; }
                qw[d0] = pack8(y); }
            qn = half_sum(qn);
            const float den = ds + wi * qn; const float hd = frcp(fmaxf(fabsf(den), em));
            LDS_WAIT();
            if (hi == 0) tb[TB_HD + r32] = hd;
            LDS_WAIT();
            u32x4 pw[4];
#pragma unroll
            for (int jj = 0; jj < 4; ++jj) { pw[0][jj] = pk2(p[0][2 * jj], p[0][2 * jj + 1]); pw[1][jj] = pk2(p[0][8 + 2 * jj], p[0][9 + 2 * jj]); pw[2][jj] = pk2(p[1][2 * jj], p[1][2 * jj + 1]); pw[3][jj] = pk2(p[1][8 + 2 * jj], p[1][9 + 2 * jj]); }
#pragma unroll
            for (int db = 0; db < 2; ++db) { f32x16 acc = f32x16{};
                const bf16_t* cp = CIN + sidx * 4096 + (size_t)(32 * db + r32) * 64 + 8 * hi; bf16x8 cf[4];
#pragma unroll
                for (int d0 = 0; d0 < 4; ++d0) cf[d0] = *(const bf16x8*)(cp + d0 * 16);
#pragma unroll
                for (int k = 0; k < 4; ++k) { LAS const char* vs = wl + OFF_VT + vaddr + db * 4096 + k * 1024; const s16x4 lo = att::vtr(vs), h4 = att::vtr(vs + 512);
                    const bf16x8 vf = (bf16x8){lo[0], lo[1], lo[2], lo[3], h4[0], h4[1], h4[2], h4[3]};
                    acc = __builtin_amdgcn_mfma_f32_32x32x16_bf16(__builtin_bit_cast(bf16x8, pw[k]), vf, acc, 0, 0, 0); }
#pragma unroll
                for (int d0 = 0; d0 < 4; ++d0) acc = __builtin_amdgcn_mfma_f32_32x32x16_bf16(__builtin_bit_cast(bf16x8, qw[d0]), cf[d0], acc, 0, 0, 0);
#pragma unroll
                for (int i = 0; i < 16; ++i) hs[db][i] += acc[i] * tb[TB_HD + crow(i, hi)]; }
        }
        const float nw0 = normw[h * 64 + r32], nw1 = normw[h * 64 + 32 + r32];
        const unsigned offp = (unsigned)((rowbase + 32 * tbk + 4 * hi) * NP + PC_MO + h * 64 + r32) * 2u, offm = (unsigned)((rowbase + 32 * tbk + 4 * hi) * D + h * 64 + r32) * 2u;
#pragma unroll
        for (int i = 0; i < 16; ++i) { float ss = hs[0][i] * hs[0][i] + hs[1][i] * hs[1][i];
            ss += __shfl_xor(ss, 1); ss += __shfl_xor(ss, 2); ss += __shfl_xor(ss, 4); ss += __shfl_xor(ss, 8); ss += __shfl_xor(ss, 16);
            const float sc = 1.0f / sqrtf(ss * (1.0f / 64.0f) + EPS);
            const unsigned ro = (unsigned)((i & 3) + 8 * (i >> 2));
            const bf16_t* op = (const bf16_t*)((const char*)P + (offp + ro * (unsigned)(NP * 2))); bf16_t* mp = (bf16_t*)((char*)MIX + (offm + ro * (unsigned)(D * 2)));
            mp[0] = (bf16_t)(pk2(hs[0][i] * sc * nw0 * sigmoid_f(bf2f(op[0])), 0.f) & 0xffffu);
            mp[32] = (bf16_t)(pk2(hs[1][i] * sc * nw1 * sigmoid_f(bf2f(op[32])), 0.f) & 0xffffu);
            if ((i & 3) == 3) asm volatile("" ::: "memory"); }
    }
    LDS_WAIT();
}
}

#define XB_TMO      128
#define XB_XCNT(j)  (256  + 64 * (j))
#define XB_XSUB(j)  (1280 + 64 * (j))
#define XB_XGEN(j)  (2304 + 64 * (j))
#define XB_TOP      3328
#define XB_TOPGEN   3392
#define XCD_BAR_WORDS 3456
#define XB_SPIN_CAP (1u << 18)
__device__ __forceinline__ unsigned xb_ld(unsigned* p)              { return __hip_atomic_load(p, __ATOMIC_RELAXED, __HIP_MEMORY_SCOPE_AGENT); }
__device__ __forceinline__ unsigned xb_add(unsigned* p, unsigned v) { return __hip_atomic_fetch_add(p, v, __ATOMIC_RELAXED, __HIP_MEMORY_SCOPE_AGENT); }
__device__ __forceinline__ unsigned xb_xcc_id() { return (unsigned)__builtin_amdgcn_s_getreg((3 << 11) | 20) & 0xFu; }
#define XB_SPIN(cond, bar) do { unsigned _sp = 0; while (cond) { __builtin_amdgcn_s_sleep(1); \
    if ((++_sp & 255u) == 0u) { if (xb_ld(&(bar)[XB_TMO])) break; if (_sp > XB_SPIN_CAP) { atomicAdd(&(bar)[XB_TMO], 1u); break; } } } } while (0)
struct XcdBarrier { unsigned* bar; unsigned x; volatile LAS unsigned* st; };
__device__ __forceinline__ XcdBarrier xcd_barrier_post(unsigned* bar, volatile LAS unsigned* st) {
    XcdBarrier b; b.bar = bar; b.x = xb_xcc_id(); b.st = st;
    if (threadIdx.x == 0) (void)xb_add(&bar[XB_XCNT(b.x)], 1u);
    return b;
}
__device__ __forceinline__ void xcd_barrier_complete(unsigned* bar, unsigned x, unsigned& nloc, unsigned& nx) {
    const unsigned G = gridDim.x * gridDim.y * gridDim.z;
    unsigned sum, cnt, mine, sp = 0u;
    for (;;) {
        sum = 0u; cnt = 0u; mine = 0u;
#pragma unroll
        for (unsigned j = 0; j < 16; ++j) { const unsigned c = xb_ld(&bar[XB_XCNT(j)]); sum += c; cnt += (c > 0u) ? 1u : 0u; mine = (j == x) ? c : mine; }
        if (sum == G) break;
        __builtin_amdgcn_s_sleep(1);
        if ((++sp & 255u) == 0u) { if (xb_ld(&bar[XB_TMO])) break; if (sp > XB_SPIN_CAP) { atomicAdd(&bar[XB_TMO], 1u); break; } }
    }
    nloc = mine > 0u ? mine : 1u; nx = cnt > 0u ? cnt : 1u;
}
__device__ __forceinline__ void xcd_barrier(const XcdBarrier& b) {
    asm volatile("s_waitcnt vmcnt(0)" ::: "memory");
    __syncthreads();
    if (threadIdx.x == 0) {
        unsigned* bar = b.bar;
        __builtin_amdgcn_s_waitcnt(0);
        unsigned nloc = b.st[0], nx = b.st[1];
        if (nloc == 0u) { xcd_barrier_complete(bar, b.x, nloc, nx); b.st[0] = nloc; b.st[1] = nx; }
        const unsigned old = xb_add(&bar[XB_XSUB(b.x)], 1u);
        const unsigned gen = old / nloc;
        if (old + 1u == (gen + 1u) * nloc) {
            __builtin_amdgcn_fence(__ATOMIC_RELEASE, "agent");
            asm volatile("s_waitcnt vmcnt(0)" ::: "memory");
            const unsigned og = xb_add(&bar[XB_TOP], 1u);
            const unsigned tg = og / nx;
            if (og + 1u == (tg + 1u) * nx) xb_add(&bar[XB_TOPGEN], 1u);
            else XB_SPIN(xb_ld(&bar[XB_TOPGEN]) == tg, bar);
            __builtin_amdgcn_fence(__ATOMIC_ACQUIRE, "agent");
            xb_add(&bar[XB_XGEN(b.x)], 1u);
            asm volatile("s_waitcnt vmcnt(0)" ::: "memory");
        } else {
            XB_SPIN(xb_ld(&bar[XB_XGEN(b.x)]) == gen, bar);
            __builtin_amdgcn_fence(__ATOMIC_ACQUIRE, "agent");
            asm volatile("s_waitcnt vmcnt(0)" ::: "memory");
        }
    }
    __syncthreads();
}

struct Args { const float* in[27]; float* out; unsigned char* ws; int ph_lo, ph_hi; };
enum { I_X = 0, I_C, I_CTX, I_CCTX, I_ADAW, I_ADAB, I_N1W, I_N2W, I_WIN, I_WOUT, I_CONVW, I_IGB, I_FGB, I_MLNW, I_RPB, I_QNW, I_KVNW, I_WUQ, I_WUKV, I_F1, I_F3, I_F2, I_RW, I_M1, I_M3, I_M2, I_FNW };

struct TrJob { const float* src; const float* src2; int ldn, K, ngrp, kind; bf16_t* dst; const float* ksc; float cs; };
struct TrItem { const float* sp; const float* kp; bf16_t* dp; int ldn, K; float cs; };
__device__ __forceinline__ void tr_resolve(const TrJob& J, int it, int lane, TrItem& T) {
    const int g = it % J.ngrp, kb = it / J.ngrp, c0 = 16 * g, k0 = 64 * kb; const float* src = J.src; int sc0 = c0; float cs = J.cs;
    if (J.kind == 1) {
        if (c0 < 512) sc0 = 2192 + c0; else if (c0 < 768) sc0 = 2704 + (c0 - 512); else if (c0 < 1792) sc0 = c0 - 768;
        else if (c0 < 2944) { sc0 = 1040 + (c0 - 1792); if (c0 < 2176) cs = 0.125f * LOG2E; }
        else if (c0 < 2976) sc0 = 2960 + (c0 - 2944); else if (c0 < 2992) sc0 = 1024 + (c0 - 2976); else { sc0 = 0; cs = 0.f; }
    } else if (J.kind == 2) {
        if (c0 < 384) sc0 = (c0 >> 6) * 96 + (c0 & 63); else { const int r = c0 - 384; sc0 = (r >> 5) * 96 + 64 + (r & 31); }
    } else if (J.kind == 3) {
        const int pn = c0 >> 8, cc = c0 & 255; if (cc >= 128) src = J.src2; sc0 = 128 * pn + (cc & 127);
    }
    T.sp = src + (size_t)(k0 + (lane >> 4)) * J.ldn + sc0 + (lane & 15); T.kp = J.ksc ? J.ksc + k0 + (lane >> 4) : nullptr; T.ldn = J.ldn; T.K = J.K; T.cs = cs;
    T.dp = J.dst + (size_t)c0 * J.K + k0;
}
__device__ __forceinline__ void tr_load(const TrItem& T, float (&v)[16], float (&kv)[16]) {
#pragma unroll
    for (int i = 0; i < 16; ++i) v[i] = T.sp[(size_t)(4 * i) * T.ldn];
    if (T.kp) {
#pragma unroll
        for (int i = 0; i < 16; ++i) kv[i] = T.kp[4 * i]; }
    else {
#pragma unroll
        for (int i = 0; i < 16; ++i) kv[i] = 1.f; }
}
__device__ __forceinline__ void tr_store(const TrItem& T, const float (&v)[16], const float (&kv)[16], LAS float* scr, int lane) {
#pragma unroll
    for (int i = 0; i < 16; ++i) scr[(4 * i + (lane >> 4)) * 17 + (lane & 15)] = v[i] * T.cs * kv[i];
    LDS_WAIT();
#pragma unroll
    for (int j = 0; j < 2; ++j) { const int id = lane + 64 * j, n = id >> 3, c = id & 7; float y[8];
#pragma unroll
        for (int e = 0; e < 8; ++e) y[e] = scr[(8 * c + e) * 17 + n];
        *(u32x4*)(T.dp + (size_t)n * T.K + 8 * c) = pack8(y); }
    LDS_WAIT();
}
template <class R> __device__ __forceinline__ void tr_run(int first, int stride, int total, const R& resolve, LAS float* scr, int lane) {
    int it = first; if (it >= total) return;
    TrItem Tc; float vc[16], kc[16]; resolve(it, Tc); tr_load(Tc, vc, kc);
    for (;;) {
        const int itn = it + stride; const bool hn = itn < total; TrItem Tn = Tc; float vn[16], kn[16];
        if (hn) { resolve(itn, Tn); tr_load(Tn, vn, kn); }
        else {
#pragma unroll
            for (int i = 0; i < 16; ++i) { vn[i] = 0.f; kn[i] = 0.f; } }
        tr_store(Tc, vc, kc, scr, lane);
        if (!hn) break;
        Tc = Tn;
#pragma unroll
        for (int i = 0; i < 16; ++i) { vc[i] = vn[i]; kc[i] = kn[i]; }
        it = itn;
    }
}
__device__ __forceinline__ int tr_job_count(const TrJob& J) { return J.ngrp * (J.K / 64); }

__device__ __forceinline__ void mod_item(LAS char* lds, const int wid0, int item, const float* c, const float* cctx, const float* adaw, const float* adab, float* modv) {
    const int lane = fresh_lane(), wid = wid0, tid = wid * 64 + lane, l = item / 96, ng = item % 96;
    LAS float* sc = (LAS float*)lds;
    LAS float* part = sc + 9 * 1024;
    __syncthreads();
    for (int i = tid; i < 9 * 1024; i += 512) { const float v = i < 8 * 1024 ? c[i] : cctx[i - 8 * 1024]; sc[i] = silu_f(v); }
    __syncthreads();
    float acc[9];
#pragma unroll
    for (int bi = 0; bi < 9; ++bi) acc[bi] = 0.f;
    const float* w = adaw + (size_t)l * 1024 * 6144 + ng * 64 + lane;
#pragma unroll 4
    for (int k = wid * 128; k < wid * 128 + 128; ++k) { const float wv = w[(size_t)k * 6144];
#pragma unroll
        for (int bi = 0; bi < 9; ++bi) acc[bi] += sc[bi * 1024 + k] * wv; }
#pragma unroll
    for (int bi = 0; bi < 9; ++bi) part[(wid * 9 + bi) * 64 + lane] = acc[bi];
    __syncthreads();
    for (int i = tid; i < 9 * 64; i += 512) { const int bi = i >> 6, n = i & 63; float s = adab[l * 6144 + ng * 64 + n];
#pragma unroll
        for (int w8 = 0; w8 < 8; ++w8) s += part[(w8 * 9 + bi) * 64 + n];
        modv[((size_t)l * 9 + bi) * 6144 + ng * 64 + n] = s; }
}

__device__ __forceinline__ void norm_row(const float* xrow, const float* nw, const float* shift, const float* scale, int lane, f32x4 (&v)[4], const bf16_t* dl = nullptr, float* xw = nullptr, int nparts = 1, size_t pstride = 0) {
    float s = 0.f;
#pragma unroll
    for (int j = 0; j < 4; ++j) { v[j] = *(const f32x4*)(xrow + 4 * lane + 256 * j);
        if (dl) { for (int p = 0; p < nparts; ++p) { const u32x2 dw = *(const u32x2*)(dl + (size_t)p * pstride + 4 * lane + 256 * j); v[j].x += bf2f(dw.x & 0xffffu); v[j].y += __uint_as_float(dw.x & 0xffff0000u); v[j].z += bf2f(dw.y & 0xffffu); v[j].w += __uint_as_float(dw.y & 0xffff0000u); }
            *(f32x4*)(xw + 4 * lane + 256 * j) = v[j]; }
        s += (v[j].x * v[j].x + v[j].y * v[j].y) + (v[j].z * v[j].z + v[j].w * v[j].w); }
    const float rs = 1.0f / sqrtf(wave_sum(s) * (1.0f / D) + EPS);
#pragma unroll
    for (int j = 0; j < 4; ++j) { const int c = 4 * lane + 256 * j; const f32x4 w = *(const f32x4*)(nw + c), sh = *(const f32x4*)(shift + c), sc = *(const f32x4*)(scale + c);
        v[j] = (v[j] * rs * w) * (1.0f + sc) + sh; }
}
__device__ __forceinline__ void store_row_bf16(bf16_t* orow, int lane, const f32x4 (&v)[4]) {
#pragma unroll
    for (int j = 0; j < 4; ++j) { u32x2 w; w.x = pk2(v[j].x, v[j].y); w.y = pk2(v[j].z, v[j].w); *(u32x2*)(orow + 4 * lane + 256 * j) = w; }
}


#if !MK_MULTI
#define GRID_BAR() do { XcdBarrier b2_ = bar; asm volatile("" : "+s"(b2_.bar)); xcd_barrier(b2_); } while (0)
#define OPQ(x) (x)
#else
#define GRID_BAR() do {} while (0)
#define OPQ(x) ({ int _v = (x); asm volatile("" : "+s"(_v)); _v; })
#endif
#ifndef MK_SITES
#define MK_SITES 0xffffffffu
#endif
#define EN(s) (((MK_SITES) >> (s)) & 1u)
#define IN(k) (OPQ(lo) <= (k) && (k) < OPQ(hi_ph))
#define SEAM(k) do { if (IN(k) && IN((k) + 1)) GRID_BAR(); } while (0)
#define PHASE_WS() GAS unsigned char* ws = (GAS unsigned char*)args.ws; asm volatile("" : "+s"(ws))
#define PHASE_IDS() PHASE_WS(); const int lane = fresh_lane(), wid = wid0, tid = wid * 64 + lane, gw = blockIdx.x * 8 + wid; (void)lane; (void)gw; (void)tid

#define x_in (args.in[I_X])
#define ctx_in (args.in[I_CTX])
#define xout (args.out)
#define modv ((float*)(ws + SM_MOD))
#define ropet ((float*)(ws + SM_ROPE))
#define stats ((float*)(ws + SM_STATS))
#define NLOC ((float*)(ws + SM_NLOC))
#define NIN ((float*)(ws + SM_NIN))
#define MG ((float*)(ws + SM_MG))
#define MINb ((float*)(ws + SM_MIN))
#define xc ((float*)(ws + WS_XC))
#define BH ((bf16_t*)(ws + WS_H))
#define CLOC ((float*)(ws + WS_H))
#define BP ((bf16_t*)(ws + WS_P))
#define QM ((bf16_t*)(ws + WS_QM))
#define KVM ((bf16_t*)(ws + WS_KVM))
#define CIN ((bf16_t*)(ws + WS_CIN))
#define Win ((bf16_t*)(ws + W_IN))
#define Wout ((bf16_t*)(ws + W_OUT))
#define Wuq ((bf16_t*)(ws + W_UQ))
#define Wukv ((bf16_t*)(ws + W_UKV))
#define Wf13 ((bf16_t*)(ws + W_F13))
#define Wf2 ((bf16_t*)(ws + W_F2))
#define tokinfo ((int*)(ws + SM_TOK))
#define tokg ((float*)(ws + SM_TOKG))
#define wgcnt ((int*)(ws + SM_WGCNT))
#define rowtok ((int*)(ws + SM_ROWTOK))
#define rowgate ((float*)(ws + SM_ROWGATE))
#define tileexp ((int*)(ws + SM_TILEEXP))
#define WMOE ((bf16_t*)(ws + WS_WMOE))
#define UB ((bf16_t*)(ws + WS_U))
#define ASORT ((bf16_t*)(ws + WS_ASORT))
#define PBY ((bf16_t*)(ws + WS_PBY))
#define PBF ((bf16_t*)(ws + WS_PBF))
#define PBW ((bf16_t*)(ws + WS_PBW))

template <int L> __device__ __forceinline__ void layer_phases(const Args& args, LAS unsigned char* lds, const int G, const int NGW, const XcdBarrier& bar, const int lo, const int hi_ph, const int wid0) {
    constexpr int l = L; constexpr int pb = 1 + 10 * l;

#define mod_l (modv + (size_t)l * 9 * 6144)
        if (EN(1) && IN(pb + 0)) { PHASE_IDS();
            const float* nw = args.in[I_N1W] + l * D;
            for (int r = gw; r < M; r += NGW) { const bool lat = r < ML; const int bi = lat ? (r >> 12) : 8;
                const float* xr = lat ? ((l == 0 ? x_in : xout) + (size_t)r * D) : ((l == 0 ? ctx_in : xc) + (size_t)(r - ML) * D);
                f32x4 v[4]; norm_row(xr, nw, mod_l + bi * 6144, mod_l + bi * 6144 + 1024, lane, v, (l == 0 || lat) ? nullptr : PBF + (size_t)(r - ML) * D, const_cast<float*>(xr), 8, (size_t)MC * D); store_row_bf16(BH + (size_t)r * D, lane, v); }
        }
        SEAM(pb + 0);
        if (EN(2) && IN(pb + 1)) { PHASE_WS();
            pg8::Gemm g{BH, D, Win + (size_t)l * 3072 * 1024, D}; pg8::StaticOrder S; S.init(M / 256, NP / 256, G, blockIdx.x, D);
            pg8::EpiP E{BP, stats, ropet};
            pg8::gemm_phase<pg8::EpiP, pg8::StaticOrder, true>(lds, g, S, E, wid0);
        }
        SEAM(pb + 1);
        if (EN(3) && IN(pb + 2)) { PHASE_WS();
            if (EN(18)) { pg8::Gemm g{BP + PC_QL, NP, Wuq + (size_t)l * 768 * 512, 512}; pg8::StaticOrder S; S.init(M / 256, 3, G, blockIdx.x, 512);
              pg8::EpiRS<true> E{QM, NQM, NQM, 384, stats, 0, 16, 1.0f / 512.0f, ropet};
              pg8::gemm_phase<pg8::EpiRS<true>, pg8::StaticOrder, true>(lds, g, S, E, wid0); }
            __syncthreads();
            if (EN(19)) { pg8::Gemm g{BP + PC_KVL, NP, Wukv + (size_t)l * 768 * 256, 256}; pg8::StaticOrder S; S.init(M / 256, 3, G, blockIdx.x, 256);
              pg8::EpiRS<false> E{KVM, NKVM, NKVM, NKVM, stats, 16, 8, 1.0f / 256.0f, ropet};
              pg8::gemm_phase<pg8::EpiRS<false>, pg8::StaticOrder, true>(lds, g, S, E, wid0); }
            __syncthreads();
            { PHASE_IDS();
            const float* convw = args.in[I_CONVW] + (size_t)l * 3 * 512; const float* igb = args.in[I_IGB] + l * 8; const float* fgb = args.in[I_FGB] + l * 8;
            for (int u = gw; u < NB * 4 * NCHK; u += NGW) { const int j = u % NCHK, bh = u / NCHK; int lane_ = lane; asm volatile("" : "+v"(lane_));
                if (EN(17)) ml::chunk_state_unit((LAS char*)lds + wid * ml::WAVE_LDS, bh >> 2, bh & 3, j, BP, convw, igb, fgb, CLOC, NLOC, MG, lane_); } }
        }
        SEAM(pb + 2);
        if (EN(4) && IN(pb + 3)) { PHASE_WS(); for (int item = blockIdx.x; item < 256; item += G) ml::scan_item((LAS char*)lds, wid0, item, CLOC, NLOC, MG, CIN, NIN, MINb); }
        SEAM(pb + 3);
        if (EN(5) && IN(pb + 4)) { GAS unsigned char* ws_ph = (GAS unsigned char*)args.ws;
            const float* convw = args.in[I_CONVW] + (size_t)l * 3 * 512; const float* igb = args.in[I_IGB] + l * 8; const float* fgb = args.in[I_FGB] + l * 8;
            const float* mnw = args.in[I_MLNW] + l * 256;
#ifndef MK_REP_MLA
#define MK_REP_MLA 1
#endif
#ifndef MK_REP_NA
#define MK_REP_NA 1
#endif
#ifndef MK_REP_ML
#define MK_REP_ML 1
#endif
            constexpr int n_mla1 = NB * 6 * 8, n_na1 = NB * 6 * 16, n_ml1 = (l == 0) ? NB * 4 * NCHK / 8 : NB * 4 * 64 / 8;
            constexpr int n_mla = n_mla1 * MK_REP_MLA, n_na = n_na1 * MK_REP_NA, n_ml = n_ml1 * MK_REP_ML, n_ctx = (l == 0) ? NB * 6 * 2 : 0;
            constexpr int n_items = n_mla + n_na + n_ml + n_ctx;
            volatile LAS int* qslot = (volatile LAS int*)(lds + LDS_MISC + 64);
            for (;;) {
                GAS unsigned char* ws = ws_ph; asm volatile("" : "+s"(ws));
                int wid_i = wid0; asm volatile("" : "+s"(wid_i));
                const int lane = fresh_lane(), tid = wid_i * 64 + lane;
                bf16_t* MIX = BH;
                __syncthreads();
                if (tid == 0) *qslot = (int)__hip_atomic_fetch_add((unsigned*)(ws + WS_CTL) + CW_QUEUE + l * 64, 1u, __ATOMIC_RELAXED, __HIP_MEMORY_SCOPE_AGENT);
                __syncthreads();
                const int u = __builtin_amdgcn_readfirstlane(*qslot);
                if (u >= n_items) break;
                att::Unit U;
                if (u < n_mla) { const int u1 = u % n_mla1; const int qb = u1 & 7, bh = u1 >> 3, b = bh / 6, h = bh % 6; const int row0 = b * T + qb * 512;
                    U.qn = QM + (size_t)row0 * NQM + h * 64; U.ldq = NQM; U.qr = QM + (size_t)row0 * NQM + 384 + h * 32; U.ldqr = NQM;
                    U.kn = KVM + h * 128; U.ldk = NKVM; U.kr = BP + PC_KR; U.ldkr = NP; U.v = KVM + h * 128 + 64; U.ldv = NKVM;
                    U.o = MIX + (size_t)row0 * D + 640 + h * 64; U.ldo = D; U.na = 64; U.rowa = b * T; U.rowc = ML + b * NC; U.rg = 0; U.rlo = 0;
                    if (EN(15)) { const bool ok = att::attn_unit64((LAS char*)lds, U, wid_i);
                        if (!ok && tid == 0) { unsigned* rd = (unsigned*)(ws + WS_CTL) + CW_REDO + l * 512; const unsigned ix = __hip_atomic_fetch_add(rd, 1u, __ATOMIC_RELAXED, __HIP_MEMORY_SCOPE_AGENT); rd[1 + ix] = (unsigned)u; } }
                } else if (u < n_mla + n_na) { const int v = (u - n_mla) % n_na1, rg = v & 15, bh = v >> 4, b = bh / 6, h = bh % 6; const int row0 = b * T + rg * 256;
                    const int rlo = min(max(4 * rg - 4, 0), 56), rhi = min(max(4 * rg - 1, 0), 56) + 7;
                    { LAS float* bt = (LAS float*)(lds + att::OFF_BIAS); const float* rp = args.in[I_RPB] + ((size_t)l * 6 + h) * 15 * 31;
                      for (int i = tid; i < 640; i += 512) { const int k = i - 64; bt[i] = (k >= 0 && k < 465) ? rp[k] * LOG2E : 0.f; } }
                    __syncthreads();
                    U.qn = BP + (size_t)row0 * NP + PC_NQ + h * 64; U.ldq = NP; U.qr = nullptr; U.ldqr = 0;
                    U.kn = BP + PC_NK + h * 64; U.ldk = NP; U.kr = nullptr; U.ldkr = 0; U.v = BP + PC_NV + h * 64; U.ldv = NP;
                    U.o = MIX + (size_t)row0 * D + 256 + h * 64; U.ldo = D; U.na = rhi - rlo + 1; U.rowa = b * T + rlo * 64; U.rowc = ML + b * NC; U.rg = rg; U.rlo = rlo;
                    if (EN(15)) { const bool ok = att::attn_unit<8, true, true>((LAS char*)lds, U, wid_i);
                        if (!ok && tid == 0) { unsigned* rd = (unsigned*)(ws + WS_CTL) + CW_REDO2 + l * 1024; const unsigned ix = __hip_atomic_fetch_add(rd, 1u, __ATOMIC_RELAXED, __HIP_MEMORY_SCOPE_AGENT); rd[1 + ix] = (unsigned)(u - n_mla); } }
                } else if (u < n_mla + n_na + n_ml) { const int id = ((u - n_mla - n_na) % n_ml1) * 8 + wid_i; int lane_ = lane; asm volatile("" : "+v"(lane_));
                    const int bh = (l == 0) ? id / NCHK : id >> 6, j = (l == 0) ? id % NCHK : 4 + (id & 63);
                    if (EN(16)) ml::out_unit((LAS char*)lds + wid_i * ml::WAVE_LDS, bh >> 2, bh & 3, j, BP, convw, igb, fgb, mnw, CIN, NIN, MINb, MIX, lane_);
                } else { const int v = u - n_mla - n_na - n_ml, kind = v & 1, bh = v >> 1, b = bh / 6, h = bh % 6; const int row0 = ML + b * NC;
                    U.na = 0; U.rowa = 0; U.rowc = row0; U.rg = 0; U.rlo = 0; U.ldo = D;
                    if (kind == 0) { U.qn = QM + (size_t)row0 * NQM + h * 64; U.ldq = NQM; U.qr = QM + (size_t)row0 * NQM + 384 + h * 32; U.ldqr = NQM;
                        U.kn = KVM + h * 128; U.ldk = NKVM; U.kr = BP + PC_KR; U.ldkr = NP; U.v = KVM + h * 128 + 64; U.ldv = NKVM; U.o = MIX + (size_t)row0 * D + 640 + h * 64;
                        if (EN(15)) (void)att::attn_unit<12, false>((LAS char*)lds, U, wid_i);
                    } else { U.qn = BP + (size_t)row0 * NP + PC_NQ + h * 64; U.ldq = NP; U.qr = nullptr; U.ldqr = 0;
                        U.kn = BP + PC_NK + h * 64; U.ldk = NP; U.kr = nullptr; U.ldkr = 0; U.v = BP + PC_NV + h * 64; U.ldv = NP; U.o = MIX + (size_t)row0 * D + 256 + h * 64;
                        if (EN(15)) (void)att::attn_unit<8, false>((LAS char*)lds, U, wid_i); }
                }
            }
        }
        SEAM(pb + 4);
        if (EN(6) && IN(pb + 5)) { PHASE_WS();
            {
              unsigned* rd = (unsigned*)(ws + WS_CTL) + CW_REDO + l * 512; const int nredo = (int)__hip_atomic_load(rd, __ATOMIC_RELAXED, __HIP_MEMORY_SCOPE_AGENT);
              unsigned* rd2 = (unsigned*)(ws + WS_CTL) + CW_REDO2 + l * 1024; const int nredo2 = (int)__hip_atomic_load(rd2, __ATOMIC_RELAXED, __HIP_MEMORY_SCOPE_AGENT);
              if (nredo2 > 0) {
                  for (int i = blockIdx.x; i < nredo2; i += G) { const int v = (int)rd2[1 + i] % (NB * 6 * 16), rg = v & 15, bh = v >> 4, b = bh / 6, h = bh % 6; const int row0 = b * T + rg * 256;
                      const int rlo = min(max(4 * rg - 4, 0), 56), rhi = min(max(4 * rg - 1, 0), 56) + 7; const int tid_ = wid0 * 64 + fresh_lane();
                      __syncthreads();
                      { LAS float* bt = (LAS float*)(lds + att::OFF_BIAS); const float* rp = args.in[I_RPB] + ((size_t)l * 6 + h) * 15 * 31;
                        for (int q = tid_; q < 640; q += 512) { const int k = q - 64; bt[q] = (k >= 0 && k < 465) ? rp[k] * LOG2E : 0.f; } }
                      __syncthreads();
                      att::Unit U; U.qn = BP + (size_t)row0 * NP + PC_NQ + h * 64; U.ldq = NP; U.qr = nullptr; U.ldqr = 0;
                      U.kn = BP + PC_NK + h * 64; U.ldk = NP; U.kr = nullptr; U.ldkr = 0; U.v = BP + PC_NV + h * 64; U.ldv = NP;
                      U.o = BH + (size_t)row0 * D + 256 + h * 64; U.ldo = D; U.na = rhi - rlo + 1; U.rowa = b * T + rlo * 64; U.rowc = ML + b * NC; U.rg = rg; U.rlo = rlo;
                      (void)att::attn_unit<8, true>((LAS char*)lds, U, wid0); }
              }
              if (nredo > 0) {
                  for (int i = blockIdx.x; i < 2 * nredo; i += G) { const int u1 = (int)rd[1 + (i >> 1)] % (NB * 6 * 8), hf = i & 1; const int qb = u1 & 7, bh = u1 >> 3, b = bh / 6, h = bh % 6; const int row0 = b * T + qb * 512 + hf * 256;
                      att::Unit U; U.qn = QM + (size_t)row0 * NQM + h * 64; U.ldq = NQM; U.qr = QM + (size_t)row0 * NQM + 384 + h * 32; U.ldqr = NQM;
                      U.kn = KVM + h * 128; U.ldk = NKVM; U.kr = BP + PC_KR; U.ldkr = NP; U.v = KVM + h * 128 + 64; U.ldv = NKVM;
                      U.o = BH + (size_t)row0 * D + 640 + h * 64; U.ldo = D; U.na = 64; U.rowa = b * T; U.rowc = ML + b * NC; U.rg = 0; U.rlo = 0;
                      (void)att::attn_unit<12, false>((LAS char*)lds, U, wid0); }
              }
              if (nredo > 0 || nredo2 > 0) GRID_BAR(); }
            pg8::Gemm g{BH, D, Wout + (size_t)l * 1024 * 1024, D}; pg8::TailSplit<pg8::StaticOrder> S; S.init(ML / 256, 4, G, blockIdx.x, D); S.init_ts(ML / 256, l == 0 ? MC / 256 : 0, 4);
            pg8::EpiRes2 E{l == 0 ? x_in : xout, xout, mod_l + 2 * 1024, 6144, PBW, (size_t)MC * D, ML};
            pg8::gemm_phase<pg8::EpiRes2, pg8::TailSplit<pg8::StaticOrder>, true>(lds, g, S, E, wid0);
        }
        SEAM(pb + 5);
        if (l == 0) {
            if (EN(7) && IN(pb + 6)) { PHASE_IDS();
                const float* nw = args.in[I_N2W] + l * D;
                for (int r = gw; r < M; r += NGW) { const bool lat = r < ML; const int bi = lat ? (r >> 12) : 8;
                    const float* xr = lat ? (xout + (size_t)r * D) : (ctx_in + (size_t)(r - ML) * D); float* xw = lat ? nullptr : (xc + (size_t)(r - ML) * D);
                    f32x4 v[4]; norm_row(xr, nw, mod_l + bi * 6144 + 3 * 1024, mod_l + bi * 6144 + 4 * 1024, lane, v, lat ? nullptr : PBW + (size_t)(r - ML) * D, xw, 4, (size_t)MC * D); store_row_bf16(BH + (size_t)r * D, lane, v); }
            }
            SEAM(pb + 6);
            if (EN(8) && IN(pb + 7)) { PHASE_WS();
                pg8::Gemm g{BH, D, Wf13, D}; pg8::StaticOrder S; S.init(M / 256, 22, G, blockIdx.x, D);
                pg8::EpiSwiglu E{BP, DFF};
                pg8::gemm_phase<pg8::EpiSwiglu, pg8::StaticOrder, true>(lds, g, S, E, wid0);
            }
            SEAM(pb + 7);
            if (EN(9) && IN(pb + 8)) { PHASE_WS();
                pg8::Gemm g{BP, DFF, Wf2, DFF}; pg8::TailSplit<pg8::StaticOrder> S; S.init(ML / 256, 4, G, blockIdx.x, DFF); S.init_ts(ML / 256, MC / 256, 8);
                pg8::EpiRes2 E{xout, xout, mod_l + 5 * 1024, 6144, PBF, (size_t)MC * D, ML};
                pg8::gemm_phase<pg8::EpiRes2, pg8::TailSplit<pg8::StaticOrder>, true>(lds, g, S, E, wid0);
            }
            SEAM(pb + 8);
        } else {
            if (EN(10) && IN(pb + 6)) { PHASE_IDS();
                { LAS float* scr = (LAS float*)(lds + wid * 4352);
                  const int per13 = 352 * 16, per2 = 64 * 44, per = per13 + per2;
                  const float* m1 = args.in[I_M1]; const float* m3 = args.in[I_M3]; const float* m2 = args.in[I_M2]; bf16_t* wm = WMOE;
                  auto resolve = [&](int it, TrItem& T) { const int e = it / per, r = it % per; bf16_t* wb = (bf16_t*)((char*)wm + (size_t)e * WMOE_E);
                      if (r < per13) { TrJob J{m1 + (size_t)e * 1024 * 2816, m3 + (size_t)e * 1024 * 2816, 2816, 1024, 352, 3, wb, nullptr, 1.f}; tr_resolve(J, r, lane, T); }
                      else { TrJob J{m2 + (size_t)e * 2816 * 1024, nullptr, 1024, 2816, 64, 0, wb + (size_t)5632 * 1024, nullptr, 1.f}; tr_resolve(J, r - per13, lane, T); } };
                  tr_run(gw, NGW, NEXP * per, resolve, scr, lane); }
                __syncthreads();
                LAS float* rw = (LAS float*)(lds + 40960);
                LAS int* esel = (LAS int*)(lds + 40960 + 32768);
                for (int i = tid; i < 8192; i += 512) rw[i] = args.in[I_RW][i];
                __syncthreads();
                const float* nw = args.in[I_N2W] + l * D;
                for (int blk = blockIdx.x; blk < ML / 128; blk += G) {
                    for (int rr = wid; rr < 128; rr += 8) { const int r = blk * 128 + rr, bi = r >> 12; f32x4 v[4];
                        norm_row(xout + (size_t)r * D, nw, mod_l + bi * 6144 + 3 * 1024, mod_l + bi * 6144 + 4 * 1024, lane, v);
                        store_row_bf16(ASORT + ((size_t)ML + r) * D, lane, v);
                        float lg[8];
#pragma unroll
                        for (int e = 0; e < 8; ++e) lg[e] = 0.f;
#pragma unroll
                        for (int j = 0; j < 4; ++j)
#pragma unroll
                            for (int q = 0; q < 4; ++q) { const int c = 4 * lane + 256 * j + q; const f32x4 w0 = *(const LAS f32x4*)(rw + c * 8), w1 = *(const LAS f32x4*)(rw + c * 8 + 4); const float hv = v[j][q];
                                lg[0] += hv * w0.x; lg[1] += hv * w0.y; lg[2] += hv * w0.z; lg[3] += hv * w0.w; lg[4] += hv * w1.x; lg[5] += hv * w1.y; lg[6] += hv * w1.z; lg[7] += hv * w1.w; }
#pragma unroll
                        for (int e = 0; e < 8; ++e) lg[e] = wave_sum(lg[e]);
                        int e0 = 0; float v0 = lg[0];
#pragma unroll
                        for (int e = 1; e < 8; ++e) if (lg[e] > v0) { v0 = lg[e]; e0 = e; }
                        int e1 = -1; float v1 = -INFINITY;
#pragma unroll
                        for (int e = 0; e < 8; ++e) if (e != e0 && lg[e] > v1) { v1 = lg[e]; e1 = e; }
                        const float g0 = 1.0f / (1.0f + expf(v1 - v0));
                        if (lane == 0) { esel[rr * 2] = e0; esel[rr * 2 + 1] = e1; tokg[(size_t)r * 2] = g0; tokg[(size_t)r * 2 + 1] = 1.0f - g0; } }
                    __syncthreads();
                    if (tid < 128) { const int e0 = esel[tid * 2], e1 = esel[tid * 2 + 1]; int s0 = 0, s1 = 0;
                        for (int q = 0; q < tid; ++q) { s0 += (esel[q * 2] == e0); s1 += (esel[q * 2 + 1] == e1); }
                        int* ti = tokinfo + (size_t)(blk * 128 + tid) * 4; ti[0] = e0; ti[1] = e1; ti[2] = s0; ti[3] = s1; }
                    if (tid < 16) { const int k = tid >> 3, e = tid & 7; int c = 0; for (int q = 0; q < 128; ++q) c += (esel[q * 2 + k] == e); wgcnt[blk * 16 + tid] = c; }
                    __syncthreads();
                }
            }
            SEAM(pb + 6);
            if (EN(11) && IN(pb + 7)) { PHASE_IDS();
                LAS int* tot = (LAS int*)(lds);
                LAS int* offp = tot + 16; LAS int* pre = tot + 32;
                __syncthreads();
                LAS int* segs = pre + 4096;
                for (int i = tid; i < 4096; i += 512) pre[i] = wgcnt[i];
                __syncthreads();
                { const int c = tid & 15, sg = tid >> 4; int sm = 0;
#pragma unroll
                  for (int q = 0; q < 8; ++q) sm += pre[(sg * 8 + q) * 16 + c];
                  segs[sg * 16 + c] = sm; }
                __syncthreads();
                { const int c = tid & 15, sg = tid >> 4; int run = 0; for (int q = 0; q < sg; ++q) run += segs[q * 16 + c];
#pragma unroll
                  for (int q = 0; q < 8; ++q) { const int v = pre[(sg * 8 + q) * 16 + c]; pre[(sg * 8 + q) * 16 + c] = run; run += v; }
                  if (sg == 31) tot[c] = run; }
                __syncthreads();
                if (tid == 0) { int o = 0; for (int e = 0; e < 8; ++e) { offp[e] = o; o += (tot[e] + tot[8 + e] + 255) & ~255; }
                    if (blockIdx.x == 0) { tileexp[320] = o >> 8; for (int e = 0; e < 8; ++e) { const int t0 = offp[e] >> 8, nt = (tot[e] + tot[8 + e] + 255) >> 8; for (int q = 0; q < nt; ++q) tileexp[t0 + q] = e; } } }
                __syncthreads();
                if (blockIdx.x == 0) { for (int i = tid; i < 8 * 256; i += 512) { const int e = i >> 8, q = i & 255, c = tot[e] + tot[8 + e]; if (q < ((256 - (c & 255)) & 255)) rowtok[offp[e] + c + q] = 0; } }
                for (int blk = blockIdx.x; blk < ML / 128; blk += G) {
                    if (tid < 256) { const int rr = tid >> 1, k = tid & 1, r = blk * 128 + rr; const int* ti = tokinfo + (size_t)r * 4;
                        const int e = ti[k], pos = offp[e] + (k == 0 ? 0 : tot[e]) + pre[blk * 16 + k * 8 + e] + ti[2 + k];
                        rowtok[pos] = r; tokinfo[(size_t)r * 4 + 2 + k] = pos; }
                }
            }
            SEAM(pb + 7);
            for (int k = 0; k < 2; ++k) {
                if (EN(12) && IN(pb + 8 + 2 * k)) { PHASE_WS();
                    const int ntl = tileexp[320], t0 = k == 0 ? 0 : 128, t1 = k == 0 ? (ntl < 128 ? ntl : 128) : ntl;
                    pg8::Gemm g{ASORT + (size_t)ML * D, D, WMOE, D}; pg8::GroupedOrder S; S.init(t1 > t0 ? t1 - t0 : 0, 22, G, blockIdx.x, D); S.tile_exp = tileexp + t0; S.estride = WMOE_E;
                    pg8::EpiSwiglu E{UB, DFF};
                    pg8::gemm_phase<pg8::EpiSwiglu, pg8::GroupedOrder, true, true>(lds, g, S, E, wid0, rowtok + t0 * 256);
                }
                SEAM(pb + 8 + 2 * k);
                if (EN(13) && IN(pb + 9 + 2 * k)) { PHASE_WS();
                    const int ntl = tileexp[320], t0 = k == 0 ? 0 : 128, t1 = k == 0 ? (ntl < 128 ? ntl : 128) : ntl;
                    const int nmp = t1 > t0 ? t1 - t0 : 0, nmain = nmp < 128 ? nmp : 128;
                    pg8::Gemm g{UB, DFF, WMOE + (size_t)5632 * 1024, DFF}; pg8::TailSplit<pg8::GroupedOrder> S; S.init(nmain, 4, G, blockIdx.x, DFF); S.tile_exp = tileexp + t0; S.estride = WMOE_E; S.init_ts(nmain, nmp - nmain, 11);
                    pg8::EpiDelta E{ASORT + (size_t)t0 * 256 * D, nullptr, 0, PBY, (size_t)7 * 256 * D, 128 * 256};
                    pg8::gemm_phase<pg8::EpiDelta, pg8::TailSplit<pg8::GroupedOrder>, true>(lds, g, S, E, wid0);
                }
                SEAM(pb + 9 + 2 * k);
            }
        }
    }

constexpr int NPHASE = 24;
__global__ void __launch_bounds__(512, 2) mega_fwd(Args args) {
    extern __shared__ __attribute__((aligned(16))) unsigned char lds_raw[];
    LAS unsigned char* lds = (LAS unsigned char*)lds_raw;
    const int G = gridDim.x, NGW = G * 8;
    const int wid0 = __builtin_amdgcn_readfirstlane(threadIdx.x >> 6);
    if (threadIdx.x < 4) ((volatile LAS unsigned*)(lds + LDS_MISC))[threadIdx.x] = 0u;
    __syncthreads();
#if !MK_MULTI
    XcdBarrier bar = xcd_barrier_post((unsigned*)(args.ws + WS_CTL) + CW_BAR, (volatile LAS unsigned*)(lds + LDS_MISC));
    constexpr int lo = 0, hi_ph = 1000;
#else
    XcdBarrier bar; bar.bar = nullptr; bar.x = 0; bar.st = nullptr;
    const int lo = args.ph_lo, hi_ph = args.ph_hi;
#endif
    if (EN(0) && IN(0)) { PHASE_IDS();
        LAS float* scr = (LAS float*)(lds + wid * 4352);
        TrJob jobs[10];
        for (int l = 0; l < 2; ++l) {
            jobs[l * 4 + 0] = TrJob{args.in[I_WIN] + (size_t)l * 1024 * 2992, nullptr, 2992, 1024, 192, 1, Win + (size_t)l * 3072 * 1024, nullptr, 1.f};
            jobs[l * 4 + 1] = TrJob{args.in[I_WOUT] + (size_t)l * 1024 * 1024, nullptr, 1024, 1024, 64, 0, Wout + (size_t)l * 1024 * 1024, nullptr, 1.f};
            jobs[l * 4 + 2] = TrJob{args.in[I_WUQ] + (size_t)l * 512 * 576, nullptr, 576, 512, 36, 2, Wuq + (size_t)l * 768 * 512, args.in[I_QNW] + l * 512, 0.10206207261596577f * LOG2E};
            jobs[l * 4 + 3] = TrJob{args.in[I_WUKV] + (size_t)l * 256 * 768, nullptr, 768, 256, 48, 0, Wukv + (size_t)l * 768 * 256, args.in[I_KVNW] + l * 256, 1.f};
        }
        jobs[8] = TrJob{args.in[I_F1], args.in[I_F3], 2816, 1024, 352, 3, Wf13, nullptr, 1.f};
        jobs[9] = TrJob{args.in[I_F2], nullptr, 1024, 2816, 64, 0, Wf2, nullptr, 1.f};
        int total = 0;
#pragma unroll
        for (int q = 0; q < 10; ++q) total += tr_job_count(jobs[q]);
        { auto resolve = [&](int it, TrItem& T) { int r = it;
#pragma unroll
              for (int q = 0; q < 10; ++q) { const int n = tr_job_count(jobs[q]); if (r >= 0 && r < n) tr_resolve(jobs[q], r, lane, T); r -= n; } };
          tr_run(gw, NGW, total, resolve, scr, lane); }
        for (int item = blockIdx.x; item < 192; item += G) mod_item((LAS char*)lds + 40960, wid0, item, args.in[I_C], args.in[I_CCTX], args.in[I_ADAW], args.in[I_ADAB], modv);
        if (blockIdx.x == 0) { const int pos = tid >> 3, jj = tid & 7; const float inv = powf(10000.0f, -(float)jj / 8.0f); const float a = (float)pos * inv; ropet[pos * 8 + jj] = cosf(a); ropet[512 + pos * 8 + jj] = sinf(a); }
    }
    SEAM(0);

    layer_phases<0>(args, lds, G, NGW, bar, lo, hi_ph, wid0);
    layer_phases<1>(args, lds, G, NGW, bar, lo, hi_ph, wid0);
    if (EN(14) && IN(23)) { PHASE_IDS();
        const float* nw = args.in[I_FNW]; const float* g5 = modv + (size_t)9 * 6144 + 5 * 1024;
        for (int r = gw; r < ML; r += NGW) { float* xr = xout + (size_t)r * D; f32x4 v[4]; float s = 0.f;
            const int p0 = tokinfo[(size_t)r * 4 + 2], p1 = tokinfo[(size_t)r * 4 + 3]; const float g0 = tokg[(size_t)r * 2], g1 = tokg[(size_t)r * 2 + 1];
            const float* gp = g5 + (size_t)(r >> 12) * 6144;
            auto yload = [&](int pos, int c) -> f32x4 { f32x4 y = {0.f, 0.f, 0.f, 0.f};
                if (pos < 65536) { const u32x2 a = *(const u32x2*)(ASORT + (size_t)pos * D + c); y.x = bf2f(a.x & 0xffffu); y.y = __uint_as_float(a.x & 0xffff0000u); y.z = bf2f(a.y & 0xffffu); y.w = __uint_as_float(a.y & 0xffff0000u); }
                else { for (int p = 0; p < 11; ++p) { const u32x2 a = *(const u32x2*)(PBY + ((size_t)p * 7 * 256 + (pos - 65536)) * D + c); y.x += bf2f(a.x & 0xffffu); y.y += __uint_as_float(a.x & 0xffff0000u); y.z += bf2f(a.y & 0xffffu); y.w += __uint_as_float(a.y & 0xffff0000u); } }
                return y; };
#pragma unroll
            for (int j = 0; j < 4; ++j) { const int c = 4 * lane + 256 * j; v[j] = *(const f32x4*)(xr + c); const f32x4 gg = *(const f32x4*)(gp + c);
                const f32x4 ya = yload(p0, c), yb = yload(p1, c);
                v[j] += gg * (ya * g0 + yb * g1);
                s += (v[j].x * v[j].x + v[j].y * v[j].y) + (v[j].z * v[j].z + v[j].w * v[j].w); }
            const float rs = 1.0f / sqrtf(wave_sum(s) * (1.0f / D) + EPS);
#pragma unroll
            for (int j = 0; j < 4; ++j) { const f32x4 w = *(const f32x4*)(nw + 4 * lane + 256 * j); *(f32x4*)(xr + 4 * lane + 256 * j) = v[j] * rs * w; } }
    }
}

extern "C" void kernel_launch(void* const* d_in, const int* in_sizes, int n_in, void* d_out, int out_size, void* d_ws, size_t ws_size, hipStream_t stream) {
    static int grid = 0;
    if (grid == 0) {
        if (n_in != 27 || out_size != ML * D || ws_size < WS_END) { fprintf(stderr, "kernel_launch: unexpected sizes (n_in %d out %d ws %zu need %zu)\n", n_in, out_size, ws_size, (size_t)WS_END); grid = -1; return; }
        int dev = 0, cus = 0;
        if (hipGetDevice(&dev) != hipSuccess || hipDeviceGetAttribute(&cus, hipDeviceAttributeMultiprocessorCount, dev) != hipSuccess) { grid = -1; return; }
        if (hipFuncSetAttribute((const void*)mega_fwd, hipFuncAttributeMaxDynamicSharedMemorySize, LDS_BYTES) != hipSuccess) { fprintf(stderr, "kernel_launch: hipFuncSetAttribute failed\n"); grid = -1; return; }
        int per_cu = 0;
        if (hipOccupancyMaxActiveBlocksPerMultiprocessor(&per_cu, (const void*)mega_fwd, 512, LDS_BYTES) != hipSuccess || per_cu < 1) fprintf(stderr, "kernel_launch: occupancy query says %d\n", per_cu);
        (void)hipGetLastError();
        grid = cus;
    }
    if (grid < 0) return;
    if (hipMemsetAsync((char*)d_ws + WS_CTL, 0, CTL_ZERO_BYTES, stream) != hipSuccess) return;
    Args a{};
    for (int i = 0; i < 27; ++i) a.in[i] = (const float*)d_in[i];
    a.out = (float*)d_out; a.ws = (unsigned char*)d_ws;
#if MK_MULTI
#ifndef MK_DUP0
#define MK_DUP0 -1
#endif
#ifndef MK_DUP1
#define MK_DUP1 -1
#endif
    for (int ph = 0; ph < NPHASE; ++ph) { a.ph_lo = ph; a.ph_hi = ph + 1; const int reps = (ph == MK_DUP0 || ph == MK_DUP1) ? 2 : 1;
        for (int r = 0; r < reps; ++r) hipLaunchKernelGGL(mega_fwd, dim3(grid), dim3(512), LDS_BYTES, stream, a); }
#else
    a.ph_lo = 0; a.ph_hi = NPHASE;
    hipLaunchKernelGGL(mega_fwd, dim3(grid), dim3(512), LDS_BYTES, stream, a);
#endif
}
```

```cpp
#include <hip/hip_runtime.h>
#include <stdint.h>
#include <stdio.h>

#ifndef MK_MULTI
#define MK_MULTI 0
#endif

#define LAS __attribute__((address_space(3)))
#define GAS __attribute__((address_space(1)))
typedef unsigned short bf16_t;
typedef short bf16x8 __attribute__((ext_vector_type(8)));
typedef short s16x4 __attribute__((ext_vector_type(4)));
typedef float f32x2 __attribute__((ext_vector_type(2)));
typedef float f32x4 __attribute__((ext_vector_type(4)));
typedef float f32x16 __attribute__((ext_vector_type(16)));
typedef unsigned u32x2 __attribute__((ext_vector_type(2)));
typedef unsigned u32x4 __attribute__((ext_vector_type(4)));
typedef __bf16 bf16x2_t __attribute__((ext_vector_type(2)));

constexpr int NB = 8, T = 4096, D = 1024, NC = 256;
constexpr int ML = NB * T, MC = NB * NC, M = ML + MC;
constexpr int NP = 3072;
constexpr int PC_QL = 0, PC_KVL = 512, PC_MQ = 768, PC_MK = 1024, PC_MV = 1280, PC_MO = 1536, PC_NQ = 1792, PC_NK = 2176, PC_NV = 2560, PC_KR = 2944, PC_GT = 2976;
constexpr int NQM = 576, NKVM = 768;
constexpr int DFF = 2816, NEXP = 8;
constexpr int NCHK = 68;
constexpr float LOG2E = 1.4426950408889634f;
constexpr float EPS = 1e-6f;

constexpr size_t MiB = 1u << 20;
constexpr size_t WS_CTL = 0, CTL_ZERO_BYTES = 1 * MiB;
constexpr size_t WS_SMALL = 1 * MiB;
constexpr size_t SM_MOD = WS_SMALL;
constexpr size_t SM_ROPE = SM_MOD + 2 * 9 * 6144 * 4;
constexpr size_t SM_STATS = WS_SMALL + 1 * MiB;
constexpr size_t SM_NLOC = WS_SMALL + 5 * MiB;
constexpr size_t SM_NIN = WS_SMALL + 7 * MiB;
constexpr size_t SM_MG = WS_SMALL + 9 * MiB;
constexpr size_t SM_MIN = SM_MG + 256 * 1024;
constexpr size_t SM_TOK = WS_SMALL + 10 * MiB;
constexpr size_t SM_TOKG = SM_TOK + (size_t)ML * 16;
constexpr size_t SM_WGCNT = WS_SMALL + 11 * MiB;
constexpr size_t SM_ROWTOK = SM_WGCNT + 64 * 1024;
constexpr size_t SM_ROWGATE = SM_ROWTOK + (size_t)2 * M * 4;
constexpr size_t SM_TILEEXP = SM_ROWGATE + (size_t)2 * M * 4;
constexpr size_t WS_WSMALL = 17 * MiB;
constexpr size_t W_IN = WS_WSMALL;
constexpr size_t W_OUT = W_IN + (size_t)2 * 3072 * 1024 * 2;
constexpr size_t W_UQ = W_OUT + (size_t)2 * 1024 * 1024 * 2;
constexpr size_t W_UKV = W_UQ + (size_t)2 * 768 * 512 * 2;
constexpr size_t W_F13 = W_UKV + (size_t)2 * 768 * 256 * 2;
constexpr size_t W_F2 = W_F13 + (size_t)5632 * 1024 * 2;
constexpr size_t WS_XC = 52 * MiB;
constexpr size_t WS_H = 60 * MiB;
constexpr size_t WS_P = 128 * MiB;
constexpr size_t WS_QM = 332 * MiB;
constexpr size_t WS_KVM = 371 * MiB;
constexpr size_t WS_CIN = 422 * MiB;
constexpr size_t WS_END_MIX = 456 * MiB;
constexpr size_t WS_WMOE = 17 * MiB;
constexpr size_t WMOE_E = (size_t)5632 * 1024 * 2 + (size_t)1024 * 2816 * 2;
constexpr size_t WS_U = 149 * MiB;
constexpr size_t WS_ASORT = 336 * MiB;
constexpr size_t WS_PBY = 472 * MiB;
constexpr size_t WS_END = 516 * MiB;
constexpr size_t WS_PBF = WS_QM;
constexpr size_t WS_PBW = WS_KVM;
static_assert(W_F2 + (size_t)1024 * 2816 * 2 <= WS_XC, "weights");
static_assert(WS_H + (size_t)M * 1024 * 2 <= WS_P && WS_P + (size_t)M * NP * 2 <= WS_QM && WS_QM + (size_t)M * NQM * 2 <= WS_KVM && WS_KVM + (size_t)M * NKVM * 2 <= WS_CIN, "map");
static_assert(WS_CIN + (size_t)2 * 8 * 4 * NCHK * 4096 * 2 <= WS_END_MIX, "map2");
static_assert(WS_WMOE + 8 * WMOE_E <= WS_U && WS_U + (size_t)M * DFF * 2 <= WS_ASORT && WS_ASORT + (size_t)2 * M * 1024 * 2 <= WS_PBY && WS_PBY + (size_t)11 * 7 * 256 * 1024 * 2 <= WS_END, "map3");
static_assert((size_t)2 * 8 * 4 * NCHK * 4096 * 4 <= (size_t)M * 1024 * 2, "C_LOC overlays BUF_H");
static_assert(SM_TILEEXP + 4096 <= WS_WSMALL && SM_TOKG + (size_t)ML * 8 <= SM_WGCNT && SM_STATS + (size_t)M * 24 * 4 <= SM_NLOC, "small map");

constexpr int CW_BAR = 4096;
constexpr int CW_QUEUE = 8192;
constexpr int CW_REDO2 = 8192 + 2048;
constexpr int CW_REDO = 8192 + 256;

constexpr int LDS_BYTES = 155648;
constexpr int LDS_MISC = 155648 - 256;

#define LDS_WAIT() asm volatile("s_waitcnt lgkmcnt(0)" ::: "memory")
#define VM_WAIT() asm volatile("s_waitcnt vmcnt(0)" ::: "memory")
__device__ __forceinline__ float bf2f(unsigned v) { return __uint_as_float(v << 16); }
__device__ __forceinline__ unsigned pk2(float lo, float hi) { f32x2 v = {lo, hi}; bf16x2_t b = __builtin_convertvector(v, bf16x2_t); return __builtin_bit_cast(unsigned, b); }
__device__ __forceinline__ void unpack8(const u32x4 w, float* f) {
    f[0] = __uint_as_float(w.x << 16); f[1] = __uint_as_float(w.x & 0xffff0000u); f[2] = __uint_as_float(w.y << 16); f[3] = __uint_as_float(w.y & 0xffff0000u);
    f[4] = __uint_as_float(w.z << 16); f[5] = __uint_as_float(w.z & 0xffff0000u); f[6] = __uint_as_float(w.w << 16); f[7] = __uint_as_float(w.w & 0xffff0000u);
}
__device__ __forceinline__ u32x4 pack8(const float* f) { u32x4 w; w.x = pk2(f[0], f[1]); w.y = pk2(f[2], f[3]); w.z = pk2(f[4], f[5]); w.w = pk2(f[6], f[7]); return w; }
__device__ __forceinline__ float wave_sum(float v) {
#pragma unroll
    for (int o = 1; o < 64; o <<= 1) v += __shfl_xor(v, o);
    return v;
}
__device__ __forceinline__ float wave_max(float v) {
#pragma unroll
    for (int o = 1; o < 64; o <<= 1) v = fmaxf(v, __shfl_xor(v, o));
    return v;
}
__device__ __forceinline__ float fexp2(float x) { return __builtin_amdgcn_exp2f(x); }
__device__ __forceinline__ float fexp(float x) { return __builtin_amdgcn_exp2f(x * LOG2E); }
__device__ __forceinline__ float frcp(float x) { return __builtin_amdgcn_rcpf(x); }
__device__ __forceinline__ float silu_f(float x) { return x * frcp(1.0f + fexp(-x)); }
__device__ __forceinline__ float sigmoid_f(float x) { return frcp(1.0f + fexp(-x)); }
__device__ __forceinline__ int fresh_lane() { int l; asm volatile("v_mbcnt_lo_u32_b32 %0, -1, 0\n\tv_mbcnt_hi_u32_b32 %0, -1, %0" : "=v"(l)); return l; }
__device__ __forceinline__ float xhalf(float v) { return __shfl_xor(v, 32); }
__device__ __forceinline__ float half_max(float v) { auto rr = __builtin_amdgcn_permlane32_swap(__float_as_uint(v), __float_as_uint(v), false, false); return fmaxf(__uint_as_float(rr[0]), __uint_as_float(rr[1])); }
__device__ __forceinline__ float half_sum(float v) { auto rr = __builtin_amdgcn_permlane32_swap(__float_as_uint(v), __float_as_uint(v), false, false); return __uint_as_float(rr[0]) + __uint_as_float(rr[1]); }

namespace pg8 {
constexpr int BM = 256, BK = 64, HALF = 128, HTB = HALF * BK * 2, STAGE_BYTES = 8 * HTB, NXCD = 8, WGM = 8;
__host__ __device__ __forceinline__ int lds_byte(int r, int c) { const int st = (r >> 4) * 2 + (c >> 5), rr = r & 15, cc = c & 31, ob = rr * 64 + cc * 2; return st * 1024 + (ob ^ (((ob >> 9) & 1) << 5)); }
__host__ __device__ __forceinline__ void stage_rc(int b, int& R, int& C) { const int st = b / 1024, sb = b % 1024, swz = sb ^ (((sb >> 9) & 1) << 5); R = (st >> 1) * 16 + swz / 64; C = (st & 1) * 32 + (swz % 64) / 2; }
__host__ __device__ __forceinline__ int perm32(int rho) { const int n = rho >> 4, i = rho & 15; return 8 * (i >> 2) + 4 * n + (i & 3); }

struct Unit { int pm, pn, kb, ke, part; };
struct Gemm { const bf16_t* A; int lda; const bf16_t* Bt; int K; };

struct StaticOrder {
    int nM, nN, nwg, G, c, nt;
    __device__ void init(int nM_, int nN_, int G_, int c_, int K_) { nM = nM_; nN = nN_; nwg = nM * nN; G = G_; c = c_; nt = K_ / BK; }
    __device__ __forceinline__ void tile_of(int L, Unit& u) const {
        int wgid = L; { const int q = nwg / NXCD, r = nwg % NXCD, xcd = wgid % NXCD, off = wgid / NXCD; wgid = (xcd < r ? xcd * (q + 1) : r * (q + 1) + (xcd - r) * q) + off; }
        const int nig = WGM * nN, gid = wgid / nig, fm = gid * WGM, gsz = (nM - fm) < WGM ? (nM - fm) : WGM;
        u.pm = fm + ((wgid % nig) % gsz); u.pn = (wgid % nig) / gsz;
    }
    __device__ bool next(int i, Unit& u) const {
        const long L = (long)i * G + c; if (L >= nwg) return false;
        tile_of((int)L, u); u.kb = 0; u.ke = nt; u.part = -1; return true;
    }
    __device__ __forceinline__ const char* a_base(const Gemm& g, const Unit& u) const { return (const char*)g.A + (size_t)u.pm * 256 * g.lda * 2 + (size_t)u.kb * (BK * 2); }
    __device__ __forceinline__ const char* b_base(const Gemm& g, const Unit& u) const { return (const char*)g.Bt + (size_t)u.pn * 256 * g.K * 2 + (size_t)u.kb * (BK * 2); }
};
struct GroupedOrder : StaticOrder {
    const int* tile_exp; size_t estride;
    __device__ __forceinline__ const char* b_base(const Gemm& g, const Unit& u) const { return (const char*)g.Bt + (size_t)tile_exp[u.pm] * estride + (size_t)u.pn * 256 * g.K * 2 + (size_t)u.kb * (BK * 2); }
};
template <class Base> struct TailSplit : Base {
    int nMain, nTail, S;
    __device__ void init_ts(int nMain_, int nTail_, int S_) { nMain = nMain_; nTail = nTail_ < 0 ? 0 : nTail_; S = S_; this->nM = nMain; this->nwg = nMain * this->nN; }
    __device__ bool next(int i, Unit& u) const {
        const long L = (long)i * this->G + this->c;
        if (L < this->nwg) { this->tile_of((int)L, u); u.kb = 0; u.ke = this->nt; u.part = -1; return true; }
        const long j = L - this->nwg; const int ntu = nTail * this->nN;
        if (j >= (long)ntu * S) return false;
        const int t = (int)(j % ntu), p = (int)(j / ntu), np = this->nt / 2;
        u.pm = nMain + t / this->nN; u.pn = t % this->nN; u.kb = 2 * (p * np / S); u.ke = 2 * ((p + 1) * np / S); u.part = p; return true;
    }
};

__device__ __forceinline__ unsigned cvt_pk_bf16(float lo, float hi) { unsigned r; asm volatile("v_cvt_pk_bf16_f32 %0, %1, %2" : "=v"(r) : "v"(lo), "v"(hi)); return r; }

template <class Epi, class Sched, bool ALIGN_EPI>
__device__ __forceinline__ void gemm_phase(LAS unsigned char* lds, const Gemm g, const Sched& S, const Epi& E, const int wid0) {
    const int lane = fresh_lane(), wid = wid0, tid = wid * 64 + lane,
    wr = wid >> 2, wc = wid & 3, fr = lane & 15, fq = lane >> 4;
    const int K = g.K;
    unsigned voffA[2], voffB[2];
#pragma unroll
    for (int i = 0; i < 2; ++i) { int R, C; stage_rc(tid * 16 + i * 8192, R, C); const int Rb = Epi::PERM ? ((R & ~31) + perm32(R & 31)) : R;
        voffA[i] = (unsigned)(R * g.lda + C) * 2u; voffB[i] = (unsigned)(Rb * K + C) * 2u; }
    const size_t kstep = (size_t)(BK * 2);
    const size_t hsA = (size_t)HALF * g.lda * 2, hsB = (size_t)HALF * K * 2;
    const unsigned ldsw = (unsigned)wid * 1024u;
    const int aoff = lds_byte(wr * 64 + fr, fq * 8), boff = lds_byte(wc * 32 + fr, fq * 8);
#define PG8_SA(b, h) (((b) * 2 + (h)) * HTB)
#define PG8_SB(b, h) ((4 + (b) * 2 + (h)) * HTB)
#define PG8_STAGE(bufoff, gbase, voff) do { _Pragma("unroll") for (int _i = 0; _i < 2; ++_i) \
        __builtin_amdgcn_global_load_lds((const unsigned*)((const char*)(gbase) + (voff)[_i]), (LAS unsigned*)(lds + (bufoff) + ldsw + _i * 8192), 16, 0, 0); } while (0)
#define PG8_LDA(dst, b, h) do { _Pragma("unroll") for (int m = 0; m < 4; ++m) _Pragma("unroll") for (int k = 0; k < 2; ++k) dst[m][k] = *(const LAS bf16x8*)(lds + PG8_SA(b, h) + aoff + m * 2048 + k * 1024); } while (0)
#define PG8_LDB(dst, b, h) do { _Pragma("unroll") for (int n = 0; n < 2; ++n) _Pragma("unroll") for (int k = 0; k < 2; ++k) dst[n][k] = *(const LAS bf16x8*)(lds + PG8_SB(b, h) + boff + n * 2048 + k * 1024); } while (0)
#define PG8_MMA(ai, bj, At, Bt) do { __builtin_amdgcn_s_setprio(1); _Pragma("unroll") for (int m = 0; m < 4; ++m) _Pragma("unroll") for (int n = 0; n < 2; ++n) _Pragma("unroll") for (int k = 0; k < 2; ++k) \
        acc[ai][bj][m][n] = __builtin_amdgcn_mfma_f32_16x16x32_bf16(Bt[n][k], At[m][k], acc[ai][bj][m][n], 0, 0, 0); __builtin_amdgcn_s_setprio(0); } while (0)
#define PG8_WAIT_V(n) asm volatile("s_waitcnt vmcnt(" #n ")" ::: "memory")
#define PG8_WAIT_L(n) asm volatile("s_waitcnt lgkmcnt(" #n ")" ::: "memory")
#define PG8_BAR __builtin_amdgcn_s_barrier()
#define PG8_SCHED __builtin_amdgcn_sched_barrier(0)
    Unit cur, nxt; int ui = 0;
    if (!S.next(0, cur)) return;
    f32x4 acc[2][2][4][2];
#pragma unroll
    for (int a = 0; a < 2; ++a)
#pragma unroll
        for (int b = 0; b < 2; ++b)
#pragma unroll
            for (int m = 0; m < 4; ++m)
#pragma unroll
                for (int n = 0; n < 2; ++n) acc[a][b][m][n] = (f32x4){0.f, 0.f, 0.f, 0.f};
    bf16x8 At[4][2], B0[2][2], B1[2][2];
    const char* cA = S.a_base(g, cur); const char* cB = S.b_base(g, cur);
    PG8_STAGE(PG8_SB(0, 0), cB, voffB); PG8_STAGE(PG8_SB(0, 1), cB + hsB, voffB); PG8_STAGE(PG8_SA(0, 0), cA, voffA); PG8_STAGE(PG8_SA(0, 1), cA + hsA, voffA);
    if (wr == 1) PG8_BAR;
    PG8_WAIT_V(2); PG8_BAR;
    PG8_STAGE(PG8_SB(1, 0), cB + kstep, voffB); PG8_STAGE(PG8_SA(1, 0), cA + kstep, voffA); PG8_STAGE(PG8_SB(1, 1), cB + hsB + kstep, voffB);
    PG8_WAIT_V(6); PG8_BAR;
    for (;;) {
        const bool has_next = S.next(ui + 1, nxt);
        const char* nA = has_next ? S.a_base(g, nxt) : cA; const char* nB = has_next ? S.b_base(g, nxt) : cB;
        const int ntc = cur.ke - cur.kb;
#pragma unroll 1
        for (int t = 0; t < ntc; t += 2) {
            const bool last = (t == ntc - 2);
            const char* a1 = cA + (size_t)(t + 1) * kstep;
            const char* a2 = last ? nA : cA + (size_t)(t + 2) * kstep; const char* b2 = last ? nB : cB + (size_t)(t + 2) * kstep;
            const char* a3 = a2 + kstep; const char* b3 = b2 + kstep;
            PG8_LDB(B0, 0, 0); PG8_LDB(B1, 0, 1); PG8_SCHED; PG8_LDA(At, 0, 0); PG8_STAGE(PG8_SA(1, 1), a1 + hsA, voffA);
            PG8_WAIT_V(8); PG8_WAIT_L(0); PG8_BAR; PG8_MMA(0, 0, At, B0); PG8_MMA(0, 1, At, B1); PG8_BAR; PG8_SCHED;
            PG8_LDA(At, 0, 1); PG8_STAGE(PG8_SB(0, 0), b2, voffB); PG8_STAGE(PG8_SB(0, 1), b2 + hsB, voffB); PG8_STAGE(PG8_SA(0, 0), a2, voffA);
            PG8_WAIT_V(8); PG8_WAIT_L(0); PG8_BAR; PG8_MMA(1, 0, At, B0); PG8_MMA(1, 1, At, B1); PG8_BAR; PG8_SCHED;
            PG8_LDB(B0, 1, 0); PG8_LDB(B1, 1, 1); PG8_SCHED; PG8_LDA(At, 1, 0); PG8_STAGE(PG8_SA(0, 1), a2 + hsA, voffA);
            PG8_WAIT_V(8); PG8_WAIT_L(0); PG8_BAR; PG8_MMA(0, 0, At, B0); PG8_MMA(0, 1, At, B1); PG8_BAR; PG8_SCHED;
            PG8_LDA(At, 1, 1); PG8_STAGE(PG8_SB(1, 0), b3, voffB); PG8_STAGE(PG8_SB(1, 1), b3 + hsB, voffB); PG8_STAGE(PG8_SA(1, 0), a3, voffA);
            PG8_WAIT_V(8); PG8_WAIT_L(0); PG8_BAR; PG8_MMA(1, 0, At, B0); PG8_MMA(1, 1, At, B1); PG8_BAR; PG8_SCHED;
        }
        if constexpr (ALIGN_EPI) { if (wr == 0) PG8_BAR; }
        E(acc, cur, wr, wc, fr, fq);
        if (!has_next) break;
#pragma unroll
        for (int a = 0; a < 2; ++a)
#pragma unroll
            for (int b = 0; b < 2; ++b)
#pragma unroll
                for (int m = 0; m < 4; ++m)
#pragma unroll
                    for (int n = 0; n < 2; ++n) acc[a][b][m][n] = (f32x4){0.f, 0.f, 0.f, 0.f};
        cur = nxt; cA = nA; cB = nB; ++ui;
        if constexpr (ALIGN_EPI) { if (wr == 1) PG8_BAR; }
    }
    PG8_WAIT_V(0);
    if constexpr (!ALIGN_EPI) { if (wr == 0) PG8_BAR; }
    PG8_BAR;
#undef PG8_SA
#undef PG8_SB
#undef PG8_STAGE
#undef PG8_LDA
#undef PG8_LDB
#undef PG8_MMA
#undef PG8_WAIT_V
#undef PG8_WAIT_L
#undef PG8_BAR
#undef PG8_SCHED
}

typedef const f32x4 (&AccRef)[2][2][4][2];

__device__ __forceinline__ void rope8(f32x4& v0, f32x4& v1, int fq, int tpos, const float* tab) {
    const int pos = (fq < 2) ? (tpos >> 6) : (tpos & 63);
    const f32x4 c0 = *(const f32x4*)(tab + pos * 8), c1 = *(const f32x4*)(tab + pos * 8 + 4), s0 = *(const f32x4*)(tab + 512 + pos * 8), s1 = *(const f32x4*)(tab + 512 + pos * 8 + 4);
    f32x4 p0, p1;
#pragma unroll
    for (int j = 0; j < 4; ++j) { p0[j] = __shfl_xor(v0[j], 16); p1[j] = __shfl_xor(v1[j], 16); }
    const float sg = (fq & 1) ? 1.f : -1.f;
    v0 = v0 * c0 + sg * (p0 * s0); v1 = v1 * c1 + sg * (p1 * s1);
}

struct EpiP {
    static constexpr bool PERM = true;
    bf16_t* P; float* stats; const float* rope;
    __device__ __forceinline__ void operator()(AccRef acc, const Unit& u, int wr, int wc, int fr, int fq) const {
        const int row0 = u.pm * BM + wr * 64 + fr, col0 = u.pn * BM + wc * 32 + 8 * fq;
        const bool do_stats = u.pn < 3, do_rope = (u.pn == 11) && (wc == 0) && (u.pm < ML / 256);
#pragma unroll
        for (int ai = 0; ai < 2; ++ai)
#pragma unroll
            for (int m = 0; m < 4; ++m) { const int row = row0 + ai * HALF + m * 16; bf16_t* rowp = P + (size_t)row * NP + col0;
#pragma unroll
                for (int bj = 0; bj < 2; ++bj) { f32x4 v0 = acc[ai][bj][m][0], v1 = acc[ai][bj][m][1];
                    if (do_stats) { float ss = (v0[0] * v0[0] + v0[1] * v0[1]) + (v0[2] * v0[2] + v0[3] * v0[3]) + (v1[0] * v1[0] + v1[1] * v1[1]) + (v1[2] * v1[2] + v1[3] * v1[3]);
                        ss += __shfl_xor(ss, 16); ss += __shfl_xor(ss, 32);
                        if (fq == 0) stats[(size_t)row * 24 + u.pn * 8 + bj * 4 + wc] = ss; }
                    if (bj == 1 && do_rope) rope8(v0, v1, fq, row & (T - 1), rope);
                    u32x4 w; w.x = cvt_pk_bf16(v0[0], v0[1]); w.y = cvt_pk_bf16(v0[2], v0[3]); w.z = cvt_pk_bf16(v1[0], v1[1]); w.w = cvt_pk_bf16(v1[2], v1[3]);
                    *(u32x4*)(rowp + bj * HALF) = w; } }
    }
};
template <bool ROPE> struct EpiRS {
    static constexpr bool PERM = true;
    bf16_t* O; int ldc, ncols, rope_c0; const float* stats; int part0, nparts; float invk; const float* rope;
    __device__ __forceinline__ void operator()(AccRef acc, const Unit& u, int wr, int wc, int fr, int fq) const {
        const int row0 = u.pm * BM + wr * 64 + fr, col0 = u.pn * BM + wc * 32 + 8 * fq;
        const int npl = nparts >> 2;
#pragma unroll
        for (int ai = 0; ai < 2; ++ai)
#pragma unroll
            for (int m = 0; m < 4; ++m) { const int row = row0 + ai * HALF + m * 16; bf16_t* rowp = O + (size_t)row * ldc + col0;
                const float* sp = stats + (size_t)row * 24 + part0 + fq * npl; float ss = sp[0] + sp[1]; if (npl == 4) ss += sp[2] + sp[3];
                ss += __shfl_xor(ss, 16); ss += __shfl_xor(ss, 32);
                const float rs = 1.0f / sqrtf(ss * invk + EPS);
#pragma unroll
                for (int bj = 0; bj < 2; ++bj) { const int c = col0 + bj * HALF; f32x4 v0 = acc[ai][bj][m][0] * rs, v1 = acc[ai][bj][m][1] * rs;
                    if (ROPE) { const int cb = u.pn * BM + bj * HALF + wc * 32;
                        if (cb >= rope_c0 && cb < ncols && u.pm < ML / 256) rope8(v0, v1, fq, row & (T - 1), rope); }
                    if (c < ncols) { u32x4 w; w.x = cvt_pk_bf16(v0[0], v0[1]); w.y = cvt_pk_bf16(v0[2], v0[3]); w.z = cvt_pk_bf16(v1[0], v1[1]); w.w = cvt_pk_bf16(v1[2], v1[3]);
                        *(u32x4*)(rowp + bj * HALF) = w; } } }
    }
};
struct EpiDelta {
    static constexpr bool PERM = true;
    bf16_t* O; const float* gate; int gstride;
    bf16_t* Op; size_t pstride; int prow0;
    __device__ __forceinline__ void operator()(AccRef acc, const Unit& u, int wr, int wc, int fr, int fq) const {
        const int row0 = u.pm * BM + wr * 64 + fr - (u.part >= 0 ? prow0 : 0), col0 = u.pn * BM + wc * 32 + 8 * fq;
        bf16_t* const Ob = u.part >= 0 ? Op + (size_t)u.part * pstride : O;
        f32x4 gv[2][2];
#pragma unroll
        for (int bj = 0; bj < 2; ++bj)
#pragma unroll
            for (int n = 0; n < 2; ++n) gv[bj][n] = gate ? *(const f32x4*)(gate + (size_t)(u.pm < ML / 256 ? (u.pm >> 4) : 8) * gstride + col0 + bj * HALF + 4 * n) : (f32x4){1.f, 1.f, 1.f, 1.f};
#pragma unroll
        for (int ai = 0; ai < 2; ++ai)
#pragma unroll
            for (int m = 0; m < 4; ++m) { bf16_t* rowp = Ob + (size_t)(row0 + ai * HALF + m * 16) * D + col0;
#pragma unroll
                for (int bj = 0; bj < 2; ++bj) { const f32x4 v0 = acc[ai][bj][m][0] * gv[bj][0], v1 = acc[ai][bj][m][1] * gv[bj][1];
                    u32x4 w; w.x = cvt_pk_bf16(v0[0], v0[1]); w.y = cvt_pk_bf16(v0[2], v0[3]); w.z = cvt_pk_bf16(v1[0], v1[1]); w.w = cvt_pk_bf16(v1[2], v1[3]);
                    *(u32x4*)(rowp + bj * HALF) = w; } }
    }
};
struct EpiRes2 {
    static constexpr bool PERM = false;
    const float* xin; float* xout; const float* gate; int gstride; bf16_t* Op; size_t pstride; int prow0;
    __device__ __forceinline__ void operator()(AccRef acc, const Unit& u, int wr, int wc, int fr, int fq) const {
        const int row0 = u.pm * BM + wr * 64 + fr, col0 = u.pn * BM + wc * 32 + 4 * fq;
        const float* gp = gate + (size_t)(u.pm < ML / 256 ? (u.pm >> 4) : 8) * gstride + col0;
        f32x4 gv[2][2];
#pragma unroll
        for (int bj = 0; bj < 2; ++bj)
#pragma unroll
            for (int n = 0; n < 2; ++n) gv[bj][n] = *(const f32x4*)(gp + bj * HALF + n * 16);
        if (u.part < 0) {
#pragma unroll
            for (int ai = 0; ai < 2; ++ai)
#pragma unroll
                for (int m = 0; m < 4; ++m) { const size_t off = (size_t)(row0 + ai * HALF + m * 16) * D + col0;
#pragma unroll
                    for (int bj = 0; bj < 2; ++bj)
#pragma unroll
                        for (int n = 0; n < 2; ++n) { const f32x4 xv = *(const f32x4*)(xin + off + bj * HALF + n * 16); *(f32x4*)(xout + off + bj * HALF + n * 16) = xv + gv[bj][n] * acc[ai][bj][m][n]; } }
        } else { bf16_t* ob = Op + (size_t)u.part * pstride;
#pragma unroll
            for (int ai = 0; ai < 2; ++ai)
#pragma unroll
                for (int m = 0; m < 4; ++m) { const size_t off = (size_t)(row0 - prow0 + ai * HALF + m * 16) * D + col0;
#pragma unroll
                    for (int bj = 0; bj < 2; ++bj)
#pragma unroll
                        for (int n = 0; n < 2; ++n) { const f32x4 y = gv[bj][n] * acc[ai][bj][m][n]; u32x2 w; w.x = cvt_pk_bf16(y[0], y[1]); w.y = cvt_pk_bf16(y[2], y[3]); *(u32x2*)(ob + off + bj * HALF + n * 16) = w; } }
        }
    }
};
struct EpiSwiglu {
    static constexpr bool PERM = true;
    bf16_t* U; int ldc;
    __device__ __forceinline__ void operator()(AccRef acc, const Unit& u, int wr, int wc, int fr, int fq) const {
        const int row0 = u.pm * BM + wr * 64 + fr, col0 = u.pn * 128 + wc * 32 + 8 * fq;
#pragma unroll
        for (int ai = 0; ai < 2; ++ai)
#pragma unroll
            for (int m = 0; m < 4; ++m) { bf16_t* rowp = U + (size_t)(row0 + ai * HALF + m * 16) * ldc + col0; float o[8];
#pragma unroll
                for (int n = 0; n < 2; ++n)
#pragma unroll
                    for (int j = 0; j < 4; ++j) { const float a = acc[ai][0][m][n][j], b = acc[ai][1][m][n][j]; o[n * 4 + j] = silu_f(a) * b; }
                u32x4 w; w.x = cvt_pk_bf16(o[0], o[1]); w.y = cvt_pk_bf16(o[2], o[3]); w.z = cvt_pk_bf16(o[4], o[5]); w.w = cvt_pk_bf16(o[6], o[7]);
                *(u32x4*)rowp = w; }
    }
};
}

namespace att {
constexpr int VSLOT = 8192, NSLOT = 3;
constexpr int OFF_K = 0;
constexpr int OFF_V = NSLOT * 12 * 1024;
constexpr int OFF_WS = OFF_V + NSLOT * VSLOT;
constexpr int OFF_OST = OFF_WS + 8 * 512;
constexpr int OFF_BIAS = OFF_OST + 8 * 4096;
constexpr int LDS_END = OFF_BIAS + 640 * 4;
__device__ __forceinline__ int crow(int r, int hi) { return (r & 3) + 8 * (r >> 2) + 4 * hi; }
__device__ __forceinline__ void glds16(const void* gsrc, unsigned lds_dst) { unsigned keep;
    asm volatile("s_mov_b32 %0, m0\n\ts_mov_b32 m0, %2\n\ts_nop 0\n\tglobal_load_lds_dwordx4 %1, off\n\ts_mov_b32 m0, %0" : "=&s"(keep) : "v"(gsrc), "s"(lds_dst) : "memory"); }
__device__ __forceinline__ void glds16s(const void* sbase, unsigned voff, unsigned lds_dst) { unsigned keep;
    asm volatile("s_mov_b32 %0, m0\n\ts_mov_b32 m0, %3\n\ts_nop 0\n\tglobal_load_lds_dwordx4 %1, %2\n\ts_mov_b32 m0, %0" : "=&s"(keep) : "v"(voff), "s"(sbase), "s"(lds_dst) : "memory"); }
__device__ __forceinline__ s16x4 vtr(LAS const char* p) { typedef short v4i16_t __attribute__((ext_vector_type(4)));
    return __builtin_bit_cast(s16x4, __builtin_amdgcn_ds_read_tr16_b64_v4i16((LAS v4i16_t*)p)); }

struct Unit {
    const bf16_t* qn; int ldq;
    const bf16_t* qr; int ldqr;
    const bf16_t* kn; int ldk;
    const bf16_t* kr; int ldkr;
    const bf16_t* v; int ldv;
    bf16_t* o; int ldo;
    int na, rowa, rowc;
    int rg, rlo;
};

template <int NCH, bool NA, bool FAST = false>
__device__ __forceinline__ bool attn_unit(LAS char* lds, const Unit& U, const int wid0) {
    const int lane = fresh_lane(), r32 = lane & 31, hi = lane >> 5, wid = wid0, tid = wid * 64 + lane; (void)tid;
    constexpr int KSLOT = NCH * 1024;
    const unsigned lds0 = (unsigned)(uintptr_t)lds;
    LAS float* wsf = (LAS float*)(lds + OFF_WS) + wid * 128;
    const int NT = U.na + 4;
    bf16x8 qf[NCH / 2];
    { const bf16_t* qp = U.qn + (size_t)(wid * 32 + r32) * U.ldq + hi * 8;
#pragma unroll
      for (int d0 = 0; d0 < 4; ++d0) qf[d0] = *(const bf16x8*)(qp + d0 * 16);
      if constexpr (NCH == 12) { const bf16_t* qp2 = U.qr + (size_t)(wid * 32 + r32) * U.ldqr + hi * 8;
#pragma unroll
          for (int d0 = 0; d0 < 2; ++d0) qf[4 + d0] = *(const bf16x8*)(qp2 + d0 * 16); } }
#pragma unroll
    for (int d0 = 0; d0 < NCH / 2; ++d0) asm volatile("" : "+v"(qf[d0]));
    VM_WAIT();
    auto tile_row = [&](int it) -> int { return it < U.na ? U.rowa + 64 * it : U.rowc + 64 * (it - U.na); };
    auto dma = [&](int it, int slot) {
        const int row = tile_row(it);
        glds16(U.v + (size_t)(row + 16 * (wid & 3) + (lane >> 2)) * U.ldv + (wid >> 2) * 32 + (lane & 3) * 8, (unsigned)__builtin_amdgcn_readfirstlane(lds0 + OFF_V + slot * VSLOT + wid * 1024));
        glds16(U.kn + (size_t)(row + lane) * U.ldk + wid * 8, (unsigned)__builtin_amdgcn_readfirstlane(lds0 + OFF_K + slot * KSLOT + wid * 1024));
        if constexpr (NCH == 12) glds16(U.kr + (size_t)(row + lane) * U.ldkr + (wid & 3) * 8, (unsigned)__builtin_amdgcn_readfirstlane(lds0 + OFF_K + slot * KSLOT + (8 + (wid & 3)) * 1024));
    };
    constexpr int NPER = (NCH == 12) ? 3 : 2;
    dma(0, 0); dma(1, 1);
    float mrun = -INFINITY, lrun = 0.f; f32x16 o[2]; o[0] = f32x16{}; o[1] = f32x16{};
    f32x16 lacc = f32x16{}; const bf16x8 ones = (bf16x8){0x3f80, 0x3f80, 0x3f80, 0x3f80, 0x3f80, 0x3f80, 0x3f80, 0x3f80};
    const int grow = NA ? 4 * U.rg + (wid >> 1) : 0, qc = 32 * (wid & 1) + r32;
    const int r0w = NA ? min(max(grow - 4, 0), 56) : 0, c0w = min(max(qc - 8, 0), 48);
    LAS const float* btab = (LAS const float*)(lds + OFF_BIAS);
    const int vaddr = ((lane >> 4) & 1) * 32 + (lane & 3) * 8 + (4 * hi + ((lane & 15) >> 2)) * 64;
    int slot = 0;
    for (int it = 0; it < NT; ++it) {
        if (it + 1 < NT) { if constexpr (NPER == 3) asm volatile("s_waitcnt vmcnt(3)" ::: "memory"); else asm volatile("s_waitcnt vmcnt(2)" ::: "memory"); }
        else asm volatile("s_waitcnt vmcnt(0)" ::: "memory");
        asm volatile("s_barrier" ::: "memory");
        if (it + 2 < NT) { const int s2 = slot >= 1 ? slot - 1 : 2; dma(it + 2, s2); }
        bool active = true; int dr = 0;
        if constexpr (NA) { if (it < U.na) { const int krow = U.rlo + it; active = (krow >= r0w) && (krow < r0w + 8); dr = krow - grow + 7; } }
        if (active) {
            LAS const char* ks = lds + OFF_K + slot * KSLOT + r32 * 16; LAS const char* vs = lds + OFF_V + slot * VSLOT + vaddr;
            f32x16 p0 = f32x16{}, p1 = f32x16{};
            { bf16x8 kf0[NCH / 2], kf1[NCH / 2];
#pragma unroll
              for (int d0 = 0; d0 < NCH / 2; ++d0) { kf0[d0] = *(const LAS bf16x8*)(ks + (2 * d0 + hi) * 1024); kf1[d0] = *(const LAS bf16x8*)(ks + (2 * d0 + hi) * 1024 + 512); }
              __builtin_amdgcn_sched_barrier(0);
#pragma unroll
              for (int d0 = 0; d0 < NCH / 2; ++d0) { p0 = __builtin_amdgcn_mfma_f32_32x32x16_bf16(kf0[d0], qf[d0], p0, 0, 0, 0); p1 = __builtin_amdgcn_mfma_f32_32x32x16_bf16(kf1[d0], qf[d0], p1, 0, 0, 0); } }
            if constexpr (NA) { if (it < U.na) {
                LAS const float* bt = btab + 64 + dr * 31 + 15 - qc;
#pragma unroll
                for (int r = 0; r < 16; ++r) { const int kc = crow(r, hi);
                    p0[r] = ((unsigned)(kc - c0w) < 16u) ? p0[r] + bt[kc] : -INFINITY;
                    p1[r] = ((unsigned)(kc + 32 - c0w) < 16u) ? p1[r] + bt[kc + 32] : -INFINITY; } } }
            if constexpr (FAST) {
#pragma unroll
                for (int r = 0; r < 16; ++r) { p0[r] = fexp2(p0[r]); p1[r] = fexp2(p1[r]); }
            } else {
            float mx = fmaxf(p0[0], p1[0]);
#pragma unroll
            for (int r = 1; r < 16; ++r) mx = fmaxf(mx, fmaxf(p0[r], p1[r]));
            mx = half_max(mx);
            const float mnew = fmaxf(mrun, mx);
            if (__any(mnew > mrun)) {
                const float alpha = fexp2(mrun - mnew);
                lrun *= alpha; if (hi == 0) wsf[r32] = alpha; LDS_WAIT();
#pragma unroll
                for (int r = 0; r < 16; ++r) { const float a = wsf[crow(r, hi)]; o[0][r] *= a; o[1][r] *= a; }
                mrun = mnew;
            }
            float ls = 0.f;
#pragma unroll
            for (int r = 0; r < 16; ++r) { p0[r] = fexp2(p0[r] - mrun); p1[r] = fexp2(p1[r] - mrun); ls += p0[r] + p1[r]; }
            lrun += ls;
            }
            u32x4 pw[4];
#pragma unroll
            for (int j = 0; j < 4; ++j) { pw[0][j] = pk2(p0[2 * j], p0[2 * j + 1]); pw[1][j] = pk2(p0[8 + 2 * j], p0[9 + 2 * j]); pw[2][j] = pk2(p1[2 * j], p1[2 * j + 1]); pw[3][j] = pk2(p1[8 + 2 * j], p1[9 + 2 * j]); }
#pragma unroll
            for (int k = 0; k < 4; ++k)
#pragma unroll
                for (int db = 0; db < 2; ++db) { const s16x4 lo = vtr(vs + db * 4096 + k * 1024), h4 = vtr(vs + db * 4096 + k * 1024 + 512);
                    const bf16x8 vf = (bf16x8){lo[0], lo[1], lo[2], lo[3], h4[0], h4[1], h4[2], h4[3]};
                    o[db] = __builtin_amdgcn_mfma_f32_32x32x16_bf16(__builtin_bit_cast(bf16x8, pw[k]), vf, o[db], 0, 0, 0);
                    if (FAST && db == 1) lacc = __builtin_amdgcn_mfma_f32_32x32x16_bf16(__builtin_bit_cast(bf16x8, pw[k]), ones, lacc, 0, 0, 0); }
        }
        slot = slot == 2 ? 0 : slot + 1;
    }
    LAS bf16_t* stg = (LAS bf16_t*)(lds + OFF_OST) + wid * 2048;
    if constexpr (FAST) {
        bool bad = false;
#pragma unroll
        for (int r = 0; r < 16; ++r) bad |= !(lacc[r] > 1e-30f && lacc[r] < 1e30f);
        LAS int* gf = (LAS int*)(lds + OFF_OST);
        asm volatile("s_waitcnt lgkmcnt(0)\n\ts_barrier" ::: "memory");
        const int ab = __any(bad) ? 1 : 0; if (lane == 0) gf[wid] = ab;
        asm volatile("s_waitcnt lgkmcnt(0)\n\ts_barrier" ::: "memory");
        int anyb = 0;
#pragma unroll
        for (int w = 0; w < 8; ++w) anyb |= gf[w];
        asm volatile("s_waitcnt lgkmcnt(0)\n\ts_barrier" ::: "memory");
        if (__builtin_amdgcn_readfirstlane(anyb)) return false;
#pragma unroll
        for (int r = 0; r < 16; ++r) { const int orow = crow(r, hi); const float il = frcp(lacc[r]);
#pragma unroll
            for (int db = 0; db < 2; ++db) stg[orow * 64 + db * 32 + r32] = (bf16_t)(pk2(o[db][r] * il, 0.f) & 0xffffu); }
    } else {
        lrun = half_sum(lrun);
        if (hi == 0) wsf[32 + r32] = frcp(lrun); LDS_WAIT();
#pragma unroll
        for (int r = 0; r < 16; ++r) { const int orow = crow(r, hi); const float il = wsf[32 + orow];
#pragma unroll
            for (int db = 0; db < 2; ++db) stg[orow * 64 + db * 32 + r32] = (bf16_t)(pk2(o[db][r] * il, 0.f) & 0xffffu); }
    }
    LDS_WAIT();
    bf16_t* Ow = U.o + (size_t)(wid * 32) * U.ldo;
#pragma unroll
    for (int i = 0; i < 4; ++i) { const int row = i * 8 + (lane >> 3), ch = lane & 7; const u32x4 v = *(const LAS u32x4*)(stg + row * 64 + ch * 8); *(u32x4*)(Ow + (size_t)row * U.ldo + ch * 8) = v; }
    asm volatile("s_waitcnt lgkmcnt(0)\n\ts_barrier" ::: "memory");
    return true;
}

__device__ __forceinline__ float rowmax32(const f32x16& p0, const f32x16& p1) {
    float a = __builtin_fmaxf(__builtin_fmaxf(p0[0], p0[1]), p1[0]), b = __builtin_fmaxf(__builtin_fmaxf(p0[2], p0[3]), p1[1]); a = __builtin_fmaxf(__builtin_fmaxf(a, p1[2]), p1[3]);
#pragma unroll
    for (int r = 4; r < 16; r += 4) { a = __builtin_fmaxf(__builtin_fmaxf(a, p0[r]), p0[r + 1]); b = __builtin_fmaxf(__builtin_fmaxf(b, p0[r + 2]), p0[r + 3]); a = __builtin_fmaxf(__builtin_fmaxf(a, p1[r]), p1[r + 1]); b = __builtin_fmaxf(__builtin_fmaxf(b, p1[r + 2]), p1[r + 3]); }
    const float m = __builtin_fmaxf(a, b); return half_max(m);
}
__device__ __forceinline__ void softmax_step(f32x16& p0, f32x16& p1, float& mref, float& lrun, f32x16 (&o)[2], LAS float* wsf, int r32, int hi, bool first, float thr) {
    const float mx = rowmax32(p0, p1);
    if (first || __any(mx > mref + thr)) {
        const float mnew = first ? mx : __builtin_fmaxf(mx, mref);
        if (!first) { const float alpha = fexp2(mref - mnew); lrun *= alpha; if (hi == 0) wsf[r32] = alpha; LDS_WAIT();
#pragma unroll
            for (int r = 0; r < 16; ++r) { const float a = wsf[crow(r, hi)]; o[0][r] *= a; o[1][r] *= a; } }
        mref = mnew;
    }
    float ls = 0.f;
#pragma unroll
    for (int r = 0; r < 16; ++r) { p0[r] = fexp2(p0[r] - mref); p1[r] = fexp2(p1[r] - mref); ls += p0[r] + p1[r]; }
    lrun += ls;
}
__device__ __forceinline__ bool attn_unit64(LAS char* lds, const Unit& U, const int wid0) {
    constexpr int NCH = 12, KSLOT = NCH * 1024;
    const int lane = fresh_lane(), r32 = lane & 31, hi = lane >> 5, wid = wid0;
    const unsigned lds0 = (unsigned)(uintptr_t)lds;
    LAS float* wsf = (LAS float*)(lds + OFF_WS) + wid * 128;
    const int NT = U.na + 4;
    bf16x8 qf[2][6];
#pragma unroll
    for (int qb = 0; qb < 2; ++qb) { const bf16_t* qp = U.qn + (size_t)(wid * 64 + qb * 32 + r32) * U.ldq + hi * 8; const bf16_t* qp2 = U.qr + (size_t)(wid * 64 + qb * 32 + r32) * U.ldqr + hi * 8;
#pragma unroll
        for (int d0 = 0; d0 < 4; ++d0) qf[qb][d0] = *(const bf16x8*)(qp + d0 * 16);
#pragma unroll
        for (int d0 = 0; d0 < 2; ++d0) qf[qb][4 + d0] = *(const bf16x8*)(qp2 + d0 * 16); }
#pragma unroll
    for (int qb = 0; qb < 2; ++qb)
#pragma unroll
        for (int d0 = 0; d0 < 6; ++d0) asm volatile("" : "+v"(qf[qb][d0]));
    VM_WAIT();
    auto tile_row = [&](int it) -> int { return it < U.na ? U.rowa + 64 * it : U.rowc + 64 * (it - U.na); };
    const unsigned offKn = (unsigned)(lane * U.ldk + wid * 8) * 2u, offKr = (unsigned)(lane * U.ldkr + (wid & 3) * 8) * 2u;
    const unsigned offV = (unsigned)((16 * (wid & 3) + (lane >> 2)) * U.ldv + (wid >> 2) * 32 + (lane & 3) * 8) * 2u;
    auto dma = [&](int it, int slot) {
        const int row = tile_row(it);
        glds16s((const char*)U.v + (size_t)row * U.ldv * 2, offV, (unsigned)__builtin_amdgcn_readfirstlane(lds0 + OFF_V + slot * VSLOT + wid * 1024));
        glds16s((const char*)U.kn + (size_t)row * U.ldk * 2, offKn, (unsigned)__builtin_amdgcn_readfirstlane(lds0 + OFF_K + slot * KSLOT + wid * 1024));
        glds16s((const char*)U.kr + (size_t)row * U.ldkr * 2, offKr, (unsigned)__builtin_amdgcn_readfirstlane(lds0 + OFF_K + slot * KSLOT + (8 + (wid & 3)) * 1024));
    };
    dma(0, 0); dma(1, 1);
    f32x16 lAcc = f32x16{}, lBcc = f32x16{};
    const bf16x8 ones = (bf16x8){0x3f80, 0x3f80, 0x3f80, 0x3f80, 0x3f80, 0x3f80, 0x3f80, 0x3f80}; f32x16 oA[2], oB[2]; oA[0] = f32x16{}; oA[1] = f32x16{}; oB[0] = f32x16{}; oB[1] = f32x16{};
    const int vaddr = ((lane >> 4) & 1) * 32 + (lane & 3) * 8 + (4 * hi + ((lane & 15) >> 2)) * 64;
    int slot = 0;
    for (int it = 0; it < NT; ++it) {
        if (it + 1 < NT) asm volatile("s_waitcnt vmcnt(3)" ::: "memory"); else asm volatile("s_waitcnt vmcnt(0)" ::: "memory");
        asm volatile("s_barrier" ::: "memory");
        if (it + 2 < NT) { const int s2 = slot >= 1 ? slot - 1 : 2; dma(it + 2, s2); }
        LAS const char* ks = lds + OFF_K + slot * KSLOT + r32 * 16; LAS const char* vs = lds + OFF_V + slot * VSLOT + vaddr;
        f32x16 pA0 = f32x16{}, pA1 = f32x16{}, pB0 = f32x16{}, pB1 = f32x16{};
        { bf16x8 a0 = *(const LAS bf16x8*)(ks + hi * 1024), a1 = *(const LAS bf16x8*)(ks + hi * 1024 + 512);
#pragma unroll
          for (int d0 = 0; d0 < 6; ++d0) {
            bf16x8 n0 = a0, n1 = a1;
            if (d0 < 5) { n0 = *(const LAS bf16x8*)(ks + (2 * d0 + 2 + hi) * 1024); n1 = *(const LAS bf16x8*)(ks + (2 * d0 + 2 + hi) * 1024 + 512); }
            __builtin_amdgcn_sched_barrier(0);
            pA0 = __builtin_amdgcn_mfma_f32_32x32x16_bf16(a0, qf[0][d0], pA0, 0, 0, 0); pA1 = __builtin_amdgcn_mfma_f32_32x32x16_bf16(a1, qf[0][d0], pA1, 0, 0, 0);
            pB0 = __builtin_amdgcn_mfma_f32_32x32x16_bf16(a0, qf[1][d0], pB0, 0, 0, 0); pB1 = __builtin_amdgcn_mfma_f32_32x32x16_bf16(a1, qf[1][d0], pB1, 0, 0, 0);
            __builtin_amdgcn_sched_barrier(0);
            a0 = n0; a1 = n1; } }
        __builtin_amdgcn_sched_barrier(0);
        { _Pragma("unroll") for (int r = 0; r < 16; ++r) { pA0[r] = fexp2(pA0[r]); pA1[r] = fexp2(pA1[r]); } }
        u32x4 pwA[4];
#pragma unroll
        for (int j = 0; j < 4; ++j) { pwA[0][j] = pk2(pA0[2 * j], pA0[2 * j + 1]); pwA[1][j] = pk2(pA0[8 + 2 * j], pA0[9 + 2 * j]); pwA[2][j] = pk2(pA1[2 * j], pA1[2 * j + 1]); pwA[3][j] = pk2(pA1[8 + 2 * j], pA1[9 + 2 * j]); }
        __builtin_amdgcn_sched_barrier(0);
        { _Pragma("unroll") for (int r = 0; r < 16; ++r) { pB0[r] = fexp2(pB0[r]); pB1[r] = fexp2(pB1[r]); } }
        u32x4 pwB[4];
#pragma unroll
        for (int j = 0; j < 4; ++j) { pwB[0][j] = pk2(pB0[2 * j], pB0[2 * j + 1]); pwB[1][j] = pk2(pB0[8 + 2 * j], pB0[9 + 2 * j]); pwB[2][j] = pk2(pB1[2 * j], pB1[2 * j + 1]); pwB[3][j] = pk2(pB1[8 + 2 * j], pB1[9 + 2 * j]); }
        __builtin_amdgcn_sched_barrier(0);
#pragma unroll
        for (int k = 0; k < 4; ++k)
#pragma unroll
            for (int db = 0; db < 2; ++db) { const s16x4 lo = vtr(vs + db * 4096 + k * 1024), h4 = vtr(vs + db * 4096 + k * 1024 + 512);
                const bf16x8 vf = (bf16x8){lo[0], lo[1], lo[2], lo[3], h4[0], h4[1], h4[2], h4[3]};
                oA[db] = __builtin_amdgcn_mfma_f32_32x32x16_bf16(__builtin_bit_cast(bf16x8, pwA[k]), vf, oA[db], 0, 0, 0);
                oB[db] = __builtin_amdgcn_mfma_f32_32x32x16_bf16(__builtin_bit_cast(bf16x8, pwB[k]), vf, oB[db], 0, 0, 0);
                if (db == 1) { lAcc = __builtin_amdgcn_mfma_f32_32x32x16_bf16(__builtin_bit_cast(bf16x8, pwA[k]), ones, lAcc, 0, 0, 0); lBcc = __builtin_amdgcn_mfma_f32_32x32x16_bf16(__builtin_bit_cast(bf16x8, pwB[k]), ones, lBcc, 0, 0, 0); } }
        slot = slot == 2 ? 0 : slot + 1;
    }
    {
        bool bad = false;
#pragma unroll
        for (int r = 0; r < 16; ++r) bad |= !(lAcc[r] > 1e-30f && lAcc[r] < 1e30f && lBcc[r] > 1e-30f && lBcc[r] < 1e30f);
        LAS int* gf = (LAS int*)(lds + OFF_OST);
        asm volatile("s_waitcnt lgkmcnt(0)\n\ts_barrier" ::: "memory");
        const int ab = __any(bad) ? 1 : 0; if (lane == 0) gf[wid] = ab;
        asm volatile("s_waitcnt lgkmcnt(0)\n\ts_barrier" ::: "memory");
        int anyb = 0;
#pragma unroll
        for (int w = 0; w < 8; ++w) anyb |= gf[w];
        asm volatile("s_waitcnt lgkmcnt(0)\n\ts_barrier" ::: "memory");
        if (__builtin_amdgcn_readfirstlane(anyb)) return false;
    }
    LAS bf16_t* stg = (LAS bf16_t*)(lds + OFF_OST) + wid * 2048;
#pragma unroll
    for (int qb = 0; qb < 2; ++qb) {
        LDS_WAIT();
#pragma unroll
        for (int r = 0; r < 16; ++r) { const int orow = crow(r, hi); const float il = frcp(qb == 0 ? lAcc[r] : lBcc[r]);
#pragma unroll
            for (int db = 0; db < 2; ++db) stg[orow * 64 + db * 32 + r32] = (bf16_t)(pk2((qb == 0 ? oA[db][r] : oB[db][r]) * il, 0.f) & 0xffffu); }
        LDS_WAIT();
        bf16_t* Ow = U.o + (size_t)(wid * 64 + qb * 32) * U.ldo;
#pragma unroll
        for (int i = 0; i < 4; ++i) { const int row = i * 8 + (lane >> 3), ch = lane & 7; const u32x4 v = *(const LAS u32x4*)(stg + row * 64 + ch * 8); *(u32x4*)(Ow + (size_t)row * U.ldo + ch * 8) = v; }
    }
    asm volatile("s_waitcnt lgkmcnt(0)\n\ts_barrier" ::: "memory");
    return true;
}
}

namespace ml {
constexpr int WAVE_LDS = 19328;
constexpr int OFF_VT = 0, OFF_KT = 8192, OFF_TB = 16384;
constexpr int TB_CS = 0, TB_BT = 128, TB_EM = 256, TB_NI = 384, TB_HD = 512, TB_QW = 544;
__device__ __forceinline__ int crow(int r, int hi) { return (r & 3) + 8 * (r >> 2) + 4 * hi; }
__device__ __forceinline__ int chunk_row(int b, int j) { return j < 4 ? ML + b * NC + j * 64 : b * T + (j - 4) * 64; }
__device__ __forceinline__ float prefix_sum(float v, int lane) {
#pragma unroll
    for (int o = 1; o < 64; o <<= 1) { const float t = __shfl_up(v, o); if (lane >= o) v += t; }
    return v;
}
__device__ __forceinline__ float prefix_max(float v, int lane) {
#pragma unroll
    for (int o = 1; o < 64; o <<= 1) { const float t = __shfl_up(v, o); if (lane >= o) v = fmaxf(v, t); }
    return v;
}
__device__ __forceinline__ float suffix_max(float v, int lane) {
#pragma unroll
    for (int o = 1; o < 64; o <<= 1) { const float t = __shfl_down(v, o); if (lane + o < 64) v = fmaxf(v, t); }
    return v;
}
struct Gates { float li[2], bcum[2], g[2]; };
__device__ __forceinline__ void load_gates(const bf16_t* P, int row, int h, const float* igb, const float* fgb, Gates& G, int lane) {
    const bf16_t* gp = P + (size_t)row * NP + PC_GT;
#pragma unroll
    for (int d = 0; d < 2; ++d) {
        const float gi = bf2f(gp[d * 4 + h]) + igb[d * 4 + h], gf = bf2f(gp[8 + d * 4 + h]) + fgb[d * 4 + h];
        const float lf = fminf(gf, 0.f) - log1pf(expf(-fabsf(gf)));
        const float ps = prefix_sum(lf, lane), tot = __shfl(ps, 63);
        G.li[d] = gi; G.g[d] = tot; G.bcum[d] = d == 0 ? ps : tot - ps + lf;
    }
}
__device__ __forceinline__ bf16x8 trfrag(LAS const char* tile, int blk, int ks, int lane) {
    const int hi = lane >> 5, q = (lane & 15) >> 2; LAS const char* p = tile + blk * 4096 + (16 * ks + 8 * hi + q) * 64 + ((lane >> 4) & 1) * 32 + (lane & 3) * 8;
    const s16x4 lo = att::vtr(p), h4 = att::vtr(p + 256);
    return (bf16x8){lo[0], lo[1], lo[2], lo[3], h4[0], h4[1], h4[2], h4[3]};
}
__device__ __forceinline__ void load_vtile(LAS char* vt, const bf16_t* P, int rowbase, int col, int lane) {
#pragma unroll
    for (int i = 0; i < 8; ++i) { const int t = i * 8 + (lane >> 3), c = lane & 7;
        const u32x4 w = *(const u32x4*)(P + (size_t)(rowbase + t) * NP + col + 8 * c); *(LAS u32x4*)(vt + (c >> 2) * 4096 + t * 64 + (c & 3) * 16) = w; }
}
__device__ __forceinline__ void conv8(const bf16_t* P, int row, int col, int pos, int len, const float* w0, const float* w1, const float* w2, float* y) {
    const bf16_t* p = P + (size_t)row * NP + col; float x0[8], x1[8], x2[8];
    unpack8(*(const u32x4*)p, x1);
    if (pos > 0) unpack8(*(const u32x4*)(p - NP), x0); else { for (int e = 0; e < 8; ++e) x0[e] = 0.f; }
    if (pos < len - 1) unpack8(*(const u32x4*)(p + NP), x2); else { for (int e = 0; e < 8; ++e) x2[e] = 0.f; }
#pragma unroll
    for (int e = 0; e < 8; ++e) y[e] = silu_f(x0[e] * w0[e] + x1[e] * w1[e] + x2[e] * w2[e]);
}

__device__ __forceinline__ void chunk_state_unit(LAS char* wl, int b, int h, int j, const bf16_t* P, const float* convw, const float* igb, const float* fgb,
                                                 float* CLOC, float* NLOC, float* MG, int lane) {
    const int r32 = lane & 31, hi = lane >> 5;
    const int rowbase = chunk_row(b, j), len = j < 4 ? NC : T, pos0 = j < 4 ? j * 64 : (j - 4) * 64;
    LAS float* tb = (LAS float*)(wl + OFF_TB);
    u32x4 vraw[8], kr0[8], kr1[8], kr2[8];
    { const int c = lane & 7; const bf16_t* pv = P + (size_t)(rowbase + (lane >> 3)) * NP + PC_MV + h * 64 + 8 * c; const bf16_t* pk = P + (size_t)(rowbase + (lane >> 3)) * NP + PC_MK + h * 64 + 8 * c;
#pragma unroll
      for (int i = 0; i < 8; ++i) { vraw[i] = *(const u32x4*)(pv + (size_t)(8 * i) * NP); kr1[i] = *(const u32x4*)(pk + (size_t)(8 * i) * NP);
          kr0[i] = *(const u32x4*)(pk + (size_t)(8 * i) * NP - NP); kr2[i] = *(const u32x4*)(pk + (size_t)(8 * i) * NP + NP); } }
    Gates G; load_gates(P, rowbase + lane, h, igb, fgb, G, lane);
    float mloc[2];
#pragma unroll
    for (int d = 0; d < 2; ++d) { const float a = G.g[d] - G.bcum[d] + G.li[d]; mloc[d] = wave_max(a); tb[d * 64 + lane] = fexp(a - mloc[d]); }
    { const int c = lane & 7; float w0[8], w1[8], w2[8]; const float* cw = convw + 256 + h * 64 + 8 * c;
#pragma unroll
      for (int e = 0; e < 8; ++e) { w0[e] = cw[e]; w1[e] = cw[512 + e]; w2[e] = cw[1024 + e]; }
#pragma unroll
      for (int i = 0; i < 8; ++i) { const int t = i * 8 + (lane >> 3); float y[8], x0[8], x1[8], x2[8]; unpack8(kr0[i], x0); unpack8(kr1[i], x1); unpack8(kr2[i], x2);
          const float m0 = (pos0 + t > 0) ? 1.f : 0.f, m2 = (pos0 + t < len - 1) ? 1.f : 0.f;
#pragma unroll
          for (int e = 0; e < 8; ++e) y[e] = 0.125f * silu_f(m0 * x0[e] * w0[e] + x1[e] * w1[e] + m2 * x2[e] * w2[e]);
          *(LAS u32x4*)(wl + OFF_KT + (c >> 2) * 4096 + t * 64 + (c & 3) * 16) = pack8(y); } }
    LDS_WAIT();
#pragma unroll 1
    for (int d = 0; d < 2; ++d) {
        LDS_WAIT();
        { const int c = lane & 7;
#pragma unroll
          for (int i = 0; i < 8; ++i) { const int t = i * 8 + (lane >> 3); const float w = tb[d * 64 + t]; float y[8]; unpack8(vraw[i], y);
#pragma unroll
              for (int e = 0; e < 8; ++e) y[e] *= w;
              *(LAS u32x4*)(wl + OFF_VT + (c >> 2) * 4096 + t * 64 + (c & 3) * 16) = pack8(y); } }
        LDS_WAIT();
        const size_t sidx = ((size_t)((d * NB + b) * 4 + h) * NCHK + j);
        float* cl = CLOC + sidx * 4096;
#pragma unroll
        for (int db = 0; db < 2; ++db) { bf16x8 af[4];
#pragma unroll
            for (int ks = 0; ks < 4; ++ks) af[ks] = trfrag(wl + OFF_VT, db, ks, lane);
#pragma unroll
            for (int dkb = 0; dkb < 2; ++dkb) { f32x16 acc = f32x16{};
#pragma unroll
                for (int ks = 0; ks < 4; ++ks) acc = __builtin_amdgcn_mfma_f32_32x32x16_bf16(af[ks], trfrag(wl + OFF_KT, dkb, ks, lane), acc, 0, 0, 0);
#pragma unroll
                for (int i = 0; i < 16; ++i) cl[(32 * db + crow(i, hi)) * 64 + 32 * dkb + r32] = acc[i]; } }
        { float sacc = 0.f; LAS const bf16_t* kt = (LAS const bf16_t*)(wl + OFF_KT + (lane >> 5) * 4096 + (lane & 31) * 2);
#pragma unroll 8
          for (int t = 0; t < 64; ++t) sacc += bf2f(kt[t * 32]) * tb[d * 64 + t];
          NLOC[sidx * 64 + lane] = sacc; }
        if (lane == 0) { MG[sidx * 2] = d == 0 ? mloc[0] : mloc[1]; MG[sidx * 2 + 1] = d == 0 ? G.g[0] : G.g[1]; }
    }
    LDS_WAIT();
}

__device__ __forceinline__ int step_chunk(int d, int s) { return d == 0 ? s : (s < 4 ? 3 - s : 71 - s); }
__device__ __forceinline__ void scan_item(LAS char* lds, const int wid0, int item, const float* CLOC, const float* NLOC, const float* MG, bf16_t* CIN, float* NIN, float* MIN_) {
    const int tid = wid0 * 64 + fresh_lane(); const int dbh = item >> 2, qd = item & 3, d = dbh >> 5;
    LAS float* mg = (LAS float*)lds; LAS float* wo = mg + 2 * NCHK; LAS float* wn = wo + NCHK;
    __syncthreads();
    if (tid < 2 * NCHK) mg[tid] = MG[(size_t)dbh * NCHK * 2 + tid];
    __syncthreads();
    if (tid == 0) { float m = -INFINITY;
        for (int s = 0; s < NCHK; ++s) { const int j = step_chunk(d, s); const float mj = mg[2 * j], gj = mg[2 * j + 1];
            if (qd == 0) MIN_[(size_t)dbh * NCHK + j] = m;
            const float mn = fmaxf(gj + m, mj); wo[s] = fexp(gj + m - mn); wn[s] = fexp(mj - mn); m = mn; } }
    __syncthreads();
    const float* cl = CLOC + (size_t)dbh * NCHK * 4096; bf16_t* ci = CIN + (size_t)dbh * NCHK * 4096;
    const int e0 = qd * 1024 + tid, e1 = e0 + 512;
    float s0 = 0.f, s1 = 0.f;
#pragma unroll 1
    for (int sb = 0; sb < NCHK; sb += 17) { float c0[17], c1[17];
#pragma unroll
        for (int i = 0; i < 17; ++i) { const int j = step_chunk(d, sb + i); c0[i] = cl[(size_t)j * 4096 + e0]; c1[i] = cl[(size_t)j * 4096 + e1]; }
#pragma unroll
        for (int i = 0; i < 17; ++i) { const int s = sb + i, j = step_chunk(d, s);
            ci[(size_t)j * 4096 + e0] = (bf16_t)(pk2(s0, 0.f) & 0xffffu); ci[(size_t)j * 4096 + e1] = (bf16_t)(pk2(s1, 0.f) & 0xffffu);
            s0 = wo[s] * s0 + wn[s] * c0[i]; s1 = wo[s] * s1 + wn[s] * c1[i]; } }
    if (tid < 16) { const int e = qd * 16 + tid; float sn = 0.f; const float* nl = NLOC + (size_t)dbh * NCHK * 64; float* ni = NIN + (size_t)dbh * NCHK * 64;
        for (int s = 0; s < NCHK; ++s) { const int j = step_chunk(d, s); const float c = nl[j * 64 + e]; ni[j * 64 + e] = sn; sn = wo[s] * sn + wn[s] * c; } }
}

__device__ __forceinline__ void out_unit(LAS char* wl, int b, int h, int j, const bf16_t* P, const float* convw, const float* igb, const float* fgb, const float* normw,
                                         const bf16_t* CIN, const float* NIN, const float* MIN_, bf16_t* MIX, int lane) {
    const int r32_ = lane & 31, hi_ = lane >> 5;
    const int rowbase = chunk_row(b, j), len = j < 4 ? NC : T, pos0 = j < 4 ? j * 64 : (j - 4) * 64;
    LAS float* tb = (LAS float*)(wl + OFF_TB);
    float min_d[2];
    { Gates G; load_gates(P, rowbase + lane, h, igb, fgb, G, lane);
#pragma unroll
      for (int d = 0; d < 2; ++d) { const float cs = G.li[d] - G.bcum[d]; const float pm = d == 0 ? prefix_max(cs, lane) : suffix_max(cs, lane);
          const size_t sidx = ((size_t)((d * NB + b) * 4 + h) * NCHK + j);
          const float mi = MIN_[sidx]; min_d[d] = mi;
          const float mt = G.bcum[d] + fmaxf(mi, pm);
          tb[TB_CS + d * 64 + lane] = cs; tb[TB_BT + d * 64 + lane] = G.bcum[d] - mt; tb[TB_EM + d * 64 + lane] = fexp(-mt); tb[TB_NI + d * 64 + lane] = NIN[sidx * 64 + lane]; } }
#pragma unroll
    for (int k = 0; k < 3; ++k) tb[TB_QW + k * 64 + lane] = convw[k * 512 + h * 64 + lane];
    load_vtile(wl + OFF_VT, P, rowbase, PC_MV + h * 64, lane);
    { const int c = lane & 7; float w0[8], w1[8], w2[8]; const float* cw = convw + 256 + h * 64 + 8 * c;
#pragma unroll
      for (int e = 0; e < 8; ++e) { w0[e] = cw[e]; w1[e] = cw[512 + e]; w2[e] = cw[1024 + e]; }
#pragma unroll 2
      for (int i = 0; i < 8; ++i) { const int t = i * 8 + (lane >> 3); float y[8]; conv8(P, rowbase + t, PC_MK + h * 64 + 8 * c, pos0 + t, len, w0, w1, w2, y);
#pragma unroll
          for (int e = 0; e < 8; ++e) y[e] *= 0.125f;
          *(LAS u32x4*)(wl + OFF_KT + c * 1024 + t * 16) = pack8(y); } }
    LDS_WAIT();
#pragma unroll 1
    for (int tbk = 0; tbk < 2; ++tbk) {
        int r32 = r32_, hi = hi_; asm volatile("" : "+v"(r32), "+v"(hi));
        const int t = 32 * tbk + r32;
        const int vaddr = ((lane >> 4) & 1) * 32 + (lane & 3) * 8 + (4 * hi + ((lane & 15) >> 2)) * 64;
        u32x4 qf[4];
#pragma unroll
        for (int d0 = 0; d0 < 4; ++d0) { const int c = 2 * d0 + hi; float w0[8], w1[8], w2[8], y[8];
#pragma unroll
            for (int e = 0; e < 8; ++e) { w0[e] = tb[TB_QW + 8 * c + e]; w1[e] = tb[TB_QW + 64 + 8 * c + e]; w2[e] = tb[TB_QW + 128 + 8 * c + e]; }
            conv8(P, rowbase + t, PC_MQ + h * 64 + 8 * c, pos0 + t, len, w0, w1, w2, y); qf[d0] = pack8(y); }
        f32x16 hs[2]; hs[0] = f32x16{}; hs[1] = f32x16{};
#pragma unroll 1
        for (int d = 0; d < 2; ++d) {
            const size_t sidx = ((size_t)((d * NB + b) * 4 + h) * NCHK + j);
            const float mi = d == 0 ? min_d[0] : min_d[1];
            const float bt = tb[TB_BT + d * 64 + t], em = tb[TB_EM + d * 64 + t];
            const float wi = (mi == -INFINITY) ? 0.f : fexp(bt + mi);
            f32x16 p[2];
#pragma unroll
            for (int sb = 0; sb < 2; ++sb) { p[sb] = f32x16{};
#pragma unroll
                for (int d0 = 0; d0 < 4; ++d0) { const bf16x8 kfr = *(const LAS bf16x8*)(wl + OFF_KT + (2 * d0 + hi) * 1024 + (32 * sb + r32) * 16);
                    p[sb] = __builtin_amdgcn_mfma_f32_32x32x16_bf16(kfr, __builtin_bit_cast(bf16x8, qf[d0]), p[sb], 0, 0, 0); } }
            float ds = 0.f;
#pragma unroll
            for (int sb = 0; sb < 2; ++sb)
#pragma unroll
                for (int i = 0; i < 16; ++i) { const int s_ = 32 * sb + crow(i, hi); const bool valid = d == 0 ? (s_ <= t) : (s_ >= t);
                    const float w = valid ? fexp(bt + tb[TB_CS + d * 64 + s_]) : 0.f; p[sb][i] *= w; ds += p[sb][i]; }
            ds = half_sum(ds);
            float qn = 0.f; u32x4 qw[4];
#pragma unroll
            for (int d0 = 0; d0 < 4; ++d0) { float y[8]; unpack8(qf[d0], y);
#pragma unroll
                for (int e = 0; e < 8; ++e) { qn += y[e] * tb[TB_NI + d * 64 + 16 * d0 + 8 * hi + e]; y[e] *= wi; }
                qw[d0] = pack8(y); }
            qn = half_sum(qn);
            const float den = ds + wi * qn; const float hd = frcp(fmaxf(fabsf(den), em));
            LDS_WAIT();
            if (hi == 0) tb[TB_HD + r32] = hd;
            LDS_WAIT();
            u32x4 pw[4];
#pragma unroll
            for (int jj = 0; jj < 4; ++jj) { pw[0][jj] = pk2(p[0][2 * jj], p[0][2 * jj + 1]); pw[1][jj] = pk2(p[0][8 + 2 * jj], p[0][9 + 2 * jj]); pw[2][jj] = pk2(p[1][2 * jj], p[1][2 * jj + 1]); pw[3][jj] = pk2(p[1][8 + 2 * jj], p[1][9 + 2 * jj]); }
#pragma unroll
            for (int db = 0; db < 2; ++db) { f32x16 acc = f32x16{};
                const bf16_t* cp = CIN + sidx * 4096 + (size_t)(32 * db + r32) * 64 + 8 * hi; bf16x8 cf[4];
#pragma unroll
                for (int d0 = 0; d0 < 4; ++d0) cf[d0] = *(const bf16x8*)(cp + d0 * 16);
#pragma unroll
                for (int k = 0; k < 4; ++k) { LAS const char* vs = wl + OFF_VT + vaddr + db * 4096 + k * 1024; const s16x4 lo = att::vtr(vs), h4 = att::vtr(vs + 512);
                    const bf16x8 vf = (bf16x8){lo[0], lo[1], lo[2], lo[3], h4[0], h4[1], h4[2], h4[3]};
                    acc = __builtin_amdgcn_mfma_f32_32x32x16_bf16(__builtin_bit_cast(bf16x8, pw[k]), vf, acc, 0, 0, 0); }
#pragma unroll
                for (int d0 = 0; d0 < 4; ++d0) acc = __builtin_amdgcn_mfma_f32_32x32x16_bf16(__builtin_bit_cast(bf16x8, qw[d0]), cf[d0], acc, 0, 0, 0);
#pragma unroll
                for (int i = 0; i < 16; ++i) hs[db][i] += acc[i] * tb[TB_HD + crow(i, hi)]; }
        }
        const float nw0 = normw[h * 64 + r32], nw1 = normw[h * 64 + 32 + r32];
        const unsigned offp = (unsigned)((rowbase + 32 * tbk + 4 * hi) * NP + PC_MO + h * 64 + r32) * 2u, offm = (unsigned)((rowbase + 32 * tbk + 4 * hi) * D + h * 64 + r32) * 2u;
#pragma unroll
        for (int i = 0; i < 16; ++i) { float ss = hs[0][i] * hs[0][i] + hs[1][i] * hs[1][i];
            ss += __shfl_xor(ss, 1); ss += __shfl_xor(ss, 2); ss += __shfl_xor(ss, 4); ss += __shfl_xor(ss, 8); ss += __shfl_xor(ss, 16);
            const float sc = 1.0f / sqrtf(ss * (1.0f / 64.0f) + EPS);
            const unsigned ro = (unsigned)((i & 3) + 8 * (i >> 2));
            const bf16_t* op = (const bf16_t*)((const char*)P + (offp + ro * (unsigned)(NP * 2))); bf16_t* mp = (bf16_t*)((char*)MIX + (offm + ro * (unsigned)(D * 2)));
            mp[0] = (bf16_t)(pk2(hs[0][i] * sc * nw0 * sigmoid_f(bf2f(op[0])), 0.f) & 0xffffu);
            mp[32] = (bf16_t)(pk2(hs[1][i] * sc * nw1 * sigmoid_f(bf2f(op[32])), 0.f) & 0xffffu);
            if ((i & 3) == 3) asm volatile("" ::: "memory"); }
    }
    LDS_WAIT();
}
}

#define XB_TMO      128
#define XB_XCNT(j)  (256  + 64 * (j))
#define XB_XSUB(j)  (1280 + 64 * (j))
#define XB_XGEN(j)  (2304 + 64 * (j))
#define XB_TOP      3328
#define XB_TOPGEN   3392
#define XCD_BAR_WORDS 3456
#define XB_SPIN_CAP (1u << 18)
__device__ __forceinline__ unsigned xb_ld(unsigned* p)              { return __hip_atomic_load(p, __ATOMIC_RELAXED, __HIP_MEMORY_SCOPE_AGENT); }
__device__ __forceinline__ unsigned xb_add(unsigned* p, unsigned v) { return __hip_atomic_fetch_add(p, v, __ATOMIC_RELAXED, __HIP_MEMORY_SCOPE_AGENT); }
__device__ __forceinline__ unsigned xb_xcc_id() { return (unsigned)__builtin_amdgcn_s_getreg((3 << 11) | 20) & 0xFu; }
#define XB_SPIN(cond, bar) do { unsigned _sp = 0; while (cond) { __builtin_amdgcn_s_sleep(1); \
    if ((++_sp & 255u) == 0u) { if (xb_ld(&(bar)[XB_TMO])) break; if (_sp > XB_SPIN_CAP) { atomicAdd(&(bar)[XB_TMO], 1u); break; } } } } while (0)
struct XcdBarrier { unsigned* bar; unsigned x; volatile LAS unsigned* st; };
__device__ __forceinline__ XcdBarrier xcd_barrier_post(unsigned* bar, volatile LAS unsigned* st) {
    XcdBarrier b; b.bar = bar; b.x = xb_xcc_id(); b.st = st;
    if (threadIdx.x == 0) (void)xb_add(&bar[XB_XCNT(b.x)], 1u);
    return b;
}
__device__ __forceinline__ void xcd_barrier_complete(unsigned* bar, unsigned x, unsigned& nloc, unsigned& nx) {
    const unsigned G = gridDim.x * gridDim.y * gridDim.z;
    unsigned sum, cnt, mine, sp = 0u;
    for (;;) {
        sum = 0u; cnt = 0u; mine = 0u;
#pragma unroll
        for (unsigned j = 0; j < 16; ++j) { const unsigned c = xb_ld(&bar[XB_XCNT(j)]); sum += c; cnt += (c > 0u) ? 1u : 0u; mine = (j == x) ? c : mine; }
        if (sum == G) break;
        __builtin_amdgcn_s_sleep(1);
        if ((++sp & 255u) == 0u) { if (xb_ld(&bar[XB_TMO])) break; if (sp > XB_SPIN_CAP) { atomicAdd(&bar[XB_TMO], 1u); break; } }
    }
    nloc = mine > 0u ? mine : 1u; nx = cnt > 0u ? cnt : 1u;
}
__device__ __forceinline__ void xcd_barrier(const XcdBarrier& b) {
    asm volatile("s_waitcnt vmcnt(0)" ::: "memory");
    __syncthreads();
    if (threadIdx.x == 0) {
        unsigned* bar = b.bar;
        __builtin_amdgcn_s_waitcnt(0);
        unsigned nloc = b.st[0], nx = b.st[1];
        if (nloc == 0u) { xcd_barrier_complete(bar, b.x, nloc, nx); b.st[0] = nloc; b.st[1] = nx; }
        const unsigned old = xb_add(&bar[XB_XSUB(b.x)], 1u);
        const unsigned gen = old / nloc;
        if (old + 1u == (gen + 1u) * nloc) {
            __builtin_amdgcn_fence(__ATOMIC_RELEASE, "agent");
            asm volatile("s_waitcnt vmcnt(0)" ::: "memory");
            const unsigned og = xb_add(&bar[XB_TOP], 1u);
            const unsigned tg = og / nx;
            if (og + 1u == (tg + 1u) * nx) xb_add(&bar[XB_TOPGEN], 1u);
            else XB_SPIN(xb_ld(&bar[XB_TOPGEN]) == tg, bar);
            __builtin_amdgcn_fence(__ATOMIC_ACQUIRE, "agent");
            xb_add(&bar[XB_XGEN(b.x)], 1u);
            asm volatile("s_waitcnt vmcnt(0)" ::: "memory");
        } else {
            XB_SPIN(xb_ld(&bar[XB_XGEN(b.x)]) == gen, bar);
            __builtin_amdgcn_fence(__ATOMIC_ACQUIRE, "agent");
            asm volatile("s_waitcnt vmcnt(0)" ::: "memory");
        }
    }
    __syncthreads();
}

struct Args { const float* in[27]; float* out; unsigned char* ws; int ph_lo, ph_hi; };
enum { I_X = 0, I_C, I_CTX, I_CCTX, I_ADAW, I_ADAB, I_N1W, I_N2W, I_WIN, I_WOUT, I_CONVW, I_IGB, I_FGB, I_MLNW, I_RPB, I_QNW, I_KVNW, I_WUQ, I_WUKV, I_F1, I_F3, I_F2, I_RW, I_M1, I_M3, I_M2, I_FNW };

struct TrJob { const float* src; const float* src2; int ldn, K, ngrp, kind; bf16_t* dst; const float* ksc; float cs; };
struct TrItem { const float* sp; const float* kp; bf16_t* dp; int ldn, K; float cs; };
__device__ __forceinline__ void tr_resolve(const TrJob& J, int it, int lane, TrItem& T) {
    const int g = it % J.ngrp, kb = it / J.ngrp, c0 = 16 * g, k0 = 64 * kb; const float* src = J.src; int sc0 = c0; float cs = J.cs;
    if (J.kind == 1) {
        if (c0 < 512) sc0 = 2192 + c0; else if (c0 < 768) sc0 = 2704 + (c0 - 512); else if (c0 < 1792) sc0 = c0 - 768;
        else if (c0 < 2944) { sc0 = 1040 + (c0 - 1792); if (c0 < 2176) cs = 0.125f * LOG2E; }
        else if (c0 < 2976) sc0 = 2960 + (c0 - 2944); else if (c0 < 2992) sc0 = 1024 + (c0 - 2976); else { sc0 = 0; cs = 0.f; }
    } else if (J.kind == 2) {
        if (c0 < 384) sc0 = (c0 >> 6) * 96 + (c0 & 63); else { const int r = c0 - 384; sc0 = (r >> 5) * 96 + 64 + (r & 31); }
    } else if (J.kind == 3) {
        const int pn = c0 >> 8, cc = c0 & 255; if (cc >= 128) src = J.src2; sc0 = 128 * pn + (cc & 127);
    }
    T.sp = src + (size_t)(k0 + (lane >> 4)) * J.ldn + sc0 + (lane & 15); T.kp = J.ksc ? J.ksc + k0 + (lane >> 4) : nullptr; T.ldn = J.ldn; T.K = J.K; T.cs = cs;
    T.dp = J.dst + (size_t)c0 * J.K + k0;
}
__device__ __forceinline__ void tr_load(const TrItem& T, float (&v)[16], float (&kv)[16]) {
#pragma unroll
    for (int i = 0; i < 16; ++i) v[i] = T.sp[(size_t)(4 * i) * T.ldn];
    if (T.kp) {
#pragma unroll
        for (int i = 0; i < 16; ++i) kv[i] = T.kp[4 * i]; }
    else {
#pragma unroll
        for (int i = 0; i < 16; ++i) kv[i] = 1.f; }
}
__device__ __forceinline__ void tr_store(const TrItem& T, const float (&v)[16], const float (&kv)[16], LAS float* scr, int lane) {
#pragma unroll
    for (int i = 0; i < 16; ++i) scr[(4 * i + (lane >> 4)) * 17 + (lane & 15)] = v[i] * T.cs * kv[i];
    LDS_WAIT();
#pragma unroll
    for (int j = 0; j < 2; ++j) { const int id = lane + 64 * j, n = id >> 3, c = id & 7; float y[8];
#pragma unroll
        for (int e = 0; e < 8; ++e) y[e] = scr[(8 * c + e) * 17 + n];
        *(u32x4*)(T.dp + (size_t)n * T.K + 8 * c) = pack8(y); }
    LDS_WAIT();
}
template <class R> __device__ __forceinline__ void tr_run(int first, int stride, int total, const R& resolve, LAS float* scr, int lane) {
    int it = first; if (it >= total) return;
    TrItem Tc; float vc[16], kc[16]; resolve(it, Tc); tr_load(Tc, vc, kc);
    for (;;) {
        const int itn = it + stride; const bool hn = itn < total; TrItem Tn = Tc; float vn[16], kn[16];
        if (hn) { resolve(itn, Tn); tr_load(Tn, vn, kn); }
        else {
#pragma unroll
            for (int i = 0; i < 16; ++i) { vn[i] = 0.f; kn[i] = 0.f; } }
        tr_store(Tc, vc, kc, scr, lane);
        if (!hn) break;
        Tc = Tn;
#pragma unroll
        for (int i = 0; i < 16; ++i) { vc[i] = vn[i]; kc[i] = kn[i]; }
        it = itn;
    }
}
__device__ __forceinline__ int tr_job_count(const TrJob& J) { return J.ngrp * (J.K / 64); }

__device__ __forceinline__ void mod_item(LAS char* lds, const int wid0, int item, const float* c, const float* cctx, const float* adaw, const float* adab, float* modv) {
    const int lane = fresh_lane(), wid = wid0, tid = wid * 64 + lane, l = item / 96, ng = item % 96;
    LAS float* sc = (LAS float*)lds;
    LAS float* part = sc + 9 * 1024;
    __syncthreads();
    for (int i = tid; i < 9 * 1024; i += 512) { const float v = i < 8 * 1024 ? c[i] : cctx[i - 8 * 1024]; sc[i] = silu_f(v); }
    __syncthreads();
    float acc[9];
#pragma unroll
    for (int bi = 0; bi < 9; ++bi) acc[bi] = 0.f;
    const float* w = adaw + (size_t)l * 1024 * 6144 + ng * 64 + lane;
#pragma unroll 1
    for (int k0 = wid * 128; k0 < wid * 128 + 128; k0 += 16) { float wv[16];
#pragma unroll
        for (int i = 0; i < 16; ++i) wv[i] = w[(size_t)(k0 + i) * 6144];
#pragma unroll
        for (int i = 0; i < 16; ++i)
#pragma unroll
            for (int bi = 0; bi < 9; ++bi) acc[bi] += sc[bi * 1024 + k0 + i] * wv[i]; }
#pragma unroll
    for (int bi = 0; bi < 9; ++bi) part[(wid * 9 + bi) * 64 + lane] = acc[bi];
    __syncthreads();
    for (int i = tid; i < 9 * 64; i += 512) { const int bi = i >> 6, n = i & 63; float s = adab[l * 6144 + ng * 64 + n];
#pragma unroll
        for (int w8 = 0; w8 < 8; ++w8) s += part[(w8 * 9 + bi) * 64 + n];
        modv[((size_t)l * 9 + bi) * 6144 + ng * 64 + n] = s; }
}

__device__ __forceinline__ void norm_row(const float* xrow, const float* nw, const float* shift, const float* scale, int lane, f32x4 (&v)[4], const bf16_t* dl = nullptr, float* xw = nullptr, int nparts = 1, size_t pstride = 0) {
    float s = 0.f;
#pragma unroll
    for (int j = 0; j < 4; ++j) { v[j] = *(const f32x4*)(xrow + 4 * lane + 256 * j);
        if (dl) { for (int p = 0; p < nparts; ++p) { const u32x2 dw = *(const u32x2*)(dl + (size_t)p * pstride + 4 * lane + 256 * j); v[j].x += bf2f(dw.x & 0xffffu); v[j].y += __uint_as_float(dw.x & 0xffff0000u); v[j].z += bf2f(dw.y & 0xffffu); v[j].w += __uint_as_float(dw.y & 0xffff0000u); }
            *(f32x4*)(xw + 4 * lane + 256 * j) = v[j]; }
        s += (v[j].x * v[j].x + v[j].y * v[j].y) + (v[j].z * v[j].z + v[j].w * v[j].w); }
    const float rs = 1.0f / sqrtf(wave_sum(s) * (1.0f / D) + EPS);
#pragma unroll
    for (int j = 0; j < 4; ++j) { const int c = 4 * lane + 256 * j; const f32x4 w = *(const f32x4*)(nw + c), sh = *(const f32x4*)(shift + c), sc = *(const f32x4*)(scale + c);
        v[j] = (v[j] * rs * w) * (1.0f + sc) + sh; }
}
__device__ __forceinline__ void store_row_bf16(bf16_t* orow, int lane, const f32x4 (&v)[4]) {
#pragma unroll
    for (int j = 0; j < 4; ++j) { u32x2 w; w.x = pk2(v[j].x, v[j].y); w.y = pk2(v[j].z, v[j].w); *(u32x2*)(orow + 4 * lane + 256 * j) = w; }
}


#if !MK_MULTI
#define GRID_BAR() do { XcdBarrier b2_ = bar; asm volatile("" : "+s"(b2_.bar)); xcd_barrier(b2_); } while (0)
#define OPQ(x) (x)
#else
#define GRID_BAR() do {} while (0)
#define OPQ(x) ({ int _v = (x); asm volatile("" : "+s"(_v)); _v; })
#endif
#ifndef MK_SITES
#define MK_SITES 0xffffffffu
#endif
#define EN(s) (((MK_SITES) >> (s)) & 1u)
#define IN(k) (OPQ(lo) <= (k) && (k) < OPQ(hi_ph))
#define SEAM(k) do { if (IN(k) && IN((k) + 1)) GRID_BAR(); } while (0)
#define PHASE_WS() GAS unsigned char* ws = (GAS unsigned char*)args.ws; asm volatile("" : "+s"(ws))
#define PHASE_IDS() PHASE_WS(); const int lane = fresh_lane(), wid = wid0, tid = wid * 64 + lane, gw = blockIdx.x * 8 + wid; (void)lane; (void)gw; (void)tid

#define x_in (args.in[I_X])
#define ctx_in (args.in[I_CTX])
#define xout (args.out)
#define modv ((float*)(ws + SM_MOD))
#define ropet ((float*)(ws + SM_ROPE))
#define stats ((float*)(ws + SM_STATS))
#define NLOC ((float*)(ws + SM_NLOC))
#define NIN ((float*)(ws + SM_NIN))
#define MG ((float*)(ws + SM_MG))
#define MINb ((float*)(ws + SM_MIN))
#define xc ((float*)(ws + WS_XC))
#define BH ((bf16_t*)(ws + WS_H))
#define CLOC ((float*)(ws + WS_H))
#define BP ((bf16_t*)(ws + WS_P))
#define QM ((bf16_t*)(ws + WS_QM))
#define KVM ((bf16_t*)(ws + WS_KVM))
#define CIN ((bf16_t*)(ws + WS_CIN))
#define Win ((bf16_t*)(ws + W_IN))
#define Wout ((bf16_t*)(ws + W_OUT))
#define Wuq ((bf16_t*)(ws + W_UQ))
#define Wukv ((bf16_t*)(ws + W_UKV))
#define Wf13 ((bf16_t*)(ws + W_F13))
#define Wf2 ((bf16_t*)(ws + W_F2))
#define tokinfo ((int*)(ws + SM_TOK))
#define tokg ((float*)(ws + SM_TOKG))
#define wgcnt ((int*)(ws + SM_WGCNT))
#define rowtok ((int*)(ws + SM_ROWTOK))
#define rowgate ((float*)(ws + SM_ROWGATE))
#define tileexp ((int*)(ws + SM_TILEEXP))
#define WMOE ((bf16_t*)(ws + WS_WMOE))
#define UB ((bf16_t*)(ws + WS_U))
#define ASORT ((bf16_t*)(ws + WS_ASORT))
#define PBY ((bf16_t*)(ws + WS_PBY))
#define PBF ((bf16_t*)(ws + WS_PBF))
#define PBW ((bf16_t*)(ws + WS_PBW))

template <int L> __device__ __forceinline__ void layer_phases(const Args& args, LAS unsigned char* lds, const int G, const int NGW, const XcdBarrier& bar, const int lo, const int hi_ph, const int wid0) {
    constexpr int l = L; constexpr int pb = 1 + 10 * l;

#define mod_l (modv + (size_t)l * 9 * 6144)
        if (EN(1) && IN(pb + 0)) { PHASE_IDS();
            const float* nw = args.in[I_N1W] + l * D;
            for (int r = gw; r < M; r += NGW) { const bool lat = r < ML; const int bi = lat ? (r >> 12) : 8;
                const float* xr = lat ? ((l == 0 ? x_in : xout) + (size_t)r * D) : ((l == 0 ? ctx_in : xc) + (size_t)(r - ML) * D);
                f32x4 v[4]; norm_row(xr, nw, mod_l + bi * 6144, mod_l + bi * 6144 + 1024, lane, v, (l == 0 || lat) ? nullptr : PBF + (size_t)(r - ML) * D, const_cast<float*>(xr), 8, (size_t)MC * D); store_row_bf16(BH + (size_t)r * D, lane, v); }
        }
        SEAM(pb + 0);
        if (EN(2) && IN(pb + 1)) { PHASE_WS();
            pg8::Gemm g{BH, D, Win + (size_t)l * 3072 * 1024, D}; pg8::StaticOrder S; S.init(M / 256, NP / 256, G, blockIdx.x, D);
            pg8::EpiP E{BP, stats, ropet};
            pg8::gemm_phase<pg8::EpiP, pg8::StaticOrder, true>(lds, g, S, E, wid0);
        }
        SEAM(pb + 1);
        if (EN(3) && IN(pb + 2)) { PHASE_WS();
            if (EN(18)) { pg8::Gemm g{BP + PC_QL, NP, Wuq + (size_t)l * 768 * 512, 512}; pg8::StaticOrder S; S.init(M / 256, 3, G, blockIdx.x, 512);
              pg8::EpiRS<true> E{QM, NQM, NQM, 384, stats, 0, 16, 1.0f / 512.0f, ropet};
              pg8::gemm_phase<pg8::EpiRS<true>, pg8::StaticOrder, true>(lds, g, S, E, wid0); }
            __syncthreads();
            if (EN(19)) { pg8::Gemm g{BP + PC_KVL, NP, Wukv + (size_t)l * 768 * 256, 256}; pg8::StaticOrder S; S.init(M / 256, 3, G, blockIdx.x, 256);
              pg8::EpiRS<false> E{KVM, NKVM, NKVM, NKVM, stats, 16, 8, 1.0f / 256.0f, ropet};
              pg8::gemm_phase<pg8::EpiRS<false>, pg8::StaticOrder, true>(lds, g, S, E, wid0); }
            __syncthreads();
            { PHASE_IDS();
            const float* convw = args.in[I_CONVW] + (size_t)l * 3 * 512; const float* igb = args.in[I_IGB] + l * 8; const float* fgb = args.in[I_FGB] + l * 8;
            for (int u = gw; u < NB * 4 * NCHK; u += NGW) { const int j = u % NCHK, bh = u / NCHK; int lane_ = lane; asm volatile("" : "+v"(lane_));
                if (EN(17)) ml::chunk_state_unit((LAS char*)lds + wid * ml::WAVE_LDS, bh >> 2, bh & 3, j, BP, convw, igb, fgb, CLOC, NLOC, MG, lane_); } }
        }
        SEAM(pb + 2);
        if (EN(4) && IN(pb + 3)) { PHASE_WS(); for (int item = blockIdx.x; item < 256; item += G) ml::scan_item((LAS char*)lds, wid0, item, CLOC, NLOC, MG, CIN, NIN, MINb); }
        SEAM(pb + 3);
        if (EN(5) && IN(pb + 4)) { GAS unsigned char* ws_ph = (GAS unsigned char*)args.ws;
            const float* convw = args.in[I_CONVW] + (size_t)l * 3 * 512; const float* igb = args.in[I_IGB] + l * 8; const float* fgb = args.in[I_FGB] + l * 8;
            const float* mnw = args.in[I_MLNW] + l * 256;
#ifndef MK_REP_MLA
#define MK_REP_MLA 1
#endif
#ifndef MK_REP_NA
#define MK_REP_NA 1
#endif
#ifndef MK_REP_ML
#define MK_REP_ML 1
#endif
            constexpr int n_mla1 = NB * 6 * 8, n_na1 = NB * 6 * 16, n_ml1 = (l == 0) ? NB * 4 * NCHK / 8 : NB * 4 * 64 / 8;
            constexpr int n_mla = n_mla1 * MK_REP_MLA, n_na = n_na1 * MK_REP_NA, n_ml = n_ml1 * MK_REP_ML, n_ctx = (l == 0) ? NB * 6 * 2 : 0;
            constexpr int n_items = n_mla + n_na + n_ml + n_ctx;
            volatile LAS int* qslot = (volatile LAS int*)(lds + LDS_MISC + 64);
            for (;;) {
                GAS unsigned char* ws = ws_ph; asm volatile("" : "+s"(ws));
                int wid_i = wid0; asm volatile("" : "+s"(wid_i));
                const int lane = fresh_lane(), tid = wid_i * 64 + lane;
                bf16_t* MIX = BH;
                __syncthreads();
                if (tid == 0) *qslot = (int)__hip_atomic_fetch_add((unsigned*)(ws + WS_CTL) + CW_QUEUE + l * 64, 1u, __ATOMIC_RELAXED, __HIP_MEMORY_SCOPE_AGENT);
                __syncthreads();
                const int u = __builtin_amdgcn_readfirstlane(*qslot);
                if (u >= n_items) break;
                att::Unit U;
                if (u < n_mla) { const int u1 = u % n_mla1; const int qb = u1 & 7, bh = u1 >> 3, b = bh / 6, h = bh % 6; const int row0 = b * T + qb * 512;
                    U.qn = QM + (size_t)row0 * NQM + h * 64; U.ldq = NQM; U.qr = QM + (size_t)row0 * NQM + 384 + h * 32; U.ldqr = NQM;
                    U.kn = KVM + h * 128; U.ldk = NKVM; U.kr = BP + PC_KR; U.ldkr = NP; U.v = KVM + h * 128 + 64; U.ldv = NKVM;
                    U.o = MIX + (size_t)row0 * D + 640 + h * 64; U.ldo = D; U.na = 64; U.rowa = b * T; U.rowc = ML + b * NC; U.rg = 0; U.rlo = 0;
                    if (EN(15)) { const bool ok = att::attn_unit64((LAS char*)lds, U, wid_i);
                        if (!ok && tid == 0) { unsigned* rd = (unsigned*)(ws + WS_CTL) + CW_REDO + l * 512; const unsigned ix = __hip_atomic_fetch_add(rd, 1u, __ATOMIC_RELAXED, __HIP_MEMORY_SCOPE_AGENT); rd[1 + ix] = (unsigned)u; } }
                } else if (u < n_mla + n_na) { const int v = (u - n_mla) % n_na1, rg = v & 15, bh = v >> 4, b = bh / 6, h = bh % 6; const int row0 = b * T + rg * 256;
                    const int rlo = min(max(4 * rg - 4, 0), 56), rhi = min(max(4 * rg - 1, 0), 56) + 7;
                    { LAS float* bt = (LAS float*)(lds + att::OFF_BIAS); const float* rp = args.in[I_RPB] + ((size_t)l * 6 + h) * 15 * 31;
                      for (int i = tid; i < 640; i += 512) { const int k = i - 64; bt[i] = (k >= 0 && k < 465) ? rp[k] * LOG2E : 0.f; } }
                    __syncthreads();
                    U.qn = BP + (size_t)row0 * NP + PC_NQ + h * 64; U.ldq = NP; U.qr = nullptr; U.ldqr = 0;
                    U.kn = BP + PC_NK + h * 64; U.ldk = NP; U.kr = nullptr; U.ldkr = 0; U.v = BP + PC_NV + h * 64; U.ldv = NP;
                    U.o = MIX + (size_t)row0 * D + 256 + h * 64; U.ldo = D; U.na = rhi - rlo + 1; U.rowa = b * T + rlo * 64; U.rowc = ML + b * NC; U.rg = rg; U.rlo = rlo;
                    if (EN(15)) { const bool ok = att::attn_unit<8, true, true>((LAS char*)lds, U, wid_i);
                        if (!ok && tid == 0) { unsigned* rd = (unsigned*)(ws + WS_CTL) + CW_REDO2 + l * 1024; const unsigned ix = __hip_atomic_fetch_add(rd, 1u, __ATOMIC_RELAXED, __HIP_MEMORY_SCOPE_AGENT); rd[1 + ix] = (unsigned)(u - n_mla); } }
                } else if (u < n_mla + n_na + n_ml) { const int id = ((u - n_mla - n_na) % n_ml1) * 8 + wid_i; int lane_ = lane; asm volatile("" : "+v"(lane_));
                    const int bh = (l == 0) ? id / NCHK : id >> 6, j = (l == 0) ? id % NCHK : 4 + (id & 63);
                    if (EN(16)) ml::out_unit((LAS char*)lds + wid_i * ml::WAVE_LDS, bh >> 2, bh & 3, j, BP, convw, igb, fgb, mnw, CIN, NIN, MINb, MIX, lane_);
                } else { const int v = u - n_mla - n_na - n_ml, kind = v & 1, bh = v >> 1, b = bh / 6, h = bh % 6; const int row0 = ML + b * NC;
                    U.na = 0; U.rowa = 0; U.rowc = row0; U.rg = 0; U.rlo = 0; U.ldo = D;
                    if (kind == 0) { U.qn = QM + (size_t)row0 * NQM + h * 64; U.ldq = NQM; U.qr = QM + (size_t)row0 * NQM + 384 + h * 32; U.ldqr = NQM;
                        U.kn = KVM + h * 128; U.ldk = NKVM; U.kr = BP + PC_KR; U.ldkr = NP; U.v = KVM + h * 128 + 64; U.ldv = NKVM; U.o = MIX + (size_t)row0 * D + 640 + h * 64;
                        if (EN(15)) (void)att::attn_unit<12, false>((LAS char*)lds, U, wid_i);
                    } else { U.qn = BP + (size_t)row0 * NP + PC_NQ + h * 64; U.ldq = NP; U.qr = nullptr; U.ldqr = 0;
                        U.kn = BP + PC_NK + h * 64; U.ldk = NP; U.kr = nullptr; U.ldkr = 0; U.v = BP + PC_NV + h * 64; U.ldv = NP; U.o = MIX + (size_t)row0 * D + 256 + h * 64;
                        if (EN(15)) (void)att::attn_unit<8, false>((LAS char*)lds, U, wid_i); }
                }
            }
        }
        SEAM(pb + 4);
        if (EN(6) && IN(pb + 5)) { PHASE_WS();
            {
              unsigned* rd = (unsigned*)(ws + WS_CTL) + CW_REDO + l * 512; const int nredo = (int)__hip_atomic_load(rd, __ATOMIC_RELAXED, __HIP_MEMORY_SCOPE_AGENT);
              unsigned* rd2 = (unsigned*)(ws + WS_CTL) + CW_REDO2 + l * 1024; const int nredo2 = (int)__hip_atomic_load(rd2, __ATOMIC_RELAXED, __HIP_MEMORY_SCOPE_AGENT);
              if (nredo2 > 0) {
                  for (int i = blockIdx.x; i < nredo2; i += G) { const int v = (int)rd2[1 + i] % (NB * 6 * 16), rg = v & 15, bh = v >> 4, b = bh / 6, h = bh % 6; const int row0 = b * T + rg * 256;
                      const int rlo = min(max(4 * rg - 4, 0), 56), rhi = min(max(4 * rg - 1, 0), 56) + 7; const int tid_ = wid0 * 64 + fresh_lane();
                      __syncthreads();
                      { LAS float* bt = (LAS float*)(lds + att::OFF_BIAS); const float* rp = args.in[I_RPB] + ((size_t)l * 6 + h) * 15 * 31;
                        for (int q = tid_; q < 640; q += 512) { const int k = q - 64; bt[q] = (k >= 0 && k < 465) ? rp[k] * LOG2E : 0.f; } }
                      __syncthreads();
                      att::Unit U; U.qn = BP + (size_t)row0 * NP + PC_NQ + h * 64; U.ldq = NP; U.qr = nullptr; U.ldqr = 0;
                      U.kn = BP + PC_NK + h * 64; U.ldk = NP; U.kr = nullptr; U.ldkr = 0; U.v = BP + PC_NV + h * 64; U.ldv = NP;
                      U.o = BH + (size_t)row0 * D + 256 + h * 64; U.ldo = D; U.na = rhi - rlo + 1; U.rowa = b * T + rlo * 64; U.rowc = ML + b * NC; U.rg = rg; U.rlo = rlo;
                      (void)att::attn_unit<8, true>((LAS char*)lds, U, wid0); }
              }
              if (nredo > 0) {
                  for (int i = blockIdx.x; i < 2 * nredo; i += G) { const int u1 = (int)rd[1 + (i >> 1)] % (NB * 6 * 8), hf = i & 1; const int qb = u1 & 7, bh = u1 >> 3, b = bh / 6, h = bh % 6; const int row0 = b * T + qb * 512 + hf * 256;
                      att::Unit U; U.qn = QM + (size_t)row0 * NQM + h * 64; U.ldq = NQM; U.qr = QM + (size_t)row0 * NQM + 384 + h * 32; U.ldqr = NQM;
                      U.kn = KVM + h * 128; U.ldk = NKVM; U.kr = BP + PC_KR; U.ldkr = NP; U.v = KVM + h * 128 + 64; U.ldv = NKVM;
                      U.o = BH + (size_t)row0 * D + 640 + h * 64; U.ldo = D; U.na = 64; U.rowa = b * T; U.rowc = ML + b * NC; U.rg = 0; U.rlo = 0;
                      (void)att::attn_unit<12, false>((LAS char*)lds, U, wid0); }
              }
              if (nredo > 0 || nredo2 > 0) GRID_BAR(); }
            pg8::Gemm g{BH, D, Wout + (size_t)l * 1024 * 1024, D}; pg8::TailSplit<pg8::StaticOrder> S; S.init(ML / 256, 4, G, blockIdx.x, D); S.init_ts(ML / 256, l == 0 ? MC / 256 : 0, 4);
            pg8::EpiRes2 E{l == 0 ? x_in : xout, xout, mod_l + 2 * 1024, 6144, PBW, (size_t)MC * D, ML};
            pg8::gemm_phase<pg8::EpiRes2, pg8::TailSplit<pg8::StaticOrder>, true>(lds, g, S, E, wid0);
        }
        SEAM(pb + 5);
        if (l == 0) {
            if (EN(7) && IN(pb + 6)) { PHASE_IDS();
                const float* nw = args.in[I_N2W] + l * D;
                for (int r = gw; r < M; r += NGW) { const bool lat = r < ML; const int bi = lat ? (r >> 12) : 8;
                    const float* xr = lat ? (xout + (size_t)r * D) : (ctx_in + (size_t)(r - ML) * D); float* xw = lat ? nullptr : (xc + (size_t)(r - ML) * D);
                    f32x4 v[4]; norm_row(xr, nw, mod_l + bi * 6144 + 3 * 1024, mod_l + bi * 6144 + 4 * 1024, lane, v, lat ? nullptr : PBW + (size_t)(r - ML) * D, xw, 4, (size_t)MC * D); store_row_bf16(BH + (size_t)r * D, lane, v); }
            }
            SEAM(pb + 6);
            if (EN(8) && IN(pb + 7)) { PHASE_WS();
                pg8::Gemm g{BH, D, Wf13, D}; pg8::StaticOrder S; S.init(M / 256, 22, G, blockIdx.x, D);
                pg8::EpiSwiglu E{BP, DFF};
                pg8::gemm_phase<pg8::EpiSwiglu, pg8::StaticOrder, true>(lds, g, S, E, wid0);
            }
            SEAM(pb + 7);
            if (EN(9) && IN(pb + 8)) { PHASE_WS();
                pg8::Gemm g{BP, DFF, Wf2, DFF}; pg8::TailSplit<pg8::StaticOrder> S; S.init(ML / 256, 4, G, blockIdx.x, DFF); S.init_ts(ML / 256, MC / 256, 8);
                pg8::EpiRes2 E{xout, xout, mod_l + 5 * 1024, 6144, PBF, (size_t)MC * D, ML};
                pg8::gemm_phase<pg8::EpiRes2, pg8::TailSplit<pg8::StaticOrder>, true>(lds, g, S, E, wid0);
            }
            SEAM(pb + 8);
        } else {
            if (EN(10) && IN(pb + 6)) { PHASE_IDS();
                { LAS float* scr = (LAS float*)(lds + wid * 4352);
                  const int per13 = 352 * 16, per2 = 64 * 44, per = per13 + per2;
                  const float* m1 = args.in[I_M1]; const float* m3 = args.in[I_M3]; const float* m2 = args.in[I_M2]; bf16_t* wm = WMOE;
                  auto resolve = [&](int it, TrItem& T) { const int e = it / per, r = it % per; bf16_t* wb = (bf16_t*)((char*)wm + (size_t)e * WMOE_E);
                      if (r < per13) { TrJob J{m1 + (size_t)e * 1024 * 2816, m3 + (size_t)e * 1024 * 2816, 2816, 1024, 352, 3, wb, nullptr, 1.f}; tr_resolve(J, r, lane, T); }
                      else { TrJob J{m2 + (size_t)e * 2816 * 1024, nullptr, 1024, 2816, 64, 0, wb + (size_t)5632 * 1024, nullptr, 1.f}; tr_resolve(J, r - per13, lane, T); } };
                  tr_run(gw, NGW, NEXP * per, resolve, scr, lane); }
                __syncthreads();
                LAS float* rw = (LAS float*)(lds + 40960);
                LAS int* esel = (LAS int*)(lds + 40960 + 32768);
                for (int i = tid; i < 8192; i += 512) rw[i] = args.in[I_RW][i];
                __syncthreads();
                const float* nw = args.in[I_N2W] + l * D;
                for (int blk = blockIdx.x; blk < ML / 128; blk += G) {
                    for (int rr = wid; rr < 128; rr += 8) { const int r = blk * 128 + rr, bi = r >> 12; f32x4 v[4];
                        norm_row(xout + (size_t)r * D, nw, mod_l + bi * 6144 + 3 * 1024, mod_l + bi * 6144 + 4 * 1024, lane, v);
                        float lg[8];
#pragma unroll
                        for (int e = 0; e < 8; ++e) lg[e] = 0.f;
#pragma unroll
                        for (int j = 0; j < 4; ++j)
#pragma unroll
                            for (int q = 0; q < 4; ++q) { const int c = 4 * lane + 256 * j + q; const f32x4 w0 = *(const LAS f32x4*)(rw + c * 8), w1 = *(const LAS f32x4*)(rw + c * 8 + 4); const float hv = v[j][q];
                                lg[0] += hv * w0.x; lg[1] += hv * w0.y; lg[2] += hv * w0.z; lg[3] += hv * w0.w; lg[4] += hv * w1.x; lg[5] += hv * w1.y; lg[6] += hv * w1.z; lg[7] += hv * w1.w; }
#pragma unroll
                        for (int e = 0; e < 8; ++e) lg[e] = wave_sum(lg[e]);
                        int e0 = 0; float v0 = lg[0];
#pragma unroll
                        for (int e = 1; e < 8; ++e) if (lg[e] > v0) { v0 = lg[e]; e0 = e; }
                        int e1 = -1; float v1 = -INFINITY;
#pragma unroll
                        for (int e = 0; e < 8; ++e) if (e != e0 && lg[e] > v1) { v1 = lg[e]; e1 = e; }
                        const float g0 = 1.0f / (1.0f + expf(v1 - v0));
                        if (lane == 0) { esel[rr * 2] = e0; esel[rr * 2 + 1] = e1; tokg[(size_t)r * 2] = g0; tokg[(size_t)r * 2 + 1] = 1.0f - g0; } }
                    __syncthreads();
                    if (tid < 128) { const int e0 = esel[tid * 2], e1 = esel[tid * 2 + 1]; int s0 = 0, s1 = 0;
                        for (int q = 0; q < tid; ++q) { s0 += (esel[q * 2] == e0); s1 += (esel[q * 2 + 1] == e1); }
                        int* ti = tokinfo + (size_t)(blk * 128 + tid) * 4; ti[0] = e0; ti[1] = e1; ti[2] = s0; ti[3] = s1; }
                    if (tid < 16) { const int k = tid >> 3, e = tid & 7; int c = 0; for (int q = 0; q < 128; ++q) c += (esel[q * 2 + k] == e); wgcnt[blk * 16 + tid] = c; }
                    __syncthreads();
                }
            }
            SEAM(pb + 6);
            if (EN(11) && IN(pb + 7)) { PHASE_IDS();
                LAS int* tot = (LAS int*)(lds);
                LAS int* offp = tot + 16; LAS int* pre = tot + 32;
                __syncthreads();
                LAS int* segs = pre + 4096;
                for (int i = tid; i < 4096; i += 512) pre[i] = wgcnt[i];
                __syncthreads();
                { const int c = tid & 15, sg = tid >> 4; int sm = 0;
#pragma unroll
                  for (int q = 0; q < 8; ++q) sm += pre[(sg * 8 + q) * 16 + c];
                  segs[sg * 16 + c] = sm; }
                __syncthreads();
                { const int c = tid & 15, sg = tid >> 4; int run = 0; for (int q = 0; q < sg; ++q) run += segs[q * 16 + c];
#pragma unroll
                  for (int q = 0; q < 8; ++q) { const int v = pre[(sg * 8 + q) * 16 + c]; pre[(sg * 8 + q) * 16 + c] = run; run += v; }
                  if (sg == 31) tot[c] = run; }
                __syncthreads();
                if (tid == 0) { int o = 0; for (int e = 0; e < 8; ++e) { offp[e] = o; o += (tot[e] + tot[8 + e] + 255) & ~255; }
                    if (blockIdx.x == 0) { tileexp[320] = o >> 8; for (int e = 0; e < 8; ++e) { const int t0 = offp[e] >> 8, nt = (tot[e] + tot[8 + e] + 255) >> 8; for (int q = 0; q < nt; ++q) tileexp[t0 + q] = e; } } }
                __syncthreads();
                const float* nw = args.in[I_N2W] + l * D;
                for (int blk = blockIdx.x; blk < ML / 128; blk += G) {
                    for (int rr = wid; rr < 128; rr += 8) { const int r = blk * 128 + rr, bi = r >> 12; f32x4 v[4];
                        norm_row(xout + (size_t)r * D, nw, mod_l + bi * 6144 + 3 * 1024, mod_l + bi * 6144 + 4 * 1024, lane, v);
                        const int* ti = tokinfo + (size_t)r * 4;
#pragma unroll
                        for (int k = 0; k < 2; ++k) { const int e = ti[k], pos = offp[e] + (k == 0 ? 0 : tot[e]) + pre[blk * 16 + k * 8 + e] + ti[2 + k];
                            store_row_bf16(ASORT + (size_t)pos * D, lane, v);
                            if (lane == 0) tokinfo[(size_t)r * 4 + 2 + k] = pos; } }
                }
            }
            SEAM(pb + 7);
            for (int k = 0; k < 2; ++k) {
                if (EN(12) && IN(pb + 8 + 2 * k)) { PHASE_WS();
                    const int ntl = tileexp[320], t0 = k == 0 ? 0 : 128, t1 = k == 0 ? (ntl < 128 ? ntl : 128) : ntl;
                    pg8::Gemm g{ASORT + (size_t)t0 * 256 * D, D, WMOE, D}; pg8::GroupedOrder S; S.init(t1 > t0 ? t1 - t0 : 0, 22, G, blockIdx.x, D); S.tile_exp = tileexp + t0; S.estride = WMOE_E;
                    pg8::EpiSwiglu E{UB, DFF};
                    pg8::gemm_phase<pg8::EpiSwiglu, pg8::GroupedOrder, true>(lds, g, S, E, wid0);
                }
                SEAM(pb + 8 + 2 * k);
                if (EN(13) && IN(pb + 9 + 2 * k)) { PHASE_WS();
                    const int ntl = tileexp[320], t0 = k == 0 ? 0 : 128, t1 = k == 0 ? (ntl < 128 ? ntl : 128) : ntl;
                    const int nmp = t1 > t0 ? t1 - t0 : 0, nmain = nmp < 128 ? nmp : 128;
                    pg8::Gemm g{UB, DFF, WMOE + (size_t)5632 * 1024, DFF}; pg8::TailSplit<pg8::GroupedOrder> S; S.init(nmain, 4, G, blockIdx.x, DFF); S.tile_exp = tileexp + t0; S.estride = WMOE_E; S.init_ts(nmain, nmp - nmain, 11);
                    pg8::EpiDelta E{ASORT + (size_t)t0 * 256 * D, nullptr, 0, PBY, (size_t)7 * 256 * D, 128 * 256};
                    pg8::gemm_phase<pg8::EpiDelta, pg8::TailSplit<pg8::GroupedOrder>, true>(lds, g, S, E, wid0);
                }
                SEAM(pb + 9 + 2 * k);
            }
        }
    }

constexpr int NPHASE = 24;
__global__ void __launch_bounds__(512, 2) mega_fwd(Args args) {
    extern __shared__ __attribute__((aligned(16))) unsigned char lds_raw[];
    LAS unsigned char* lds = (LAS unsigned char*)lds_raw;
    const int G = gridDim.x, NGW = G * 8;
    const int wid0 = __builtin_amdgcn_readfirstlane(threadIdx.x >> 6);
    if (threadIdx.x < 4) ((volatile LAS unsigned*)(lds + LDS_MISC))[threadIdx.x] = 0u;
    __syncthreads();
#if !MK_MULTI
    XcdBarrier bar = xcd_barrier_post((unsigned*)(args.ws + WS_CTL) + CW_BAR, (volatile LAS unsigned*)(lds + LDS_MISC));
    constexpr int lo = 0, hi_ph = 1000;
#else
    XcdBarrier bar; bar.bar = nullptr; bar.x = 0; bar.st = nullptr;
    const int lo = args.ph_lo, hi_ph = args.ph_hi;
#endif
    if (EN(0) && IN(0)) { PHASE_IDS();
        LAS float* scr = (LAS float*)(lds + wid * 4352);
        TrJob jobs[10];
        for (int l = 0; l < 2; ++l) {
            jobs[l * 4 + 0] = TrJob{args.in[I_WIN] + (size_t)l * 1024 * 2992, nullptr, 2992, 1024, 192, 1, Win + (size_t)l * 3072 * 1024, nullptr, 1.f};
            jobs[l * 4 + 1] = TrJob{args.in[I_WOUT] + (size_t)l * 1024 * 1024, nullptr, 1024, 1024, 64, 0, Wout + (size_t)l * 1024 * 1024, nullptr, 1.f};
            jobs[l * 4 + 2] = TrJob{args.in[I_WUQ] + (size_t)l * 512 * 576, nullptr, 576, 512, 36, 2, Wuq + (size_t)l * 768 * 512, args.in[I_QNW] + l * 512, 0.10206207261596577f * LOG2E};
            jobs[l * 4 + 3] = TrJob{args.in[I_WUKV] + (size_t)l * 256 * 768, nullptr, 768, 256, 48, 0, Wukv + (size_t)l * 768 * 256, args.in[I_KVNW] + l * 256, 1.f};
        }
        jobs[8] = TrJob{args.in[I_F1], args.in[I_F3], 2816, 1024, 352, 3, Wf13, nullptr, 1.f};
        jobs[9] = TrJob{args.in[I_F2], nullptr, 1024, 2816, 64, 0, Wf2, nullptr, 1.f};
        int total = 0;
#pragma unroll
        for (int q = 0; q < 10; ++q) total += tr_job_count(jobs[q]);
        { auto resolve = [&](int it, TrItem& T) { int r = it;
#pragma unroll
              for (int q = 0; q < 10; ++q) { const int n = tr_job_count(jobs[q]); if (r >= 0 && r < n) tr_resolve(jobs[q], r, lane, T); r -= n; } };
          tr_run(gw, NGW, total, resolve, scr, lane); }
        for (int item = blockIdx.x; item < 192; item += G) mod_item((LAS char*)lds + 40960, wid0, item, args.in[I_C], args.in[I_CCTX], args.in[I_ADAW], args.in[I_ADAB], modv);
        if (blockIdx.x == 0) { const int pos = tid >> 3, jj = tid & 7; const float inv = powf(10000.0f, -(float)jj / 8.0f); const float a = (float)pos * inv; ropet[pos * 8 + jj] = cosf(a); ropet[512 + pos * 8 + jj] = sinf(a); }
    }
    SEAM(0);

    layer_phases<0>(args, lds, G, NGW, bar, lo, hi_ph, wid0);
    layer_phases<1>(args, lds, G, NGW, bar, lo, hi_ph, wid0);
    if (EN(14) && IN(23)) { PHASE_IDS();
        const float* nw = args.in[I_FNW]; const float* g5 = modv + (size_t)9 * 6144 + 5 * 1024;
        auto unpk = [](const u32x2 a) -> f32x4 { f32x4 y; y.x = bf2f(a.x & 0xffffu); y.y = __uint_as_float(a.x & 0xffff0000u); y.z = bf2f(a.y & 0xffffu); y.w = __uint_as_float(a.y & 0xffff0000u); return y; };
        auto yload = [&](int pos, int c) -> f32x4 { f32x4 y = {0.f, 0.f, 0.f, 0.f};
            if (pos < 65536) y = unpk(*(const u32x2*)(ASORT + (size_t)pos * D + c));
            else { for (int p = 0; p < 11; ++p) y += unpk(*(const u32x2*)(PBY + ((size_t)p * 7 * 256 + (pos - 65536)) * D + c)); }
            return y; };
        auto row_slow = [&](int r) { float* xr = xout + (size_t)r * D; f32x4 v[4]; float s = 0.f;
            const int p0 = tokinfo[(size_t)r * 4 + 2], p1 = tokinfo[(size_t)r * 4 + 3]; const float g0 = tokg[(size_t)r * 2], g1 = tokg[(size_t)r * 2 + 1];
            const float* gp = g5 + (size_t)(r >> 12) * 6144;
#pragma unroll
            for (int j = 0; j < 4; ++j) { const int c = 4 * lane + 256 * j; v[j] = *(const f32x4*)(xr + c); const f32x4 gg = *(const f32x4*)(gp + c);
                const f32x4 ya = yload(p0, c), yb = yload(p1, c);
                v[j] += gg * (ya * g0 + yb * g1);
                s += (v[j].x * v[j].x + v[j].y * v[j].y) + (v[j].z * v[j].z + v[j].w * v[j].w); }
            const float rs = 1.0f / sqrtf(wave_sum(s) * (1.0f / D) + EPS);
#pragma unroll
            for (int j = 0; j < 4; ++j) { const f32x4 w = *(const f32x4*)(nw + 4 * lane + 256 * j); *(f32x4*)(xr + 4 * lane + 256 * j) = v[j] * rs * w; } };
        for (int r = gw; r < ML; r += 2 * NGW) { const int rA = r, rB = r + NGW;
            if (rB >= ML) { row_slow(rA); continue; }
            const int pA0 = tokinfo[(size_t)rA * 4 + 2], pA1 = tokinfo[(size_t)rA * 4 + 3], pB0 = tokinfo[(size_t)rB * 4 + 2], pB1 = tokinfo[(size_t)rB * 4 + 3];
            if (__builtin_amdgcn_readfirstlane((pA0 | pA1 | pB0 | pB1) >= 65536 ? 1 : 0)) { row_slow(rA); row_slow(rB); continue; }
            const float gA0 = tokg[(size_t)rA * 2], gA1 = tokg[(size_t)rA * 2 + 1], gB0 = tokg[(size_t)rB * 2], gB1 = tokg[(size_t)rB * 2 + 1];
            float* xa = xout + (size_t)rA * D; float* xb = xout + (size_t)rB * D;
            f32x4 va[4], vb[4]; u32x2 ya0[4], ya1[4], yb0[4], yb1[4];
#pragma unroll
            for (int j = 0; j < 4; ++j) { const int c = 4 * lane + 256 * j; va[j] = *(const f32x4*)(xa + c); vb[j] = *(const f32x4*)(xb + c);
                ya0[j] = *(const u32x2*)(ASORT + (size_t)pA0 * D + c); ya1[j] = *(const u32x2*)(ASORT + (size_t)pA1 * D + c);
                yb0[j] = *(const u32x2*)(ASORT + (size_t)pB0 * D + c); yb1[j] = *(const u32x2*)(ASORT + (size_t)pB1 * D + c); }
            const float* gpa = g5 + (size_t)(rA >> 12) * 6144; const float* gpb = g5 + (size_t)(rB >> 12) * 6144;
            float sa = 0.f, sb = 0.f;
#pragma unroll
            for (int j = 0; j < 4; ++j) { const int c = 4 * lane + 256 * j; const f32x4 ga = *(const f32x4*)(gpa + c), gb = *(const f32x4*)(gpb + c);
                va[j] += ga * (unpk(ya0[j]) * gA0 + unpk(ya1[j]) * gA1); vb[j] += gb * (unpk(yb0[j]) * gB0 + unpk(yb1[j]) * gB1);
                sa += (va[j].x * va[j].x + va[j].y * va[j].y) + (va[j].z * va[j].z + va[j].w * va[j].w); sb += (vb[j].x * vb[j].x + vb[j].y * vb[j].y) + (vb[j].z * vb[j].z + vb[j].w * vb[j].w); }
            const float rsa = 1.0f / sqrtf(wave_sum(sa) * (1.0f / D) + EPS), rsb = 1.0f / sqrtf(wave_sum(sb) * (1.0f / D) + EPS);
#pragma unroll
            for (int j = 0; j < 4; ++j) { const f32x4 w = *(const f32x4*)(nw + 4 * lane + 256 * j); *(f32x4*)(xa + 4 * lane + 256 * j) = va[j] * rsa * w; *(f32x4*)(xb + 4 * lane + 256 * j) = vb[j] * rsb * w; } }
    }
}

extern "C" void kernel_launch(void* const* d_in, const int* in_sizes, int n_in, void* d_out, int out_size, void* d_ws, size_t ws_size, hipStream_t stream) {
    static int grid = 0;
    if (grid == 0) {
        if (n_in != 27 || out_size != ML * D || ws_size < WS_END) { fprintf(stderr, "kernel_launch: unexpected sizes (n_in %d out %d ws %zu need %zu)\n", n_in, out_size, ws_size, (size_t)WS_END); grid = -1; return; }
        int dev = 0, cus = 0;
        if (hipGetDevice(&dev) != hipSuccess || hipDeviceGetAttribute(&cus, hipDeviceAttributeMultiprocessorCount, dev) != hipSuccess) { grid = -1; return; }
        if (hipFuncSetAttribute((const void*)mega_fwd, hipFuncAttributeMaxDynamicSharedMemorySize, LDS_BYTES) != hipSuccess) { fprintf(stderr, "kernel_launch: hipFuncSetAttribute failed\n"); grid = -1; return; }
        int per_cu = 0;
        if (hipOccupancyMaxActiveBlocksPerMultiprocessor(&per_cu, (const void*)mega_fwd, 512, LDS_BYTES) != hipSuccess || per_cu < 1) fprintf(stderr, "kernel_launch: occupancy query says %d\n", per_cu);
        (void)hipGetLastError();
        grid = cus;
    }
    if (grid < 0) return;
    if (hipMemsetAsync((char*)d_ws + WS_CTL, 0, CTL_ZERO_BYTES, stream) != hipSuccess) return;
    Args a{};
    for (int i = 0; i < 27; ++i) a.in[i] = (const float*)d_in[i];
    a.out = (float*)d_out; a.ws = (unsigned char*)d_ws;
#if MK_MULTI
#ifndef MK_DUP0
#define MK_DUP0 -1
#endif
#ifndef MK_DUP1
#define MK_DUP1 -1
#endif
    for (int ph = 0; ph < NPHASE; ++ph) { a.ph_lo = ph; a.ph_hi = ph + 1; const int reps = (ph == MK_DUP0 || ph == MK_DUP1) ? 2 : 1;
        for (int r = 0; r < reps; ++r) hipLaunchKernelGGL(mega_fwd, dim3(grid), dim3(512), LDS_BYTES, stream, a); }
#else
    a.ph_lo = 0; a.ph_hi = NPHASE;
    hipLaunchKernelGGL(mega_fwd, dim3(grid), dim3(512), LDS_BYTES, stream, a);
#endif
}
```

```cpp
#include <hip/hip_runtime.h>
#include <stdint.h>
#include <stdio.h>

#ifndef MK_MULTI
#define MK_MULTI 0
#endif

#define LAS __attribute__((address_space(3)))
#define GAS __attribute__((address_space(1)))
typedef unsigned short bf16_t;
typedef short bf16x8 __attribute__((ext_vector_type(8)));
typedef short s16x4 __attribute__((ext_vector_type(4)));
typedef float f32x2 __attribute__((ext_vector_type(2)));
typedef float f32x4 __attribute__((ext_vector_type(4)));
typedef float f32x16 __attribute__((ext_vector_type(16)));
typedef unsigned u32x2 __attribute__((ext_vector_type(2)));
typedef unsigned u32x4 __attribute__((ext_vector_type(4)));
typedef __bf16 bf16x2_t __attribute__((ext_vector_type(2)));

constexpr int NB = 8, T = 4096, D = 1024, NC = 256;
constexpr int ML = NB * T, MC = NB * NC, M = ML + MC;
constexpr int NP = 3072;
constexpr int PC_QL = 0, PC_KVL = 512, PC_MQ = 768, PC_MK = 1024, PC_MV = 1280, PC_MO = 1536, PC_NQ = 1792, PC_NK = 2176, PC_NV = 2560, PC_KR = 2944, PC_GT = 2976;
constexpr int NQM = 576, NKVM = 768;
constexpr int DFF = 2816, NEXP = 8;
constexpr int NCHK = 68;
constexpr float LOG2E = 1.4426950408889634f;
constexpr float EPS = 1e-6f;

constexpr size_t MiB = 1u << 20;
constexpr size_t WS_CTL = 0, CTL_ZERO_BYTES = 1 * MiB;
constexpr size_t WS_SMALL = 1 * MiB;
constexpr size_t SM_MOD = WS_SMALL;
constexpr size_t SM_ROPE = SM_MOD + 2 * 9 * 6144 * 4;
constexpr size_t SM_STATS = WS_SMALL + 1 * MiB;
constexpr size_t SM_NLOC = WS_SMALL + 5 * MiB;
constexpr size_t SM_NIN = WS_SMALL + 7 * MiB;
constexpr size_t SM_MG = WS_SMALL + 9 * MiB;
constexpr size_t SM_MIN = SM_MG + 256 * 1024;
constexpr size_t SM_TOK = WS_SMALL + 10 * MiB;
constexpr size_t SM_TOKG = SM_TOK + (size_t)ML * 16;
constexpr size_t SM_WGCNT = WS_SMALL + 11 * MiB;
constexpr size_t SM_ROWTOK = SM_WGCNT + 64 * 1024;
constexpr size_t SM_ROWGATE = SM_ROWTOK + (size_t)2 * M * 4;
constexpr size_t SM_TILEEXP = SM_ROWGATE + (size_t)2 * M * 4;
constexpr size_t WS_WSMALL = 17 * MiB;
constexpr size_t W_IN = WS_WSMALL;
constexpr size_t W_OUT = W_IN + (size_t)2 * 3072 * 1024 * 2;
constexpr size_t W_UQ = W_OUT + (size_t)2 * 1024 * 1024 * 2;
constexpr size_t W_UKV = W_UQ + (size_t)2 * 768 * 512 * 2;
constexpr size_t W_F13 = W_UKV + (size_t)2 * 768 * 256 * 2;
constexpr size_t W_F2 = W_F13 + (size_t)5632 * 1024 * 2;
constexpr size_t WS_XC = 52 * MiB;
constexpr size_t WS_H = 60 * MiB;
constexpr size_t WS_P = 128 * MiB;
constexpr size_t WS_QM = 332 * MiB;
constexpr size_t WS_KVM = 371 * MiB;
constexpr size_t WS_CIN = 422 * MiB;
constexpr size_t WS_END_MIX = 456 * MiB;
constexpr size_t WS_WMOE = 17 * MiB;
constexpr size_t WMOE_E = (size_t)5632 * 1024 * 2 + (size_t)1024 * 2816 * 2;
constexpr size_t WS_U = 149 * MiB;
constexpr size_t WS_ASORT = 336 * MiB;
constexpr size_t WS_PBY = 472 * MiB;
constexpr size_t WS_END = 516 * MiB;
constexpr size_t WS_PBF = WS_QM;
constexpr size_t WS_PBW = WS_KVM;
static_assert(W_F2 + (size_t)1024 * 2816 * 2 <= WS_XC, "weights");
static_assert(WS_H + (size_t)M * 1024 * 2 <= WS_P && WS_P + (size_t)M * NP * 2 <= WS_QM && WS_QM + (size_t)M * NQM * 2 <= WS_KVM && WS_KVM + (size_t)M * NKVM * 2 <= WS_CIN, "map");
static_assert(WS_CIN + (size_t)2 * 8 * 4 * NCHK * 4096 * 2 <= WS_END_MIX, "map2");
static_assert(WS_WMOE + 8 * WMOE_E <= WS_U && WS_U + (size_t)M * DFF * 2 <= WS_ASORT && WS_ASORT + (size_t)2 * M * 1024 * 2 <= WS_PBY && WS_PBY + (size_t)11 * 7 * 256 * 1024 * 2 <= WS_END, "map3");
static_assert((size_t)2 * 8 * 4 * NCHK * 4096 * 4 <= (size_t)M * 1024 * 2, "C_LOC overlays BUF_H");
static_assert(SM_TILEEXP + 4096 <= WS_WSMALL && SM_TOKG + (size_t)ML * 8 <= SM_WGCNT && SM_STATS + (size_t)M * 24 * 4 <= SM_NLOC, "small map");

constexpr int CW_BAR = 4096;
constexpr int CW_QUEUE = 8192;
constexpr int CW_REDO2 = 8192 + 2048;
constexpr int CW_REDO = 8192 + 256;

constexpr int LDS_BYTES = 155648;
constexpr int LDS_MISC = 155648 - 256;

#define LDS_WAIT() asm volatile("s_waitcnt lgkmcnt(0)" ::: "memory")
#define VM_WAIT() asm volatile("s_waitcnt vmcnt(0)" ::: "memory")
__device__ __forceinline__ float bf2f(unsigned v) { return __uint_as_float(v << 16); }
__device__ __forceinline__ unsigned pk2(float lo, float hi) { f32x2 v = {lo, hi}; bf16x2_t b = __builtin_convertvector(v, bf16x2_t); return __builtin_bit_cast(unsigned, b); }
__device__ __forceinline__ void unpack8(const u32x4 w, float* f) {
    f[0] = __uint_as_float(w.x << 16); f[1] = __uint_as_float(w.x & 0xffff0000u); f[2] = __uint_as_float(w.y << 16); f[3] = __uint_as_float(w.y & 0xffff0000u);
    f[4] = __uint_as_float(w.z << 16); f[5] = __uint_as_float(w.z & 0xffff0000u); f[6] = __uint_as_float(w.w << 16); f[7] = __uint_as_float(w.w & 0xffff0000u);
}
__device__ __forceinline__ u32x4 pack8(const float* f) { u32x4 w; w.x = pk2(f[0], f[1]); w.y = pk2(f[2], f[3]); w.z = pk2(f[4], f[5]); w.w = pk2(f[6], f[7]); return w; }
__device__ __forceinline__ float wave_sum(float v) {
#pragma unroll
    for (int o = 1; o < 64; o <<= 1) v += __shfl_xor(v, o);
    return v;
}
__device__ __forceinline__ float wave_max(float v) {
#pragma unroll
    for (int o = 1; o < 64; o <<= 1) v = fmaxf(v, __shfl_xor(v, o));
    return v;
}
__device__ __forceinline__ float fexp2(float x) { return __builtin_amdgcn_exp2f(x); }
__device__ __forceinline__ float fexp(float x) { return __builtin_amdgcn_exp2f(x * LOG2E); }
__device__ __forceinline__ float frcp(float x) { return __builtin_amdgcn_rcpf(x); }
__device__ __forceinline__ float silu_f(float x) { return x * frcp(1.0f + fexp(-x)); }
__device__ __forceinline__ float sigmoid_f(float x) { return frcp(1.0f + fexp(-x)); }
__device__ __forceinline__ int fresh_lane() { int l; asm volatile("v_mbcnt_lo_u32_b32 %0, -1, 0\n\tv_mbcnt_hi_u32_b32 %0, -1, %0" : "=v"(l)); return l; }
__device__ __forceinline__ float xhalf(float v) { return __shfl_xor(v, 32); }
__device__ __forceinline__ float half_max(float v) { auto rr = __builtin_amdgcn_permlane32_swap(__float_as_uint(v), __float_as_uint(v), false, false); return fmaxf(__uint_as_float(rr[0]), __uint_as_float(rr[1])); }
__device__ __forceinline__ float half_sum(float v) { auto rr = __builtin_amdgcn_permlane32_swap(__float_as_uint(v), __float_as_uint(v), false, false); return __uint_as_float(rr[0]) + __uint_as_float(rr[1]); }

namespace pg8 {
constexpr int BM = 256, BK = 64, HALF = 128, HTB = HALF * BK * 2, STAGE_BYTES = 8 * HTB, NXCD = 8, WGM = 8;
__host__ __device__ __forceinline__ int lds_byte(int r, int c) { const int st = (r >> 4) * 2 + (c >> 5), rr = r & 15, cc = c & 31, ob = rr * 64 + cc * 2; return st * 1024 + (ob ^ (((ob >> 9) & 1) << 5)); }
__host__ __device__ __forceinline__ void stage_rc(int b, int& R, int& C) { const int st = b / 1024, sb = b % 1024, swz = sb ^ (((sb >> 9) & 1) << 5); R = (st >> 1) * 16 + swz / 64; C = (st & 1) * 32 + (swz % 64) / 2; }
__host__ __device__ __forceinline__ int perm32(int rho) { const int n = rho >> 4, i = rho & 15; return 8 * (i >> 2) + 4 * n + (i & 3); }

struct Unit { int pm, pn, kb, ke, part; };
struct Gemm { const bf16_t* A; int lda; const bf16_t* Bt; int K; };

struct StaticOrder {
    int nM, nN, nwg, G, c, nt;
    __device__ void init(int nM_, int nN_, int G_, int c_, int K_) { nM = nM_; nN = nN_; nwg = nM * nN; G = G_; c = c_; nt = K_ / BK; }
    __device__ __forceinline__ void tile_of(int L, Unit& u) const {
        int wgid = L; { const int q = nwg / NXCD, r = nwg % NXCD, xcd = wgid % NXCD, off = wgid / NXCD; wgid = (xcd < r ? xcd * (q + 1) : r * (q + 1) + (xcd - r) * q) + off; }
        const int nig = WGM * nN, gid = wgid / nig, fm = gid * WGM, gsz = (nM - fm) < WGM ? (nM - fm) : WGM;
        u.pm = fm + ((wgid % nig) % gsz); u.pn = (wgid % nig) / gsz;
    }
    __device__ bool next(int i, Unit& u) const {
        const long L = (long)i * G + c; if (L >= nwg) return false;
        tile_of((int)L, u); u.kb = 0; u.ke = nt; u.part = -1; return true;
    }
    __device__ __forceinline__ const char* a_base(const Gemm& g, const Unit& u) const { return (const char*)g.A + (size_t)u.pm * 256 * g.lda * 2 + (size_t)u.kb * (BK * 2); }
    __device__ __forceinline__ const char* b_base(const Gemm& g, const Unit& u) const { return (const char*)g.Bt + (size_t)u.pn * 256 * g.K * 2 + (size_t)u.kb * (BK * 2); }
};
struct GroupedOrder : StaticOrder {
    const int* tile_exp; size_t estride;
    __device__ __forceinline__ const char* b_base(const Gemm& g, const Unit& u) const { return (const char*)g.Bt + (size_t)tile_exp[u.pm] * estride + (size_t)u.pn * 256 * g.K * 2 + (size_t)u.kb * (BK * 2); }
};
template <class Base> struct TailSplit : Base {
    int nMain, nTail, S;
    __device__ void init_ts(int nMain_, int nTail_, int S_) { nMain = nMain_; nTail = nTail_ < 0 ? 0 : nTail_; S = S_; this->nM = nMain; this->nwg = nMain * this->nN; }
    __device__ bool next(int i, Unit& u) const {
        const long L = (long)i * this->G + this->c;
        if (L < this->nwg) { this->tile_of((int)L, u); u.kb = 0; u.ke = this->nt; u.part = -1; return true; }
        const long j = L - this->nwg; const int ntu = nTail * this->nN;
        if (j >= (long)ntu * S) return false;
        const int t = (int)(j % ntu), p = (int)(j / ntu), np = this->nt / 2;
        u.pm = nMain + t / this->nN; u.pn = t % this->nN; u.kb = 2 * (p * np / S); u.ke = 2 * ((p + 1) * np / S); u.part = p; return true;
    }
};

__device__ __forceinline__ unsigned cvt_pk_bf16(float lo, float hi) { unsigned r; asm volatile("v_cvt_pk_bf16_f32 %0, %1, %2" : "=v"(r) : "v"(lo), "v"(hi)); return r; }

template <class Epi, class Sched, bool ALIGN_EPI>
__device__ __forceinline__ void gemm_phase(LAS unsigned char* lds, const Gemm g, const Sched& S, const Epi& E, const int wid0) {
    const int lane = fresh_lane(), wid = wid0, tid = wid * 64 + lane,
    wr = wid >> 2, wc = wid & 3, fr = lane & 15, fq = lane >> 4;
    const int K = g.K;
    unsigned voffA[2], voffB[2];
#pragma unroll
    for (int i = 0; i < 2; ++i) { int R, C; stage_rc(tid * 16 + i * 8192, R, C); const int Rb = Epi::PERM ? ((R & ~31) + perm32(R & 31)) : R;
        voffA[i] = (unsigned)(R * g.lda + C) * 2u; voffB[i] = (unsigned)(Rb * K + C) * 2u; }
    const size_t kstep = (size_t)(BK * 2);
    const size_t hsA = (size_t)HALF * g.lda * 2, hsB = (size_t)HALF * K * 2;
    const unsigned ldsw = (unsigned)wid * 1024u;
    const int aoff = lds_byte(wr * 64 + fr, fq * 8), boff = lds_byte(wc * 32 + fr, fq * 8);
#define PG8_SA(b, h) (((b) * 2 + (h)) * HTB)
#define PG8_SB(b, h) ((4 + (b) * 2 + (h)) * HTB)
#define PG8_STAGE(bufoff, gbase, voff) do { _Pragma("unroll") for (int _i = 0; _i < 2; ++_i) \
        __builtin_amdgcn_global_load_lds((const unsigned*)((const char*)(gbase) + (voff)[_i]), (LAS unsigned*)(lds + (bufoff) + ldsw + _i * 8192), 16, 0, 0); } while (0)
#define PG8_LDA(dst, b, h) do { _Pragma("unroll") for (int m = 0; m < 4; ++m) _Pragma("unroll") for (int k = 0; k < 2; ++k) dst[m][k] = *(const LAS bf16x8*)(lds + PG8_SA(b, h) + aoff + m * 2048 + k * 1024); } while (0)
#define PG8_LDB(dst, b, h) do { _Pragma("unroll") for (int n = 0; n < 2; ++n) _Pragma("unroll") for (int k = 0; k < 2; ++k) dst[n][k] = *(const LAS bf16x8*)(lds + PG8_SB(b, h) + boff + n * 2048 + k * 1024); } while (0)
#define PG8_MMA(ai, bj, At, Bt) do { __builtin_amdgcn_s_setprio(1); _Pragma("unroll") for (int m = 0; m < 4; ++m) _Pragma("unroll") for (int n = 0; n < 2; ++n) _Pragma("unroll") for (int k = 0; k < 2; ++k) \
        acc[ai][bj][m][n] = __builtin_amdgcn_mfma_f32_16x16x32_bf16(Bt[n][k], At[m][k], acc[ai][bj][m][n], 0, 0, 0); __builtin_amdgcn_s_setprio(0); } while (0)
#define PG8_WAIT_V(n) asm volatile("s_waitcnt vmcnt(" #n ")" ::: "memory")
#define PG8_WAIT_L(n) asm volatile("s_waitcnt lgkmcnt(" #n ")" ::: "memory")
#define PG8_BAR __builtin_amdgcn_s_barrier()
#define PG8_SCHED __builtin_amdgcn_sched_barrier(0)
    Unit cur, nxt; int ui = 0;
    if (!S.next(0, cur)) return;
    f32x4 acc[2][2][4][2];
#pragma unroll
    for (int a = 0; a < 2; ++a)
#pragma unroll
        for (int b = 0; b < 2; ++b)
#pragma unroll
            for (int m = 0; m < 4; ++m)
#pragma unroll
                for (int n = 0; n < 2; ++n) acc[a][b][m][n] = (f32x4){0.f, 0.f, 0.f, 0.f};
    bf16x8 At[4][2], B0[2][2], B1[2][2];
    const char* cA = S.a_base(g, cur); const char* cB = S.b_base(g, cur);
    PG8_STAGE(PG8_SB(0, 0), cB, voffB); PG8_STAGE(PG8_SB(0, 1), cB + hsB, voffB); PG8_STAGE(PG8_SA(0, 0), cA, voffA); PG8_STAGE(PG8_SA(0, 1), cA + hsA, voffA);
    if (wr == 1) PG8_BAR;
    PG8_WAIT_V(2); PG8_BAR;
    PG8_STAGE(PG8_SB(1, 0), cB + kstep, voffB); PG8_STAGE(PG8_SA(1, 0), cA + kstep, voffA); PG8_STAGE(PG8_SB(1, 1), cB + hsB + kstep, voffB);
    PG8_WAIT_V(6); PG8_BAR;
    for (;;) {
        const bool has_next = S.next(ui + 1, nxt);
        const char* nA = has_next ? S.a_base(g, nxt) : cA; const char* nB = has_next ? S.b_base(g, nxt) : cB;
        const int ntc = cur.ke - cur.kb;
#pragma unroll 1
        for (int t = 0; t < ntc; t += 2) {
            const bool last = (t == ntc - 2);
            const char* a1 = cA + (size_t)(t + 1) * kstep;
            const char* a2 = last ? nA : cA + (size_t)(t + 2) * kstep; const char* b2 = last ? nB : cB + (size_t)(t + 2) * kstep;
            const char* a3 = a2 + kstep; const char* b3 = b2 + kstep;
            PG8_LDB(B0, 0, 0); PG8_LDB(B1, 0, 1); PG8_SCHED; PG8_LDA(At, 0, 0); PG8_STAGE(PG8_SA(1, 1), a1 + hsA, voffA);
            PG8_WAIT_V(8); PG8_WAIT_L(0); PG8_BAR; PG8_MMA(0, 0, At, B0); PG8_MMA(0, 1, At, B1); PG8_BAR; PG8_SCHED;
            PG8_LDA(At, 0, 1); PG8_STAGE(PG8_SB(0, 0), b2, voffB); PG8_STAGE(PG8_SB(0, 1), b2 + hsB, voffB); PG8_STAGE(PG8_SA(0, 0), a2, voffA);
            PG8_WAIT_V(8); PG8_WAIT_L(0); PG8_BAR; PG8_MMA(1, 0, At, B0); PG8_MMA(1, 1, At, B1); PG8_BAR; PG8_SCHED;
            PG8_LDB(B0, 1, 0); PG8_LDB(B1, 1, 1); PG8_SCHED; PG8_LDA(At, 1, 0); PG8_STAGE(PG8_SA(0, 1), a2 + hsA, voffA);
            PG8_WAIT_V(8); PG8_WAIT_L(0); PG8_BAR; PG8_MMA(0, 0, At, B0); PG8_MMA(0, 1, At, B1); PG8_BAR; PG8_SCHED;
            PG8_LDA(At, 1, 1); PG8_STAGE(PG8_SB(1, 0), b3, voffB); PG8_STAGE(PG8_SB(1, 1), b3 + hsB, voffB); PG8_STAGE(PG8_SA(1, 0), a3, voffA);
            PG8_WAIT_V(8); PG8_WAIT_L(0); PG8_BAR; PG8_MMA(1, 0, At, B0); PG8_MMA(1, 1, At, B1); PG8_BAR; PG8_SCHED;
        }
        if constexpr (ALIGN_EPI) { if (wr == 0) PG8_BAR; }
        E(acc, cur, wr, wc, fr, fq);
        if (!has_next) break;
#pragma unroll
        for (int a = 0; a < 2; ++a)
#pragma unroll
            for (int b = 0; b < 2; ++b)
#pragma unroll
                for (int m = 0; m < 4; ++m)
#pragma unroll
                    for (int n = 0; n < 2; ++n) acc[a][b][m][n] = (f32x4){0.f, 0.f, 0.f, 0.f};
        cur = nxt; cA = nA; cB = nB; ++ui;
        if constexpr (ALIGN_EPI) { if (wr == 1) PG8_BAR; }
    }
    PG8_WAIT_V(0);
    if constexpr (!ALIGN_EPI) { if (wr == 0) PG8_BAR; }
    PG8_BAR;
#undef PG8_SA
#undef PG8_SB
#undef PG8_STAGE
#undef PG8_LDA
#undef PG8_LDB
#undef PG8_MMA
#undef PG8_WAIT_V
#undef PG8_WAIT_L
#undef PG8_BAR
#undef PG8_SCHED
}

typedef const f32x4 (&AccRef)[2][2][4][2];

__device__ __forceinline__ void rope8(f32x4& v0, f32x4& v1, int fq, int tpos, const float* tab) {
    const int pos = (fq < 2) ? (tpos >> 6) : (tpos & 63);
    const f32x4 c0 = *(const f32x4*)(tab + pos * 8), c1 = *(const f32x4*)(tab + pos * 8 + 4), s0 = *(const f32x4*)(tab + 512 + pos * 8), s1 = *(const f32x4*)(tab + 512 + pos * 8 + 4);
    f32x4 p0, p1;
#pragma unroll
    for (int j = 0; j < 4; ++j) { p0[j] = __shfl_xor(v0[j], 16); p1[j] = __shfl_xor(v1[j], 16); }
    const float sg = (fq & 1) ? 1.f : -1.f;
    v0 = v0 * c0 + sg * (p0 * s0); v1 = v1 * c1 + sg * (p1 * s1);
}

struct EpiP {
    static constexpr bool PERM = true;
    bf16_t* P; float* stats; const float* rope;
    __device__ __forceinline__ void operator()(AccRef acc, const Unit& u, int wr, int wc, int fr, int fq) const {
        const int row0 = u.pm * BM + wr * 64 + fr, col0 = u.pn * BM + wc * 32 + 8 * fq;
        const bool do_stats = u.pn < 3, do_rope = (u.pn == 11) && (wc == 0) && (u.pm < ML / 256);
#pragma unroll
        for (int ai = 0; ai < 2; ++ai)
#pragma unroll
            for (int m = 0; m < 4; ++m) { const int row = row0 + ai * HALF + m * 16; bf16_t* rowp = P + (size_t)row * NP + col0;
#pragma unroll
                for (int bj = 0; bj < 2; ++bj) { f32x4 v0 = acc[ai][bj][m][0], v1 = acc[ai][bj][m][1];
                    if (do_stats) { float ss = (v0[0] * v0[0] + v0[1] * v0[1]) + (v0[2] * v0[2] + v0[3] * v0[3]) + (v1[0] * v1[0] + v1[1] * v1[1]) + (v1[2] * v1[2] + v1[3] * v1[3]);
                        ss += __shfl_xor(ss, 16); ss += __shfl_xor(ss, 32);
                        if (fq == 0) stats[(size_t)row * 24 + u.pn * 8 + bj * 4 + wc] = ss; }
                    if (bj == 1 && do_rope) rope8(v0, v1, fq, row & (T - 1), rope);
                    u32x4 w; w.x = cvt_pk_bf16(v0[0], v0[1]); w.y = cvt_pk_bf16(v0[2], v0[3]); w.z = cvt_pk_bf16(v1[0], v1[1]); w.w = cvt_pk_bf16(v1[2], v1[3]);
                    *(u32x4*)(rowp + bj * HALF) = w; } }
    }
};
template <bool ROPE> struct EpiRS {
    static constexpr bool PERM = true;
    bf16_t* O; int ldc, ncols, rope_c0; const float* stats; int part0, nparts; float invk; const float* rope;
    __device__ __forceinline__ void operator()(AccRef acc, const Unit& u, int wr, int wc, int fr, int fq) const {
        const int row0 = u.pm * BM + wr * 64 + fr, col0 = u.pn * BM + wc * 32 + 8 * fq;
        const int npl = nparts >> 2;
#pragma unroll
        for (int ai = 0; ai < 2; ++ai)
#pragma unroll
            for (int m = 0; m < 4; ++m) { const int row = row0 + ai * HALF + m * 16; bf16_t* rowp = O + (size_t)row * ldc + col0;
                const float* sp = stats + (size_t)row * 24 + part0 + fq * npl; float ss = sp[0] + sp[1]; if (npl == 4) ss += sp[2] + sp[3];
                ss += __shfl_xor(ss, 16); ss += __shfl_xor(ss, 32);
                const float rs = 1.0f / sqrtf(ss * invk + EPS);
#pragma unroll
                for (int bj = 0; bj < 2; ++bj) { const int c = col0 + bj * HALF; f32x4 v0 = acc[ai][bj][m][0] * rs, v1 = acc[ai][bj][m][1] * rs;
                    if (ROPE) { const int cb = u.pn * BM + bj * HALF + wc * 32;
                        if (cb >= rope_c0 && cb < ncols && u.pm < ML / 256) rope8(v0, v1, fq, row & (T - 1), rope); }
                    if (c < ncols) { u32x4 w; w.x = cvt_pk_bf16(v0[0], v0[1]); w.y = cvt_pk_bf16(v0[2], v0[3]); w.z = cvt_pk_bf16(v1[0], v1[1]); w.w = cvt_pk_bf16(v1[2], v1[3]);
                        *(u32x4*)(rowp + bj * HALF) = w; } } }
    }
};
struct EpiDelta {
    static constexpr bool PERM = true;
    bf16_t* O; const float* gate; int gstride;
    bf16_t* Op; size_t pstride; int prow0;
    __device__ __forceinline__ void operator()(AccRef acc, const Unit& u, int wr, int wc, int fr, int fq) const {
        const int row0 = u.pm * BM + wr * 64 + fr - (u.part >= 0 ? prow0 : 0), col0 = u.pn * BM + wc * 32 + 8 * fq;
        bf16_t* const Ob = u.part >= 0 ? Op + (size_t)u.part * pstride : O;
        f32x4 gv[2][2];
#pragma unroll
        for (int bj = 0; bj < 2; ++bj)
#pragma unroll
            for (int n = 0; n < 2; ++n) gv[bj][n] = gate ? *(const f32x4*)(gate + (size_t)(u.pm < ML / 256 ? (u.pm >> 4) : 8) * gstride + col0 + bj * HALF + 4 * n) : (f32x4){1.f, 1.f, 1.f, 1.f};
#pragma unroll
        for (int ai = 0; ai < 2; ++ai)
#pragma unroll
            for (int m = 0; m < 4; ++m) { bf16_t* rowp = Ob + (size_t)(row0 + ai * HALF + m * 16) * D + col0;
#pragma unroll
                for (int bj = 0; bj < 2; ++bj) { const f32x4 v0 = acc[ai][bj][m][0] * gv[bj][0], v1 = acc[ai][bj][m][1] * gv[bj][1];
                    u32x4 w; w.x = cvt_pk_bf16(v0[0], v0[1]); w.y = cvt_pk_bf16(v0[2], v0[3]); w.z = cvt_pk_bf16(v1[0], v1[1]); w.w = cvt_pk_bf16(v1[2], v1[3]);
                    *(u32x4*)(rowp + bj * HALF) = w; } }
    }
};
struct EpiRes2 {
    static constexpr bool PERM = false;
    const float* xin; float* xout; const float* gate; int gstride; bf16_t* Op; size_t pstride; int prow0;
    __device__ __forceinline__ void operator()(AccRef acc, const Unit& u, int wr, int wc, int fr, int fq) const {
        const int row0 = u.pm * BM + wr * 64 + fr, col0 = u.pn * BM + wc * 32 + 4 * fq;
        const float* gp = gate + (size_t)(u.pm < ML / 256 ? (u.pm >> 4) : 8) * gstride + col0;
        f32x4 gv[2][2];
#pragma unroll
        for (int bj = 0; bj < 2; ++bj)
#pragma unroll
            for (int n = 0; n < 2; ++n) gv[bj][n] = *(const f32x4*)(gp + bj * HALF + n * 16);
        if (u.part < 0) {
#pragma unroll
            for (int ai = 0; ai < 2; ++ai)
#pragma unroll
                for (int m = 0; m < 4; ++m) { const size_t off = (size_t)(row0 + ai * HALF + m * 16) * D + col0;
#pragma unroll
                    for (int bj = 0; bj < 2; ++bj)
#pragma unroll
                        for (int n = 0; n < 2; ++n) { const f32x4 xv = *(const f32x4*)(xin + off + bj * HALF + n * 16); *(f32x4*)(xout + off + bj * HALF + n * 16) = xv + gv[bj][n] * acc[ai][bj][m][n]; } }
        } else { bf16_t* ob = Op + (size_t)u.part * pstride;
#pragma unroll
            for (int ai = 0; ai < 2; ++ai)
#pragma unroll
                for (int m = 0; m < 4; ++m) { const size_t off = (size_t)(row0 - prow0 + ai * HALF + m * 16) * D + col0;
#pragma unroll
                    for (int bj = 0; bj < 2; ++bj)
#pragma unroll
                        for (int n = 0; n < 2; ++n) { const f32x4 y = gv[bj][n] * acc[ai][bj][m][n]; u32x2 w; w.x = cvt_pk_bf16(y[0], y[1]); w.y = cvt_pk_bf16(y[2], y[3]); *(u32x2*)(ob + off + bj * HALF + n * 16) = w; } }
        }
    }
};
struct EpiSwiglu {
    static constexpr bool PERM = true;
    bf16_t* U; int ldc;
    __device__ __forceinline__ void operator()(AccRef acc, const Unit& u, int wr, int wc, int fr, int fq) const {
        const int row0 = u.pm * BM + wr * 64 + fr, col0 = u.pn * 128 + wc * 32 + 8 * fq;
#pragma unroll
        for (int ai = 0; ai < 2; ++ai)
#pragma unroll
            for (int m = 0; m < 4; ++m) { bf16_t* rowp = U + (size_t)(row0 + ai * HALF + m * 16) * ldc + col0; float o[8];
#pragma unroll
                for (int n = 0; n < 2; ++n)
#pragma unroll
                    for (int j = 0; j < 4; ++j) { const float a = acc[ai][0][m][n][j], b = acc[ai][1][m][n][j]; o[n * 4 + j] = silu_f(a) * b; }
                u32x4 w; w.x = cvt_pk_bf16(o[0], o[1]); w.y = cvt_pk_bf16(o[2], o[3]); w.z = cvt_pk_bf16(o[4], o[5]); w.w = cvt_pk_bf16(o[6], o[7]);
                *(u32x4*)rowp = w; }
    }
};
}

namespace att {
constexpr int VSLOT = 8192, NSLOT = 3;
constexpr int OFF_K = 0;
constexpr int OFF_V = NSLOT * 12 * 1024;
constexpr int OFF_WS = OFF_V + NSLOT * VSLOT;
constexpr int OFF_OST = OFF_WS + 8 * 512;
constexpr int OFF_BIAS = OFF_OST + 8 * 4096;
constexpr int LDS_END = OFF_BIAS + 640 * 4;
__device__ __forceinline__ int crow(int r, int hi) { return (r & 3) + 8 * (r >> 2) + 4 * hi; }
__device__ __forceinline__ void glds16(const void* gsrc, unsigned lds_dst) { unsigned keep;
    asm volatile("s_mov_b32 %0, m0\n\ts_mov_b32 m0, %2\n\ts_nop 0\n\tglobal_load_lds_dwordx4 %1, off\n\ts_mov_b32 m0, %0" : "=&s"(keep) : "v"(gsrc), "s"(lds_dst) : "memory"); }
__device__ __forceinline__ void glds16s(const void* sbase, unsigned voff, unsigned lds_dst) { unsigned keep;
    asm volatile("s_mov_b32 %0, m0\n\ts_mov_b32 m0, %3\n\ts_nop 0\n\tglobal_load_lds_dwordx4 %1, %2\n\ts_mov_b32 m0, %0" : "=&s"(keep) : "v"(voff), "s"(sbase), "s"(lds_dst) : "memory"); }
__device__ __forceinline__ s16x4 vtr(LAS const char* p) { typedef short v4i16_t __attribute__((ext_vector_type(4)));
    return __builtin_bit_cast(s16x4, __builtin_amdgcn_ds_read_tr16_b64_v4i16((LAS v4i16_t*)p)); }

struct Unit {
    const bf16_t* qn; int ldq;
    const bf16_t* qr; int ldqr;
    const bf16_t* kn; int ldk;
    const bf16_t* kr; int ldkr;
    const bf16_t* v; int ldv;
    bf16_t* o; int ldo;
    int na, rowa, rowc;
    int rg, rlo;
};

template <int NCH, bool NA, bool FAST = false>
__device__ __forceinline__ bool attn_unit(LAS char* lds, const Unit& U, const int wid0) {
    const int lane = fresh_lane(), r32 = lane & 31, hi = lane >> 5, wid = wid0, tid = wid * 64 + lane; (void)tid;
    constexpr int KSLOT = NCH * 1024;
    const unsigned lds0 = (unsigned)(uintptr_t)lds;
    LAS float* wsf = (LAS float*)(lds + OFF_WS) + wid * 128;
    const int NT = U.na + 4;
    bf16x8 qf[NCH / 2];
    { const bf16_t* qp = U.qn + (size_t)(wid * 32 + r32) * U.ldq + hi * 8;
#pragma unroll
      for (int d0 = 0; d0 < 4; ++d0) qf[d0] = *(const bf16x8*)(qp + d0 * 16);
      if constexpr (NCH == 12) { const bf16_t* qp2 = U.qr + (size_t)(wid * 32 + r32) * U.ldqr + hi * 8;
#pragma unroll
          for (int d0 = 0; d0 < 2; ++d0) qf[4 + d0] = *(const bf16x8*)(qp2 + d0 * 16); } }
#pragma unroll
    for (int d0 = 0; d0 < NCH / 2; ++d0) asm volatile("" : "+v"(qf[d0]));
    VM_WAIT();
    auto tile_row = [&](int it) -> int { return it < U.na ? U.rowa + 64 * it : U.rowc + 64 * (it - U.na); };
    auto dma = [&](int it, int slot) {
        const int row = tile_row(it);
        glds16(U.v + (size_t)(row + 16 * (wid & 3) + (lane >> 2)) * U.ldv + (wid >> 2) * 32 + (lane & 3) * 8, (unsigned)__builtin_amdgcn_readfirstlane(lds0 + OFF_V + slot * VSLOT + wid * 1024));
        glds16(U.kn + (size_t)(row + lane) * U.ldk + wid * 8, (unsigned)__builtin_amdgcn_readfirstlane(lds0 + OFF_K + slot * KSLOT + wid * 1024));
        if constexpr (NCH == 12) glds16(U.kr + (size_t)(row + lane) * U.ldkr + (wid & 3) * 8, (unsigned)__builtin_amdgcn_readfirstlane(lds0 + OFF_K + slot * KSLOT + (8 + (wid & 3)) * 1024));
    };
    constexpr int NPER = (NCH == 12) ? 3 : 2;
    dma(0, 0); dma(1, 1);
    float mrun = -INFINITY, lrun = 0.f; f32x16 o[2]; o[0] = f32x16{}; o[1] = f32x16{};
    f32x16 lacc = f32x16{}; const bf16x8 ones = (bf16x8){0x3f80, 0x3f80, 0x3f80, 0x3f80, 0x3f80, 0x3f80, 0x3f80, 0x3f80};
    const int grow = NA ? 4 * U.rg + (wid >> 1) : 0, qc = 32 * (wid & 1) + r32;
    const int r0w = NA ? min(max(grow - 4, 0), 56) : 0, c0w = min(max(qc - 8, 0), 48);
    LAS const float* btab = (LAS const float*)(lds + OFF_BIAS);
    const int vaddr = ((lane >> 4) & 1) * 32 + (lane & 3) * 8 + (4 * hi + ((lane & 15) >> 2)) * 64;
    int slot = 0;
    for (int it = 0; it < NT; ++it) {
        if (it + 1 < NT) { if constexpr (NPER == 3) asm volatile("s_waitcnt vmcnt(3)" ::: "memory"); else asm volatile("s_waitcnt vmcnt(2)" ::: "memory"); }
        else asm volatile("s_waitcnt vmcnt(0)" ::: "memory");
        asm volatile("s_barrier" ::: "memory");
        if (it + 2 < NT) { const int s2 = slot >= 1 ? slot - 1 : 2; dma(it + 2, s2); }
        bool active = true; int dr = 0;
        if constexpr (NA) { if (it < U.na) { const int krow = U.rlo + it; active = (krow >= r0w) && (krow < r0w + 8); dr = krow - grow + 7; } }
        if (active) {
            LAS const char* ks = lds + OFF_K + slot * KSLOT + r32 * 16; LAS const char* vs = lds + OFF_V + slot * VSLOT + vaddr;
            f32x16 p0 = f32x16{}, p1 = f32x16{};
            { bf16x8 kf0[NCH / 2], kf1[NCH / 2];
#pragma unroll
              for (int d0 = 0; d0 < NCH / 2; ++d0) { kf0[d0] = *(const LAS bf16x8*)(ks + (2 * d0 + hi) * 1024); kf1[d0] = *(const LAS bf16x8*)(ks + (2 * d0 + hi) * 1024 + 512); }
              __builtin_amdgcn_sched_barrier(0);
#pragma unroll
              for (int d0 = 0; d0 < NCH / 2; ++d0) { p0 = __builtin_amdgcn_mfma_f32_32x32x16_bf16(kf0[d0], qf[d0], p0, 0, 0, 0); p1 = __builtin_amdgcn_mfma_f32_32x32x16_bf16(kf1[d0], qf[d0], p1, 0, 0, 0); } }
            if constexpr (NA) { if (it < U.na) {
                LAS const float* bt = btab + 64 + dr * 31 + 15 - qc;
#pragma unroll
                for (int r = 0; r < 16; ++r) { const int kc = crow(r, hi);
                    p0[r] = ((unsigned)(kc - c0w) < 16u) ? p0[r] + bt[kc] : -INFINITY;
                    p1[r] = ((unsigned)(kc + 32 - c0w) < 16u) ? p1[r] + bt[kc + 32] : -INFINITY; } } }
            if constexpr (FAST) {
#pragma unroll
                for (int r = 0; r < 16; ++r) { p0[r] = fexp2(p0[r]); p1[r] = fexp2(p1[r]); }
            } else {
            float mx = fmaxf(p0[0], p1[0]);
#pragma unroll
            for (int r = 1; r < 16; ++r) mx = fmaxf(mx, fmaxf(p0[r], p1[r]));
            mx = half_max(mx);
            const float mnew = fmaxf(mrun, mx);
            if (__any(mnew > mrun)) {
                const float alpha = fexp2(mrun - mnew);
                lrun *= alpha; if (hi == 0) wsf[r32] = alpha; LDS_WAIT();
#pragma unroll
                for (int r = 0; r < 16; ++r) { const float a = wsf[crow(r, hi)]; o[0][r] *= a; o[1][r] *= a; }
                mrun = mnew;
            }
            float ls = 0.f;
#pragma unroll
            for (int r = 0; r < 16; ++r) { p0[r] = fexp2(p0[r] - mrun); p1[r] = fexp2(p1[r] - mrun); ls += p0[r] + p1[r]; }
            lrun += ls;
            }
            u32x4 pw[4];
#pragma unroll
            for (int j = 0; j < 4; ++j) { pw[0][j] = pk2(p0[2 * j], p0[2 * j + 1]); pw[1][j] = pk2(p0[8 + 2 * j], p0[9 + 2 * j]); pw[2][j] = pk2(p1[2 * j], p1[2 * j + 1]); pw[3][j] = pk2(p1[8 + 2 * j], p1[9 + 2 * j]); }
#pragma unroll
            for (int k = 0; k < 4; ++k)
#pragma unroll
                for (int db = 0; db < 2; ++db) { const s16x4 lo = vtr(vs + db * 4096 + k * 1024), h4 = vtr(vs + db * 4096 + k * 1024 + 512);
                    const bf16x8 vf = (bf16x8){lo[0], lo[1], lo[2], lo[3], h4[0], h4[1], h4[2], h4[3]};
                    o[db] = __builtin_amdgcn_mfma_f32_32x32x16_bf16(__builtin_bit_cast(bf16x8, pw[k]), vf, o[db], 0, 0, 0);
                    if (FAST && db == 1) lacc = __builtin_amdgcn_mfma_f32_32x32x16_bf16(__builtin_bit_cast(bf16x8, pw[k]), ones, lacc, 0, 0, 0); }
        }
        slot = slot == 2 ? 0 : slot + 1;
    }
    LAS bf16_t* stg = (LAS bf16_t*)(lds + OFF_OST) + wid * 2048;
    if constexpr (FAST) {
        bool bad = false;
#pragma unroll
        for (int r = 0; r < 16; ++r) bad |= !(lacc[r] > 1e-30f && lacc[r] < 1e30f);
        LAS int* gf = (LAS int*)(lds + OFF_OST);
        asm volatile("s_waitcnt lgkmcnt(0)\n\ts_barrier" ::: "memory");
        const int ab = __any(bad) ? 1 : 0; if (lane == 0) gf[wid] = ab;
        asm volatile("s_waitcnt lgkmcnt(0)\n\ts_barrier" ::: "memory");
        int anyb = 0;
#pragma unroll
        for (int w = 0; w < 8; ++w) anyb |= gf[w];
        asm volatile("s_waitcnt lgkmcnt(0)\n\ts_barrier" ::: "memory");
        if (__builtin_amdgcn_readfirstlane(anyb)) return false;
#pragma unroll
        for (int r = 0; r < 16; ++r) { const int orow = crow(r, hi); const float il = frcp(lacc[r]);
#pragma unroll
            for (int db = 0; db < 2; ++db) stg[orow * 64 + db * 32 + r32] = (bf16_t)(pk2(o[db][r] * il, 0.f) & 0xffffu); }
    } else {
        lrun = half_sum(lrun);
        if (hi == 0) wsf[32 + r32] = frcp(lrun); LDS_WAIT();
#pragma unroll
        for (int r = 0; r < 16; ++r) { const int orow = crow(r, hi); const float il = wsf[32 + orow];
#pragma unroll
            for (int db = 0; db < 2; ++db) stg[orow * 64 + db * 32 + r32] = (bf16_t)(pk2(o[db][r] * il, 0.f) & 0xffffu); }
    }
    LDS_WAIT();
    bf16_t* Ow = U.o + (size_t)(wid * 32) * U.ldo;
#pragma unroll
    for (int i = 0; i < 4; ++i) { const int row = i * 8 + (lane >> 3), ch = lane & 7; const u32x4 v = *(const LAS u32x4*)(stg + row * 64 + ch * 8); *(u32x4*)(Ow + (size_t)row * U.ldo + ch * 8) = v; }
    asm volatile("s_waitcnt lgkmcnt(0)\n\ts_barrier" ::: "memory");
    return true;
}

__device__ __forceinline__ float rowmax32(const f32x16& p0, const f32x16& p1) {
    float a = __builtin_fmaxf(__builtin_fmaxf(p0[0], p0[1]), p1[0]), b = __builtin_fmaxf(__builtin_fmaxf(p0[2], p0[3]), p1[1]); a = __builtin_fmaxf(__builtin_fmaxf(a, p1[2]), p1[3]);
#pragma unroll
    for (int r = 4; r < 16; r += 4) { a = __builtin_fmaxf(__builtin_fmaxf(a, p0[r]), p0[r + 1]); b = __builtin_fmaxf(__builtin_fmaxf(b, p0[r + 2]), p0[r + 3]); a = __builtin_fmaxf(__builtin_fmaxf(a, p1[r]), p1[r + 1]); b = __builtin_fmaxf(__builtin_fmaxf(b, p1[r + 2]), p1[r + 3]); }
    const float m = __builtin_fmaxf(a, b); return half_max(m);
}
__device__ __forceinline__ void softmax_step(f32x16& p0, f32x16& p1, float& mref, float& lrun, f32x16 (&o)[2], LAS float* wsf, int r32, int hi, bool first, float thr) {
    const float mx = rowmax32(p0, p1);
    if (first || __any(mx > mref + thr)) {
        const float mnew = first ? mx : __builtin_fmaxf(mx, mref);
        if (!first) { const float alpha = fexp2(mref - mnew); lrun *= alpha; if (hi == 0) wsf[r32] = alpha; LDS_WAIT();
#pragma unroll
            for (int r = 0; r < 16; ++r) { const float a = wsf[crow(r, hi)]; o[0][r] *= a; o[1][r] *= a; } }
        mref = mnew;
    }
    float ls = 0.f;
#pragma unroll
    for (int r = 0; r < 16; ++r) { p0[r] = fexp2(p0[r] - mref); p1[r] = fexp2(p1[r] - mref); ls += p0[r] + p1[r]; }
    lrun += ls;
}
__device__ __forceinline__ bool attn_unit64(LAS char* lds, const Unit& U, const int wid0) {
    constexpr int NCH = 12, KSLOT = NCH * 1024;
    const int lane = fresh_lane(), r32 = lane & 31, hi = lane >> 5, wid = wid0;
    const unsigned lds0 = (unsigned)(uintptr_t)lds;
    LAS float* wsf = (LAS float*)(lds + OFF_WS) + wid * 128;
    const int NT = U.na + 4;
    bf16x8 qf[2][6];
#pragma unroll
    for (int qb = 0; qb < 2; ++qb) { const bf16_t* qp = U.qn + (size_t)(wid * 64 + qb * 32 + r32) * U.ldq + hi * 8; const bf16_t* qp2 = U.qr + (size_t)(wid * 64 + qb * 32 + r32) * U.ldqr + hi * 8;
#pragma unroll
        for (int d0 = 0; d0 < 4; ++d0) qf[qb][d0] = *(const bf16x8*)(qp + d0 * 16);
#pragma unroll
        for (int d0 = 0; d0 < 2; ++d0) qf[qb][4 + d0] = *(const bf16x8*)(qp2 + d0 * 16); }
#pragma unroll
    for (int qb = 0; qb < 2; ++qb)
#pragma unroll
        for (int d0 = 0; d0 < 6; ++d0) asm volatile("" : "+v"(qf[qb][d0]));
    VM_WAIT();
    auto tile_row = [&](int it) -> int { return it < U.na ? U.rowa + 64 * it : U.rowc + 64 * (it - U.na); };
    const unsigned offKn = (unsigned)(lane * U.ldk + wid * 8) * 2u, offKr = (unsigned)(lane * U.ldkr + (wid & 3) * 8) * 2u;
    const unsigned offV = (unsigned)((16 * (wid & 3) + (lane >> 2)) * U.ldv + (wid >> 2) * 32 + (lane & 3) * 8) * 2u;
    auto dma = [&](int it, int slot) {
        const int row = tile_row(it);
        glds16s((const char*)U.v + (size_t)row * U.ldv * 2, offV, (unsigned)__builtin_amdgcn_readfirstlane(lds0 + OFF_V + slot * VSLOT + wid * 1024));
        glds16s((const char*)U.kn + (size_t)row * U.ldk * 2, offKn, (unsigned)__builtin_amdgcn_readfirstlane(lds0 + OFF_K + slot * KSLOT + wid * 1024));
        glds16s((const char*)U.kr + (size_t)row * U.ldkr * 2, offKr, (unsigned)__builtin_amdgcn_readfirstlane(lds0 + OFF_K + slot * KSLOT + (8 + (wid & 3)) * 1024));
    };
    dma(0, 0); dma(1, 1);
    f32x16 lAcc = f32x16{}, lBcc = f32x16{};
    const bf16x8 ones = (bf16x8){0x3f80, 0x3f80, 0x3f80, 0x3f80, 0x3f80, 0x3f80, 0x3f80, 0x3f80}; f32x16 oA[2], oB[2]; oA[0] = f32x16{}; oA[1] = f32x16{}; oB[0] = f32x16{}; oB[1] = f32x16{};
    const int vaddr = ((lane >> 4) & 1) * 32 + (lane & 3) * 8 + (4 * hi + ((lane & 15) >> 2)) * 64;
    int slot = 0;
    for (int it = 0; it < NT; ++it) {
        if (it + 1 < NT) asm volatile("s_waitcnt vmcnt(3)" ::: "memory"); else asm volatile("s_waitcnt vmcnt(0)" ::: "memory");
        asm volatile("s_barrier" ::: "memory");
        if (it + 2 < NT) { const int s2 = slot >= 1 ? slot - 1 : 2; dma(it + 2, s2); }
        LAS const char* ks = lds + OFF_K + slot * KSLOT + r32 * 16; LAS const char* vs = lds + OFF_V + slot * VSLOT + vaddr;
        f32x16 pA0 = f32x16{}, pA1 = f32x16{}, pB0 = f32x16{}, pB1 = f32x16{};
        { bf16x8 a0 = *(const LAS bf16x8*)(ks + hi * 1024), a1 = *(const LAS bf16x8*)(ks + hi * 1024 + 512);
#pragma unroll
          for (int d0 = 0; d0 < 6; ++d0) {
            bf16x8 n0 = a0, n1 = a1;
            if (d0 < 5) { n0 = *(const LAS bf16x8*)(ks + (2 * d0 + 2 + hi) * 1024); n1 = *(const LAS bf16x8*)(ks + (2 * d0 + 2 + hi) * 1024 + 512); }
            __builtin_amdgcn_sched_barrier(0);
            pA0 = __builtin_amdgcn_mfma_f32_32x32x16_bf16(a0, qf[0][d0], pA0, 0, 0, 0); pA1 = __builtin_amdgcn_mfma_f32_32x32x16_bf16(a1, qf[0][d0], pA1, 0, 0, 0);
            pB0 = __builtin_amdgcn_mfma_f32_32x32x16_bf16(a0, qf[1][d0], pB0, 0, 0, 0); pB1 = __builtin_amdgcn_mfma_f32_32x32x16_bf16(a1, qf[1][d0], pB1, 0, 0, 0);
            __builtin_amdgcn_sched_barrier(0);
            a0 = n0; a1 = n1; } }
        __builtin_amdgcn_sched_barrier(0);
        { _Pragma("unroll") for (int r = 0; r < 16; ++r) { pA0[r] = fexp2(pA0[r]); pA1[r] = fexp2(pA1[r]); } }
        u32x4 pwA[4];
#pragma unroll
        for (int j = 0; j < 4; ++j) { pwA[0][j] = pk2(pA0[2 * j], pA0[2 * j + 1]); pwA[1][j] = pk2(pA0[8 + 2 * j], pA0[9 + 2 * j]); pwA[2][j] = pk2(pA1[2 * j], pA1[2 * j + 1]); pwA[3][j] = pk2(pA1[8 + 2 * j], pA1[9 + 2 * j]); }
        __builtin_amdgcn_sched_barrier(0);
        { _Pragma("unroll") for (int r = 0; r < 16; ++r) { pB0[r] = fexp2(pB0[r]); pB1[r] = fexp2(pB1[r]); } }
        u32x4 pwB[4];
#pragma unroll
        for (int j = 0; j < 4; ++j) { pwB[0][j] = pk2(pB0[2 * j], pB0[2 * j + 1]); pwB[1][j] = pk2(pB0[8 + 2 * j], pB0[9 + 2 * j]); pwB[2][j] = pk2(pB1[2 * j], pB1[2 * j + 1]); pwB[3][j] = pk2(pB1[8 + 2 * j], pB1[9 + 2 * j]); }
        __builtin_amdgcn_sched_barrier(0);
#pragma unroll
        for (int k = 0; k < 4; ++k)
#pragma unroll
            for (int db = 0; db < 2; ++db) { const s16x4 lo = vtr(vs + db * 4096 + k * 1024), h4 = vtr(vs + db * 4096 + k * 1024 + 512);
                const bf16x8 vf = (bf16x8){lo[0], lo[1], lo[2], lo[3], h4[0], h4[1], h4[2], h4[3]};
                oA[db] = __builtin_amdgcn_mfma_f32_32x32x16_bf16(__builtin_bit_cast(bf16x8, pwA[k]), vf, oA[db], 0, 0, 0);
                oB[db] = __builtin_amdgcn_mfma_f32_32x32x16_bf16(__builtin_bit_cast(bf16x8, pwB[k]), vf, oB[db], 0, 0, 0);
                if (db == 1) { lAcc = __builtin_amdgcn_mfma_f32_32x32x16_bf16(__builtin_bit_cast(bf16x8, pwA[k]), ones, lAcc, 0, 0, 0); lBcc = __builtin_amdgcn_mfma_f32_32x32x16_bf16(__builtin_bit_cast(bf16x8, pwB[k]), ones, lBcc, 0, 0, 0); } }
        slot = slot == 2 ? 0 : slot + 1;
    }
    {
        bool bad = false;
#pragma unroll
        for (int r = 0; r < 16; ++r) bad |= !(lAcc[r] > 1e-30f && lAcc[r] < 1e30f && lBcc[r] > 1e-30f && lBcc[r] < 1e30f);
        LAS int* gf = (LAS int*)(lds + OFF_OST);
        asm volatile("s_waitcnt lgkmcnt(0)\n\ts_barrier" ::: "memory");
        const int ab = __any(bad) ? 1 : 0; if (lane == 0) gf[wid] = ab;
        asm volatile("s_waitcnt lgkmcnt(0)\n\ts_barrier" ::: "memory");
        int anyb = 0;
#pragma unroll
        for (int w = 0; w < 8; ++w) anyb |= gf[w];
        asm volatile("s_waitcnt lgkmcnt(0)\n\ts_barrier" ::: "memory");
        if (__builtin_amdgcn_readfirstlane(anyb)) return false;
    }
    LAS bf16_t* stg = (LAS bf16_t*)(lds + OFF_OST) + wid * 2048;
#pragma unroll
    for (int qb = 0; qb < 2; ++qb) {
        LDS_WAIT();
#pragma unroll
        for (int r = 0; r < 16; ++r) { const int orow = crow(r, hi); const float il = frcp(qb == 0 ? lAcc[r] : lBcc[r]);
#pragma unroll
            for (int db = 0; db < 2; ++db) stg[orow * 64 + db * 32 + r32] = (bf16_t)(pk2((qb == 0 ? oA[db][r] : oB[db][r]) * il, 0.f) & 0xffffu); }
        LDS_WAIT();
        bf16_t* Ow = U.o + (size_t)(wid * 64 + qb * 32) * U.ldo;
#pragma unroll
        for (int i = 0; i < 4; ++i) { const int row = i * 8 + (lane >> 3), ch = lane & 7; const u32x4 v = *(const LAS u32x4*)(stg + row * 64 + ch * 8); *(u32x4*)(Ow + (size_t)row * U.ldo + ch * 8) = v; }
    }
    asm volatile("s_waitcnt lgkmcnt(0)\n\ts_barrier" ::: "memory");
    return true;
}
}

namespace ml {
constexpr int WAVE_LDS = 19328;
constexpr int OFF_VT = 0, OFF_KT = 8192, OFF_TB = 16384;
constexpr int TB_CS = 0, TB_BT = 128, TB_EM = 256, TB_NI = 384, TB_HD = 512, TB_QW = 544;
__device__ __forceinline__ int crow(int r, int hi) { return (r & 3) + 8 * (r >> 2) + 4 * hi; }
__device__ __forceinline__ int chunk_row(int b, int j) { return j < 4 ? ML + b * NC + j * 64 : b * T + (j - 4) * 64; }
__device__ __forceinline__ float prefix_sum(float v, int lane) {
#pragma unroll
    for (int o = 1; o < 64; o <<= 1) { const float t = __shfl_up(v, o); if (lane >= o) v += t; }
    return v;
}
__device__ __forceinline__ float prefix_max(float v, int lane) {
#pragma unroll
    for (int o = 1; o < 64; o <<= 1) { const float t = __shfl_up(v, o); if (lane >= o) v = fmaxf(v, t); }
    return v;
}
__device__ __forceinline__ float suffix_max(float v, int lane) {
#pragma unroll
    for (int o = 1; o < 64; o <<= 1) { const float t = __shfl_down(v, o); if (lane + o < 64) v = fmaxf(v, t); }
    return v;
}
struct Gates { float li[2], bcum[2], g[2]; };
__device__ __forceinline__ void load_gates(const bf16_t* P, int row, int h, const float* igb, const float* fgb, Gates& G, int lane) {
    const bf16_t* gp = P + (size_t)row * NP + PC_GT;
#pragma unroll
    for (int d = 0; d < 2; ++d) {
        const float gi = bf2f(gp[d * 4 + h]) + igb[d * 4 + h], gf = bf2f(gp[8 + d * 4 + h]) + fgb[d * 4 + h];
        const float lf = fminf(gf, 0.f) - log1pf(expf(-fabsf(gf)));
        const float ps = prefix_sum(lf, lane), tot = __shfl(ps, 63);
        G.li[d] = gi; G.g[d] = tot; G.bcum[d] = d == 0 ? ps : tot - ps + lf;
    }
}
__device__ __forceinline__ bf16x8 trfrag(LAS const char* tile, int blk, int ks, int lane) {
    const int hi = lane >> 5, q = (lane & 15) >> 2; LAS const char* p = tile + blk * 4096 + (16 * ks + 8 * hi + q) * 64 + ((lane >> 4) & 1) * 32 + (lane & 3) * 8;
    const s16x4 lo = att::vtr(p), h4 = att::vtr(p + 256);
    return (bf16x8){lo[0], lo[1], lo[2], lo[3], h4[0], h4[1], h4[2], h4[3]};
}
__device__ __forceinline__ void load_vtile(LAS char* vt, const bf16_t* P, int rowbase, int col, int lane) {
#pragma unroll
    for (int i = 0; i < 8; ++i) { const int t = i * 8 + (lane >> 3), c = lane & 7;
        const u32x4 w = *(const u32x4*)(P + (size_t)(rowbase + t) * NP + col + 8 * c); *(LAS u32x4*)(vt + (c >> 2) * 4096 + t * 64 + (c & 3) * 16) = w; }
}
__device__ __forceinline__ void conv8(const bf16_t* P, int row, int col, int pos, int len, const float* w0, const float* w1, const float* w2, float* y) {
    const bf16_t* p = P + (size_t)row * NP + col; float x0[8], x1[8], x2[8];
    unpack8(*(const u32x4*)p, x1);
    if (pos > 0) unpack8(*(const u32x4*)(p - NP), x0); else { for (int e = 0; e < 8; ++e) x0[e] = 0.f; }
    if (pos < len - 1) unpack8(*(const u32x4*)(p + NP), x2); else { for (int e = 0; e < 8; ++e) x2[e] = 0.f; }
#pragma unroll
    for (int e = 0; e < 8; ++e) y[e] = silu_f(x0[e] * w0[e] + x1[e] * w1[e] + x2[e] * w2[e]);
}

__device__ __forceinline__ void chunk_state_unit(LAS char* wl, int b, int h, int j, const bf16_t* P, const float* convw, const float* igb, const float* fgb,
                                                 float* CLOC, float* NLOC, float* MG, int lane) {
    const int r32 = lane & 31, hi = lane >> 5;
    const int rowbase = chunk_row(b, j), len = j < 4 ? NC : T, pos0 = j < 4 ? j * 64 : (j - 4) * 64;
    LAS float* tb = (LAS float*)(wl + OFF_TB);
    u32x4 vraw[8], kr0[8], kr1[8], kr2[8];
    { const int c = lane & 7; const bf16_t* pv = P + (size_t)(rowbase + (lane >> 3)) * NP + PC_MV + h * 64 + 8 * c; const bf16_t* pk = P + (size_t)(rowbase + (lane >> 3)) * NP + PC_MK + h * 64 + 8 * c;
#pragma unroll
      for (int i = 0; i < 8; ++i) { vraw[i] = *(const u32x4*)(pv + (size_t)(8 * i) * NP); kr1[i] = *(const u32x4*)(pk + (size_t)(8 * i) * NP);
          kr0[i] = *(const u32x4*)(pk + (size_t)(8 * i) * NP - NP); kr2[i] = *(const u32x4*)(pk + (size_t)(8 * i) * NP + NP); } }
    Gates G; load_gates(P, rowbase + lane, h, igb, fgb, G, lane);
    float mloc[2];
#pragma unroll
    for (int d = 0; d < 2; ++d) { const float a = G.g[d] - G.bcum[d] + G.li[d]; mloc[d] = wave_max(a); tb[d * 64 + lane] = fexp(a - mloc[d]); }
    { const int c = lane & 7; float w0[8], w1[8], w2[8]; const float* cw = convw + 256 + h * 64 + 8 * c;
#pragma unroll
      for (int e = 0; e < 8; ++e) { w0[e] = cw[e]; w1[e] = cw[512 + e]; w2[e] = cw[1024 + e]; }
#pragma unroll
      for (int i = 0; i < 8; ++i) { const int t = i * 8 + (lane >> 3); float y[8], x0[8], x1[8], x2[8]; unpack8(kr0[i], x0); unpack8(kr1[i], x1); unpack8(kr2[i], x2);
          const bool hp = pos0 + t > 0, hn = pos0 + t < len - 1;
#pragma unroll
          for (int e = 0; e < 8; ++e) y[e] = 0.125f * silu_f((hp ? x0[e] : 0.f) * w0[e] + x1[e] * w1[e] + (hn ? x2[e] : 0.f) * w2[e]);
          *(LAS u32x4*)(wl + OFF_KT + (c >> 2) * 4096 + t * 64 + (c & 3) * 16) = pack8(y); } }
    LDS_WAIT();
#pragma unroll 1
    for (int d = 0; d < 2; ++d) {
        LDS_WAIT();
        { const int c = lane & 7;
#pragma unroll
          for (int i = 0; i < 8; ++i) { const int t = i * 8 + (lane >> 3); const float w = tb[d * 64 + t]; float y[8]; unpack8(vraw[i], y);
#pragma unroll
              for (int e = 0; e < 8; ++e) y[e] *= w;
              *(LAS u32x4*)(wl + OFF_VT + (c >> 2) * 4096 + t * 64 + (c & 3) * 16) = pack8(y); } }
        LDS_WAIT();
        const size_t sidx = ((size_t)((d * NB + b) * 4 + h) * NCHK + j);
        float* cl = CLOC + sidx * 4096;
#pragma unroll
        for (int db = 0; db < 2; ++db) { bf16x8 af[4];
#pragma unroll
            for (int ks = 0; ks < 4; ++ks) af[ks] = trfrag(wl + OFF_VT, db, ks, lane);
#pragma unroll
            for (int dkb = 0; dkb < 2; ++dkb) { f32x16 acc = f32x16{};
#pragma unroll
                for (int ks = 0; ks < 4; ++ks) acc = __builtin_amdgcn_mfma_f32_32x32x16_bf16(af[ks], trfrag(wl + OFF_KT, dkb, ks, lane), acc, 0, 0, 0);
#pragma unroll
                for (int i = 0; i < 16; ++i) cl[(32 * db + crow(i, hi)) * 64 + 32 * dkb + r32] = acc[i]; } }
        { float sacc = 0.f; LAS const bf16_t* kt = (LAS const bf16_t*)(wl + OFF_KT + (lane >> 5) * 4096 + (lane & 31) * 2);
#pragma unroll 8
          for (int t = 0; t < 64; ++t) sacc += bf2f(kt[t * 32]) * tb[d * 64 + t];
          NLOC[sidx * 64 + lane] = sacc; }
        if (lane == 0) { MG[sidx * 2] = d == 0 ? mloc[0] : mloc[1]; MG[sidx * 2 + 1] = d == 0 ? G.g[0] : G.g[1]; }
    }
    LDS_WAIT();
}

__device__ __forceinline__ int step_chunk(int d, int s) { return d == 0 ? s : (s < 4 ? 3 - s : 71 - s); }
__device__ __forceinline__ void scan_item(LAS char* lds, const int wid0, int item, const float* CLOC, const float* NLOC, const float* MG, bf16_t* CIN, float* NIN, float* MIN_) {
    const int tid = wid0 * 64 + fresh_lane(); const int dbh = item >> 2, qd = item & 3, d = dbh >> 5;
    LAS float* mg = (LAS float*)lds; LAS float* wo = mg + 2 * NCHK; LAS float* wn = wo + NCHK;
    __syncthreads();
    if (tid < 2 * NCHK) mg[tid] = MG[(size_t)dbh * NCHK * 2 + tid];
    __syncthreads();
    if (tid == 0) { float m = -INFINITY;
        for (int s = 0; s < NCHK; ++s) { const int j = step_chunk(d, s); const float mj = mg[2 * j], gj = mg[2 * j + 1];
            if (qd == 0) MIN_[(size_t)dbh * NCHK + j] = m;
            const float mn = fmaxf(gj + m, mj); wo[s] = fexp(gj + m - mn); wn[s] = fexp(mj - mn); m = mn; } }
    __syncthreads();
    const float* cl = CLOC + (size_t)dbh * NCHK * 4096; bf16_t* ci = CIN + (size_t)dbh * NCHK * 4096;
    const int e0 = qd * 1024 + tid, e1 = e0 + 512;
    float s0 = 0.f, s1 = 0.f;
    const int en = qd * 16 + (tid & 15); float sn = 0.f; const float* nl = NLOC + (size_t)dbh * NCHK * 64; float* ni = NIN + (size_t)dbh * NCHK * 64;
#pragma unroll 1
    for (int sb = 0; sb < NCHK; sb += 17) { float c0[17], c1[17], cn[17];
#pragma unroll
        for (int i = 0; i < 17; ++i) { const int j = step_chunk(d, sb + i); c0[i] = cl[(size_t)j * 4096 + e0]; c1[i] = cl[(size_t)j * 4096 + e1]; cn[i] = nl[j * 64 + en]; }
#pragma unroll
        for (int i = 0; i < 17; ++i) { const int s = sb + i, j = step_chunk(d, s);
            ci[(size_t)j * 4096 + e0] = (bf16_t)(pk2(s0, 0.f) & 0xffffu); ci[(size_t)j * 4096 + e1] = (bf16_t)(pk2(s1, 0.f) & 0xffffu);
            if (tid < 16) ni[j * 64 + en] = sn;
            s0 = wo[s] * s0 + wn[s] * c0[i]; s1 = wo[s] * s1 + wn[s] * c1[i]; sn = wo[s] * sn + wn[s] * cn[i]; } }
}

__device__ __forceinline__ void out_unit(LAS char* wl, int b, int h, int j, const bf16_t* P, const float* convw, const float* igb, const float* fgb, const float* normw,
                                         const bf16_t* CIN, const float* NIN, const float* MIN_, bf16_t* MIX, int lane) {
    const int r32_ = lane & 31, hi_ = lane >> 5;
    const int rowbase = chunk_row(b, j), len = j < 4 ? NC : T, pos0 = j < 4 ? j * 64 : (j - 4) * 64;
    LAS float* tb = (LAS float*)(wl + OFF_TB);
    float min_d[2];
    { Gates G; load_gates(P, rowbase + lane, h, igb, fgb, G, lane);
#pragma unroll
      for (int d = 0; d < 2; ++d) { const float cs = G.li[d] - G.bcum[d]; const float pm = d == 0 ? prefix_max(cs, lane) : suffix_max(cs, lane);
          const size_t sidx = ((size_t)((d * NB + b) * 4 + h) * NCHK + j);
          const float mi = MIN_[sidx]; min_d[d] = mi;
          const float mt = G.bcum[d] + fmaxf(mi, pm);
          tb[TB_CS + d * 64 + lane] = cs; tb[TB_BT + d * 64 + lane] = G.bcum[d] - mt; tb[TB_EM + d * 64 + lane] = fexp(-mt); tb[TB_NI + d * 64 + lane] = NIN[sidx * 64 + lane]; } }
#pragma unroll
    for (int k = 0; k < 3; ++k) tb[TB_QW + k * 64 + lane] = convw[k * 512 + h * 64 + lane];
    load_vtile(wl + OFF_VT, P, rowbase, PC_MV + h * 64, lane);
    { const int c = lane & 7; float w0[8], w1[8], w2[8]; const float* cw = convw + 256 + h * 64 + 8 * c;
#pragma unroll
      for (int e = 0; e < 8; ++e) { w0[e] = cw[e]; w1[e] = cw[512 + e]; w2[e] = cw[1024 + e]; }
#pragma unroll 2
      for (int i = 0; i < 8; ++i) { const int t = i * 8 + (lane >> 3); float y[8]; conv8(P, rowbase + t, PC_MK + h * 64 + 8 * c, pos0 + t, len, w0, w1, w2, y);
#pragma unroll
          for (int e = 0; e < 8; ++e) y[e] *= 0.125f;
          *(LAS u32x4*)(wl + OFF_KT + c * 1024 + t * 16) = pack8(y); } }
    LDS_WAIT();
#pragma unroll 1
    for (int tbk = 0; tbk < 2; ++tbk) {
        int r32 = r32_, hi = hi_; asm volatile("" : "+v"(r32), "+v"(hi));
        const int t = 32 * tbk + r32;
        const int vaddr = ((lane >> 4) & 1) * 32 + (lane & 3) * 8 + (4 * hi + ((lane & 15) >> 2)) * 64;
        u32x4 qf[4];
#pragma unroll
        for (int d0 = 0; d0 < 4; ++d0) { const int c = 2 * d0 + hi; float w0[8], w1[8], w2[8], y[8];
#pragma unroll
            for (int e = 0; e < 8; ++e) { w0[e] = tb[TB_QW + 8 * c + e]; w1[e] = tb[TB_QW + 64 + 8 * c + e]; w2[e] = tb[TB_QW + 128 + 8 * c + e]; }
            conv8(P, rowbase + t, PC_MQ + h * 64 + 8 * c, pos0 + t, len, w0, w1, w2, y); qf[d0] = pack8(y); }
        f32x16 hs[2]; hs[0] = f32x16{}; hs[1] = f32x16{};
#pragma unroll 1
        for (int d = 0; d < 2; ++d) {
            const size_t sidx = ((size_t)((d * NB + b) * 4 + h) * NCHK + j);
            const float mi = d == 0 ? min_d[0] : min_d[1];
            const float bt = tb[TB_BT + d * 64 + t], em = tb[TB_EM + d * 64 + t];
            const float wi = (mi == -INFINITY) ? 0.f : fexp(bt + mi);
            f32x16 p[2];
#pragma unroll
            for (int sb = 0; sb < 2; ++sb) { p[sb] = f32x16{};
#pragma unroll
                for (int d0 = 0; d0 < 4; ++d0) { const bf16x8 kfr = *(const LAS bf16x8*)(wl + OFF_KT + (2 * d0 + hi) * 1024 + (32 * sb + r32) * 16);
                    p[sb] = __builtin_amdgcn_mfma_f32_32x32x16_bf16(kfr, __builtin_bit_cast(bf16x8, qf[d0]), p[sb], 0, 0, 0); } }
            float ds = 0.f;
#pragma unroll
            for (int sb = 0; sb < 2; ++sb)
#pragma unroll
                for (int i = 0; i < 16; ++i) { const int s_ = 32 * sb + crow(i, hi); const bool valid = d == 0 ? (s_ <= t) : (s_ >= t);
                    const float w = valid ? fexp(bt + tb[TB_CS + d * 64 + s_]) : 0.f; p[sb][i] *= w; ds += p[sb][i]; }
            ds = half_sum(ds);
            float qn = 0.f; u32x4 qw[4];
#pragma unroll
            for (int d0 = 0; d0 < 4; ++d0) { float y[8]; unpack8(qf[d0], y);
#pragma unroll
                for (int e = 0; e < 8; ++e) { qn += y[e] * tb[TB_NI + d * 64 + 16 * d0 + 8 * hi + e]; y[e] *= wi; }
                qw[d0] = pack8(y); }
            qn = half_sum(qn);
            const float den = ds + wi * qn; const float hd = frcp(fmaxf(fabsf(den), em));
            LDS_WAIT();
            if (hi == 0) tb[TB_HD + r32] = hd;
            LDS_WAIT();
            u32x4 pw[4];
#pragma unroll
            for (int jj = 0; jj < 4; ++jj) { pw[0][jj] = pk2(p[0][2 * jj], p[0][2 * jj + 1]); pw[1][jj] = pk2(p[0][8 + 2 * jj], p[0][9 + 2 * jj]); pw[2][jj] = pk2(p[1][2 * jj], p[1][2 * jj + 1]); pw[3][jj] = pk2(p[1][8 + 2 * jj], p[1][9 + 2 * jj]); }
#pragma unroll
            for (int db = 0; db < 2; ++db) { f32x16 acc = f32x16{};
                const bf16_t* cp = CIN + sidx * 4096 + (size_t)(32 * db + r32) * 64 + 8 * hi; bf16x8 cf[4];
#pragma unroll
                for (int d0 = 0; d0 < 4; ++d0) cf[d0] = *(const bf16x8*)(cp + d0 * 16);
#pragma unroll
                for (int k = 0; k < 4; ++k) { LAS const char* vs = wl + OFF_VT + vaddr + db * 4096 + k * 1024; const s16x4 lo = att::vtr(vs), h4 = att::vtr(vs + 512);
                    const bf16x8 vf = (bf16x8){lo[0], lo[1], lo[2], lo[3], h4[0], h4[1], h4[2], h4[3]};
                    acc = __builtin_amdgcn_mfma_f32_32x32x16_bf16(__builtin_bit_cast(bf16x8, pw[k]), vf, acc, 0, 0, 0); }
#pragma unroll
                for (int d0 = 0; d0 < 4; ++d0) acc = __builtin_amdgcn_mfma_f32_32x32x16_bf16(__builtin_bit_cast(bf16x8, qw[d0]), cf[d0], acc, 0, 0, 0);
#pragma unroll
                for (int i = 0; i < 16; ++i) hs[db][i] += acc[i] * tb[TB_HD + crow(i, hi)]; }
        }
        const float nw0 = normw[h * 64 + r32], nw1 = normw[h * 64 + 32 + r32];
        const unsigned offp = (unsigned)((rowbase + 32 * tbk + 4 * hi) * NP + PC_MO + h * 64 + r32) * 2u, offm = (unsigned)((rowbase + 32 * tbk + 4 * hi) * D + h * 64 + r32) * 2u;
#pragma unroll
        for (int i = 0; i < 16; ++i) { float ss = hs[0][i] * hs[0][i] + hs[1][i] * hs[1][i];
            ss += __shfl_xor(ss, 1); ss += __shfl_xor(ss, 2); ss += __shfl_xor(ss, 4); ss += __shfl_xor(ss, 8); ss += __shfl_xor(ss, 16);
            const float sc = 1.0f / sqrtf(ss * (1.0f / 64.0f) + EPS);
            const unsigned ro = (unsigned)((i & 3) + 8 * (i >> 2));
            const bf16_t* op = (const bf16_t*)((const char*)P + (offp + ro * (unsigned)(NP * 2))); bf16_t* mp = (bf16_t*)((char*)MIX + (offm + ro * (unsigned)(D * 2)));
            mp[0] = (bf16_t)(pk2(hs[0][i] * sc * nw0 * sigmoid_f(bf2f(op[0])), 0.f) & 0xffffu);
            mp[32] = (bf16_t)(pk2(hs[1][i] * sc * nw1 * sigmoid_f(bf2f(op[32])), 0.f) & 0xffffu);
            if ((i & 3) == 3) asm volatile("" ::: "memory"); }
    }
    LDS_WAIT();
}
}

#define XB_TMO      128
#define XB_XCNT(j)  (256  + 64 * (j))
#define XB_XSUB(j)  (1280 + 64 * (j))
#define XB_XGEN(j)  (2304 + 64 * (j))
#define XB_TOP      3328
#define XB_TOPGEN   3392
#define XCD_BAR_WORDS 3456
#define XB_SPIN_CAP (1u << 18)
__device__ __forceinline__ unsigned xb_ld(unsigned* p)              { return __hip_atomic_load(p, __ATOMIC_RELAXED, __HIP_MEMORY_SCOPE_AGENT); }
__device__ __forceinline__ unsigned xb_add(unsigned* p, unsigned v) { return __hip_atomic_fetch_add(p, v, __ATOMIC_RELAXED, __HIP_MEMORY_SCOPE_AGENT); }
__device__ __forceinline__ unsigned xb_xcc_id() { return (unsigned)__builtin_amdgcn_s_getreg((3 << 11) | 20) & 0xFu; }
#define XB_SPIN(cond, bar) do { unsigned _sp = 0; while (cond) { __builtin_amdgcn_s_sleep(1); \
    if ((++_sp & 255u) == 0u) { if (xb_ld(&(bar)[XB_TMO])) break; if (_sp > XB_SPIN_CAP) { atomicAdd(&(bar)[XB_TMO], 1u); break; } } } } while (0)
struct XcdBarrier { unsigned* bar; unsigned x; volatile LAS unsigned* st; };
__device__ __forceinline__ XcdBarrier xcd_barrier_post(unsigned* bar, volatile LAS unsigned* st) {
    XcdBarrier b; b.bar = bar; b.x = xb_xcc_id(); b.st = st;
    if (threadIdx.x == 0) (void)xb_add(&bar[XB_XCNT(b.x)], 1u);
    return b;
}
__device__ __forceinline__ void xcd_barrier_complete(unsigned* bar, unsigned x, unsigned& nloc, unsigned& nx) {
    const unsigned G = gridDim.x * gridDim.y * gridDim.z;
    unsigned sum, cnt, mine, sp = 0u;
    for (;;) {
        sum = 0u; cnt = 0u; mine = 0u;
#pragma unroll
        for (unsigned j = 0; j < 16; ++j) { const unsigned c = xb_ld(&bar[XB_XCNT(j)]); sum += c; cnt += (c > 0u) ? 1u : 0u; mine = (j == x) ? c : mine; }
        if (sum == G) break;
        __builtin_amdgcn_s_sleep(1);
        if ((++sp & 255u) == 0u) { if (xb_ld(&bar[XB_TMO])) break; if (sp > XB_SPIN_CAP) { atomicAdd(&bar[XB_TMO], 1u); break; } }
    }
    nloc = mine > 0u ? mine : 1u; nx = cnt > 0u ? cnt : 1u;
}
__device__ __forceinline__ void xcd_barrier(const XcdBarrier& b) {
    asm volatile("s_waitcnt vmcnt(0)" ::: "memory");
    __syncthreads();
    if (threadIdx.x == 0) {
        unsigned* bar = b.bar;
        __builtin_amdgcn_s_waitcnt(0);
        unsigned nloc = b.st[0], nx = b.st[1];
        if (nloc == 0u) { xcd_barrier_complete(bar, b.x, nloc, nx); b.st[0] = nloc; b.st[1] = nx; }
        const unsigned old = xb_add(&bar[XB_XSUB(b.x)], 1u);
        const unsigned gen = old / nloc;
        if (old + 1u == (gen + 1u) * nloc) {
            __builtin_amdgcn_fence(__ATOMIC_RELEASE, "agent");
            asm volatile("s_waitcnt vmcnt(0)" ::: "memory");
            const unsigned og = xb_add(&bar[XB_TOP], 1u);
            const unsigned tg = og / nx;
            if (og + 1u == (tg + 1u) * nx) xb_add(&bar[XB_TOPGEN], 1u);
            else XB_SPIN(xb_ld(&bar[XB_TOPGEN]) == tg, bar);
            __builtin_amdgcn_fence(__ATOMIC_ACQUIRE, "agent");
            xb_add(&bar[XB_XGEN(b.x)], 1u);
            asm volatile("s_waitcnt vmcnt(0)" ::: "memory");
        } else {
            XB_SPIN(xb_ld(&bar[XB_XGEN(b.x)]) == gen, bar);
            __builtin_amdgcn_fence(__ATOMIC_ACQUIRE, "agent");
            asm volatile("s_waitcnt vmcnt(0)" ::: "memory");
        }
    }
    __syncthreads();
}

struct Args { const float* in[27]; float* out; unsigned char* ws; int ph_lo, ph_hi; };
enum { I_X = 0, I_C, I_CTX, I_CCTX, I_ADAW, I_ADAB, I_N1W, I_N2W, I_WIN, I_WOUT, I_CONVW, I_IGB, I_FGB, I_MLNW, I_RPB, I_QNW, I_KVNW, I_WUQ, I_WUKV, I_F1, I_F3, I_F2, I_RW, I_M1, I_M3, I_M2, I_FNW };

struct TrJob { const float* src; const float* src2; int ldn, K, ngrp, kind; bf16_t* dst; const float* ksc; float cs; };
struct TrItem { const float* sp; const float* kp; bf16_t* dp; int ldn, K; float cs; };
__device__ __forceinline__ void tr_resolve(const TrJob& J, int it, int lane, TrItem& T) {
    const int g = it % J.ngrp, kb = it / J.ngrp, c0 = 16 * g, k0 = 64 * kb; const float* src = J.src; int sc0 = c0; float cs = J.cs;
    if (J.kind == 1) {
        if (c0 < 512) sc0 = 2192 + c0; else if (c0 < 768) sc0 = 2704 + (c0 - 512); else if (c0 < 1792) sc0 = c0 - 768;
        else if (c0 < 2944) { sc0 = 1040 + (c0 - 1792); if (c0 < 2176) cs = 0.125f * LOG2E; }
        else if (c0 < 2976) sc0 = 2960 + (c0 - 2944); else if (c0 < 2992) sc0 = 1024 + (c0 - 2976); else { sc0 = 0; cs = 0.f; }
    } else if (J.kind == 2) {
        if (c0 < 384) sc0 = (c0 >> 6) * 96 + (c0 & 63); else { const int r = c0 - 384; sc0 = (r >> 5) * 96 + 64 + (r & 31); }
    } else if (J.kind == 3) {
        const int pn = c0 >> 8, cc = c0 & 255; if (cc >= 128) src = J.src2; sc0 = 128 * pn + (cc & 127);
    }
    T.sp = src + (size_t)(k0 + (lane >> 4)) * J.ldn + sc0 + (lane & 15); T.kp = J.ksc ? J.ksc + k0 + (lane >> 4) : nullptr; T.ldn = J.ldn; T.K = J.K; T.cs = cs;
    T.dp = J.dst + (size_t)c0 * J.K + k0;
}
__device__ __forceinline__ void tr_load(const TrItem& T, float (&v)[16], float (&kv)[16]) {
#pragma unroll
    for (int i = 0; i < 16; ++i) v[i] = T.sp[(size_t)(4 * i) * T.ldn];
    if (T.kp) {
#pragma unroll
        for (int i = 0; i < 16; ++i) kv[i] = T.kp[4 * i]; }
    else {
#pragma unroll
        for (int i = 0; i < 16; ++i) kv[i] = 1.f; }
}
__device__ __forceinline__ void tr_store(const TrItem& T, const float (&v)[16], const float (&kv)[16], LAS float* scr, int lane) {
#pragma unroll
    for (int i = 0; i < 16; ++i) scr[(4 * i + (lane >> 4)) * 17 + (lane & 15)] = v[i] * T.cs * kv[i];
    LDS_WAIT();
#pragma unroll
    for (int j = 0; j < 2; ++j) { const int id = lane + 64 * j, n = id >> 3, c = id & 7; float y[8];
#pragma unroll
        for (int e = 0; e < 8; ++e) y[e] = scr[(8 * c + e) * 17 + n];
        *(u32x4*)(T.dp + (size_t)n * T.K + 8 * c) = pack8(y); }
    LDS_WAIT();
}
template <class R> __device__ __forceinline__ void tr_run(int first, int stride, int total, const R& resolve, LAS float* scr, int lane) {
    int it = first; if (it >= total) return;
    TrItem Tc; float vc[16], kc[16]; resolve(it, Tc); tr_load(Tc, vc, kc);
    for (;;) {
        const int itn = it + stride; const bool hn = itn < total; TrItem Tn = Tc; float vn[16], kn[16];
        if (hn) { resolve(itn, Tn); tr_load(Tn, vn, kn); }
        else {
#pragma unroll
            for (int i = 0; i < 16; ++i) { vn[i] = 0.f; kn[i] = 0.f; } }
        tr_store(Tc, vc, kc, scr, lane);
        if (!hn) break;
        Tc = Tn;
#pragma unroll
        for (int i = 0; i < 16; ++i) { vc[i] = vn[i]; kc[i] = kn[i]; }
        it = itn;
    }
}
__device__ __forceinline__ int tr_job_count(const TrJob& J) { return J.ngrp * (J.K / 64); }

__device__ __forceinline__ void mod_item(LAS char* lds, const int wid0, int item, const float* c, const float* cctx, const float* adaw, const float* adab, float* modv) {
    const int lane = fresh_lane(), wid = wid0, tid = wid * 64 + lane, l = item / 96, ng = item % 96;
    LAS float* sc = (LAS float*)lds;
    LAS float* part = sc + 9 * 1024;
    __syncthreads();
    for (int i = tid; i < 9 * 1024; i += 512) { const float v = i < 8 * 1024 ? c[i] : cctx[i - 8 * 1024]; sc[i] = silu_f(v); }
    __syncthreads();
    float acc[9];
#pragma unroll
    for (int bi = 0; bi < 9; ++bi) acc[bi] = 0.f;
    const float* w = adaw + (size_t)l * 1024 * 6144 + ng * 64 + lane;
#pragma unroll 1
    for (int k0 = wid * 128; k0 < wid * 128 + 128; k0 += 16) { float wv[16];
#pragma unroll
        for (int i = 0; i < 16; ++i) wv[i] = w[(size_t)(k0 + i) * 6144];
#pragma unroll
        for (int i = 0; i < 16; ++i)
#pragma unroll
            for (int bi = 0; bi < 9; ++bi) acc[bi] += sc[bi * 1024 + k0 + i] * wv[i]; }
#pragma unroll
    for (int bi = 0; bi < 9; ++bi) part[(wid * 9 + bi) * 64 + lane] = acc[bi];
    __syncthreads();
    for (int i = tid; i < 9 * 64; i += 512) { const int bi = i >> 6, n = i & 63; float s = adab[l * 6144 + ng * 64 + n];
#pragma unroll
        for (int w8 = 0; w8 < 8; ++w8) s += part[(w8 * 9 + bi) * 64 + n];
        modv[((size_t)l * 9 + bi) * 6144 + ng * 64 + n] = s; }
}

__device__ __forceinline__ void norm_row(const float* xrow, const float* nw, const float* shift, const float* scale, int lane, f32x4 (&v)[4], const bf16_t* dl = nullptr, float* xw = nullptr, int nparts = 1, size_t pstride = 0) {
    float s = 0.f;
#pragma unroll
    for (int j = 0; j < 4; ++j) { v[j] = *(const f32x4*)(xrow + 4 * lane + 256 * j);
        if (dl) { for (int p = 0; p < nparts; ++p) { const u32x2 dw = *(const u32x2*)(dl + (size_t)p * pstride + 4 * lane + 256 * j); v[j].x += bf2f(dw.x & 0xffffu); v[j].y += __uint_as_float(dw.x & 0xffff0000u); v[j].z += bf2f(dw.y & 0xffffu); v[j].w += __uint_as_float(dw.y & 0xffff0000u); }
            *(f32x4*)(xw + 4 * lane + 256 * j) = v[j]; }
        s += (v[j].x * v[j].x + v[j].y * v[j].y) + (v[j].z * v[j].z + v[j].w * v[j].w); }
    const float rs = 1.0f / sqrtf(wave_sum(s) * (1.0f / D) + EPS);
#pragma unroll
    for (int j = 0; j < 4; ++j) { const int c = 4 * lane + 256 * j; const f32x4 w = *(const f32x4*)(nw + c), sh = *(const f32x4*)(shift + c), sc = *(const f32x4*)(scale + c);
        v[j] = (v[j] * rs * w) * (1.0f + sc) + sh; }
}
__device__ __forceinline__ void store_row_bf16(bf16_t* orow, int lane, const f32x4 (&v)[4]) {
#pragma unroll
    for (int j = 0; j < 4; ++j) { u32x2 w; w.x = pk2(v[j].x, v[j].y); w.y = pk2(v[j].z, v[j].w); *(u32x2*)(orow + 4 * lane + 256 * j) = w; }
}


#if !MK_MULTI
#define GRID_BAR() do { XcdBarrier b2_ = bar; asm volatile("" : "+s"(b2_.bar)); xcd_barrier(b2_); } while (0)
#define OPQ(x) (x)
#else
#define GRID_BAR() do {} while (0)
#define OPQ(x) ({ int _v = (x); asm volatile("" : "+s"(_v)); _v; })
#endif
#ifndef MK_SITES
#define MK_SITES 0xffffffffu
#endif
#define EN(s) (((MK_SITES) >> (s)) & 1u)
#define IN(k) (OPQ(lo) <= (k) && (k) < OPQ(hi_ph))
#define SEAM(k) do { if (IN(k) && IN((k) + 1)) GRID_BAR(); } while (0)
#define PHASE_WS() GAS unsigned char* ws = (GAS unsigned char*)args.ws; asm volatile("" : "+s"(ws))
#define PHASE_IDS() PHASE_WS(); const int lane = fresh_lane(), wid = wid0, tid = wid * 64 + lane, gw = blockIdx.x * 8 + wid; (void)lane; (void)gw; (void)tid

#define x_in (args.in[I_X])
#define ctx_in (args.in[I_CTX])
#define xout (args.out)
#define modv ((float*)(ws + SM_MOD))
#define ropet ((float*)(ws + SM_ROPE))
#define stats ((float*)(ws + SM_STATS))
#define NLOC ((float*)(ws + SM_NLOC))
#define NIN ((float*)(ws + SM_NIN))
#define MG ((float*)(ws + SM_MG))
#define MINb ((float*)(ws + SM_MIN))
#define xc ((float*)(ws + WS_XC))
#define BH ((bf16_t*)(ws + WS_H))
#define CLOC ((float*)(ws + WS_H))
#define BP ((bf16_t*)(ws + WS_P))
#define QM ((bf16_t*)(ws + WS_QM))
#define KVM ((bf16_t*)(ws + WS_KVM))
#define CIN ((bf16_t*)(ws + WS_CIN))
#define Win ((bf16_t*)(ws + W_IN))
#define Wout ((bf16_t*)(ws + W_OUT))
#define Wuq ((bf16_t*)(ws + W_UQ))
#define Wukv ((bf16_t*)(ws + W_UKV))
#define Wf13 ((bf16_t*)(ws + W_F13))
#define Wf2 ((bf16_t*)(ws + W_F2))
#define tokinfo ((int*)(ws + SM_TOK))
#define tokg ((float*)(ws + SM_TOKG))
#define wgcnt ((int*)(ws + SM_WGCNT))
#define rowtok ((int*)(ws + SM_ROWTOK))
#define rowgate ((float*)(ws + SM_ROWGATE))
#define tileexp ((int*)(ws + SM_TILEEXP))
#define WMOE ((bf16_t*)(ws + WS_WMOE))
#define UB ((bf16_t*)(ws + WS_U))
#define ASORT ((bf16_t*)(ws + WS_ASORT))
#define PBY ((bf16_t*)(ws + WS_PBY))
#define PBF ((bf16_t*)(ws + WS_PBF))
#define PBW ((bf16_t*)(ws + WS_PBW))

template <int L> __device__ __forceinline__ void layer_phases(const Args& args, LAS unsigned char* lds, const int G, const int NGW, const XcdBarrier& bar, const int lo, const int hi_ph, const int wid0) {
    constexpr int l = L; constexpr int pb = 1 + 10 * l;

#define mod_l (modv + (size_t)l * 9 * 6144)
        if (EN(1) && IN(pb + 0)) { PHASE_IDS();
            const float* nw = args.in[I_N1W] + l * D;
            for (int r = gw; r < M; r += NGW) { const bool lat = r < ML; const int bi = lat ? (r >> 12) : 8;
                const float* xr = lat ? ((l == 0 ? x_in : xout) + (size_t)r * D) : ((l == 0 ? ctx_in : xc) + (size_t)(r - ML) * D);
                f32x4 v[4]; norm_row(xr, nw, mod_l + bi * 6144, mod_l + bi * 6144 + 1024, lane, v, (l == 0 || lat) ? nullptr : PBF + (size_t)(r - ML) * D, const_cast<float*>(xr), 8, (size_t)MC * D); store_row_bf16(BH + (size_t)r * D, lane, v); }
        }
        SEAM(pb + 0);
        if (EN(2) && IN(pb + 1)) { PHASE_WS();
            pg8::Gemm g{BH, D, Win + (size_t)l * 3072 * 1024, D}; pg8::StaticOrder S; S.init(M / 256, NP / 256, G, blockIdx.x, D);
            pg8::EpiP E{BP, stats, ropet};
            pg8::gemm_phase<pg8::EpiP, pg8::StaticOrder, true>(lds, g, S, E, wid0);
        }
        SEAM(pb + 1);
        if (EN(3) && IN(pb + 2)) { PHASE_WS();
            if (EN(18)) { pg8::Gemm g{BP + PC_QL, NP, Wuq + (size_t)l * 768 * 512, 512}; pg8::StaticOrder S; S.init(M / 256, 3, G, blockIdx.x, 512);
              pg8::EpiRS<true> E{QM, NQM, NQM, 384, stats, 0, 16, 1.0f / 512.0f, ropet};
              pg8::gemm_phase<pg8::EpiRS<true>, pg8::StaticOrder, true>(lds, g, S, E, wid0); }
            __syncthreads();
            if (EN(19)) { pg8::Gemm g{BP + PC_KVL, NP, Wukv + (size_t)l * 768 * 256, 256}; pg8::StaticOrder S; S.init(M / 256, 3, G, blockIdx.x, 256);
              pg8::EpiRS<false> E{KVM, NKVM, NKVM, NKVM, stats, 16, 8, 1.0f / 256.0f, ropet};
              pg8::gemm_phase<pg8::EpiRS<false>, pg8::StaticOrder, true>(lds, g, S, E, wid0); }
            __syncthreads();
            { PHASE_IDS();
            const float* convw = args.in[I_CONVW] + (size_t)l * 3 * 512; const float* igb = args.in[I_IGB] + l * 8; const float* fgb = args.in[I_FGB] + l * 8;
            for (int k = 0; ; ++k) { const int u = (k & 1) ? k * NGW + (NGW - 1 - gw) : k * NGW + gw;
                if (u >= NB * 4 * NCHK) { if (k * NGW >= NB * 4 * NCHK) break; else continue; }
                const int j = u % NCHK, bh = u / NCHK; int lane_ = lane; asm volatile("" : "+v"(lane_));
                if (EN(17)) ml::chunk_state_unit((LAS char*)lds + wid * ml::WAVE_LDS, bh >> 2, bh & 3, j, BP, convw, igb, fgb, CLOC, NLOC, MG, lane_); } }
        }
        SEAM(pb + 2);
        if (EN(4) && IN(pb + 3)) { PHASE_WS(); for (int item = blockIdx.x; item < 256; item += G) ml::scan_item((LAS char*)lds, wid0, item, CLOC, NLOC, MG, CIN, NIN, MINb); }
        SEAM(pb + 3);
        if (EN(5) && IN(pb + 4)) { GAS unsigned char* ws_ph = (GAS unsigned char*)args.ws;
            const float* convw = args.in[I_CONVW] + (size_t)l * 3 * 512; const float* igb = args.in[I_IGB] + l * 8; const float* fgb = args.in[I_FGB] + l * 8;
            const float* mnw = args.in[I_MLNW] + l * 256;
#ifndef MK_REP_MLA
#define MK_REP_MLA 1
#endif
#ifndef MK_REP_NA
#define MK_REP_NA 1
#endif
#ifndef MK_REP_ML
#define MK_REP_ML 1
#endif
            constexpr int n_mla1 = NB * 6 * 8, n_na1 = NB * 6 * 16, n_ml1 = (l == 0) ? NB * 4 * NCHK / 8 : NB * 4 * 64 / 8;
            constexpr int n_mla = n_mla1 * MK_REP_MLA, n_na = n_na1 * MK_REP_NA, n_ml = n_ml1 * MK_REP_ML, n_ctx = (l == 0) ? NB * 6 * 2 : 0;
            constexpr int n_items = n_mla + n_na + n_ml + n_ctx;
            volatile LAS int* qslot = (volatile LAS int*)(lds + LDS_MISC + 64);
            for (;;) {
                GAS unsigned char* ws = ws_ph; asm volatile("" : "+s"(ws));
                int wid_i = wid0; asm volatile("" : "+s"(wid_i));
                const int lane = fresh_lane(), tid = wid_i * 64 + lane;
                bf16_t* MIX = BH;
                __syncthreads();
                if (tid == 0) *qslot = (int)__hip_atomic_fetch_add((unsigned*)(ws + WS_CTL) + CW_QUEUE + l * 64, 1u, __ATOMIC_RELAXED, __HIP_MEMORY_SCOPE_AGENT);
                __syncthreads();
                const int u = __builtin_amdgcn_readfirstlane(*qslot);
                if (u >= n_items) break;
                att::Unit U;
                if (u < n_mla) { const int u1 = u % n_mla1; const int qb = u1 & 7, bh = u1 >> 3, b = bh / 6, h = bh % 6; const int row0 = b * T + qb * 512;
                    U.qn = QM + (size_t)row0 * NQM + h * 64; U.ldq = NQM; U.qr = QM + (size_t)row0 * NQM + 384 + h * 32; U.ldqr = NQM;
                    U.kn = KVM + h * 128; U.ldk = NKVM; U.kr = BP + PC_KR; U.ldkr = NP; U.v = KVM + h * 128 + 64; U.ldv = NKVM;
                    U.o = MIX + (size_t)row0 * D + 640 + h * 64; U.ldo = D; U.na = 64; U.rowa = b * T; U.rowc = ML + b * NC; U.rg = 0; U.rlo = 0;
                    if (EN(15)) { const bool ok = att::attn_unit64((LAS char*)lds, U, wid_i);
                        if (!ok && tid == 0) { unsigned* rd = (unsigned*)(ws + WS_CTL) + CW_REDO + l * 512; const unsigned ix = __hip_atomic_fetch_add(rd, 1u, __ATOMIC_RELAXED, __HIP_MEMORY_SCOPE_AGENT); rd[1 + ix] = (unsigned)u; } }
                } else if (u < n_mla + n_na) { const int v = (u - n_mla) % n_na1, rg = v & 15, bh = v >> 4, b = bh / 6, h = bh % 6; const int row0 = b * T + rg * 256;
                    const int rlo = min(max(4 * rg - 4, 0), 56), rhi = min(max(4 * rg - 1, 0), 56) + 7;
                    { LAS float* bt = (LAS float*)(lds + att::OFF_BIAS); const float* rp = args.in[I_RPB] + ((size_t)l * 6 + h) * 15 * 31;
                      for (int i = tid; i < 640; i += 512) { const int k = i - 64; bt[i] = (k >= 0 && k < 465) ? rp[k] * LOG2E : 0.f; } }
                    __syncthreads();
                    U.qn = BP + (size_t)row0 * NP + PC_NQ + h * 64; U.ldq = NP; U.qr = nullptr; U.ldqr = 0;
                    U.kn = BP + PC_NK + h * 64; U.ldk = NP; U.kr = nullptr; U.ldkr = 0; U.v = BP + PC_NV + h * 64; U.ldv = NP;
                    U.o = MIX + (size_t)row0 * D + 256 + h * 64; U.ldo = D; U.na = rhi - rlo + 1; U.rowa = b * T + rlo * 64; U.rowc = ML + b * NC; U.rg = rg; U.rlo = rlo;
                    if (EN(15)) { const bool ok = att::attn_unit<8, true, true>((LAS char*)lds, U, wid_i);
                        if (!ok && tid == 0) { unsigned* rd = (unsigned*)(ws + WS_CTL) + CW_REDO2 + l * 1024; const unsigned ix = __hip_atomic_fetch_add(rd, 1u, __ATOMIC_RELAXED, __HIP_MEMORY_SCOPE_AGENT); rd[1 + ix] = (unsigned)(u - n_mla); } }
                } else if (u < n_mla + n_na + n_ml) { const int id = ((u - n_mla - n_na) % n_ml1) * 8 + wid_i; int lane_ = lane; asm volatile("" : "+v"(lane_));
                    const int bh = (l == 0) ? id / NCHK : id >> 6, j = (l == 0) ? id % NCHK : 4 + (id & 63);
                    if (EN(16)) ml::out_unit((LAS char*)lds + wid_i * ml::WAVE_LDS, bh >> 2, bh & 3, j, BP, convw, igb, fgb, mnw, CIN, NIN, MINb, MIX, lane_);
                } else { const int v = u - n_mla - n_na - n_ml, kind = v & 1, bh = v >> 1, b = bh / 6, h = bh % 6; const int row0 = ML + b * NC;
                    U.na = 0; U.rowa = 0; U.rowc = row0; U.rg = 0; U.rlo = 0; U.ldo = D;
                    if (kind == 0) { U.qn = QM + (size_t)row0 * NQM + h * 64; U.ldq = NQM; U.qr = QM + (size_t)row0 * NQM + 384 + h * 32; U.ldqr = NQM;
                        U.kn = KVM + h * 128; U.ldk = NKVM; U.kr = BP + PC_KR; U.ldkr = NP; U.v = KVM + h * 128 + 64; U.ldv = NKVM; U.o = MIX + (size_t)row0 * D + 640 + h * 64;
                        if (EN(15)) (void)att::attn_unit<12, false>((LAS char*)lds, U, wid_i);
                    } else { U.qn = BP + (size_t)row0 * NP + PC_NQ + h * 64; U.ldq = NP; U.qr = nullptr; U.ldqr = 0;
                        U.kn = BP + PC_NK + h * 64; U.ldk = NP; U.kr = nullptr; U.ldkr = 0; U.v = BP + PC_NV + h * 64; U.ldv = NP; U.o = MIX + (size_t)row0 * D + 256 + h * 64;
                        if (EN(15)) (void)att::attn_unit<8, false>((LAS char*)lds, U, wid_i); }
                }
            }
        }
        SEAM(pb + 4);
        if (EN(6) && IN(pb + 5)) { PHASE_WS();
            {
              unsigned* rd = (unsigned*)(ws + WS_CTL) + CW_REDO + l * 512; const int nredo = (int)__hip_atomic_load(rd, __ATOMIC_RELAXED, __HIP_MEMORY_SCOPE_AGENT);
              unsigned* rd2 = (unsigned*)(ws + WS_CTL) + CW_REDO2 + l * 1024; const int nredo2 = (int)__hip_atomic_load(rd2, __ATOMIC_RELAXED, __HIP_MEMORY_SCOPE_AGENT);
              if (nredo2 > 0) {
                  for (int i = blockIdx.x; i < nredo2; i += G) { const int v = (int)rd2[1 + i] % (NB * 6 * 16), rg = v & 15, bh = v >> 4, b = bh / 6, h = bh % 6; const int row0 = b * T + rg * 256;
                      const int rlo = min(max(4 * rg - 4, 0), 56), rhi = min(max(4 * rg - 1, 0), 56) + 7; const int tid_ = wid0 * 64 + fresh_lane();
                      __syncthreads();
                      { LAS float* bt = (LAS float*)(lds + att::OFF_BIAS); const float* rp = args.in[I_RPB] + ((size_t)l * 6 + h) * 15 * 31;
                        for (int q = tid_; q < 640; q += 512) { const int k = q - 64; bt[q] = (k >= 0 && k < 465) ? rp[k] * LOG2E : 0.f; } }
                      __syncthreads();
                      att::Unit U; U.qn = BP + (size_t)row0 * NP + PC_NQ + h * 64; U.ldq = NP; U.qr = nullptr; U.ldqr = 0;
                      U.kn = BP + PC_NK + h * 64; U.ldk = NP; U.kr = nullptr; U.ldkr = 0; U.v = BP + PC_NV + h * 64; U.ldv = NP;
                      U.o = BH + (size_t)row0 * D + 256 + h * 64; U.ldo = D; U.na = rhi - rlo + 1; U.rowa = b * T + rlo * 64; U.rowc = ML + b * NC; U.rg = rg; U.rlo = rlo;
                      (void)att::attn_unit<8, true>((LAS char*)lds, U, wid0); }
              }
              if (nredo > 0) {
                  for (int i = blockIdx.x; i < 2 * nredo; i += G) { const int u1 = (int)rd[1 + (i >> 1)] % (NB * 6 * 8), hf = i & 1; const int qb = u1 & 7, bh = u1 >> 3, b = bh / 6, h = bh % 6; const int row0 = b * T + qb * 512 + hf * 256;
                      att::Unit U; U.qn = QM + (size_t)row0 * NQM + h * 64; U.ldq = NQM; U.qr = QM + (size_t)row0 * NQM + 384 + h * 32; U.ldqr = NQM;
                      U.kn = KVM + h * 128; U.ldk = NKVM; U.kr = BP + PC_KR; U.ldkr = NP; U.v = KVM + h * 128 + 64; U.ldv = NKVM;
                      U.o = BH + (size_t)row0 * D + 640 + h * 64; U.ldo = D; U.na = 64; U.rowa = b * T; U.rowc = ML + b * NC; U.rg = 0; U.rlo = 0;
                      (void)att::attn_unit<12, false>((LAS char*)lds, U, wid0); }
              }
              if (nredo > 0 || nredo2 > 0) GRID_BAR(); }
            pg8::Gemm g{BH, D, Wout + (size_t)l * 1024 * 1024, D}; pg8::TailSplit<pg8::StaticOrder> S; S.init(ML / 256, 4, G, blockIdx.x, D); S.init_ts(ML / 256, l == 0 ? MC / 256 : 0, 4);
            pg8::EpiRes2 E{l == 0 ? x_in : xout, xout, mod_l + 2 * 1024, 6144, PBW, (size_t)MC * D, ML};
            pg8::gemm_phase<pg8::EpiRes2, pg8::TailSplit<pg8::StaticOrder>, true>(lds, g, S, E, wid0);
        }
        SEAM(pb + 5);
        if (l == 0) {
            if (EN(7) && IN(pb + 6)) { PHASE_IDS();
                const float* nw = args.in[I_N2W] + l * D;
                for (int r = gw; r < M; r += NGW) { const bool lat = r < ML; const int bi = lat ? (r >> 12) : 8;
                    const float* xr = lat ? (xout + (size_t)r * D) : (ctx_in + (size_t)(r - ML) * D); float* xw = lat ? nullptr : (xc + (size_t)(r - ML) * D);
                    f32x4 v[4]; norm_row(xr, nw, mod_l + bi * 6144 + 3 * 1024, mod_l + bi * 6144 + 4 * 1024, lane, v, lat ? nullptr : PBW + (size_t)(r - ML) * D, xw, 4, (size_t)MC * D); store_row_bf16(BH + (size_t)r * D, lane, v); }
            }
            SEAM(pb + 6);
            if (EN(8) && IN(pb + 7)) { PHASE_WS();
                pg8::Gemm g{BH, D, Wf13, D}; pg8::StaticOrder S; S.init(M / 256, 22, G, blockIdx.x, D);
                pg8::EpiSwiglu E{BP, DFF};
                pg8::gemm_phase<pg8::EpiSwiglu, pg8::StaticOrder, true>(lds, g, S, E, wid0);
            }
            SEAM(pb + 7);
            if (EN(9) && IN(pb + 8)) { PHASE_WS();
                pg8::Gemm g{BP, DFF, Wf2, DFF}; pg8::TailSplit<pg8::StaticOrder> S; S.init(ML / 256, 4, G, blockIdx.x, DFF); S.init_ts(ML / 256, MC / 256, 8);
                pg8::EpiRes2 E{xout, xout, mod_l + 5 * 1024, 6144, PBF, (size_t)MC * D, ML};
                pg8::gemm_phase<pg8::EpiRes2, pg8::TailSplit<pg8::StaticOrder>, true>(lds, g, S, E, wid0);
            }
            SEAM(pb + 8);
        } else {
            if (EN(10) && IN(pb + 6)) { PHASE_IDS();
                { LAS float* scr = (LAS float*)(lds + wid * 4352);
                  const int per13 = 352 * 16, per2 = 64 * 44, per = per13 + per2;
                  const float* m1 = args.in[I_M1]; const float* m3 = args.in[I_M3]; const float* m2 = args.in[I_M2]; bf16_t* wm = WMOE;
                  auto resolve = [&](int it, TrItem& T) { const int e = it / per, r = it % per; bf16_t* wb = (bf16_t*)((char*)wm + (size_t)e * WMOE_E);
                      if (r < per13) { TrJob J{m1 + (size_t)e * 1024 * 2816, m3 + (size_t)e * 1024 * 2816, 2816, 1024, 352, 3, wb, nullptr, 1.f}; tr_resolve(J, r, lane, T); }
                      else { TrJob J{m2 + (size_t)e * 2816 * 1024, nullptr, 1024, 2816, 64, 0, wb + (size_t)5632 * 1024, nullptr, 1.f}; tr_resolve(J, r - per13, lane, T); } };
                  tr_run(gw, NGW, NEXP * per, resolve, scr, lane); }
                __syncthreads();
                LAS float* rw = (LAS float*)(lds + 40960);
                LAS int* esel = (LAS int*)(lds + 40960 + 32768);
                for (int i = tid; i < 8192; i += 512) rw[i] = args.in[I_RW][i];
                __syncthreads();
                const float* nw = args.in[I_N2W] + l * D;
                for (int blk = blockIdx.x; blk < ML / 128; blk += G) {
                    for (int rr = wid; rr < 128; rr += 8) { const int r = blk * 128 + rr, bi = r >> 12; f32x4 v[4];
                        norm_row(xout + (size_t)r * D, nw, mod_l + bi * 6144 + 3 * 1024, mod_l + bi * 6144 + 4 * 1024, lane, v);
                        float lg[8];
#pragma unroll
                        for (int e = 0; e < 8; ++e) lg[e] = 0.f;
#pragma unroll
                        for (int j = 0; j < 4; ++j)
#pragma unroll
                            for (int q = 0; q < 4; ++q) { const int c = 4 * lane + 256 * j + q; const f32x4 w0 = *(const LAS f32x4*)(rw + c * 8), w1 = *(const LAS f32x4*)(rw + c * 8 + 4); const float hv = v[j][q];
                                lg[0] += hv * w0.x; lg[1] += hv * w0.y; lg[2] += hv * w0.z; lg[3] += hv * w0.w; lg[4] += hv * w1.x; lg[5] += hv * w1.y; lg[6] += hv * w1.z; lg[7] += hv * w1.w; }
#pragma unroll
                        for (int e = 0; e < 8; ++e) lg[e] = wave_sum(lg[e]);
                        int e0 = 0; float v0 = lg[0];
#pragma unroll
                        for (int e = 1; e < 8; ++e) if (lg[e] > v0) { v0 = lg[e]; e0 = e; }
                        int e1 = -1; float v1 = -INFINITY;
#pragma unroll
                        for (int e = 0; e < 8; ++e) if (e != e0 && lg[e] > v1) { v1 = lg[e]; e1 = e; }
                        const float g0 = 1.0f / (1.0f + expf(v1 - v0));
                        if (lane == 0) { esel[rr * 2] = e0; esel[rr * 2 + 1] = e1; tokg[(size_t)r * 2] = g0; tokg[(size_t)r * 2 + 1] = 1.0f - g0; } }
                    __syncthreads();
                    if (tid < 128) { const int e0 = esel[tid * 2], e1 = esel[tid * 2 + 1]; int s0 = 0, s1 = 0;
                        for (int q = 0; q < tid; ++q) { s0 += (esel[q * 2] == e0); s1 += (esel[q * 2 + 1] == e1); }
                        int* ti = tokinfo + (size_t)(blk * 128 + tid) * 4; ti[0] = e0; ti[1] = e1; ti[2] = s0; ti[3] = s1; }
                    if (tid < 16) { const int k = tid >> 3, e = tid & 7; int c = 0; for (int q = 0; q < 128; ++q) c += (esel[q * 2 + k] == e); wgcnt[blk * 16 + tid] = c; }
                    __syncthreads();
                }
            }
            SEAM(pb + 6);
            if (EN(11) && IN(pb + 7)) { PHASE_IDS();
                LAS int* tot = (LAS int*)(lds);
                LAS int* offp = tot + 16; LAS int* pre = tot + 32;
                __syncthreads();
                LAS int* segs = pre + 4096;
                for (int i = tid; i < 4096; i += 512) pre[i] = wgcnt[i];
                __syncthreads();
                { const int c = tid & 15, sg = tid >> 4; int sm = 0;
#pragma unroll
                  for (int q = 0; q < 8; ++q) sm += pre[(sg * 8 + q) * 16 + c];
                  segs[sg * 16 + c] = sm; }
                __syncthreads();
                { const int c = tid & 15, sg = tid >> 4; int run = 0; for (int q = 0; q < sg; ++q) run += segs[q * 16 + c];
#pragma unroll
                  for (int q = 0; q < 8; ++q) { const int v = pre[(sg * 8 + q) * 16 + c]; pre[(sg * 8 + q) * 16 + c] = run; run += v; }
                  if (sg == 31) tot[c] = run; }
                __syncthreads();
                if (tid == 0) { int o = 0; for (int e = 0; e < 8; ++e) { offp[e] = o; o += (tot[e] + tot[8 + e] + 255) & ~255; }
                    if (blockIdx.x == 0) { tileexp[320] = o >> 8; for (int e = 0; e < 8; ++e) { const int t0 = offp[e] >> 8, nt = (tot[e] + tot[8 + e] + 255) >> 8; for (int q = 0; q < nt; ++q) tileexp[t0 + q] = e; } } }
                __syncthreads();
                const float* nw = args.in[I_N2W] + l * D;
                for (int blk = blockIdx.x; blk < ML / 128; blk += G) {
                    for (int rr = wid; rr < 128; rr += 8) { const int r = blk * 128 + rr, bi = r >> 12; f32x4 v[4];
                        norm_row(xout + (size_t)r * D, nw, mod_l + bi * 6144 + 3 * 1024, mod_l + bi * 6144 + 4 * 1024, lane, v);
                        const int* ti = tokinfo + (size_t)r * 4;
#pragma unroll
                        for (int k = 0; k < 2; ++k) { const int e = ti[k], pos = offp[e] + (k == 0 ? 0 : tot[e]) + pre[blk * 16 + k * 8 + e] + ti[2 + k];
                            store_row_bf16(ASORT + (size_t)pos * D, lane, v);
                            if (lane == 0) tokinfo[(size_t)r * 4 + 2 + k] = pos; } }
                }
            }
            SEAM(pb + 7);
            for (int k = 0; k < 2; ++k) {
                if (EN(12) && IN(pb + 8 + 2 * k)) { PHASE_WS();
                    const int ntl = tileexp[320], t0 = k == 0 ? 0 : 128, t1 = k == 0 ? (ntl < 128 ? ntl : 128) : ntl;
                    pg8::Gemm g{ASORT + (size_t)t0 * 256 * D, D, WMOE, D}; pg8::GroupedOrder S; S.init(t1 > t0 ? t1 - t0 : 0, 22, G, blockIdx.x, D); S.tile_exp = tileexp + t0; S.estride = WMOE_E;
                    pg8::EpiSwiglu E{UB, DFF};
                    pg8::gemm_phase<pg8::EpiSwiglu, pg8::GroupedOrder, true>(lds, g, S, E, wid0);
                }
                SEAM(pb + 8 + 2 * k);
                if (EN(13) && IN(pb + 9 + 2 * k)) { PHASE_WS();
                    const int ntl = tileexp[320], t0 = k == 0 ? 0 : 128, t1 = k == 0 ? (ntl < 128 ? ntl : 128) : ntl;
                    const int nmp = t1 > t0 ? t1 - t0 : 0, nmain = nmp < 128 ? nmp : 128;
                    pg8::Gemm g{UB, DFF, WMOE + (size_t)5632 * 1024, DFF}; pg8::TailSplit<pg8::GroupedOrder> S; S.init(nmain, 4, G, blockIdx.x, DFF); S.tile_exp = tileexp + t0; S.estride = WMOE_E; S.init_ts(nmain, nmp - nmain, 11);
                    pg8::EpiDelta E{ASORT + (size_t)t0 * 256 * D, nullptr, 0, PBY, (size_t)7 * 256 * D, 128 * 256};
                    pg8::gemm_phase<pg8::EpiDelta, pg8::TailSplit<pg8::GroupedOrder>, true>(lds, g, S, E, wid0);
                }
                SEAM(pb + 9 + 2 * k);
            }
        }
    }

constexpr int NPHASE = 24;
__global__ void __launch_bounds__(512, 2) mega_fwd(Args args) {
    extern __shared__ __attribute__((aligned(16))) unsigned char lds_raw[];
    LAS unsigned char* lds = (LAS unsigned char*)lds_raw;
    const int G = gridDim.x, NGW = G * 8;
    const int wid0 = __builtin_amdgcn_readfirstlane(threadIdx.x >> 6);
    if (threadIdx.x < 4) ((volatile LAS unsigned*)(lds + LDS_MISC))[threadIdx.x] = 0u;
    __syncthreads();
#if !MK_MULTI
    XcdBarrier bar = xcd_barrier_post((unsigned*)(args.ws + WS_CTL) + CW_BAR, (volatile LAS unsigned*)(lds + LDS_MISC));
    constexpr int lo = 0, hi_ph = 1000;
#else
    XcdBarrier bar; bar.bar = nullptr; bar.x = 0; bar.st = nullptr;
    const int lo = args.ph_lo, hi_ph = args.ph_hi;
#endif
    if (EN(0) && IN(0)) { PHASE_IDS();
        LAS float* scr = (LAS float*)(lds + wid * 4352);
        TrJob jobs[10];
        for (int l = 0; l < 2; ++l) {
            jobs[l * 4 + 0] = TrJob{args.in[I_WIN] + (size_t)l * 1024 * 2992, nullptr, 2992, 1024, 192, 1, Win + (size_t)l * 3072 * 1024, nullptr, 1.f};
            jobs[l * 4 + 1] = TrJob{args.in[I_WOUT] + (size_t)l * 1024 * 1024, nullptr, 1024, 1024, 64, 0, Wout + (size_t)l * 1024 * 1024, nullptr, 1.f};
            jobs[l * 4 + 2] = TrJob{args.in[I_WUQ] + (size_t)l * 512 * 576, nullptr, 576, 512, 36, 2, Wuq + (size_t)l * 768 * 512, args.in[I_QNW] + l * 512, 0.10206207261596577f * LOG2E};
            jobs[l * 4 + 3] = TrJob{args.in[I_WUKV] + (size_t)l * 256 * 768, nullptr, 768, 256, 48, 0, Wukv + (size_t)l * 768 * 256, args.in[I_KVNW] + l * 256, 1.f};
        }
        jobs[8] = TrJob{args.in[I_F1], args.in[I_F3], 2816, 1024, 352, 3, Wf13, nullptr, 1.f};
        jobs[9] = TrJob{args.in[I_F2], nullptr, 1024, 2816, 64, 0, Wf2, nullptr, 1.f};
        int total = 0;
#pragma unroll
        for (int q = 0; q < 10; ++q) total += tr_job_count(jobs[q]);
        { auto resolve = [&](int it, TrItem& T) { int r = it;
#pragma unroll
              for (int q = 0; q < 10; ++q) { const int n = tr_job_count(jobs[q]); if (r >= 0 && r < n) tr_resolve(jobs[q], r, lane, T); r -= n; } };
          tr_run(gw, NGW, total, resolve, scr, lane); }
        for (int item = blockIdx.x; item < 192; item += G) mod_item((LAS char*)lds + 40960, wid0, item, args.in[I_C], args.in[I_CCTX], args.in[I_ADAW], args.in[I_ADAB], modv);
        if (blockIdx.x == G - 1) { const int pos = tid >> 3, jj = tid & 7; const float inv = powf(10000.0f, -(float)jj / 8.0f); const float a = (float)pos * inv; ropet[pos * 8 + jj] = cosf(a); ropet[512 + pos * 8 + jj] = sinf(a); }
    }
    SEAM(0);

    layer_phases<0>(args, lds, G, NGW, bar, lo, hi_ph, wid0);
    layer_phases<1>(args, lds, G, NGW, bar, lo, hi_ph, wid0);
    if (EN(14) && IN(23)) { PHASE_IDS();
        const float* nw = args.in[I_FNW]; const float* g5 = modv + (size_t)9 * 6144 + 5 * 1024;
        auto unpk = [](const u32x2 a) -> f32x4 { f32x4 y; y.x = bf2f(a.x & 0xffffu); y.y = __uint_as_float(a.x & 0xffff0000u); y.z = bf2f(a.y & 0xffffu); y.w = __uint_as_float(a.y & 0xffff0000u); return y; };
        auto yload = [&](int pos, int c) -> f32x4 { f32x4 y = {0.f, 0.f, 0.f, 0.f};
            if (pos < 65536) y = unpk(*(const u32x2*)(ASORT + (size_t)pos * D + c));
            else { for (int p = 0; p < 11; ++p) y += unpk(*(const u32x2*)(PBY + ((size_t)p * 7 * 256 + (pos - 65536)) * D + c)); }
            return y; };
        auto row_slow = [&](int r) { float* xr = xout + (size_t)r * D; f32x4 v[4]; float s = 0.f;
            const int p0 = tokinfo[(size_t)r * 4 + 2], p1 = tokinfo[(size_t)r * 4 + 3]; const float g0 = tokg[(size_t)r * 2], g1 = tokg[(size_t)r * 2 + 1];
            const float* gp = g5 + (size_t)(r >> 12) * 6144;
#pragma unroll
            for (int j = 0; j < 4; ++j) { const int c = 4 * lane + 256 * j; v[j] = *(const f32x4*)(xr + c); const f32x4 gg = *(const f32x4*)(gp + c);
                const f32x4 ya = yload(p0, c), yb = yload(p1, c);
                v[j] += gg * (ya * g0 + yb * g1);
                s += (v[j].x * v[j].x + v[j].y * v[j].y) + (v[j].z * v[j].z + v[j].w * v[j].w); }
            const float rs = 1.0f / sqrtf(wave_sum(s) * (1.0f / D) + EPS);
#pragma unroll
            for (int j = 0; j < 4; ++j) { const f32x4 w = *(const f32x4*)(nw + 4 * lane + 256 * j); *(f32x4*)(xr + 4 * lane + 256 * j) = v[j] * rs * w; } };
        for (int r = gw; r < ML; r += 2 * NGW) { const int rA = r, rB = r + NGW;
            if (rB >= ML) { row_slow(rA); continue; }
            const int pA0 = tokinfo[(size_t)rA * 4 + 2], pA1 = tokinfo[(size_t)rA * 4 + 3], pB0 = tokinfo[(size_t)rB * 4 + 2], pB1 = tokinfo[(size_t)rB * 4 + 3];
            if (__builtin_amdgcn_readfirstlane((pA0 | pA1 | pB0 | pB1) >= 65536 ? 1 : 0)) { row_slow(rA); row_slow(rB); continue; }
            const float gA0 = tokg[(size_t)rA * 2], gA1 = tokg[(size_t)rA * 2 + 1], gB0 = tokg[(size_t)rB * 2], gB1 = tokg[(size_t)rB * 2 + 1];
            float* xa = xout + (size_t)rA * D; float* xb = xout + (size_t)rB * D;
            f32x4 va[4], vb[4]; u32x2 ya0[4], ya1[4], yb0[4], yb1[4];
#pragma unroll
            for (int j = 0; j < 4; ++j) { const int c = 4 * lane + 256 * j; va[j] = *(const f32x4*)(xa + c); vb[j] = *(const f32x4*)(xb + c);
                ya0[j] = *(const u32x2*)(ASORT + (size_t)pA0 * D + c); ya1[j] = *(const u32x2*)(ASORT + (size_t)pA1 * D + c);
                yb0[j] = *(const u32x2*)(ASORT + (size_t)pB0 * D + c); yb1[j] = *(const u32x2*)(ASORT + (size_t)pB1 * D + c); }
            const float* gpa = g5 + (size_t)(rA >> 12) * 6144; const float* gpb = g5 + (size_t)(rB >> 12) * 6144;
            float sa = 0.f, sb = 0.f;
#pragma unroll
            for (int j = 0; j < 4; ++j) { const int c = 4 * lane + 256 * j; const f32x4 ga = *(const f32x4*)(gpa + c), gb = *(const f32x4*)(gpb + c);
                va[j] += ga * (unpk(ya0[j]) * gA0 + unpk(ya1[j]) * gA1); vb[j] += gb * (unpk(yb0[j]) * gB0 + unpk(yb1[j]) * gB1);
                sa += (va[j].x * va[j].x + va[j].y * va[j].y) + (va[j].z * va[j].z + va[j].w * va[j].w); sb += (vb[j].x * vb[j].x + vb[j].y * vb[j].y) + (vb[j].z * vb[j].z + vb[j].w * vb[j].w); }
            const float rsa = 1.0f / sqrtf(wave_sum(sa) * (1.0f / D) + EPS), rsb = 1.0f / sqrtf(wave_sum(sb) * (1.0f / D) + EPS);
#pragma unroll
            for (int j = 0; j < 4; ++j) { const f32x4 w = *(const f32x4*)(nw + 4 * lane + 256 * j); *(f32x4*)(xa + 4 * lane + 256 * j) = va[j] * rsa * w; *(f32x4*)(xb + 4 * lane + 256 * j) = vb[j] * rsb * w; } }
    }
}

extern "C" void kernel_launch(void* const* d_in, const int* in_sizes, int n_in, void* d_out, int out_size, void* d_ws, size_t ws_size, hipStream_t stream) {
    static int grid = 0;
    if (grid == 0) {
        if (n_in != 27 || out_size != ML * D || ws_size < WS_END) { fprintf(stderr, "kernel_launch: unexpected sizes (n_in %d out %d ws %zu need %zu)\n", n_in, out_size, ws_size, (size_t)WS_END); grid = -1; return; }
        int dev = 0, cus = 0;
        if (hipGetDevice(&dev) != hipSuccess || hipDeviceGetAttribute(&cus, hipDeviceAttributeMultiprocessorCount, dev) != hipSuccess) { grid = -1; return; }
        if (hipFuncSetAttribute((const void*)mega_fwd, hipFuncAttributeMaxDynamicSharedMemorySize, LDS_BYTES) != hipSuccess) { fprintf(stderr, "kernel_launch: hipFuncSetAttribute failed\n"); grid = -1; return; }
        int per_cu = 0;
        if (hipOccupancyMaxActiveBlocksPerMultiprocessor(&per_cu, (const void*)mega_fwd, 512, LDS_BYTES) != hipSuccess || per_cu < 1) fprintf(stderr, "kernel_launch: occupancy query says %d\n", per_cu);
        (void)hipGetLastError();
        grid = cus;
    }
    if (grid < 0) return;
    if (hipMemsetAsync((char*)d_ws + WS_CTL, 0, CTL_ZERO_BYTES, stream) != hipSuccess) return;
    Args a{};
    for (int i = 0; i < 27; ++i) a.in[i] = (const float*)d_in[i];
    a.out = (float*)d_out; a.ws = (unsigned char*)d_ws;
#if MK_MULTI
#ifndef MK_DUP0
#define MK_DUP0 -1
#endif
#ifndef MK_DUP1
#define MK_DUP1 -1
#endif
    for (int ph = 0; ph < NPHASE; ++ph) { a.ph_lo = ph; a.ph_hi = ph + 1; const int reps = (ph == MK_DUP0 || ph == MK_DUP1) ? 2 : 1;
        for (int r = 0; r < reps; ++r) hipLaunchKernelGGL(mega_fwd, dim3(grid), dim3(512), LDS_BYTES, stream, a); }
#else
    a.ph_lo = 0; a.ph_hi = NPHASE;
    hipLaunchKernelGGL(mega_fwd, dim3(grid), dim3(512), LDS_BYTES, stream, a);
#endif
}
```

```cpp
#include <hip/hip_runtime.h>
#include <stdint.h>
#include <stdio.h>

#ifndef MK_MULTI
#define MK_MULTI 0
#endif

#define LAS __attribute__((address_space(3)))
#define GAS __attribute__((address_space(1)))
typedef unsigned short bf16_t;
typedef short bf16x8 __attribute__((ext_vector_type(8)));
typedef short s16x4 __attribute__((ext_vector_type(4)));
typedef float f32x2 __attribute__((ext_vector_type(2)));
typedef float f32x4 __attribute__((ext_vector_type(4)));
typedef float f32x16 __attribute__((ext_vector_type(16)));
typedef unsigned u32x2 __attribute__((ext_vector_type(2)));
typedef unsigned u32x4 __attribute__((ext_vector_type(4)));
typedef __bf16 bf16x2_t __attribute__((ext_vector_type(2)));

constexpr int NB = 8, T = 4096, D = 1024, NC = 256;
constexpr int ML = NB * T, MC = NB * NC, M = ML + MC;
constexpr int NP = 3072;
constexpr int PC_QL = 0, PC_KVL = 512, PC_MQ = 768, PC_MK = 1024, PC_MV = 1280, PC_MO = 1536, PC_NQ = 1792, PC_NK = 2176, PC_NV = 2560, PC_KR = 2944, PC_GT = 2976;
constexpr int NQM = 576, NKVM = 768;
constexpr int DFF = 2816, NEXP = 8;
constexpr int NCHK = 68;
constexpr float LOG2E = 1.4426950408889634f;
constexpr float EPS = 1e-6f;

constexpr size_t MiB = 1u << 20;
constexpr size_t WS_CTL = 0, CTL_ZERO_BYTES = 1 * MiB;
constexpr size_t WS_SMALL = 1 * MiB;
constexpr size_t SM_MOD = WS_SMALL;
constexpr size_t SM_ROPE = SM_MOD + 2 * 9 * 6144 * 4;
constexpr size_t SM_STATS = WS_SMALL + 1 * MiB;
constexpr size_t SM_NLOC = WS_SMALL + 5 * MiB;
constexpr size_t SM_NIN = WS_SMALL + 7 * MiB;
constexpr size_t SM_MG = WS_SMALL + 9 * MiB;
constexpr size_t SM_MIN = SM_MG + 256 * 1024;
constexpr size_t SM_TOK = WS_SMALL + 10 * MiB;
constexpr size_t SM_TOKG = SM_TOK + (size_t)ML * 16;
constexpr size_t SM_WGCNT = WS_SMALL + 11 * MiB;
constexpr size_t SM_ROWTOK = SM_WGCNT + 64 * 1024;
constexpr size_t SM_ROWGATE = SM_ROWTOK + (size_t)2 * M * 4;
constexpr size_t SM_TILEEXP = SM_ROWGATE + (size_t)2 * M * 4;
constexpr size_t WS_WSMALL = 17 * MiB;
constexpr size_t W_IN = WS_WSMALL;
constexpr size_t W_OUT = W_IN + (size_t)2 * 3072 * 1024 * 2;
constexpr size_t W_UQ = W_OUT + (size_t)2 * 1024 * 1024 * 2;
constexpr size_t W_UKV = W_UQ + (size_t)2 * 768 * 512 * 2;
constexpr size_t W_F13 = W_UKV + (size_t)2 * 768 * 256 * 2;
constexpr size_t W_F2 = W_F13 + (size_t)5632 * 1024 * 2;
constexpr size_t WS_XC = 52 * MiB;
constexpr size_t WS_H = 60 * MiB;
constexpr size_t WS_P = 128 * MiB;
constexpr size_t WS_QM = 332 * MiB;
constexpr size_t WS_KVM = 371 * MiB;
constexpr size_t WS_CIN = 422 * MiB;
constexpr size_t WS_END_MIX = 456 * MiB;
constexpr size_t WS_WMOE = 17 * MiB;
constexpr size_t WMOE_E = (size_t)5632 * 1024 * 2 + (size_t)1024 * 2816 * 2;
constexpr size_t WS_U = 149 * MiB;
constexpr size_t WS_ASORT = 336 * MiB;
constexpr size_t WS_PBY = 472 * MiB;
constexpr size_t WS_END = 516 * MiB;
constexpr size_t WS_PBF = WS_QM;
constexpr size_t WS_PBW = WS_KVM;
static_assert(W_F2 + (size_t)1024 * 2816 * 2 <= WS_XC, "weights");
static_assert(WS_H + (size_t)M * 1024 * 2 <= WS_P && WS_P + (size_t)M * NP * 2 <= WS_QM && WS_QM + (size_t)M * NQM * 2 <= WS_KVM && WS_KVM + (size_t)M * NKVM * 2 <= WS_CIN, "map");
static_assert(WS_CIN + (size_t)2 * 8 * 4 * NCHK * 4096 * 2 <= WS_END_MIX, "map2");
static_assert(WS_WMOE + 8 * WMOE_E <= WS_U && WS_U + (size_t)M * DFF * 2 <= WS_ASORT && WS_ASORT + (size_t)2 * M * 1024 * 2 <= WS_PBY && WS_PBY + (size_t)11 * 7 * 256 * 1024 * 2 <= WS_END, "map3");
static_assert((size_t)2 * 8 * 4 * NCHK * 4096 * 4 <= (size_t)M * 1024 * 2, "C_LOC overlays BUF_H");
static_assert(SM_TILEEXP + 4096 <= WS_WSMALL && SM_TOKG + (size_t)ML * 8 <= SM_WGCNT && SM_STATS + (size_t)M * 24 * 4 <= SM_NLOC, "small map");

constexpr int CW_BAR = 4096;
constexpr int CW_QUEUE = 8192;
constexpr int CW_REDO2 = 8192 + 2048;
constexpr int CW_REDO = 8192 + 256;

constexpr int LDS_BYTES = 155648;
constexpr int LDS_MISC = 155648 - 256;

#define LDS_WAIT() asm volatile("s_waitcnt lgkmcnt(0)" ::: "memory")
#define VM_WAIT() asm volatile("s_waitcnt vmcnt(0)" ::: "memory")
__device__ __forceinline__ float bf2f(unsigned v) { return __uint_as_float(v << 16); }
__device__ __forceinline__ unsigned pk2(float lo, float hi) { f32x2 v = {lo, hi}; bf16x2_t b = __builtin_convertvector(v, bf16x2_t); return __builtin_bit_cast(unsigned, b); }
__device__ __forceinline__ void unpack8(const u32x4 w, float* f) {
    f[0] = __uint_as_float(w.x << 16); f[1] = __uint_as_float(w.x & 0xffff0000u); f[2] = __uint_as_float(w.y << 16); f[3] = __uint_as_float(w.y & 0xffff0000u);
    f[4] = __uint_as_float(w.z << 16); f[5] = __uint_as_float(w.z & 0xffff0000u); f[6] = __uint_as_float(w.w << 16); f[7] = __uint_as_float(w.w & 0xffff0000u);
}
__device__ __forceinline__ u32x4 pack8(const float* f) { u32x4 w; w.x = pk2(f[0], f[1]); w.y = pk2(f[2], f[3]); w.z = pk2(f[4], f[5]); w.w = pk2(f[6], f[7]); return w; }
__device__ __forceinline__ float wave_sum(float v) {
#pragma unroll
    for (int o = 1; o < 64; o <<= 1) v += __shfl_xor(v, o);
    return v;
}
__device__ __forceinline__ float wave_max(float v) {
#pragma unroll
    for (int o = 1; o < 64; o <<= 1) v = fmaxf(v, __shfl_xor(v, o));
    return v;
}
__device__ __forceinline__ float fexp2(float x) { return __builtin_amdgcn_exp2f(x); }
__device__ __forceinline__ float fexp(float x) { return __builtin_amdgcn_exp2f(x * LOG2E); }
__device__ __forceinline__ float frcp(float x) { return __builtin_amdgcn_rcpf(x); }
__device__ __forceinline__ float silu_f(float x) { return x * frcp(1.0f + fexp(-x)); }
__device__ __forceinline__ float sigmoid_f(float x) { return frcp(1.0f + fexp(-x)); }
__device__ __forceinline__ int fresh_lane() { int l; asm volatile("v_mbcnt_lo_u32_b32 %0, -1, 0\n\tv_mbcnt_hi_u32_b32 %0, -1, %0" : "=v"(l)); return l; }
__device__ __forceinline__ float xhalf(float v) { return __shfl_xor(v, 32); }
__device__ __forceinline__ float half_max(float v) { auto rr = __builtin_amdgcn_permlane32_swap(__float_as_uint(v), __float_as_uint(v), false, false); return fmaxf(__uint_as_float(rr[0]), __uint_as_float(rr[1])); }
__device__ __forceinline__ float half_sum(float v) { auto rr = __builtin_amdgcn_permlane32_swap(__float_as_uint(v), __float_as_uint(v), false, false); return __uint_as_float(rr[0]) + __uint_as_float(rr[1]); }

namespace pg8 {
constexpr int BM = 256, BK = 64, HALF = 128, HTB = HALF * BK * 2, STAGE_BYTES = 8 * HTB, NXCD = 8, WGM = 8;
__host__ __device__ __forceinline__ int lds_byte(int r, int c) { const int st = (r >> 4) * 2 + (c >> 5), rr = r & 15, cc = c & 31, ob = rr * 64 + cc * 2; return st * 1024 + (ob ^ (((ob >> 9) & 1) << 5)); }
__host__ __device__ __forceinline__ void stage_rc(int b, int& R, int& C) { const int st = b / 1024, sb = b % 1024, swz = sb ^ (((sb >> 9) & 1) << 5); R = (st >> 1) * 16 + swz / 64; C = (st & 1) * 32 + (swz % 64) / 2; }
__host__ __device__ __forceinline__ int perm32(int rho) { const int n = rho >> 4, i = rho & 15; return 8 * (i >> 2) + 4 * n + (i & 3); }

struct Unit { int pm, pn, kb, ke, part; };
struct Gemm { const bf16_t* A; int lda; const bf16_t* Bt; int K; };

struct StaticOrder {
    int nM, nN, nwg, G, c, nt;
    __device__ void init(int nM_, int nN_, int G_, int c_, int K_) { nM = nM_; nN = nN_; nwg = nM * nN; G = G_; c = c_; nt = K_ / BK; }
    __device__ __forceinline__ void tile_of(int L, Unit& u) const {
        int wgid = L; { const int q = nwg / NXCD, r = nwg % NXCD, xcd = wgid % NXCD, off = wgid / NXCD; wgid = (xcd < r ? xcd * (q + 1) : r * (q + 1) + (xcd - r) * q) + off; }
        const int nig = WGM * nN, gid = wgid / nig, fm = gid * WGM, gsz = (nM - fm) < WGM ? (nM - fm) : WGM;
        u.pm = fm + ((wgid % nig) % gsz); u.pn = (wgid % nig) / gsz;
    }
    __device__ bool next(int i, Unit& u) const {
        const long L = (long)i * G + c; if (L >= nwg) return false;
        tile_of((int)L, u); u.kb = 0; u.ke = nt; u.part = -1; return true;
    }
    __device__ __forceinline__ const char* a_base(const Gemm& g, const Unit& u) const { return (const char*)g.A + (size_t)u.pm * 256 * g.lda * 2 + (size_t)u.kb * (BK * 2); }
    __device__ __forceinline__ const char* b_base(const Gemm& g, const Unit& u) const { return (const char*)g.Bt + (size_t)u.pn * 256 * g.K * 2 + (size_t)u.kb * (BK * 2); }
};
struct GroupedOrder : StaticOrder {
    const int* tile_exp; size_t estride;
    __device__ __forceinline__ const char* b_base(const Gemm& g, const Unit& u) const { return (const char*)g.Bt + (size_t)tile_exp[u.pm] * estride + (size_t)u.pn * 256 * g.K * 2 + (size_t)u.kb * (BK * 2); }
};
template <class Base> struct TailSplit : Base {
    int nMain, nTail, S;
    __device__ void init_ts(int nMain_, int nTail_, int S_) { nMain = nMain_; nTail = nTail_ < 0 ? 0 : nTail_; S = S_; this->nM = nMain; this->nwg = nMain * this->nN; }
    __device__ bool next(int i, Unit& u) const {
        const long L = (long)i * this->G + this->c;
        if (L < this->nwg) { this->tile_of((int)L, u); u.kb = 0; u.ke = this->nt; u.part = -1; return true; }
        const long j = L - this->nwg; const int ntu = nTail * this->nN;
        if (j >= (long)ntu * S) return false;
        const int t = (int)(j % ntu), p = (int)(j / ntu), np = this->nt / 2;
        u.pm = nMain + t / this->nN; u.pn = t % this->nN; u.kb = 2 * (p * np / S); u.ke = 2 * ((p + 1) * np / S); u.part = p; return true;
    }
};

__device__ __forceinline__ unsigned cvt_pk_bf16(float lo, float hi) { unsigned r; asm volatile("v_cvt_pk_bf16_f32 %0, %1, %2" : "=v"(r) : "v"(lo), "v"(hi)); return r; }

template <class Epi, class Sched, bool ALIGN_EPI>
__device__ __forceinline__ void gemm_phase(LAS unsigned char* lds, const Gemm g, const Sched& S, const Epi& E, const int wid0) {
    const int lane = fresh_lane(), wid = wid0, tid = wid * 64 + lane,
    wr = wid >> 2, wc = wid & 3, fr = lane & 15, fq = lane >> 4;
    const int K = g.K;
    unsigned voffA[2], voffB[2];
#pragma unroll
    for (int i = 0; i < 2; ++i) { int R, C; stage_rc(tid * 16 + i * 8192, R, C); const int Rb = Epi::PERM ? ((R & ~31) + perm32(R & 31)) : R;
        voffA[i] = (unsigned)(R * g.lda + C) * 2u; voffB[i] = (unsigned)(Rb * K + C) * 2u; }
    const size_t kstep = (size_t)(BK * 2);
    const size_t hsA = (size_t)HALF * g.lda * 2, hsB = (size_t)HALF * K * 2;
    const unsigned ldsw = (unsigned)wid * 1024u;
    const int aoff = lds_byte(wr * 64 + fr, fq * 8), boff = lds_byte(wc * 32 + fr, fq * 8);
#define PG8_SA(b, h) (((b) * 2 + (h)) * HTB)
#define PG8_SB(b, h) ((4 + (b) * 2 + (h)) * HTB)
#define PG8_STAGE(bufoff, gbase, voff) do { _Pragma("unroll") for (int _i = 0; _i < 2; ++_i) \
        __builtin_amdgcn_global_load_lds((const unsigned*)((const char*)(gbase) + (voff)[_i]), (LAS unsigned*)(lds + (bufoff) + ldsw + _i * 8192), 16, 0, 0); } while (0)
#define PG8_LDA(dst, b, h) do { _Pragma("unroll") for (int m = 0; m < 4; ++m) _Pragma("unroll") for (int k = 0; k < 2; ++k) dst[m][k] = *(const LAS bf16x8*)(lds + PG8_SA(b, h) + aoff + m * 2048 + k * 1024); } while (0)
#define PG8_LDB(dst, b, h) do { _Pragma("unroll") for (int n = 0; n < 2; ++n) _Pragma("unroll") for (int k = 0; k < 2; ++k) dst[n][k] = *(const LAS bf16x8*)(lds + PG8_SB(b, h) + boff + n * 2048 + k * 1024); } while (0)
#define PG8_MMA(ai, bj, At, Bt) do { __builtin_amdgcn_s_setprio(1); _Pragma("unroll") for (int m = 0; m < 4; ++m) _Pragma("unroll") for (int n = 0; n < 2; ++n) _Pragma("unroll") for (int k = 0; k < 2; ++k) \
        acc[ai][bj][m][n] = __builtin_amdgcn_mfma_f32_16x16x32_bf16(Bt[n][k], At[m][k], acc[ai][bj][m][n], 0, 0, 0); __builtin_amdgcn_s_setprio(0); } while (0)
#define PG8_WAIT_V(n) asm volatile("s_waitcnt vmcnt(" #n ")" ::: "memory")
#define PG8_WAIT_L(n) asm volatile("s_waitcnt lgkmcnt(" #n ")" ::: "memory")
#define PG8_BAR __builtin_amdgcn_s_barrier()
#define PG8_SCHED __builtin_amdgcn_sched_barrier(0)
    Unit cur, nxt; int ui = 0;
    if (!S.next(0, cur)) return;
    f32x4 acc[2][2][4][2];
#pragma unroll
    for (int a = 0; a < 2; ++a)
#pragma unroll
        for (int b = 0; b < 2; ++b)
#pragma unroll
            for (int m = 0; m < 4; ++m)
#pragma unroll
                for (int n = 0; n < 2; ++n) acc[a][b][m][n] = (f32x4){0.f, 0.f, 0.f, 0.f};
    bf16x8 At[4][2], B0[2][2], B1[2][2];
    const char* cA = S.a_base(g, cur); const char* cB = S.b_base(g, cur);
    PG8_STAGE(PG8_SB(0, 0), cB, voffB); PG8_STAGE(PG8_SB(0, 1), cB + hsB, voffB); PG8_STAGE(PG8_SA(0, 0), cA, voffA); PG8_STAGE(PG8_SA(0, 1), cA + hsA, voffA);
    if (wr == 1) PG8_BAR;
    PG8_WAIT_V(2); PG8_BAR;
    PG8_STAGE(PG8_SB(1, 0), cB + kstep, voffB); PG8_STAGE(PG8_SA(1, 0), cA + kstep, voffA); PG8_STAGE(PG8_SB(1, 1), cB + hsB + kstep, voffB);
    PG8_WAIT_V(6); PG8_BAR;
    for (;;) {
        const bool has_next = S.next(ui + 1, nxt);
        const char* nA = has_next ? S.a_base(g, nxt) : cA; const char* nB = has_next ? S.b_base(g, nxt) : cB;
        const int ntc = cur.ke - cur.kb;
#pragma unroll 1
        for (int t = 0; t < ntc; t += 2) {
            const bool last = (t == ntc - 2);
            const char* a1 = cA + (size_t)(t + 1) * kstep;
            const char* a2 = last ? nA : cA + (size_t)(t + 2) * kstep; const char* b2 = last ? nB : cB + (size_t)(t + 2) * kstep;
            const char* a3 = a2 + kstep; const char* b3 = b2 + kstep;
            PG8_LDB(B0, 0, 0); PG8_LDB(B1, 0, 1); PG8_SCHED; PG8_LDA(At, 0, 0); PG8_STAGE(PG8_SA(1, 1), a1 + hsA, voffA);
            PG8_WAIT_V(8); PG8_WAIT_L(0); PG8_BAR; PG8_MMA(0, 0, At, B0); PG8_MMA(0, 1, At, B1); PG8_BAR; PG8_SCHED;
            PG8_LDA(At, 0, 1); PG8_STAGE(PG8_SB(0, 0), b2, voffB); PG8_STAGE(PG8_SB(0, 1), b2 + hsB, voffB); PG8_STAGE(PG8_SA(0, 0), a2, voffA);
            PG8_WAIT_V(8); PG8_WAIT_L(0); PG8_BAR; PG8_MMA(1, 0, At, B0); PG8_MMA(1, 1, At, B1); PG8_BAR; PG8_SCHED;
            PG8_LDB(B0, 1, 0); PG8_LDB(B1, 1, 1); PG8_SCHED; PG8_LDA(At, 1, 0); PG8_STAGE(PG8_SA(0, 1), a2 + hsA, voffA);
            PG8_WAIT_V(8); PG8_WAIT_L(0); PG8_BAR; PG8_MMA(0, 0, At, B0); PG8_MMA(0, 1, At, B1); PG8_BAR; PG8_SCHED;
            PG8_LDA(At, 1, 1); PG8_STAGE(PG8_SB(1, 0), b3, voffB); PG8_STAGE(PG8_SB(1, 1), b3 + hsB, voffB); PG8_STAGE(PG8_SA(1, 0), a3, voffA);
            PG8_WAIT_V(8); PG8_WAIT_L(0); PG8_BAR; PG8_MMA(1, 0, At, B0); PG8_MMA(1, 1, At, B1); PG8_BAR; PG8_SCHED;
        }
        if constexpr (ALIGN_EPI) { if (wr == 0) PG8_BAR; }
        E(acc, cur, wr, wc, fr, fq);
        if (!has_next) break;
#pragma unroll
        for (int a = 0; a < 2; ++a)
#pragma unroll
            for (int b = 0; b < 2; ++b)
#pragma unroll
                for (int m = 0; m < 4; ++m)
#pragma unroll
                    for (int n = 0; n < 2; ++n) acc[a][b][m][n] = (f32x4){0.f, 0.f, 0.f, 0.f};
        cur = nxt; cA = nA; cB = nB; ++ui;
        if constexpr (ALIGN_EPI) { if (wr == 1) PG8_BAR; }
    }
    PG8_WAIT_V(0);
    if constexpr (!ALIGN_EPI) { if (wr == 0) PG8_BAR; }
    PG8_BAR;
#undef PG8_SA
#undef PG8_SB
#undef PG8_STAGE
#undef PG8_LDA
#undef PG8_LDB
#undef PG8_MMA
#undef PG8_WAIT_V
#undef PG8_WAIT_L
#undef PG8_BAR
#undef PG8_SCHED
}

typedef const f32x4 (&AccRef)[2][2][4][2];

__device__ __forceinline__ void rope8(f32x4& v0, f32x4& v1, int fq, int tpos, const float* tab) {
    const int pos = (fq < 2) ? (tpos >> 6) : (tpos & 63);
    const f32x4 c0 = *(const f32x4*)(tab + pos * 8), c1 = *(const f32x4*)(tab + pos * 8 + 4), s0 = *(const f32x4*)(tab + 512 + pos * 8), s1 = *(const f32x4*)(tab + 512 + pos * 8 + 4);
    f32x4 p0, p1;
#pragma unroll
    for (int j = 0; j < 4; ++j) { p0[j] = __shfl_xor(v0[j], 16); p1[j] = __shfl_xor(v1[j], 16); }
    const float sg = (fq & 1) ? 1.f : -1.f;
    v0 = v0 * c0 + sg * (p0 * s0); v1 = v1 * c1 + sg * (p1 * s1);
}

struct EpiP {
    static constexpr bool PERM = true;
    bf16_t* P; float* stats; const float* rope;
    __device__ __forceinline__ void operator()(AccRef acc, const Unit& u, int wr, int wc, int fr, int fq) const {
        const int row0 = u.pm * BM + wr * 64 + fr, col0 = u.pn * BM + wc * 32 + 8 * fq;
        const bool do_stats = u.pn < 3, do_rope = (u.pn == 11) && (wc == 0) && (u.pm < ML / 256);
#pragma unroll
        for (int ai = 0; ai < 2; ++ai)
#pragma unroll
            for (int m = 0; m < 4; ++m) { const int row = row0 + ai * HALF + m * 16; bf16_t* rowp = P + (size_t)row * NP + col0;
#pragma unroll
                for (int bj = 0; bj < 2; ++bj) { f32x4 v0 = acc[ai][bj][m][0], v1 = acc[ai][bj][m][1];
                    if (do_stats) { float ss = (v0[0] * v0[0] + v0[1] * v0[1]) + (v0[2] * v0[2] + v0[3] * v0[3]) + (v1[0] * v1[0] + v1[1] * v1[1]) + (v1[2] * v1[2] + v1[3] * v1[3]);
                        ss += __shfl_xor(ss, 16); ss += __shfl_xor(ss, 32);
                        if (fq == 0) stats[(size_t)row * 24 + u.pn * 8 + bj * 4 + wc] = ss; }
                    if (bj == 1 && do_rope) rope8(v0, v1, fq, row & (T - 1), rope);
                    u32x4 w; w.x = cvt_pk_bf16(v0[0], v0[1]); w.y = cvt_pk_bf16(v0[2], v0[3]); w.z = cvt_pk_bf16(v1[0], v1[1]); w.w = cvt_pk_bf16(v1[2], v1[3]);
                    *(u32x4*)(rowp + bj * HALF) = w; } }
    }
};
template <bool ROPE> struct EpiRS {
    static constexpr bool PERM = true;
    bf16_t* O; int ldc, ncols, rope_c0; const float* stats; int part0, nparts; float invk; const float* rope;
    __device__ __forceinline__ void operator()(AccRef acc, const Unit& u, int wr, int wc, int fr, int fq) const {
        const int row0 = u.pm * BM + wr * 64 + fr, col0 = u.pn * BM + wc * 32 + 8 * fq;
        const int npl = nparts >> 2;
#pragma unroll
        for (int ai = 0; ai < 2; ++ai)
#pragma unroll
            for (int m = 0; m < 4; ++m) { const int row = row0 + ai * HALF + m * 16; bf16_t* rowp = O + (size_t)row * ldc + col0;
                const float* sp = stats + (size_t)row * 24 + part0 + fq * npl; float ss = sp[0] + sp[1]; if (npl == 4) ss += sp[2] + sp[3];
                ss += __shfl_xor(ss, 16); ss += __shfl_xor(ss, 32);
                const float rs = 1.0f / sqrtf(ss * invk + EPS);
#pragma unroll
                for (int bj = 0; bj < 2; ++bj) { const int c = col0 + bj * HALF; f32x4 v0 = acc[ai][bj][m][0] * rs, v1 = acc[ai][bj][m][1] * rs;
                    if (ROPE) { const int cb = u.pn * BM + bj * HALF + wc * 32;
                        if (cb >= rope_c0 && cb < ncols && u.pm < ML / 256) rope8(v0, v1, fq, row & (T - 1), rope); }
                    if (c < ncols) { u32x4 w; w.x = cvt_pk_bf16(v0[0], v0[1]); w.y = cvt_pk_bf16(v0[2], v0[3]); w.z = cvt_pk_bf16(v1[0], v1[1]); w.w = cvt_pk_bf16(v1[2], v1[3]);
                        *(u32x4*)(rowp + bj * HALF) = w; } } }
    }
};
struct EpiDelta {
    static constexpr bool PERM = true;
    bf16_t* O; const float* gate; int gstride;
    bf16_t* Op; size_t pstride; int prow0;
    __device__ __forceinline__ void operator()(AccRef acc, const Unit& u, int wr, int wc, int fr, int fq) const {
        const int row0 = u.pm * BM + wr * 64 + fr - (u.part >= 0 ? prow0 : 0), col0 = u.pn * BM + wc * 32 + 8 * fq;
        bf16_t* const Ob = u.part >= 0 ? Op + (size_t)u.part * pstride : O;
        f32x4 gv[2][2];
#pragma unroll
        for (int bj = 0; bj < 2; ++bj)
#pragma unroll
            for (int n = 0; n < 2; ++n) gv[bj][n] = gate ? *(const f32x4*)(gate + (size_t)(u.pm < ML / 256 ? (u.pm >> 4) : 8) * gstride + col0 + bj * HALF + 4 * n) : (f32x4){1.f, 1.f, 1.f, 1.f};
#pragma unroll
        for (int ai = 0; ai < 2; ++ai)
#pragma unroll
            for (int m = 0; m < 4; ++m) { bf16_t* rowp = Ob + (size_t)(row0 + ai * HALF + m * 16) * D + col0;
#pragma unroll
                for (int bj = 0; bj < 2; ++bj) { const f32x4 v0 = acc[ai][bj][m][0] * gv[bj][0], v1 = acc[ai][bj][m][1] * gv[bj][1];
                    u32x4 w; w.x = cvt_pk_bf16(v0[0], v0[1]); w.y = cvt_pk_bf16(v0[2], v0[3]); w.z = cvt_pk_bf16(v1[0], v1[1]); w.w = cvt_pk_bf16(v1[2], v1[3]);
                    *(u32x4*)(rowp + bj * HALF) = w; } }
    }
};
struct EpiRes2 {
    static constexpr bool PERM = false;
    const float* xin; float* xout; const float* gate; int gstride; bf16_t* Op; size_t pstride; int prow0;
    __device__ __forceinline__ void operator()(AccRef acc, const Unit& u, int wr, int wc, int fr, int fq) const {
        const int row0 = u.pm * BM + wr * 64 + fr, col0 = u.pn * BM + wc * 32 + 4 * fq;
        const float* gp = gate + (size_t)(u.pm < ML / 256 ? (u.pm >> 4) : 8) * gstride + col0;
        f32x4 gv[2][2];
#pragma unroll
        for (int bj = 0; bj < 2; ++bj)
#pragma unroll
            for (int n = 0; n < 2; ++n) gv[bj][n] = *(const f32x4*)(gp + bj * HALF + n * 16);
        if (u.part < 0) {
#pragma unroll
            for (int ai = 0; ai < 2; ++ai)
#pragma unroll
                for (int m = 0; m < 4; ++m) { const size_t off = (size_t)(row0 + ai * HALF + m * 16) * D + col0;
#pragma unroll
                    for (int bj = 0; bj < 2; ++bj)
#pragma unroll
                        for (int n = 0; n < 2; ++n) { const f32x4 xv = *(const f32x4*)(xin + off + bj * HALF + n * 16); *(f32x4*)(xout + off + bj * HALF + n * 16) = xv + gv[bj][n] * acc[ai][bj][m][n]; } }
        } else { bf16_t* ob = Op + (size_t)u.part * pstride;
#pragma unroll
            for (int ai = 0; ai < 2; ++ai)
#pragma unroll
                for (int m = 0; m < 4; ++m) { const size_t off = (size_t)(row0 - prow0 + ai * HALF + m * 16) * D + col0;
#pragma unroll
                    for (int bj = 0; bj < 2; ++bj)
#pragma unroll
                        for (int n = 0; n < 2; ++n) { const f32x4 y = gv[bj][n] * acc[ai][bj][m][n]; u32x2 w; w.x = cvt_pk_bf16(y[0], y[1]); w.y = cvt_pk_bf16(y[2], y[3]); *(u32x2*)(ob + off + bj * HALF + n * 16) = w; } }
        }
    }
};
constexpr int XBP = 2048;
template <bool XF32> struct EpiResB {
    static constexpr bool PERM = true;
    const float* xin; bf16_t* xb; const float* gate; int gstride; bf16_t* Op; size_t pstride; int prow0;
    __device__ __forceinline__ void operator()(AccRef acc, const Unit& u, int wr, int wc, int fr, int fq) const {
        const int row0 = u.pm * BM + wr * 64 + fr, col0 = u.pn * BM + wc * 32 + 8 * fq;
        const float* gp = gate + (size_t)(u.pm < ML / 256 ? (u.pm >> 4) : 8) * gstride + col0;
        f32x4 gv[2][2];
#pragma unroll
        for (int bj = 0; bj < 2; ++bj)
#pragma unroll
            for (int n = 0; n < 2; ++n) gv[bj][n] = *(const f32x4*)(gp + bj * HALF + 4 * n);
        if (u.part < 0) {
#pragma unroll
            for (int ai = 0; ai < 2; ++ai)
#pragma unroll
                for (int m = 0; m < 4; ++m) { const int row = row0 + ai * HALF + m * 16;
#pragma unroll
                    for (int bj = 0; bj < 2; ++bj) { f32x4 x0, x1; bf16_t* xp = xb + (size_t)row * XBP + col0 + bj * HALF;
                        if constexpr (XF32) { const float* xf = xin + (size_t)row * D + col0 + bj * HALF; x0 = *(const f32x4*)xf; x1 = *(const f32x4*)(xf + 4); }
                        else { const u32x4 w = *(const u32x4*)xp; x0 = (f32x4){__uint_as_float(w.x << 16), __uint_as_float(w.x & 0xffff0000u), __uint_as_float(w.y << 16), __uint_as_float(w.y & 0xffff0000u)};
                            x1 = (f32x4){__uint_as_float(w.z << 16), __uint_as_float(w.z & 0xffff0000u), __uint_as_float(w.w << 16), __uint_as_float(w.w & 0xffff0000u)}; }
                        const f32x4 y0 = x0 + gv[bj][0] * acc[ai][bj][m][0], y1 = x1 + gv[bj][1] * acc[ai][bj][m][1];
                        u32x4 o; o.x = cvt_pk_bf16(y0[0], y0[1]); o.y = cvt_pk_bf16(y0[2], y0[3]); o.z = cvt_pk_bf16(y1[0], y1[1]); o.w = cvt_pk_bf16(y1[2], y1[3]);
                        *(u32x4*)xp = o; } }
        } else { bf16_t* ob = Op + (size_t)u.part * pstride;
#pragma unroll
            for (int ai = 0; ai < 2; ++ai)
#pragma unroll
                for (int m = 0; m < 4; ++m) { bf16_t* rowp = ob + (size_t)(row0 - prow0 + ai * HALF + m * 16) * D + col0;
#pragma unroll
                    for (int bj = 0; bj < 2; ++bj) { const f32x4 y0 = gv[bj][0] * acc[ai][bj][m][0], y1 = gv[bj][1] * acc[ai][bj][m][1];
                        u32x4 o; o.x = cvt_pk_bf16(y0[0], y0[1]); o.y = cvt_pk_bf16(y0[2], y0[3]); o.z = cvt_pk_bf16(y1[0], y1[1]); o.w = cvt_pk_bf16(y1[2], y1[3]);
                        *(u32x4*)(rowp + bj * HALF) = o; } }
        }
    }
};
struct EpiSwiglu {
    static constexpr bool PERM = true;
    bf16_t* U; int ldc;
    __device__ __forceinline__ void operator()(AccRef acc, const Unit& u, int wr, int wc, int fr, int fq) const {
        const int row0 = u.pm * BM + wr * 64 + fr, col0 = u.pn * 128 + wc * 32 + 8 * fq;
#pragma unroll
        for (int ai = 0; ai < 2; ++ai)
#pragma unroll
            for (int m = 0; m < 4; ++m) { bf16_t* rowp = U + (size_t)(row0 + ai * HALF + m * 16) * ldc + col0; float o[8];
#pragma unroll
                for (int n = 0; n < 2; ++n)
#pragma unroll
                    for (int j = 0; j < 4; ++j) { const float a = acc[ai][0][m][n][j], b = acc[ai][1][m][n][j]; o[n * 4 + j] = silu_f(a) * b; }
                u32x4 w; w.x = cvt_pk_bf16(o[0], o[1]); w.y = cvt_pk_bf16(o[2], o[3]); w.z = cvt_pk_bf16(o[4], o[5]); w.w = cvt_pk_bf16(o[6], o[7]);
                *(u32x4*)rowp = w; }
    }
};
}

namespace att {
constexpr int VSLOT = 8192, NSLOT = 3;
constexpr int OFF_K = 0;
constexpr int OFF_V = NSLOT * 12 * 1024;
constexpr int OFF_WS = OFF_V + NSLOT * VSLOT;
constexpr int OFF_OST = OFF_WS + 8 * 512;
constexpr int OFF_BIAS = OFF_OST + 8 * 4096;
constexpr int LDS_END = OFF_BIAS + 640 * 4;
__device__ __forceinline__ int crow(int r, int hi) { return (r & 3) + 8 * (r >> 2) + 4 * hi; }
__device__ __forceinline__ void glds16(const void* gsrc, unsigned lds_dst) { unsigned keep;
    asm volatile("s_mov_b32 %0, m0\n\ts_mov_b32 m0, %2\n\ts_nop 0\n\tglobal_load_lds_dwordx4 %1, off\n\ts_mov_b32 m0, %0" : "=&s"(keep) : "v"(gsrc), "s"(lds_dst) : "memory"); }
__device__ __forceinline__ void glds16s(const void* sbase, unsigned voff, unsigned lds_dst) { unsigned keep;
    asm volatile("s_mov_b32 %0, m0\n\ts_mov_b32 m0, %3\n\ts_nop 0\n\tglobal_load_lds_dwordx4 %1, %2\n\ts_mov_b32 m0, %0" : "=&s"(keep) : "v"(voff), "s"(sbase), "s"(lds_dst) : "memory"); }
__device__ __forceinline__ s16x4 vtr(LAS const char* p) { typedef short v4i16_t __attribute__((ext_vector_type(4)));
    return __builtin_bit_cast(s16x4, __builtin_amdgcn_ds_read_tr16_b64_v4i16((LAS v4i16_t*)p)); }

struct Unit {
    const bf16_t* qn; int ldq;
    const bf16_t* qr; int ldqr;
    const bf16_t* kn; int ldk;
    const bf16_t* kr; int ldkr;
    const bf16_t* v; int ldv;
    bf16_t* o; int ldo;
    int na, rowa, rowc;
    int rg, rlo;
};

template <int NCH, bool NA, bool FAST = false>
__device__ __forceinline__ bool attn_unit(LAS char* lds, const Unit& U, const int wid0) {
    const int lane = fresh_lane(), r32 = lane & 31, hi = lane >> 5, wid = wid0, tid = wid * 64 + lane; (void)tid;
    constexpr int KSLOT = NCH * 1024;
    const unsigned lds0 = (unsigned)(uintptr_t)lds;
    LAS float* wsf = (LAS float*)(lds + OFF_WS) + wid * 128;
    const int NT = U.na + 4;
    bf16x8 qf[NCH / 2];
    { const bf16_t* qp = U.qn + (size_t)(wid * 32 + r32) * U.ldq + hi * 8;
#pragma unroll
      for (int d0 = 0; d0 < 4; ++d0) qf[d0] = *(const bf16x8*)(qp + d0 * 16);
      if constexpr (NCH == 12) { const bf16_t* qp2 = U.qr + (size_t)(wid * 32 + r32) * U.ldqr + hi * 8;
#pragma unroll
          for (int d0 = 0; d0 < 2; ++d0) qf[4 + d0] = *(const bf16x8*)(qp2 + d0 * 16); } }
#pragma unroll
    for (int d0 = 0; d0 < NCH / 2; ++d0) asm volatile("" : "+v"(qf[d0]));
    VM_WAIT();
    auto tile_row = [&](int it) -> int { return it < U.na ? U.rowa + 64 * it : U.rowc + 64 * (it - U.na); };
    auto dma = [&](int it, int slot) {
        const int row = tile_row(it);
        glds16(U.v + (size_t)(row + 16 * (wid & 3) + (lane >> 2)) * U.ldv + (wid >> 2) * 32 + (lane & 3) * 8, (unsigned)__builtin_amdgcn_readfirstlane(lds0 + OFF_V + slot * VSLOT + wid * 1024));
        glds16(U.kn + (size_t)(row + lane) * U.ldk + wid * 8, (unsigned)__builtin_amdgcn_readfirstlane(lds0 + OFF_K + slot * KSLOT + wid * 1024));
        if constexpr (NCH == 12) glds16(U.kr + (size_t)(row + lane) * U.ldkr + (wid & 3) * 8, (unsigned)__builtin_amdgcn_readfirstlane(lds0 + OFF_K + slot * KSLOT + (8 + (wid & 3)) * 1024));
    };
    constexpr int NPER = (NCH == 12) ? 3 : 2;
    dma(0, 0); dma(1, 1);
    float mrun = -INFINITY, lrun = 0.f; f32x16 o[2]; o[0] = f32x16{}; o[1] = f32x16{};
    f32x16 lacc = f32x16{}; const bf16x8 ones = (bf16x8){0x3f80, 0x3f80, 0x3f80, 0x3f80, 0x3f80, 0x3f80, 0x3f80, 0x3f80};
    const int grow = NA ? 4 * U.rg + (wid >> 1) : 0, qc = 32 * (wid & 1) + r32;
    const int r0w = NA ? min(max(grow - 4, 0), 56) : 0, c0w = min(max(qc - 8, 0), 48);
    LAS const float* btab = (LAS const float*)(lds + OFF_BIAS);
    const int vaddr = ((lane >> 4) & 1) * 32 + (lane & 3) * 8 + (4 * hi + ((lane & 15) >> 2)) * 64;
    int slot = 0;
    for (int it = 0; it < NT; ++it) {
        if (it + 1 < NT) { if constexpr (NPER == 3) asm volatile("s_waitcnt vmcnt(3)" ::: "memory"); else asm volatile("s_waitcnt vmcnt(2)" ::: "memory"); }
        else asm volatile("s_waitcnt vmcnt(0)" ::: "memory");
        asm volatile("s_barrier" ::: "memory");
        if (it + 2 < NT) { const int s2 = slot >= 1 ? slot - 1 : 2; dma(it + 2, s2); }
        bool active = true; int dr = 0;
        if constexpr (NA) { if (it < U.na) { const int krow = U.rlo + it; active = (krow >= r0w) && (krow < r0w + 8); dr = krow - grow + 7; } }
        if (active) {
            LAS const char* ks = lds + OFF_K + slot * KSLOT + r32 * 16; LAS const char* vs = lds + OFF_V + slot * VSLOT + vaddr;
            f32x16 p0 = f32x16{}, p1 = f32x16{};
            { bf16x8 kf0[NCH / 2], kf1[NCH / 2];
#pragma unroll
              for (int d0 = 0; d0 < NCH / 2; ++d0) { kf0[d0] = *(const LAS bf16x8*)(ks + (2 * d0 + hi) * 1024); kf1[d0] = *(const LAS bf16x8*)(ks + (2 * d0 + hi) * 1024 + 512); }
              __builtin_amdgcn_sched_barrier(0);
#pragma unroll
              for (int d0 = 0; d0 < NCH / 2; ++d0) { p0 = __builtin_amdgcn_mfma_f32_32x32x16_bf16(kf0[d0], qf[d0], p0, 0, 0, 0); p1 = __builtin_amdgcn_mfma_f32_32x32x16_bf16(kf1[d0], qf[d0], p1, 0, 0, 0); } }
            if constexpr (NA) { if (it < U.na) {
                LAS const float* bt = btab + 64 + dr * 31 + 15 - qc;
#pragma unroll
                for (int r = 0; r < 16; ++r) { const int kc = crow(r, hi);
                    p0[r] = ((unsigned)(kc - c0w) < 16u) ? p0[r] + bt[kc] : -INFINITY;
                    p1[r] = ((unsigned)(kc + 32 - c0w) < 16u) ? p1[r] + bt[kc + 32] : -INFINITY; } } }
            if constexpr (FAST) {
#pragma unroll
                for (int r = 0; r < 16; ++r) { p0[r] = fexp2(p0[r]); p1[r] = fexp2(p1[r]); }
            } else {
            float mx = fmaxf(p0[0], p1[0]);
#pragma unroll
            for (int r = 1; r < 16; ++r) mx = fmaxf(mx, fmaxf(p0[r], p1[r]));
            mx = half_max(mx);
            const float mnew = fmaxf(mrun, mx);
            if (__any(mnew > mrun)) {
                const float alpha = fexp2(mrun - mnew);
                lrun *= alpha; if (hi == 0) wsf[r32] = alpha; LDS_WAIT();
#pragma unroll
                for (int r = 0; r < 16; ++r) { const float a = wsf[crow(r, hi)]; o[0][r] *= a; o[1][r] *= a; }
                mrun = mnew;
            }
            float ls = 0.f;
#pragma unroll
            for (int r = 0; r < 16; ++r) { p0[r] = fexp2(p0[r] - mrun); p1[r] = fexp2(p1[r] - mrun); ls += p0[r] + p1[r]; }
            lrun += ls;
            }
            u32x4 pw[4];
#pragma unroll
            for (int j = 0; j < 4; ++j) { pw[0][j] = pk2(p0[2 * j], p0[2 * j + 1]); pw[1][j] = pk2(p0[8 + 2 * j], p0[9 + 2 * j]); pw[2][j] = pk2(p1[2 * j], p1[2 * j + 1]); pw[3][j] = pk2(p1[8 + 2 * j], p1[9 + 2 * j]); }
#pragma unroll
            for (int k = 0; k < 4; ++k)
#pragma unroll
                for (int db = 0; db < 2; ++db) { const s16x4 lo = vtr(vs + db * 4096 + k * 1024), h4 = vtr(vs + db * 4096 + k * 1024 + 512);
                    const bf16x8 vf = (bf16x8){lo[0], lo[1], lo[2], lo[3], h4[0], h4[1], h4[2], h4[3]};
                    o[db] = __builtin_amdgcn_mfma_f32_32x32x16_bf16(__builtin_bit_cast(bf16x8, pw[k]), vf, o[db], 0, 0, 0);
                    if (FAST && db == 1) lacc = __builtin_amdgcn_mfma_f32_32x32x16_bf16(__builtin_bit_cast(bf16x8, pw[k]), ones, lacc, 0, 0, 0); }
        }
        slot = slot == 2 ? 0 : slot + 1;
    }
    LAS bf16_t* stg = (LAS bf16_t*)(lds + OFF_OST) + wid * 2048;
    if constexpr (FAST) {
        bool bad = false;
#pragma unroll
        for (int r = 0; r < 16; ++r) bad |= !(lacc[r] > 1e-30f && lacc[r] < 1e30f);
        LAS int* gf = (LAS int*)(lds + OFF_OST);
        asm volatile("s_waitcnt lgkmcnt(0)\n\ts_barrier" ::: "memory");
        const int ab = __any(bad) ? 1 : 0; if (lane == 0) gf[wid] = ab;
        asm volatile("s_waitcnt lgkmcnt(0)\n\ts_barrier" ::: "memory");
        int anyb = 0;
#pragma unroll
        for (int w = 0; w < 8; ++w) anyb |= gf[w];
        asm volatile("s_waitcnt lgkmcnt(0)\n\ts_barrier" ::: "memory");
        if (__builtin_amdgcn_readfirstlane(anyb)) return false;
#pragma unroll
        for (int r = 0; r < 16; ++r) { const int orow = crow(r, hi); const float il = frcp(lacc[r]);
#pragma unroll
            for (int db = 0; db < 2; ++db) stg[orow * 64 + db * 32 + r32] = (bf16_t)(pk2(o[db][r] * il, 0.f) & 0xffffu); }
    } else {
        lrun = half_sum(lrun);
        if (hi == 0) wsf[32 + r32] = frcp(lrun); LDS_WAIT();
#pragma unroll
        for (int r = 0; r < 16; ++r) { const int orow = crow(r, hi); const float il = wsf[32 + orow];
#pragma unroll
            for (int db = 0; db < 2; ++db) stg[orow * 64 + db * 32 + r32] = (bf16_t)(pk2(o[db][r] * il, 0.f) & 0xffffu); }
    }
    LDS_WAIT();
    bf16_t* Ow = U.o + (size_t)(wid * 32) * U.ldo;
#pragma unroll
    for (int i = 0; i < 4; ++i) { const int row = i * 8 + (lane >> 3), ch = lane & 7; const u32x4 v = *(const LAS u32x4*)(stg + row * 64 + ch * 8); *(u32x4*)(Ow + (size_t)row * U.ldo + ch * 8) = v; }
    asm volatile("s_waitcnt lgkmcnt(0)\n\ts_barrier" ::: "memory");
    return true;
}

__device__ __forceinline__ float rowmax32(const f32x16& p0, const f32x16& p1) {
    float a = __builtin_fmaxf(__builtin_fmaxf(p0[0], p0[1]), p1[0]), b = __builtin_fmaxf(__builtin_fmaxf(p0[2], p0[3]), p1[1]); a = __builtin_fmaxf(__builtin_fmaxf(a, p1[2]), p1[3]);
#pragma unroll
    for (int r = 4; r < 16; r += 4) { a = __builtin_fmaxf(__builtin_fmaxf(a, p0[r]), p0[r + 1]); b = __builtin_fmaxf(__builtin_fmaxf(b, p0[r + 2]), p0[r + 3]); a = __builtin_fmaxf(__builtin_fmaxf(a, p1[r]), p1[r + 1]); b = __builtin_fmaxf(__builtin_fmaxf(b, p1[r + 2]), p1[r + 3]); }
    const float m = __builtin_fmaxf(a, b); return half_max(m);
}
__device__ __forceinline__ void softmax_step(f32x16& p0, f32x16& p1, float& mref, float& lrun, f32x16 (&o)[2], LAS float* wsf, int r32, int hi, bool first, float thr) {
    const float mx = rowmax32(p0, p1);
    if (first || __any(mx > mref + thr)) {
        const float mnew = first ? mx : __builtin_fmaxf(mx, mref);
        if (!first) { const float alpha = fexp2(mref - mnew); lrun *= alpha; if (hi == 0) wsf[r32] = alpha; LDS_WAIT();
#pragma unroll
            for (int r = 0; r < 16; ++r) { const float a = wsf[crow(r, hi)]; o[0][r] *= a; o[1][r] *= a; } }
        mref = mnew;
    }
    float ls = 0.f;
#pragma unroll
    for (int r = 0; r < 16; ++r) { p0[r] = fexp2(p0[r] - mref); p1[r] = fexp2(p1[r] - mref); ls += p0[r] + p1[r]; }
    lrun += ls;
}
__device__ __forceinline__ bool attn_unit64(LAS char* lds, const Unit& U, const int wid0) {
    constexpr int NCH = 12, KSLOT = NCH * 1024;
    const int lane = fresh_lane(), r32 = lane & 31, hi = lane >> 5, wid = wid0;
    const unsigned lds0 = (unsigned)(uintptr_t)lds;
    LAS float* wsf = (LAS float*)(lds + OFF_WS) + wid * 128;
    const int NT = U.na + 4;
    bf16x8 qf[2][6];
#pragma unroll
    for (int qb = 0; qb < 2; ++qb) { const bf16_t* qp = U.qn + (size_t)(wid * 64 + qb * 32 + r32) * U.ldq + hi * 8; const bf16_t* qp2 = U.qr + (size_t)(wid * 64 + qb * 32 + r32) * U.ldqr + hi * 8;
#pragma unroll
        for (int d0 = 0; d0 < 4; ++d0) qf[qb][d0] = *(const bf16x8*)(qp + d0 * 16);
#pragma unroll
        for (int d0 = 0; d0 < 2; ++d0) qf[qb][4 + d0] = *(const bf16x8*)(qp2 + d0 * 16); }
#pragma unroll
    for (int qb = 0; qb < 2; ++qb)
#pragma unroll
        for (int d0 = 0; d0 < 6; ++d0) asm volatile("" : "+v"(qf[qb][d0]));
    VM_WAIT();
    auto tile_row = [&](int it) -> int { return it < U.na ? U.rowa + 64 * it : U.rowc + 64 * (it - U.na); };
    const unsigned offKn = (unsigned)(lane * U.ldk + wid * 8) * 2u, offKr = (unsigned)(lane * U.ldkr + (wid & 3) * 8) * 2u;
    const unsigned offV = (unsigned)((16 * (wid & 3) + (lane >> 2)) * U.ldv + (wid >> 2) * 32 + (lane & 3) * 8) * 2u;
    auto dma = [&](int it, int slot) {
        const int row = tile_row(it);
        glds16s((const char*)U.v + (size_t)row * U.ldv * 2, offV, (unsigned)__builtin_amdgcn_readfirstlane(lds0 + OFF_V + slot * VSLOT + wid * 1024));
        glds16s((const char*)U.kn + (size_t)row * U.ldk * 2, offKn, (unsigned)__builtin_amdgcn_readfirstlane(lds0 + OFF_K + slot * KSLOT + wid * 1024));
        glds16s((const char*)U.kr + (size_t)row * U.ldkr * 2, offKr, (unsigned)__builtin_amdgcn_readfirstlane(lds0 + OFF_K + slot * KSLOT + (8 + (wid & 3)) * 1024));
    };
    dma(0, 0); dma(1, 1);
    f32x16 lAcc = f32x16{}, lBcc = f32x16{};
    const bf16x8 ones = (bf16x8){0x3f80, 0x3f80, 0x3f80, 0x3f80, 0x3f80, 0x3f80, 0x3f80, 0x3f80}; f32x16 oA[2], oB[2]; oA[0] = f32x16{}; oA[1] = f32x16{}; oB[0] = f32x16{}; oB[1] = f32x16{};
    const int vaddr = ((lane >> 4) & 1) * 32 + (lane & 3) * 8 + (4 * hi + ((lane & 15) >> 2)) * 64;
    int slot = 0;
    for (int it = 0; it < NT; ++it) {
        if (it + 1 < NT) asm volatile("s_waitcnt vmcnt(3)" ::: "memory"); else asm volatile("s_waitcnt vmcnt(0)" ::: "memory");
        asm volatile("s_barrier" ::: "memory");
        if (it + 2 < NT) { const int s2 = slot >= 1 ? slot - 1 : 2; dma(it + 2, s2); }
        LAS const char* ks = lds + OFF_K + slot * KSLOT + r32 * 16; LAS const char* vs = lds + OFF_V + slot * VSLOT + vaddr;
        f32x16 pA0 = f32x16{}, pA1 = f32x16{}, pB0 = f32x16{}, pB1 = f32x16{};
        { bf16x8 a0 = *(const LAS bf16x8*)(ks + hi * 1024), a1 = *(const LAS bf16x8*)(ks + hi * 1024 + 512);
#pragma unroll
          for (int d0 = 0; d0 < 6; ++d0) {
            bf16x8 n0 = a0, n1 = a1;
            if (d0 < 5) { n0 = *(const LAS bf16x8*)(ks + (2 * d0 + 2 + hi) * 1024); n1 = *(const LAS bf16x8*)(ks + (2 * d0 + 2 + hi) * 1024 + 512); }
            __builtin_amdgcn_sched_barrier(0);
            pA0 = __builtin_amdgcn_mfma_f32_32x32x16_bf16(a0, qf[0][d0], pA0, 0, 0, 0); pA1 = __builtin_amdgcn_mfma_f32_32x32x16_bf16(a1, qf[0][d0], pA1, 0, 0, 0);
            pB0 = __builtin_amdgcn_mfma_f32_32x32x16_bf16(a0, qf[1][d0], pB0, 0, 0, 0); pB1 = __builtin_amdgcn_mfma_f32_32x32x16_bf16(a1, qf[1][d0], pB1, 0, 0, 0);
            __builtin_amdgcn_sched_barrier(0);
            a0 = n0; a1 = n1; } }
        __builtin_amdgcn_sched_barrier(0);
        { _Pragma("unroll") for (int r = 0; r < 16; ++r) { pA0[r] = fexp2(pA0[r]); pA1[r] = fexp2(pA1[r]); } }
        u32x4 pwA[4];
#pragma unroll
        for (int j = 0; j < 4; ++j) { pwA[0][j] = pk2(pA0[2 * j], pA0[2 * j + 1]); pwA[1][j] = pk2(pA0[8 + 2 * j], pA0[9 + 2 * j]); pwA[2][j] = pk2(pA1[2 * j], pA1[2 * j + 1]); pwA[3][j] = pk2(pA1[8 + 2 * j], pA1[9 + 2 * j]); }
        __builtin_amdgcn_sched_barrier(0);
        { _Pragma("unroll") for (int r = 0; r < 16; ++r) { pB0[r] = fexp2(pB0[r]); pB1[r] = fexp2(pB1[r]); } }
        u32x4 pwB[4];
#pragma unroll
        for (int j = 0; j < 4; ++j) { pwB[0][j] = pk2(pB0[2 * j], pB0[2 * j + 1]); pwB[1][j] = pk2(pB0[8 + 2 * j], pB0[9 + 2 * j]); pwB[2][j] = pk2(pB1[2 * j], pB1[2 * j + 1]); pwB[3][j] = pk2(pB1[8 + 2 * j], pB1[9 + 2 * j]); }
        __builtin_amdgcn_sched_barrier(0);
#pragma unroll
        for (int k = 0; k < 4; ++k)
#pragma unroll
            for (int db = 0; db < 2; ++db) { const s16x4 lo = vtr(vs + db * 4096 + k * 1024), h4 = vtr(vs + db * 4096 + k * 1024 + 512);
                const bf16x8 vf = (bf16x8){lo[0], lo[1], lo[2], lo[3], h4[0], h4[1], h4[2], h4[3]};
                oA[db] = __builtin_amdgcn_mfma_f32_32x32x16_bf16(__builtin_bit_cast(bf16x8, pwA[k]), vf, oA[db], 0, 0, 0);
                oB[db] = __builtin_amdgcn_mfma_f32_32x32x16_bf16(__builtin_bit_cast(bf16x8, pwB[k]), vf, oB[db], 0, 0, 0);
                if (db == 1) { lAcc = __builtin_amdgcn_mfma_f32_32x32x16_bf16(__builtin_bit_cast(bf16x8, pwA[k]), ones, lAcc, 0, 0, 0); lBcc = __builtin_amdgcn_mfma_f32_32x32x16_bf16(__builtin_bit_cast(bf16x8, pwB[k]), ones, lBcc, 0, 0, 0); } }
        slot = slot == 2 ? 0 : slot + 1;
    }
    {
        bool bad = false;
#pragma unroll
        for (int r = 0; r < 16; ++r) bad |= !(lAcc[r] > 1e-30f && lAcc[r] < 1e30f && lBcc[r] > 1e-30f && lBcc[r] < 1e30f);
        LAS int* gf = (LAS int*)(lds + OFF_OST);
        asm volatile("s_waitcnt lgkmcnt(0)\n\ts_barrier" ::: "memory");
        const int ab = __any(bad) ? 1 : 0; if (lane == 0) gf[wid] = ab;
        asm volatile("s_waitcnt lgkmcnt(0)\n\ts_barrier" ::: "memory");
        int anyb = 0;
#pragma unroll
        for (int w = 0; w < 8; ++w) anyb |= gf[w];
        asm volatile("s_waitcnt lgkmcnt(0)\n\ts_barrier" ::: "memory");
        if (__builtin_amdgcn_readfirstlane(anyb)) return false;
    }
    LAS bf16_t* stg = (LAS bf16_t*)(lds + OFF_OST) + wid * 2048;
#pragma unroll
    for (int qb = 0; qb < 2; ++qb) {
        LDS_WAIT();
#pragma unroll
        for (int r = 0; r < 16; ++r) { const int orow = crow(r, hi); const float il = frcp(qb == 0 ? lAcc[r] : lBcc[r]);
#pragma unroll
            for (int db = 0; db < 2; ++db) stg[orow * 64 + db * 32 + r32] = (bf16_t)(pk2((qb == 0 ? oA[db][r] : oB[db][r]) * il, 0.f) & 0xffffu); }
        LDS_WAIT();
        bf16_t* Ow = U.o + (size_t)(wid * 64 + qb * 32) * U.ldo;
#pragma unroll
        for (int i = 0; i < 4; ++i) { const int row = i * 8 + (lane >> 3), ch = lane & 7; const u32x4 v = *(const LAS u32x4*)(stg + row * 64 + ch * 8); *(u32x4*)(Ow + (size_t)row * U.ldo + ch * 8) = v; }
    }
    asm volatile("s_waitcnt lgkmcnt(0)\n\ts_barrier" ::: "memory");
    return true;
}
}

namespace ml {
constexpr int WAVE_LDS = 19328;
constexpr int OFF_VT = 0, OFF_KT = 8192, OFF_TB = 16384;
constexpr int TB_CS = 0, TB_BT = 128, TB_EM = 256, TB_NI = 384, TB_HD = 512, TB_QW = 544;
__device__ __forceinline__ int crow(int r, int hi) { return (r & 3) + 8 * (r >> 2) + 4 * hi; }
__device__ __forceinline__ int chunk_row(int b, int j) { return j < 4 ? ML + b * NC + j * 64 : b * T + (j - 4) * 64; }
__device__ __forceinline__ float prefix_sum(float v, int lane) {
#pragma unroll
    for (int o = 1; o < 64; o <<= 1) { const float t = __shfl_up(v, o); if (lane >= o) v += t; }
    return v;
}
__device__ __forceinline__ float prefix_max(float v, int lane) {
#pragma unroll
    for (int o = 1; o < 64; o <<= 1) { const float t = __shfl_up(v, o); if (lane >= o) v = fmaxf(v, t); }
    return v;
}
__device__ __forceinline__ float suffix_max(float v, int lane) {
#pragma unroll
    for (int o = 1; o < 64; o <<= 1) { const float t = __shfl_down(v, o); if (lane + o < 64) v = fmaxf(v, t); }
    return v;
}
struct Gates { float li[2], bcum[2], g[2]; };
__device__ __forceinline__ void load_gates(const bf16_t* P, int row, int h, const float* igb, const float* fgb, Gates& G, int lane) {
    const bf16_t* gp = P + (size_t)row * NP + PC_GT;
#pragma unroll
    for (int d = 0; d < 2; ++d) {
        const float gi = bf2f(gp[d * 4 + h]) + igb[d * 4 + h], gf = bf2f(gp[8 + d * 4 + h]) + fgb[d * 4 + h];
        const float lf = fminf(gf, 0.f) - log1pf(expf(-fabsf(gf)));
        const float ps = prefix_sum(lf, lane), tot = __shfl(ps, 63);
        G.li[d] = gi; G.g[d] = tot; G.bcum[d] = d == 0 ? ps : tot - ps + lf;
    }
}
__device__ __forceinline__ bf16x8 trfrag(LAS const char* tile, int blk, int ks, int lane) {
    const int hi = lane >> 5, q = (lane & 15) >> 2; LAS const char* p = tile + blk * 4096 + (16 * ks + 8 * hi + q) * 64 + ((lane >> 4) & 1) * 32 + (lane & 3) * 8;
    const s16x4 lo = att::vtr(p), h4 = att::vtr(p + 256);
    return (bf16x8){lo[0], lo[1], lo[2], lo[3], h4[0], h4[1], h4[2], h4[3]};
}
__device__ __forceinline__ void load_vtile(LAS char* vt, const bf16_t* P, int rowbase, int col, int lane) {
#pragma unroll
    for (int i = 0; i < 8; ++i) { const int t = i * 8 + (lane >> 3), c = lane & 7;
        const u32x4 w = *(const u32x4*)(P + (size_t)(rowbase + t) * NP + col + 8 * c); *(LAS u32x4*)(vt + (c >> 2) * 4096 + t * 64 + (c & 3) * 16) = w; }
}
__device__ __forceinline__ void conv8(const bf16_t* P, int row, int col, int pos, int len, const float* w0, const float* w1, const float* w2, float* y) {
    const bf16_t* p = P + (size_t)row * NP + col; float x0[8], x1[8], x2[8];
    unpack8(*(const u32x4*)p, x1);
    if (pos > 0) unpack8(*(const u32x4*)(p - NP), x0); else { for (int e = 0; e < 8; ++e) x0[e] = 0.f; }
    if (pos < len - 1) unpack8(*(const u32x4*)(p + NP), x2); else { for (int e = 0; e < 8; ++e) x2[e] = 0.f; }
#pragma unroll
    for (int e = 0; e < 8; ++e) y[e] = silu_f(x0[e] * w0[e] + x1[e] * w1[e] + x2[e] * w2[e]);
}

__device__ __forceinline__ void chunk_state_unit(LAS char* wl, int b, int h, int j, const bf16_t* P, const float* convw, const float* igb, const float* fgb,
                                                 float* CLOC, float* NLOC, float* MG, int lane) {
    const int r32 = lane & 31, hi = lane >> 5;
    const int rowbase = chunk_row(b, j), len = j < 4 ? NC : T, pos0 = j < 4 ? j * 64 : (j - 4) * 64;
    LAS float* tb = (LAS float*)(wl + OFF_TB);
    u32x4 vraw[8], kr0[8], kr1[8], kr2[8];
    { const int c = lane & 7; const bf16_t* pv = P + (size_t)(rowbase + (lane >> 3)) * NP + PC_MV + h * 64 + 8 * c; const bf16_t* pk = P + (size_t)(rowbase + (lane >> 3)) * NP + PC_MK + h * 64 + 8 * c;
#pragma unroll
      for (int i = 0; i < 8; ++i) { vraw[i] = *(const u32x4*)(pv + (size_t)(8 * i) * NP); kr1[i] = *(const u32x4*)(pk + (size_t)(8 * i) * NP);
          kr0[i] = *(const u32x4*)(pk + (size_t)(8 * i) * NP - NP); kr2[i] = *(const u32x4*)(pk + (size_t)(8 * i) * NP + NP); } }
    Gates G; load_gates(P, rowbase + lane, h, igb, fgb, G, lane);
    float mloc[2];
#pragma unroll
    for (int d = 0; d < 2; ++d) { const float a = G.g[d] - G.bcum[d] + G.li[d]; mloc[d] = wave_max(a); tb[d * 64 + lane] = fexp(a - mloc[d]); }
    { const int c = lane & 7; float w0[8], w1[8], w2[8]; const float* cw = convw + 256 + h * 64 + 8 * c;
#pragma unroll
      for (int e = 0; e < 8; ++e) { w0[e] = cw[e]; w1[e] = cw[512 + e]; w2[e] = cw[1024 + e]; }
#pragma unroll
      for (int i = 0; i < 8; ++i) { const int t = i * 8 + (lane >> 3); float y[8], x0[8], x1[8], x2[8]; unpack8(kr0[i], x0); unpack8(kr1[i], x1); unpack8(kr2[i], x2);
          const bool hp = pos0 + t > 0, hn = pos0 + t < len - 1;
#pragma unroll
          for (int e = 0; e < 8; ++e) y[e] = 0.125f * silu_f((hp ? x0[e] : 0.f) * w0[e] + x1[e] * w1[e] + (hn ? x2[e] : 0.f) * w2[e]);
          *(LAS u32x4*)(wl + OFF_KT + (c >> 2) * 4096 + t * 64 + (c & 3) * 16) = pack8(y); } }
    LDS_WAIT();
#pragma unroll 1
    for (int d = 0; d < 2; ++d) {
        LDS_WAIT();
        { const int c = lane & 7;
#pragma unroll
          for (int i = 0; i < 8; ++i) { const int t = i * 8 + (lane >> 3); const float w = tb[d * 64 + t]; float y[8]; unpack8(vraw[i], y);
#pragma unroll
              for (int e = 0; e < 8; ++e) y[e] *= w;
              *(LAS u32x4*)(wl + OFF_VT + (c >> 2) * 4096 + t * 64 + (c & 3) * 16) = pack8(y); } }
        LDS_WAIT();
        const size_t sidx = ((size_t)((d * NB + b) * 4 + h) * NCHK + j);
        float* cl = CLOC + sidx * 4096;
#pragma unroll
        for (int db = 0; db < 2; ++db) { bf16x8 af[4];
#pragma unroll
            for (int ks = 0; ks < 4; ++ks) af[ks] = trfrag(wl + OFF_VT, db, ks, lane);
#pragma unroll
            for (int dkb = 0; dkb < 2; ++dkb) { f32x16 acc = f32x16{};
#pragma unroll
                for (int ks = 0; ks < 4; ++ks) acc = __builtin_amdgcn_mfma_f32_32x32x16_bf16(af[ks], trfrag(wl + OFF_KT, dkb, ks, lane), acc, 0, 0, 0);
#pragma unroll
                for (int i = 0; i < 16; ++i) cl[(32 * db + crow(i, hi)) * 64 + 32 * dkb + r32] = acc[i]; } }
        { float sacc = 0.f; LAS const bf16_t* kt = (LAS const bf16_t*)(wl + OFF_KT + (lane >> 5) * 4096 + (lane & 31) * 2);
#pragma unroll 8
          for (int t = 0; t < 64; ++t) sacc += bf2f(kt[t * 32]) * tb[d * 64 + t];
          NLOC[sidx * 64 + lane] = sacc; }
        if (lane == 0) { MG[sidx * 2] = d == 0 ? mloc[0] : mloc[1]; MG[sidx * 2 + 1] = d == 0 ? G.g[0] : G.g[1]; }
    }
    LDS_WAIT();
}

__device__ __forceinline__ int step_chunk(int d, int s) { return d == 0 ? s : (s < 4 ? 3 - s : 71 - s); }
__device__ __forceinline__ void scan_item(LAS char* lds, const int wid0, int item, const float* CLOC, const float* NLOC, const float* MG, bf16_t* CIN, float* NIN, float* MIN_) {
    const int tid = wid0 * 64 + fresh_lane(); const int dbh = item >> 2, qd = item & 3, d = dbh >> 5;
    LAS float* mg = (LAS float*)lds; LAS float* wo = mg + 2 * NCHK; LAS float* wn = wo + NCHK;
    __syncthreads();
    if (tid < 2 * NCHK) mg[tid] = MG[(size_t)dbh * NCHK * 2 + tid];
    __syncthreads();
    if (tid == 0) { float m = -INFINITY;
        for (int s = 0; s < NCHK; ++s) { const int j = step_chunk(d, s); const float mj = mg[2 * j], gj = mg[2 * j + 1];
            if (qd == 0) MIN_[(size_t)dbh * NCHK + j] = m;
            const float mn = fmaxf(gj + m, mj); wo[s] = fexp(gj + m - mn); wn[s] = fexp(mj - mn); m = mn; } }
    __syncthreads();
    const float* cl = CLOC + (size_t)dbh * NCHK * 4096; bf16_t* ci = CIN + (size_t)dbh * NCHK * 4096;
    const int e0 = qd * 1024 + tid, e1 = e0 + 512;
    float s0 = 0.f, s1 = 0.f;
    const int en = qd * 16 + (tid & 15); float sn = 0.f; const float* nl = NLOC + (size_t)dbh * NCHK * 64; float* ni = NIN + (size_t)dbh * NCHK * 64;
#pragma unroll 1
    for (int sb = 0; sb < NCHK; sb += 17) { float c0[17], c1[17], cn[17];
#pragma unroll
        for (int i = 0; i < 17; ++i) { const int j = step_chunk(d, sb + i); c0[i] = cl[(size_t)j * 4096 + e0]; c1[i] = cl[(size_t)j * 4096 + e1]; cn[i] = nl[j * 64 + en]; }
#pragma unroll
        for (int i = 0; i < 17; ++i) { const int s = sb + i, j = step_chunk(d, s);
            ci[(size_t)j * 4096 + e0] = (bf16_t)(pk2(s0, 0.f) & 0xffffu); ci[(size_t)j * 4096 + e1] = (bf16_t)(pk2(s1, 0.f) & 0xffffu);
            if (tid < 16) ni[j * 64 + en] = sn;
            s0 = wo[s] * s0 + wn[s] * c0[i]; s1 = wo[s] * s1 + wn[s] * c1[i]; sn = wo[s] * sn + wn[s] * cn[i]; } }
}

__device__ __forceinline__ void out_unit(LAS char* wl, int b, int h, int j, const bf16_t* P, const float* convw, const float* igb, const float* fgb, const float* normw,
                                         const bf16_t* CIN, const float* NIN, const float* MIN_, bf16_t* MIX, int lane) {
    const int r32_ = lane & 31, hi_ = lane >> 5;
    const int rowbase = chunk_row(b, j), len = j < 4 ? NC : T, pos0 = j < 4 ? j * 64 : (j - 4) * 64;
    LAS float* tb = (LAS float*)(wl + OFF_TB);
    float min_d[2];
    { Gates G; load_gates(P, rowbase + lane, h, igb, fgb, G, lane);
#pragma unroll
      for (int d = 0; d < 2; ++d) { const float cs = G.li[d] - G.bcum[d]; const float pm = d == 0 ? prefix_max(cs, lane) : suffix_max(cs, lane);
          const size_t sidx = ((size_t)((d * NB + b) * 4 + h) * NCHK + j);
          const float mi = MIN_[sidx]; min_d[d] = mi;
          const float mt = G.bcum[d] + fmaxf(mi, pm);
          tb[TB_CS + d * 64 + lane] = cs; tb[TB_BT + d * 64 + lane] = G.bcum[d] - mt; tb[TB_EM + d * 64 + lane] = fexp(-mt); tb[TB_NI + d * 64 + lane] = NIN[sidx * 64 + lane]; } }
#pragma unroll
    for (int k = 0; k < 3; ++k) tb[TB_QW + k * 64 + lane] = convw[k * 512 + h * 64 + lane];
    load_vtile(wl + OFF_VT, P, rowbase, PC_MV + h * 64, lane);
    { const int c = lane & 7; float w0[8], w1[8], w2[8]; const float* cw = convw + 256 + h * 64 + 8 * c;
#pragma unroll
      for (int e = 0; e < 8; ++e) { w0[e] = cw[e]; w1[e] = cw[512 + e]; w2[e] = cw[1024 + e]; }
#pragma unroll 2
      for (int i = 0; i < 8; ++i) { const int t = i * 8 + (lane >> 3); float y[8]; conv8(P, rowbase + t, PC_MK + h * 64 + 8 * c, pos0 + t, len, w0, w1, w2, y);
#pragma unroll
          for (int e = 0; e < 8; ++e) y[e] *= 0.125f;
          *(LAS u32x4*)(wl + OFF_KT + c * 1024 + t * 16) = pack8(y); } }
    LDS_WAIT();
#pragma unroll 1
    for (int tbk = 0; tbk < 2; ++tbk) {
        int r32 = r32_, hi = hi_; asm volatile("" : "+v"(r32), "+v"(hi));
        const int t = 32 * tbk + r32;
        const int vaddr = ((lane >> 4) & 1) * 32 + (lane & 3) * 8 + (4 * hi + ((lane & 15) >> 2)) * 64;
        u32x4 qf[4];
#pragma unroll
        for (int d0 = 0; d0 < 4; ++d0) { const int c = 2 * d0 + hi; float w0[8], w1[8], w2[8], y[8];
#pragma unroll
            for (int e = 0; e < 8; ++e) { w0[e] = tb[TB_QW + 8 * c + e]; w1[e] = tb[TB_QW + 64 + 8 * c + e]; w2[e] = tb[TB_QW + 128 + 8 * c + e]; }
            conv8(P, rowbase + t, PC_MQ + h * 64 + 8 * c, pos0 + t, len, w0, w1, w2, y); qf[d0] = pack8(y); }
        f32x16 hs[2]; hs[0] = f32x16{}; hs[1] = f32x16{};
#pragma unroll 1
        for (int d = 0; d < 2; ++d) {
            const size_t sidx = ((size_t)((d * NB + b) * 4 + h) * NCHK + j);
            const float mi = d == 0 ? min_d[0] : min_d[1];
            const float bt = tb[TB_BT + d * 64 + t], em = tb[TB_EM + d * 64 + t];
            const float wi = (mi == -INFINITY) ? 0.f : fexp(bt + mi);
            f32x16 p[2];
#pragma unroll
            for (int sb = 0; sb < 2; ++sb) { p[sb] = f32x16{};
#pragma unroll
                for (int d0 = 0; d0 < 4; ++d0) { const bf16x8 kfr = *(const LAS bf16x8*)(wl + OFF_KT + (2 * d0 + hi) * 1024 + (32 * sb + r32) * 16);
                    p[sb] = __builtin_amdgcn_mfma_f32_32x32x16_bf16(kfr, __builtin_bit_cast(bf16x8, qf[d0]), p[sb], 0, 0, 0); } }
            float ds = 0.f;
#pragma unroll
            for (int sb = 0; sb < 2; ++sb)
#pragma unroll
                for (int i = 0; i < 16; ++i) { const int s_ = 32 * sb + crow(i, hi); const bool valid = d == 0 ? (s_ <= t) : (s_ >= t);
                    const float w = valid ? fexp(bt + tb[TB_CS + d * 64 + s_]) : 0.f; p[sb][i] *= w; ds += p[sb][i]; }
            ds = half_sum(ds);
            float qn = 0.f; u32x4 qw[4];
#pragma unroll
            for (int d0 = 0; d0 < 4; ++d0) { float y[8]; unpack8(qf[d0], y);
#pragma unroll
                for (int e = 0; e < 8; ++e) { qn += y[e] * tb[TB_NI + d * 64 + 16 * d0 + 8 * hi + e]; y[e] *= wi; }
                qw[d0] = pack8(y); }
            qn = half_sum(qn);
            const float den = ds + wi * qn; const float hd = frcp(fmaxf(fabsf(den), em));
            LDS_WAIT();
            if (hi == 0) tb[TB_HD + r32] = hd;
            LDS_WAIT();
            u32x4 pw[4];
#pragma unroll
            for (int jj = 0; jj < 4; ++jj) { pw[0][jj] = pk2(p[0][2 * jj], p[0][2 * jj + 1]); pw[1][jj] = pk2(p[0][8 + 2 * jj], p[0][9 + 2 * jj]); pw[2][jj] = pk2(p[1][2 * jj], p[1][2 * jj + 1]); pw[3][jj] = pk2(p[1][8 + 2 * jj], p[1][9 + 2 * jj]); }
#pragma unroll
            for (int db = 0; db < 2; ++db) { f32x16 acc = f32x16{};
                const bf16_t* cp = CIN + sidx * 4096 + (size_t)(32 * db + r32) * 64 + 8 * hi; bf16x8 cf[4];
#pragma unroll
                for (int d0 = 0; d0 < 4; ++d0) cf[d0] = *(const bf16x8*)(cp + d0 * 16);
#pragma unroll
                for (int k = 0; k < 4; ++k) { LAS const char* vs = wl + OFF_VT + vaddr + db * 4096 + k * 1024; const s16x4 lo = att::vtr(vs), h4 = att::vtr(vs + 512);
                    const bf16x8 vf = (bf16x8){lo[0], lo[1], lo[2], lo[3], h4[0], h4[1], h4[2], h4[3]};
                    acc = __builtin_amdgcn_mfma_f32_32x32x16_bf16(__builtin_bit_cast(bf16x8, pw[k]), vf, acc, 0, 0, 0); }
#pragma unroll
                for (int d0 = 0; d0 < 4; ++d0) acc = __builtin_amdgcn_mfma_f32_32x32x16_bf16(__builtin_bit_cast(bf16x8, qw[d0]), cf[d0], acc, 0, 0, 0);
#pragma unroll
                for (int i = 0; i < 16; ++i) hs[db][i] += acc[i] * tb[TB_HD + crow(i, hi)]; }
        }
        const float nw0 = normw[h * 64 + r32], nw1 = normw[h * 64 + 32 + r32];
        const unsigned offp = (unsigned)((rowbase + 32 * tbk + 4 * hi) * NP + PC_MO + h * 64 + r32) * 2u, offm = (unsigned)((rowbase + 32 * tbk + 4 * hi) * D + h * 64 + r32) * 2u;
#pragma unroll
        for (int i = 0; i < 16; ++i) { float ss = hs[0][i] * hs[0][i] + hs[1][i] * hs[1][i];
            ss += __shfl_xor(ss, 1); ss += __shfl_xor(ss, 2); ss += __shfl_xor(ss, 4); ss += __shfl_xor(ss, 8); ss += __shfl_xor(ss, 16);
            const float sc = 1.0f / sqrtf(ss * (1.0f / 64.0f) + EPS);
            const unsigned ro = (unsigned)((i & 3) + 8 * (i >> 2));
            const bf16_t* op = (const bf16_t*)((const char*)P + (offp + ro * (unsigned)(NP * 2))); bf16_t* mp = (bf16_t*)((char*)MIX + (offm + ro * (unsigned)(D * 2)));
            mp[0] = (bf16_t)(pk2(hs[0][i] * sc * nw0 * sigmoid_f(bf2f(op[0])), 0.f) & 0xffffu);
            mp[32] = (bf16_t)(pk2(hs[1][i] * sc * nw1 * sigmoid_f(bf2f(op[32])), 0.f) & 0xffffu);
            if ((i & 3) == 3) asm volatile("" ::: "memory"); }
    }
    LDS_WAIT();
}
}

#define XB_TMO      128
#define XB_XCNT(j)  (256  + 64 * (j))
#define XB_XSUB(j)  (1280 + 64 * (j))
#define XB_XGEN(j)  (2304 + 64 * (j))
#define XB_TOP      3328
#define XB_TOPGEN   3392
#define XCD_BAR_WORDS 3456
#define XB_SPIN_CAP (1u << 18)
__device__ __forceinline__ unsigned xb_ld(unsigned* p)              { return __hip_atomic_load(p, __ATOMIC_RELAXED, __HIP_MEMORY_SCOPE_AGENT); }
__device__ __forceinline__ unsigned xb_add(unsigned* p, unsigned v) { return __hip_atomic_fetch_add(p, v, __ATOMIC_RELAXED, __HIP_MEMORY_SCOPE_AGENT); }
__device__ __forceinline__ unsigned xb_xcc_id() { return (unsigned)__builtin_amdgcn_s_getreg((3 << 11) | 20) & 0xFu; }
#define XB_SPIN(cond, bar) do { unsigned _sp = 0; while (cond) { __builtin_amdgcn_s_sleep(1); \
    if ((++_sp & 255u) == 0u) { if (xb_ld(&(bar)[XB_TMO])) break; if (_sp > XB_SPIN_CAP) { atomicAdd(&(bar)[XB_TMO], 1u); break; } } } } while (0)
struct XcdBarrier { unsigned* bar; unsigned x; volatile LAS unsigned* st; };
__device__ __forceinline__ XcdBarrier xcd_barrier_post(unsigned* bar, volatile LAS unsigned* st) {
    XcdBarrier b; b.bar = bar; b.x = xb_xcc_id(); b.st = st;
    if (threadIdx.x == 0) (void)xb_add(&bar[XB_XCNT(b.x)], 1u);
    return b;
}
__device__ __forceinline__ void xcd_barrier_complete(unsigned* bar, unsigned x, unsigned& nloc, unsigned& nx) {
    const unsigned G = gridDim.x * gridDim.y * gridDim.z;
    unsigned sum, cnt, mine, sp = 0u;
    for (;;) {
        sum = 0u; cnt = 0u; mine = 0u;
#pragma unroll
        for (unsigned j = 0; j < 16; ++j) { const unsigned c = xb_ld(&bar[XB_XCNT(j)]); sum += c; cnt += (c > 0u) ? 1u : 0u; mine = (j == x) ? c : mine; }
        if (sum == G) break;
        __builtin_amdgcn_s_sleep(1);
        if ((++sp & 255u) == 0u) { if (xb_ld(&bar[XB_TMO])) break; if (sp > XB_SPIN_CAP) { atomicAdd(&bar[XB_TMO], 1u); break; } }
    }
    nloc = mine > 0u ? mine : 1u; nx = cnt > 0u ? cnt : 1u;
}
__device__ __forceinline__ void xcd_barrier(const XcdBarrier& b) {
    asm volatile("s_waitcnt vmcnt(0)" ::: "memory");
    __syncthreads();
    if (threadIdx.x == 0) {
        unsigned* bar = b.bar;
        __builtin_amdgcn_s_waitcnt(0);
        unsigned nloc = b.st[0], nx = b.st[1];
        if (nloc == 0u) { xcd_barrier_complete(bar, b.x, nloc, nx); b.st[0] = nloc; b.st[1] = nx; }
        const unsigned old = xb_add(&bar[XB_XSUB(b.x)], 1u);
        const unsigned gen = old / nloc;
        if (old + 1u == (gen + 1u) * nloc) {
            __builtin_amdgcn_fence(__ATOMIC_RELEASE, "agent");
            asm volatile("s_waitcnt vmcnt(0)" ::: "memory");
            const unsigned og = xb_add(&bar[XB_TOP], 1u);
            const unsigned tg = og / nx;
            if (og + 1u == (tg + 1u) * nx) xb_add(&bar[XB_TOPGEN], 1u);
            else XB_SPIN(xb_ld(&bar[XB_TOPGEN]) == tg, bar);
            __builtin_amdgcn_fence(__ATOMIC_ACQUIRE, "agent");
            xb_add(&bar[XB_XGEN(b.x)], 1u);
            asm volatile("s_waitcnt vmcnt(0)" ::: "memory");
        } else {
            XB_SPIN(xb_ld(&bar[XB_XGEN(b.x)]) == gen, bar);
            __builtin_amdgcn_fence(__ATOMIC_ACQUIRE, "agent");
            asm volatile("s_waitcnt vmcnt(0)" ::: "memory");
        }
    }
    __syncthreads();
}

struct Args { const float* in[27]; float* out; unsigned char* ws; int ph_lo, ph_hi; };
enum { I_X = 0, I_C, I_CTX, I_CCTX, I_ADAW, I_ADAB, I_N1W, I_N2W, I_WIN, I_WOUT, I_CONVW, I_IGB, I_FGB, I_MLNW, I_RPB, I_QNW, I_KVNW, I_WUQ, I_WUKV, I_F1, I_F3, I_F2, I_RW, I_M1, I_M3, I_M2, I_FNW };

struct TrJob { const float* src; const float* src2; int ldn, K, ngrp, kind; bf16_t* dst; const float* ksc; float cs; };
struct TrItem { const float* sp; const float* kp; bf16_t* dp; int ldn, K; float cs; };
__device__ __forceinline__ void tr_resolve(const TrJob& J, int it, int lane, TrItem& T) {
    const int g = it % J.ngrp, kb = it / J.ngrp, c0 = 16 * g, k0 = 64 * kb; const float* src = J.src; int sc0 = c0; float cs = J.cs;
    if (J.kind == 1) {
        if (c0 < 512) sc0 = 2192 + c0; else if (c0 < 768) sc0 = 2704 + (c0 - 512); else if (c0 < 1792) sc0 = c0 - 768;
        else if (c0 < 2944) { sc0 = 1040 + (c0 - 1792); if (c0 < 2176) cs = 0.125f * LOG2E; }
        else if (c0 < 2976) sc0 = 2960 + (c0 - 2944); else if (c0 < 2992) sc0 = 1024 + (c0 - 2976); else { sc0 = 0; cs = 0.f; }
    } else if (J.kind == 2) {
        if (c0 < 384) sc0 = (c0 >> 6) * 96 + (c0 & 63); else { const int r = c0 - 384; sc0 = (r >> 5) * 96 + 64 + (r & 31); }
    } else if (J.kind == 3) {
        const int pn = c0 >> 8, cc = c0 & 255; if (cc >= 128) src = J.src2; sc0 = 128 * pn + (cc & 127);
    }
    T.sp = src + (size_t)(k0 + (lane >> 4)) * J.ldn + sc0 + (lane & 15); T.kp = J.ksc ? J.ksc + k0 + (lane >> 4) : nullptr; T.ldn = J.ldn; T.K = J.K; T.cs = cs;
    T.dp = J.dst + (size_t)c0 * J.K + k0;
}
__device__ __forceinline__ void tr_load(const TrItem& T, float (&v)[16], float (&kv)[16]) {
#pragma unroll
    for (int i = 0; i < 16; ++i) v[i] = T.sp[(size_t)(4 * i) * T.ldn];
    if (T.kp) {
#pragma unroll
        for (int i = 0; i < 16; ++i) kv[i] = T.kp[4 * i]; }
    else {
#pragma unroll
        for (int i = 0; i < 16; ++i) kv[i] = 1.f; }
}
__device__ __forceinline__ void tr_store(const TrItem& T, const float (&v)[16], const float (&kv)[16], LAS float* scr, int lane) {
#pragma unroll
    for (int i = 0; i < 16; ++i) scr[(4 * i + (lane >> 4)) * 17 + (lane & 15)] = v[i] * T.cs * kv[i];
    LDS_WAIT();
#pragma unroll
    for (int j = 0; j < 2; ++j) { const int id = lane + 64 * j, n = id >> 3, c = id & 7; float y[8];
#pragma unroll
        for (int e = 0; e < 8; ++e) y[e] = scr[(8 * c + e) * 17 + n];
        *(u32x4*)(T.dp + (size_t)n * T.K + 8 * c) = pack8(y); }
    LDS_WAIT();
}
template <class R> __device__ __forceinline__ void tr_run(int first, int stride, int total, const R& resolve, LAS float* scr, int lane) {
    int it = first; if (it >= total) return;
    TrItem Tc; float vc[16], kc[16]; resolve(it, Tc); tr_load(Tc, vc, kc);
    for (;;) {
        const int itn = it + stride; const bool hn = itn < total; TrItem Tn = Tc; float vn[16], kn[16];
        if (hn) { resolve(itn, Tn); tr_load(Tn, vn, kn); }
        else {
#pragma unroll
            for (int i = 0; i < 16; ++i) { vn[i] = 0.f; kn[i] = 0.f; } }
        tr_store(Tc, vc, kc, scr, lane);
        if (!hn) break;
        Tc = Tn;
#pragma unroll
        for (int i = 0; i < 16; ++i) { vc[i] = vn[i]; kc[i] = kn[i]; }
        it = itn;
    }
}
__device__ __forceinline__ int tr_job_count(const TrJob& J) { return J.ngrp * (J.K / 64); }

__device__ __forceinline__ void mod_item(LAS char* lds, const int wid0, int item, const float* c, const float* cctx, const float* adaw, const float* adab, float* modv) {
    const int lane = fresh_lane(), wid = wid0, tid = wid * 64 + lane, l = item / 96, ng = item % 96;
    LAS float* sc = (LAS float*)lds;
    LAS float* part = sc + 9 * 1024;
    __syncthreads();
    for (int i = tid; i < 9 * 1024; i += 512) { const float v = i < 8 * 1024 ? c[i] : cctx[i - 8 * 1024]; sc[i] = silu_f(v); }
    __syncthreads();
    float acc[9];
#pragma unroll
    for (int bi = 0; bi < 9; ++bi) acc[bi] = 0.f;
    const float* w = adaw + (size_t)l * 1024 * 6144 + ng * 64 + lane;
#pragma unroll 1
    for (int k0 = wid * 128; k0 < wid * 128 + 128; k0 += 16) { float wv[16];
#pragma unroll
        for (int i = 0; i < 16; ++i) wv[i] = w[(size_t)(k0 + i) * 6144];
#pragma unroll
        for (int i = 0; i < 16; ++i)
#pragma unroll
            for (int bi = 0; bi < 9; ++bi) acc[bi] += sc[bi * 1024 + k0 + i] * wv[i]; }
#pragma unroll
    for (int bi = 0; bi < 9; ++bi) part[(wid * 9 + bi) * 64 + lane] = acc[bi];
    __syncthreads();
    for (int i = tid; i < 9 * 64; i += 512) { const int bi = i >> 6, n = i & 63; float s = adab[l * 6144 + ng * 64 + n];
#pragma unroll
        for (int w8 = 0; w8 < 8; ++w8) s += part[(w8 * 9 + bi) * 64 + n];
        modv[((size_t)l * 9 + bi) * 6144 + ng * 64 + n] = s; }
}

__device__ __forceinline__ void norm_row(const float* xrow, const float* nw, const float* shift, const float* scale, int lane, f32x4 (&v)[4], const bf16_t* dl = nullptr, float* xw = nullptr, int nparts = 1, size_t pstride = 0) {
    float s = 0.f;
#pragma unroll
    for (int j = 0; j < 4; ++j) { v[j] = *(const f32x4*)(xrow + 4 * lane + 256 * j);
        if (dl) { for (int p = 0; p < nparts; ++p) { const u32x2 dw = *(const u32x2*)(dl + (size_t)p * pstride + 4 * lane + 256 * j); v[j].x += bf2f(dw.x & 0xffffu); v[j].y += __uint_as_float(dw.x & 0xffff0000u); v[j].z += bf2f(dw.y & 0xffffu); v[j].w += __uint_as_float(dw.y & 0xffff0000u); }
            *(f32x4*)(xw + 4 * lane + 256 * j) = v[j]; }
        s += (v[j].x * v[j].x + v[j].y * v[j].y) + (v[j].z * v[j].z + v[j].w * v[j].w); }
    const float rs = 1.0f / sqrtf(wave_sum(s) * (1.0f / D) + EPS);
#pragma unroll
    for (int j = 0; j < 4; ++j) { const int c = 4 * lane + 256 * j; const f32x4 w = *(const f32x4*)(nw + c), sh = *(const f32x4*)(shift + c), sc = *(const f32x4*)(scale + c);
        v[j] = (v[j] * rs * w) * (1.0f + sc) + sh; }
}
__device__ __forceinline__ void store_row_bf16(bf16_t* orow, int lane, const f32x4 (&v)[4]) {
#pragma unroll
    for (int j = 0; j < 4; ++j) { u32x2 w; w.x = pk2(v[j].x, v[j].y); w.y = pk2(v[j].z, v[j].w); *(u32x2*)(orow + 4 * lane + 256 * j) = w; }
}

constexpr int XBP = pg8::XBP;
__device__ __forceinline__ void xb_load(const bf16_t* xrow, int lane, u32x4 (&w)[2]) { w[0] = *(const u32x4*)(xrow + 8 * lane); w[1] = *(const u32x4*)(xrow + 8 * lane + 512); }
__device__ __forceinline__ void norm_fin_b(const u32x4 (&w)[2], const float* nw, const float* shift, const float* scale, int lane, float (&v)[16]) {
    unpack8(w[0], v); unpack8(w[1], v + 8);
    float s = 0.f;
#pragma unroll
    for (int e = 0; e < 16; ++e) s += v[e] * v[e];
    const float rs = 1.0f / sqrtf(wave_sum(s) * (1.0f / D) + EPS);
#pragma unroll
    for (int j = 0; j < 2; ++j)
#pragma unroll
        for (int h = 0; h < 2; ++h) { const int c = 8 * lane + 512 * j + 4 * h; const f32x4 wv = *(const f32x4*)(nw + c), sh = *(const f32x4*)(shift + c), sc = *(const f32x4*)(scale + c);
#pragma unroll
            for (int q = 0; q < 4; ++q) v[8 * j + 4 * h + q] = (v[8 * j + 4 * h + q] * rs * wv[q]) * (1.0f + sc[q]) + sh[q]; }
}
__device__ __forceinline__ void store_row_b(bf16_t* orow, int lane, const float (&v)[16]) { *(u32x4*)(orow + 8 * lane) = pack8(v); *(u32x4*)(orow + 8 * lane + 512) = pack8(v + 8); }


#if !MK_MULTI
#define GRID_BAR() do { XcdBarrier b2_ = bar; asm volatile("" : "+s"(b2_.bar)); xcd_barrier(b2_); } while (0)
#define OPQ(x) (x)
#else
#define GRID_BAR() do {} while (0)
#define OPQ(x) ({ int _v = (x); asm volatile("" : "+s"(_v)); _v; })
#endif
#ifndef MK_SITES
#define MK_SITES 0xffffffffu
#endif
#define EN(s) (((MK_SITES) >> (s)) & 1u)
#define IN(k) (OPQ(lo) <= (k) && (k) < OPQ(hi_ph))
#define SEAM(k) do { if (IN(k) && IN((k) + 1)) GRID_BAR(); } while (0)
#define PHASE_WS() GAS unsigned char* ws = (GAS unsigned char*)args.ws; asm volatile("" : "+s"(ws))
#define PHASE_IDS() PHASE_WS(); const int lane = fresh_lane(), wid = wid0, tid = wid * 64 + lane, gw = blockIdx.x * 8 + wid; (void)lane; (void)gw; (void)tid

#define x_in (args.in[I_X])
#define ctx_in (args.in[I_CTX])
#define xout (args.out)
#define XB ((bf16_t*)args.out + 1024)
#define modv ((float*)(ws + SM_MOD))
#define ropet ((float*)(ws + SM_ROPE))
#define stats ((float*)(ws + SM_STATS))
#define NLOC ((float*)(ws + SM_NLOC))
#define NIN ((float*)(ws + SM_NIN))
#define MG ((float*)(ws + SM_MG))
#define MINb ((float*)(ws + SM_MIN))
#define xc ((float*)(ws + WS_XC))
#define BH ((bf16_t*)(ws + WS_H))
#define CLOC ((float*)(ws + WS_H))
#define BP ((bf16_t*)(ws + WS_P))
#define QM ((bf16_t*)(ws + WS_QM))
#define KVM ((bf16_t*)(ws + WS_KVM))
#define CIN ((bf16_t*)(ws + WS_CIN))
#define Win ((bf16_t*)(ws + W_IN))
#define Wout ((bf16_t*)(ws + W_OUT))
#define Wuq ((bf16_t*)(ws + W_UQ))
#define Wukv ((bf16_t*)(ws + W_UKV))
#define Wf13 ((bf16_t*)(ws + W_F13))
#define Wf2 ((bf16_t*)(ws + W_F2))
#define tokinfo ((int*)(ws + SM_TOK))
#define tokg ((float*)(ws + SM_TOKG))
#define wgcnt ((int*)(ws + SM_WGCNT))
#define rowtok ((int*)(ws + SM_ROWTOK))
#define rowgate ((float*)(ws + SM_ROWGATE))
#define tileexp ((int*)(ws + SM_TILEEXP))
#define WMOE ((bf16_t*)(ws + WS_WMOE))
#define UB ((bf16_t*)(ws + WS_U))
#define ASORT ((bf16_t*)(ws + WS_ASORT))
#define PBY ((bf16_t*)(ws + WS_PBY))
#define PBF ((bf16_t*)(ws + WS_PBF))
#define PBW ((bf16_t*)(ws + WS_PBW))

template <int L> __device__ __forceinline__ void layer_phases(const Args& args, LAS unsigned char* lds, const int G, const int NGW, const XcdBarrier& bar, const int lo, const int hi_ph, const int wid0) {
    constexpr int l = L; constexpr int pb = 1 + 10 * l;

#define mod_l (modv + (size_t)l * 9 * 6144)
        if (EN(1) && IN(pb + 0)) { PHASE_IDS();
            const float* nw = args.in[I_N1W] + l * D;
            if (l == 0) {
                for (int r = gw; r < M; r += NGW) { const bool lat = r < ML; const int bi = lat ? (r >> 12) : 8;
                    const float* xr = lat ? (x_in + (size_t)r * D) : (ctx_in + (size_t)(r - ML) * D);
                    f32x4 v[4]; norm_row(xr, nw, mod_l + bi * 6144, mod_l + bi * 6144 + 1024, lane, v); store_row_bf16(BH + (size_t)r * D, lane, v); }
            } else {
                for (int r = gw; r < ML; r += 2 * NGW) { const int rB = r + NGW; const bool hb = rB < ML;
                    u32x4 wa[2], wb[2]; xb_load(XB + (size_t)r * XBP, lane, wa); xb_load(XB + (size_t)(hb ? rB : r) * XBP, lane, wb);
                    float v[16]; norm_fin_b(wa, nw, mod_l + (r >> 12) * 6144, mod_l + (r >> 12) * 6144 + 1024, lane, v); store_row_b(BH + (size_t)r * D, lane, v);
                    if (hb) { norm_fin_b(wb, nw, mod_l + (rB >> 12) * 6144, mod_l + (rB >> 12) * 6144 + 1024, lane, v); store_row_b(BH + (size_t)rB * D, lane, v); } }
                for (int r = ML + gw; r < M; r += NGW) { float* xr = xc + (size_t)(r - ML) * D;
                    f32x4 v[4]; norm_row(xr, nw, mod_l + 8 * 6144, mod_l + 8 * 6144 + 1024, lane, v, PBF + (size_t)(r - ML) * D, xr, 8, (size_t)MC * D); store_row_bf16(BH + (size_t)r * D, lane, v); }
            }
        }
        SEAM(pb + 0);
        if (EN(2) && IN(pb + 1)) { PHASE_WS();
            pg8::Gemm g{BH, D, Win + (size_t)l * 3072 * 1024, D}; pg8::StaticOrder S; S.init(M / 256, NP / 256, G, blockIdx.x, D);
            pg8::EpiP E{BP, stats, ropet};
            pg8::gemm_phase<pg8::EpiP, pg8::StaticOrder, true>(lds, g, S, E, wid0);
        }
        SEAM(pb + 1);
        if (EN(3) && IN(pb + 2)) { PHASE_WS();
            if (EN(18)) { pg8::Gemm g{BP + PC_QL, NP, Wuq + (size_t)l * 768 * 512, 512}; pg8::StaticOrder S; S.init(M / 256, 3, G, blockIdx.x, 512);
              pg8::EpiRS<true> E{QM, NQM, NQM, 384, stats, 0, 16, 1.0f / 512.0f, ropet};
              pg8::gemm_phase<pg8::EpiRS<true>, pg8::StaticOrder, true>(lds, g, S, E, wid0); }
            __syncthreads();
            if (EN(19)) { pg8::Gemm g{BP + PC_KVL, NP, Wukv + (size_t)l * 768 * 256, 256}; pg8::StaticOrder S; S.init(M / 256, 3, G, blockIdx.x, 256);
              pg8::EpiRS<false> E{KVM, NKVM, NKVM, NKVM, stats, 16, 8, 1.0f / 256.0f, ropet};
              pg8::gemm_phase<pg8::EpiRS<false>, pg8::StaticOrder, true>(lds, g, S, E, wid0); }
            __syncthreads();
            { PHASE_IDS();
            const float* convw = args.in[I_CONVW] + (size_t)l * 3 * 512; const float* igb = args.in[I_IGB] + l * 8; const float* fgb = args.in[I_FGB] + l * 8;
            for (int k = 0; ; ++k) { const int u = (k & 1) ? k * NGW + (NGW - 1 - gw) : k * NGW + gw;
                if (u >= NB * 4 * NCHK) { if (k * NGW >= NB * 4 * NCHK) break; else continue; }
                const int j = u % NCHK, bh = u / NCHK; int lane_ = lane; asm volatile("" : "+v"(lane_));
                if (EN(17)) ml::chunk_state_unit((LAS char*)lds + wid * ml::WAVE_LDS, bh >> 2, bh & 3, j, BP, convw, igb, fgb, CLOC, NLOC, MG, lane_); } }
        }
        SEAM(pb + 2);
        if (EN(4) && IN(pb + 3)) { PHASE_WS(); for (int item = blockIdx.x; item < 256; item += G) ml::scan_item((LAS char*)lds, wid0, item, CLOC, NLOC, MG, CIN, NIN, MINb); }
        SEAM(pb + 3);
        if (EN(5) && IN(pb + 4)) { GAS unsigned char* ws_ph = (GAS unsigned char*)args.ws;
            const float* convw = args.in[I_CONVW] + (size_t)l * 3 * 512; const float* igb = args.in[I_IGB] + l * 8; const float* fgb = args.in[I_FGB] + l * 8;
            const float* mnw = args.in[I_MLNW] + l * 256;
#ifndef MK_REP_MLA
#define MK_REP_MLA 1
#endif
#ifndef MK_REP_NA
#define MK_REP_NA 1
#endif
#ifndef MK_REP_ML
#define MK_REP_ML 1
#endif
            constexpr int n_mla1 = NB * 6 * 8, n_na1 = NB * 6 * 16, n_ml1 = (l == 0) ? NB * 4 * NCHK / 8 : NB * 4 * 64 / 8;
            constexpr int n_mla = n_mla1 * MK_REP_MLA, n_na = n_na1 * MK_REP_NA, n_ml = n_ml1 * MK_REP_ML, n_ctx = (l == 0) ? NB * 6 * 2 : 0;
            constexpr int n_items = n_mla + n_na + n_ml + n_ctx;
            volatile LAS int* qslot = (volatile LAS int*)(lds + LDS_MISC + 64);
            for (;;) {
                GAS unsigned char* ws = ws_ph; asm volatile("" : "+s"(ws));
                int wid_i = wid0; asm volatile("" : "+s"(wid_i));
                const int lane = fresh_lane(), tid = wid_i * 64 + lane;
                bf16_t* MIX = BH;
                __syncthreads();
                if (tid == 0) *qslot = (int)__hip_atomic_fetch_add((unsigned*)(ws + WS_CTL) + CW_QUEUE + l * 64, 1u, __ATOMIC_RELAXED, __HIP_MEMORY_SCOPE_AGENT);
                __syncthreads();
                const int u = __builtin_amdgcn_readfirstlane(*qslot);
                if (u >= n_items) break;
                att::Unit U;
                if (u < n_mla) { const int u1 = u % n_mla1; const int qb = u1 & 7, bh = u1 >> 3, b = bh / 6, h = bh % 6; const int row0 = b * T + qb * 512;
                    U.qn = QM + (size_t)row0 * NQM + h * 64; U.ldq = NQM; U.qr = QM + (size_t)row0 * NQM + 384 + h * 32; U.ldqr = NQM;
                    U.kn = KVM + h * 128; U.ldk = NKVM; U.kr = BP + PC_KR; U.ldkr = NP; U.v = KVM + h * 128 + 64; U.ldv = NKVM;
                    U.o = MIX + (size_t)row0 * D + 640 + h * 64; U.ldo = D; U.na = 64; U.rowa = b * T; U.rowc = ML + b * NC; U.rg = 0; U.rlo = 0;
                    if (EN(15)) { const bool ok = att::attn_unit64((LAS char*)lds, U, wid_i);
                        if (!ok && tid == 0) { unsigned* rd = (unsigned*)(ws + WS_CTL) + CW_REDO + l * 512; const unsigned ix = __hip_atomic_fetch_add(rd, 1u, __ATOMIC_RELAXED, __HIP_MEMORY_SCOPE_AGENT); rd[1 + ix] = (unsigned)u; } }
                } else if (u < n_mla + n_na) { const int v = (u - n_mla) % n_na1, rg = v & 15, bh = v >> 4, b = bh / 6, h = bh % 6; const int row0 = b * T + rg * 256;
                    const int rlo = min(max(4 * rg - 4, 0), 56), rhi = min(max(4 * rg - 1, 0), 56) + 7;
                    { LAS float* bt = (LAS float*)(lds + att::OFF_BIAS); const float* rp = args.in[I_RPB] + ((size_t)l * 6 + h) * 15 * 31;
                      for (int i = tid; i < 640; i += 512) { const int k = i - 64; bt[i] = (k >= 0 && k < 465) ? rp[k] * LOG2E : 0.f; } }
                    __syncthreads();
                    U.qn = BP + (size_t)row0 * NP + PC_NQ + h * 64; U.ldq = NP; U.qr = nullptr; U.ldqr = 0;
                    U.kn = BP + PC_NK + h * 64; U.ldk = NP; U.kr = nullptr; U.ldkr = 0; U.v = BP + PC_NV + h * 64; U.ldv = NP;
                    U.o = MIX + (size_t)row0 * D + 256 + h * 64; U.ldo = D; U.na = rhi - rlo + 1; U.rowa = b * T + rlo * 64; U.rowc = ML + b * NC; U.rg = rg; U.rlo = rlo;
                    if (EN(15)) { const bool ok = att::attn_unit<8, true, true>((LAS char*)lds, U, wid_i);
                        if (!ok && tid == 0) { unsigned* rd = (unsigned*)(ws + WS_CTL) + CW_REDO2 + l * 1024; const unsigned ix = __hip_atomic_fetch_add(rd, 1u, __ATOMIC_RELAXED, __HIP_MEMORY_SCOPE_AGENT); rd[1 + ix] = (unsigned)(u - n_mla); } }
                } else if (u < n_mla + n_na + n_ml) { const int id = ((u - n_mla - n_na) % n_ml1) * 8 + wid_i; int lane_ = lane; asm volatile("" : "+v"(lane_));
                    const int bh = (l == 0) ? id / NCHK : id >> 6, j = (l == 0) ? id % NCHK : 4 + (id & 63);
                    if (EN(16)) ml::out_unit((LAS char*)lds + wid_i * ml::WAVE_LDS, bh >> 2, bh & 3, j, BP, convw, igb, fgb, mnw, CIN, NIN, MINb, MIX, lane_);
                } else { const int v = u - n_mla - n_na - n_ml, kind = v & 1, bh = v >> 1, b = bh / 6, h = bh % 6; const int row0 = ML + b * NC;
                    U.na = 0; U.rowa = 0; U.rowc = row0; U.rg = 0; U.rlo = 0; U.ldo = D;
                    if (kind == 0) { U.qn = QM + (size_t)row0 * NQM + h * 64; U.ldq = NQM; U.qr = QM + (size_t)row0 * NQM + 384 + h * 32; U.ldqr = NQM;
                        U.kn = KVM + h * 128; U.ldk = NKVM; U.kr = BP + PC_KR; U.ldkr = NP; U.v = KVM + h * 128 + 64; U.ldv = NKVM; U.o = MIX + (size_t)row0 * D + 640 + h * 64;
                        if (EN(15)) (void)att::attn_unit<12, false>((LAS char*)lds, U, wid_i);
                    } else { U.qn = BP + (size_t)row0 * NP + PC_NQ + h * 64; U.ldq = NP; U.qr = nullptr; U.ldqr = 0;
                        U.kn = BP + PC_NK + h * 64; U.ldk = NP; U.kr = nullptr; U.ldkr = 0; U.v = BP + PC_NV + h * 64; U.ldv = NP; U.o = MIX + (size_t)row0 * D + 256 + h * 64;
                        if (EN(15)) (void)att::attn_unit<8, false>((LAS char*)lds, U, wid_i); }
                }
            }
        }
        SEAM(pb + 4);
        if (EN(6) && IN(pb + 5)) { PHASE_WS();
            {
              unsigned* rd = (unsigned*)(ws + WS_CTL) + CW_REDO + l * 512; const int nredo = (int)__hip_atomic_load(rd, __ATOMIC_RELAXED, __HIP_MEMORY_SCOPE_AGENT);
              unsigned* rd2 = (unsigned*)(ws + WS_CTL) + CW_REDO2 + l * 1024; const int nredo2 = (int)__hip_atomic_load(rd2, __ATOMIC_RELAXED, __HIP_MEMORY_SCOPE_AGENT);
              if (nredo2 > 0) {
                  for (int i = blockIdx.x; i < nredo2; i += G) { const int v = (int)rd2[1 + i] % (NB * 6 * 16), rg = v & 15, bh = v >> 4, b = bh / 6, h = bh % 6; const int row0 = b * T + rg * 256;
                      const int rlo = min(max(4 * rg - 4, 0), 56), rhi = min(max(4 * rg - 1, 0), 56) + 7; const int tid_ = wid0 * 64 + fresh_lane();
                      __syncthreads();
                      { LAS float* bt = (LAS float*)(lds + att::OFF_BIAS); const float* rp = args.in[I_RPB] + ((size_t)l * 6 + h) * 15 * 31;
                        for (int q = tid_; q < 640; q += 512) { const int k = q - 64; bt[q] = (k >= 0 && k < 465) ? rp[k] * LOG2E : 0.f; } }
                      __syncthreads();
                      att::Unit U; U.qn = BP + (size_t)row0 * NP + PC_NQ + h * 64; U.ldq = NP; U.qr = nullptr; U.ldqr = 0;
                      U.kn = BP + PC_NK + h * 64; U.ldk = NP; U.kr = nullptr; U.ldkr = 0; U.v = BP + PC_NV + h * 64; U.ldv = NP;
                      U.o = BH + (size_t)row0 * D + 256 + h * 64; U.ldo = D; U.na = rhi - rlo + 1; U.rowa = b * T + rlo * 64; U.rowc = ML + b * NC; U.rg = rg; U.rlo = rlo;
                      (void)att::attn_unit<8, true>((LAS char*)lds, U, wid0); }
              }
              if (nredo > 0) {
                  for (int i = blockIdx.x; i < 2 * nredo; i += G) { const int u1 = (int)rd[1 + (i >> 1)] % (NB * 6 * 8), hf = i & 1; const int qb = u1 & 7, bh = u1 >> 3, b = bh / 6, h = bh % 6; const int row0 = b * T + qb * 512 + hf * 256;
                      att::Unit U; U.qn = QM + (size_t)row0 * NQM + h * 64; U.ldq = NQM; U.qr = QM + (size_t)row0 * NQM + 384 + h * 32; U.ldqr = NQM;
                      U.kn = KVM + h * 128; U.ldk = NKVM; U.kr = BP + PC_KR; U.ldkr = NP; U.v = KVM + h * 128 + 64; U.ldv = NKVM;
                      U.o = BH + (size_t)row0 * D + 640 + h * 64; U.ldo = D; U.na = 64; U.rowa = b * T; U.rowc = ML + b * NC; U.rg = 0; U.rlo = 0;
                      (void)att::attn_unit<12, false>((LAS char*)lds, U, wid0); }
              }
              if (nredo > 0 || nredo2 > 0) GRID_BAR(); }
            pg8::Gemm g{BH, D, Wout + (size_t)l * 1024 * 1024, D}; pg8::TailSplit<pg8::StaticOrder> S; S.init(ML / 256, 4, G, blockIdx.x, D); S.init_ts(ML / 256, l == 0 ? MC / 256 : 0, 4);
            pg8::EpiResB<(l == 0)> E{x_in, XB, mod_l + 2 * 1024, 6144, PBW, (size_t)MC * D, ML};
            pg8::gemm_phase<pg8::EpiResB<(l == 0)>, pg8::TailSplit<pg8::StaticOrder>, true>(lds, g, S, E, wid0);
        }
        SEAM(pb + 5);
        if (l == 0) {
            if (EN(7) && IN(pb + 6)) { PHASE_IDS();
                const float* nw = args.in[I_N2W] + l * D;
                for (int r = gw; r < ML; r += 2 * NGW) { const int rB = r + NGW; const bool hb = rB < ML;
                    u32x4 wa[2], wb[2]; xb_load(XB + (size_t)r * XBP, lane, wa); xb_load(XB + (size_t)(hb ? rB : r) * XBP, lane, wb);
                    float v[16]; norm_fin_b(wa, nw, mod_l + (r >> 12) * 6144 + 3 * 1024, mod_l + (r >> 12) * 6144 + 4 * 1024, lane, v); store_row_b(BH + (size_t)r * D, lane, v);
                    if (hb) { norm_fin_b(wb, nw, mod_l + (rB >> 12) * 6144 + 3 * 1024, mod_l + (rB >> 12) * 6144 + 4 * 1024, lane, v); store_row_b(BH + (size_t)rB * D, lane, v); } }
                for (int r = ML + gw; r < M; r += NGW) { const float* xr = ctx_in + (size_t)(r - ML) * D; float* xw = xc + (size_t)(r - ML) * D;
                    f32x4 v[4]; norm_row(xr, nw, mod_l + 8 * 6144 + 3 * 1024, mod_l + 8 * 6144 + 4 * 1024, lane, v, PBW + (size_t)(r - ML) * D, xw, 4, (size_t)MC * D); store_row_bf16(BH + (size_t)r * D, lane, v); }
            }
            SEAM(pb + 6);
            if (EN(8) && IN(pb + 7)) { PHASE_WS();
                pg8::Gemm g{BH, D, Wf13, D}; pg8::StaticOrder S; S.init(M / 256, 22, G, blockIdx.x, D);
                pg8::EpiSwiglu E{BP, DFF};
                pg8::gemm_phase<pg8::EpiSwiglu, pg8::StaticOrder, true>(lds, g, S, E, wid0);
            }
            SEAM(pb + 7);
            if (EN(9) && IN(pb + 8)) { PHASE_WS();
                pg8::Gemm g{BP, DFF, Wf2, DFF}; pg8::TailSplit<pg8::StaticOrder> S; S.init(ML / 256, 4, G, blockIdx.x, DFF); S.init_ts(ML / 256, MC / 256, 8);
                pg8::EpiResB<false> E{nullptr, XB, mod_l + 5 * 1024, 6144, PBF, (size_t)MC * D, ML};
                pg8::gemm_phase<pg8::EpiResB<false>, pg8::TailSplit<pg8::StaticOrder>, true>(lds, g, S, E, wid0);
            }
            SEAM(pb + 8);
        } else {
            if (EN(10) && IN(pb + 6)) { PHASE_IDS();
                { LAS float* scr = (LAS float*)(lds + wid * 4352);
                  const int per13 = 352 * 16, per2 = 64 * 44, per = per13 + per2;
                  const float* m1 = args.in[I_M1]; const float* m3 = args.in[I_M3]; const float* m2 = args.in[I_M2]; bf16_t* wm = WMOE;
                  auto resolve = [&](int it, TrItem& T) { const int e = it / per, r = it % per; bf16_t* wb = (bf16_t*)((char*)wm + (size_t)e * WMOE_E);
                      if (r < per13) { TrJob J{m1 + (size_t)e * 1024 * 2816, m3 + (size_t)e * 1024 * 2816, 2816, 1024, 352, 3, wb, nullptr, 1.f}; tr_resolve(J, r, lane, T); }
                      else { TrJob J{m2 + (size_t)e * 2816 * 1024, nullptr, 1024, 2816, 64, 0, wb + (size_t)5632 * 1024, nullptr, 1.f}; tr_resolve(J, r - per13, lane, T); } };
                  tr_run(gw, NGW, NEXP * per, resolve, scr, lane); }
                __syncthreads();
                LAS float* rw = (LAS float*)(lds + 40960);
                LAS int* esel = (LAS int*)(lds + 40960 + 32768);
                for (int i = tid; i < 8192; i += 512) rw[i] = args.in[I_RW][i];
                __syncthreads();
                const float* nw = args.in[I_N2W] + l * D;
                for (int blk = blockIdx.x; blk < ML / 128; blk += G) {
                    u32x4 wnx[2]; xb_load(XB + (size_t)(blk * 128 + wid) * XBP, lane, wnx);
                    for (int rr = wid; rr < 128; rr += 8) { const int r = blk * 128 + rr, bi = r >> 12; float v[16];
                        u32x4 wc[2]; wc[0] = wnx[0]; wc[1] = wnx[1];
                        if (rr + 8 < 128) xb_load(XB + (size_t)(r + 8) * XBP, lane, wnx);
                        norm_fin_b(wc, nw, mod_l + bi * 6144 + 3 * 1024, mod_l + bi * 6144 + 4 * 1024, lane, v);
                        float lg[8];
#pragma unroll
                        for (int e = 0; e < 8; ++e) lg[e] = 0.f;
#pragma unroll
                        for (int j = 0; j < 2; ++j)
#pragma unroll
                            for (int q = 0; q < 8; ++q) { const int c = 8 * lane + 512 * j + q; const f32x4 w0 = *(const LAS f32x4*)(rw + c * 8), w1 = *(const LAS f32x4*)(rw + c * 8 + 4); const float hv = v[8 * j + q];
                                lg[0] += hv * w0.x; lg[1] += hv * w0.y; lg[2] += hv * w0.z; lg[3] += hv * w0.w; lg[4] += hv * w1.x; lg[5] += hv * w1.y; lg[6] += hv * w1.z; lg[7] += hv * w1.w; }
#pragma unroll
                        for (int e = 0; e < 8; ++e) lg[e] = wave_sum(lg[e]);
                        int e0 = 0; float v0 = lg[0];
#pragma unroll
                        for (int e = 1; e < 8; ++e) if (lg[e] > v0) { v0 = lg[e]; e0 = e; }
                        int e1 = -1; float v1 = -INFINITY;
#pragma unroll
                        for (int e = 0; e < 8; ++e) if (e != e0 && lg[e] > v1) { v1 = lg[e]; e1 = e; }
                        const float g0 = 1.0f / (1.0f + expf(v1 - v0));
                        if (lane == 0) { esel[rr * 2] = e0; esel[rr * 2 + 1] = e1; tokg[(size_t)r * 2] = g0; tokg[(size_t)r * 2 + 1] = 1.0f - g0; } }
                    __syncthreads();
                    if (tid < 128) { const int e0 = esel[tid * 2], e1 = esel[tid * 2 + 1]; int s0 = 0, s1 = 0;
                        for (int q = 0; q < tid; ++q) { s0 += (esel[q * 2] == e0); s1 += (esel[q * 2 + 1] == e1); }
                        int* ti = tokinfo + (size_t)(blk * 128 + tid) * 4; ti[0] = e0; ti[1] = e1; ti[2] = s0; ti[3] = s1; }
                    if (tid < 16) { const int k = tid >> 3, e = tid & 7; int c = 0; for (int q = 0; q < 128; ++q) c += (esel[q * 2 + k] == e); wgcnt[blk * 16 + tid] = c; }
                    __syncthreads();
                }
            }
            SEAM(pb + 6);
            if (EN(11) && IN(pb + 7)) { PHASE_IDS();
                LAS int* tot = (LAS int*)(lds);
                LAS int* offp = tot + 16; LAS int* pre = tot + 32;
                __syncthreads();
                LAS int* segs = pre + 4096;
                for (int i = tid; i < 4096; i += 512) pre[i] = wgcnt[i];
                __syncthreads();
                { const int c = tid & 15, sg = tid >> 4; int sm = 0;
#pragma unroll
                  for (int q = 0; q < 8; ++q) sm += pre[(sg * 8 + q) * 16 + c];
                  segs[sg * 16 + c] = sm; }
                __syncthreads();
                { const int c = tid & 15, sg = tid >> 4; int run = 0; for (int q = 0; q < sg; ++q) run += segs[q * 16 + c];
#pragma unroll
                  for (int q = 0; q < 8; ++q) { const int v = pre[(sg * 8 + q) * 16 + c]; pre[(sg * 8 + q) * 16 + c] = run; run += v; }
                  if (sg == 31) tot[c] = run; }
                __syncthreads();
                if (tid == 0) { int o = 0; for (int e = 0; e < 8; ++e) { offp[e] = o; o += (tot[e] + tot[8 + e] + 255) & ~255; }
                    if (blockIdx.x == 0) { tileexp[320] = o >> 8; for (int e = 0; e < 8; ++e) { const int t0 = offp[e] >> 8, nt = (tot[e] + tot[8 + e] + 255) >> 8; for (int q = 0; q < nt; ++q) tileexp[t0 + q] = e; } } }
                __syncthreads();
                const float* nw = args.in[I_N2W] + l * D;
                for (int blk = blockIdx.x; blk < ML / 128; blk += G) {
                    u32x4 wnx[2]; xb_load(XB + (size_t)(blk * 128 + wid) * XBP, lane, wnx);
                    for (int rr = wid; rr < 128; rr += 8) { const int r = blk * 128 + rr, bi = r >> 12; float v[16];
                        u32x4 wc[2]; wc[0] = wnx[0]; wc[1] = wnx[1];
                        if (rr + 8 < 128) xb_load(XB + (size_t)(r + 8) * XBP, lane, wnx);
                        norm_fin_b(wc, nw, mod_l + bi * 6144 + 3 * 1024, mod_l + bi * 6144 + 4 * 1024, lane, v);
                        const int* ti = tokinfo + (size_t)r * 4;
#pragma unroll
                        for (int k = 0; k < 2; ++k) { const int e = ti[k], pos = offp[e] + (k == 0 ? 0 : tot[e]) + pre[blk * 16 + k * 8 + e] + ti[2 + k];
                            store_row_b(ASORT + (size_t)pos * D, lane, v);
                            if (lane == 0) tokinfo[(size_t)r * 4 + 2 + k] = pos; } }
                }
            }
            SEAM(pb + 7);
            for (int k = 0; k < 2; ++k) {
                if (EN(12) && IN(pb + 8 + 2 * k)) { PHASE_WS();
                    const int ntl = tileexp[320], t0 = k == 0 ? 0 : 128, t1 = k == 0 ? (ntl < 128 ? ntl : 128) : ntl;
                    pg8::Gemm g{ASORT + (size_t)t0 * 256 * D, D, WMOE, D}; pg8::GroupedOrder S; S.init(t1 > t0 ? t1 - t0 : 0, 22, G, blockIdx.x, D); S.tile_exp = tileexp + t0; S.estride = WMOE_E;
                    pg8::EpiSwiglu E{UB, DFF};
                    pg8::gemm_phase<pg8::EpiSwiglu, pg8::GroupedOrder, true>(lds, g, S, E, wid0);
                }
                SEAM(pb + 8 + 2 * k);
                if (EN(13) && IN(pb + 9 + 2 * k)) { PHASE_WS();
                    const int ntl = tileexp[320], t0 = k == 0 ? 0 : 128, t1 = k == 0 ? (ntl < 128 ? ntl : 128) : ntl;
                    const int nmp = t1 > t0 ? t1 - t0 : 0, nmain = nmp < 128 ? nmp : 128;
                    pg8::Gemm g{UB, DFF, WMOE + (size_t)5632 * 1024, DFF}; pg8::TailSplit<pg8::GroupedOrder> S; S.init(nmain, 4, G, blockIdx.x, DFF); S.tile_exp = tileexp + t0; S.estride = WMOE_E; S.init_ts(nmain, nmp - nmain, 11);
                    pg8::EpiDelta E{ASORT + (size_t)t0 * 256 * D, nullptr, 0, PBY, (size_t)7 * 256 * D, 128 * 256};
                    pg8::gemm_phase<pg8::EpiDelta, pg8::TailSplit<pg8::GroupedOrder>, true>(lds, g, S, E, wid0);
                }
                SEAM(pb + 9 + 2 * k);
            }
        }
    }

constexpr int NPHASE = 24;
__global__ void __launch_bounds__(512, 2) mega_fwd(Args args) {
    extern __shared__ __attribute__((aligned(16))) unsigned char lds_raw[];
    LAS unsigned char* lds = (LAS unsigned char*)lds_raw;
    const int G = gridDim.x, NGW = G * 8;
    const int wid0 = __builtin_amdgcn_readfirstlane(threadIdx.x >> 6);
    if (threadIdx.x < 4) ((volatile LAS unsigned*)(lds + LDS_MISC))[threadIdx.x] = 0u;
    __syncthreads();
#if !MK_MULTI
    XcdBarrier bar = xcd_barrier_post((unsigned*)(args.ws + WS_CTL) + CW_BAR, (volatile LAS unsigned*)(lds + LDS_MISC));
    constexpr int lo = 0, hi_ph = 1000;
#else
    XcdBarrier bar; bar.bar = nullptr; bar.x = 0; bar.st = nullptr;
    const int lo = args.ph_lo, hi_ph = args.ph_hi;
#endif
    if (EN(0) && IN(0)) { PHASE_IDS();
        LAS float* scr = (LAS float*)(lds + wid * 4352);
        TrJob jobs[10];
        for (int l = 0; l < 2; ++l) {
            jobs[l * 4 + 0] = TrJob{args.in[I_WIN] + (size_t)l * 1024 * 2992, nullptr, 2992, 1024, 192, 1, Win + (size_t)l * 3072 * 1024, nullptr, 1.f};
            jobs[l * 4 + 1] = TrJob{args.in[I_WOUT] + (size_t)l * 1024 * 1024, nullptr, 1024, 1024, 64, 0, Wout + (size_t)l * 1024 * 1024, nullptr, 1.f};
            jobs[l * 4 + 2] = TrJob{args.in[I_WUQ] + (size_t)l * 512 * 576, nullptr, 576, 512, 36, 2, Wuq + (size_t)l * 768 * 512, args.in[I_QNW] + l * 512, 0.10206207261596577f * LOG2E};
            jobs[l * 4 + 3] = TrJob{args.in[I_WUKV] + (size_t)l * 256 * 768, nullptr, 768, 256, 48, 0, Wukv + (size_t)l * 768 * 256, args.in[I_KVNW] + l * 256, 1.f};
        }
        jobs[8] = TrJob{args.in[I_F1], args.in[I_F3], 2816, 1024, 352, 3, Wf13, nullptr, 1.f};
        jobs[9] = TrJob{args.in[I_F2], nullptr, 1024, 2816, 64, 0, Wf2, nullptr, 1.f};
        int total = 0;
#pragma unroll
        for (int q = 0; q < 10; ++q) total += tr_job_count(jobs[q]);
        { auto resolve = [&](int it, TrItem& T) { int r = it;
#pragma unroll
              for (int q = 0; q < 10; ++q) { const int n = tr_job_count(jobs[q]); if (r >= 0 && r < n) tr_resolve(jobs[q], r, lane, T); r -= n; } };
          tr_run(gw, NGW, total, resolve, scr, lane); }
        for (int item = blockIdx.x; item < 192; item += G) mod_item((LAS char*)lds + 40960, wid0, item, args.in[I_C], args.in[I_CCTX], args.in[I_ADAW], args.in[I_ADAB], modv);
        if (blockIdx.x == G - 1) { const int pos = tid >> 3, jj = tid & 7; const float inv = powf(10000.0f, -(float)jj / 8.0f); const float a = (float)pos * inv; ropet[pos * 8 + jj] = cosf(a); ropet[512 + pos * 8 + jj] = sinf(a); }
    }
    SEAM(0);

    layer_phases<0>(args, lds, G, NGW, bar, lo, hi_ph, wid0);
    layer_phases<1>(args, lds, G, NGW, bar, lo, hi_ph, wid0);
    if (EN(14) && IN(23)) { PHASE_IDS();
        const float* nw = args.in[I_FNW]; const float* g5 = modv + (size_t)9 * 6144 + 5 * 1024;
        auto yslow = [&](int pos, int c, float* y) {
            if (pos < 65536) unpack8(*(const u32x4*)(ASORT + (size_t)pos * D + c), y);
            else { for (int e = 0; e < 8; ++e) y[e] = 0.f;
                for (int p = 0; p < 11; ++p) { float t[8]; unpack8(*(const u32x4*)(PBY + ((size_t)p * 7 * 256 + (pos - 65536)) * D + c), t);
                    for (int e = 0; e < 8; ++e) y[e] += t[e]; } } };
        auto finish = [&](int r, float (&v)[16]) {
            float sq = 0.f;
#pragma unroll
            for (int e = 0; e < 16; ++e) sq += v[e] * v[e];
            const float rs = 1.0f / sqrtf(wave_sum(sq) * (1.0f / D) + EPS);
            float* xr = xout + (size_t)r * D;
#pragma unroll
            for (int j = 0; j < 2; ++j)
#pragma unroll
                for (int h = 0; h < 2; ++h) { const int c = 8 * lane + 512 * j + 4 * h; const f32x4 w = *(const f32x4*)(nw + c);
                    f32x4 o; o.x = v[8 * j + 4 * h] * rs * w.x; o.y = v[8 * j + 4 * h + 1] * rs * w.y; o.z = v[8 * j + 4 * h + 2] * rs * w.z; o.w = v[8 * j + 4 * h + 3] * rs * w.w;
                    *(f32x4*)(xr + c) = o; } };
        auto combine = [&](int r, const u32x4 (&xw)[2], const float (&ya)[16], const float (&yb)[16], float g0, float g1, float (&v)[16]) {
            const float* gp = g5 + (size_t)(r >> 12) * 6144;
            unpack8(xw[0], v); unpack8(xw[1], v + 8);
#pragma unroll
            for (int j = 0; j < 2; ++j)
#pragma unroll
                for (int h = 0; h < 2; ++h) { const int c = 8 * lane + 512 * j + 4 * h; const f32x4 gg = *(const f32x4*)(gp + c);
#pragma unroll
                    for (int q = 0; q < 4; ++q) { const int e = 8 * j + 4 * h + q; v[e] += gg[q] * (ya[e] * g0 + yb[e] * g1); } } };
        auto row_slow = [&](int r) {
            const int p0 = tokinfo[(size_t)r * 4 + 2], p1 = tokinfo[(size_t)r * 4 + 3]; const float g0 = tokg[(size_t)r * 2], g1 = tokg[(size_t)r * 2 + 1];
            u32x4 xw[2]; xb_load(XB + (size_t)r * XBP, lane, xw);
            float ya[16], yb[16], v[16];
            yslow(p0, 8 * lane, ya); yslow(p0, 8 * lane + 512, ya + 8); yslow(p1, 8 * lane, yb); yslow(p1, 8 * lane + 512, yb + 8);
            combine(r, xw, ya, yb, g0, g1, v); finish(r, v); };
        for (int r = gw; r < ML; r += 2 * NGW) { const int rA = r, rB = r + NGW;
            if (rB >= ML) { row_slow(rA); continue; }
            const int pA0 = tokinfo[(size_t)rA * 4 + 2], pA1 = tokinfo[(size_t)rA * 4 + 3], pB0 = tokinfo[(size_t)rB * 4 + 2], pB1 = tokinfo[(size_t)rB * 4 + 3];
            if (__builtin_amdgcn_readfirstlane((pA0 | pA1 | pB0 | pB1) >= 65536 ? 1 : 0)) { row_slow(rA); row_slow(rB); continue; }
            const float gA0 = tokg[(size_t)rA * 2], gA1 = tokg[(size_t)rA * 2 + 1], gB0 = tokg[(size_t)rB * 2], gB1 = tokg[(size_t)rB * 2 + 1];
            u32x4 xa[2], xb2[2], a0[2], a1[2], b0[2], b1[2];
            xb_load(XB + (size_t)rA * XBP, lane, xa); xb_load(XB + (size_t)rB * XBP, lane, xb2);
            xb_load(ASORT + (size_t)pA0 * D, lane, a0); xb_load(ASORT + (size_t)pA1 * D, lane, a1); xb_load(ASORT + (size_t)pB0 * D, lane, b0); xb_load(ASORT + (size_t)pB1 * D, lane, b1);
            float ya[16], yb[16], v[16];
            unpack8(a0[0], ya); unpack8(a0[1], ya + 8); unpack8(a1[0], yb); unpack8(a1[1], yb + 8);
            combine(rA, xa, ya, yb, gA0, gA1, v); finish(rA, v);
            unpack8(b0[0], ya); unpack8(b0[1], ya + 8); unpack8(b1[0], yb); unpack8(b1[1], yb + 8);
            combine(rB, xb2, ya, yb, gB0, gB1, v); finish(rB, v); }
    }
}

extern "C" void kernel_launch(void* const* d_in, const int* in_sizes, int n_in, void* d_out, int out_size, void* d_ws, size_t ws_size, hipStream_t stream) {
    static int grid = 0;
    if (grid == 0) {
        if (n_in != 27 || out_size != ML * D || ws_size < WS_END) { fprintf(stderr, "kernel_launch: unexpected sizes (n_in %d out %d ws %zu need %zu)\n", n_in, out_size, ws_size, (size_t)WS_END); grid = -1; return; }
        int dev = 0, cus = 0;
        if (hipGetDevice(&dev) != hipSuccess || hipDeviceGetAttribute(&cus, hipDeviceAttributeMultiprocessorCount, dev) != hipSuccess) { grid = -1; return; }
        if (hipFuncSetAttribute((const void*)mega_fwd, hipFuncAttributeMaxDynamicSharedMemorySize, LDS_BYTES) != hipSuccess) { fprintf(stderr, "kernel_launch: hipFuncSetAttribute failed\n"); grid = -1; return; }
        int per_cu = 0;
        if (hipOccupancyMaxActiveBlocksPerMultiprocessor(&per_cu, (const void*)mega_fwd, 512, LDS_BYTES) != hipSuccess || per_cu < 1) fprintf(stderr, "kernel_launch: occupancy query says %d\n", per_cu);
        (void)hipGetLastError();
        grid = cus;
    }
    if (grid < 0) return;
    if (hipMemsetAsync((char*)d_ws + WS_CTL, 0, CTL_ZERO_BYTES, stream) != hipSuccess) return;
    Args a{};
    for (int i = 0; i < 27; ++i) a.in[i] = (const float*)d_in[i];
    a.out = (float*)d_out; a.ws = (unsigned char*)d_ws;
#if MK_MULTI
#ifndef MK_DUP0
#define MK_DUP0 -1
#endif
#ifndef MK_DUP1
#define MK_DUP1 -1
#endif
    for (int ph = 0; ph < NPHASE; ++ph) { a.ph_lo = ph; a.ph_hi = ph + 1; const int reps = (ph == MK_DUP0 || ph == MK_DUP1) ? 2 : 1;
        for (int r = 0; r < reps; ++r) hipLaunchKernelGGL(mega_fwd, dim3(grid), dim3(512), LDS_BYTES, stream, a); }
#else
    a.ph_lo = 0; a.ph_hi = NPHASE;
    hipLaunchKernelGGL(mega_fwd, dim3(grid), dim3(512), LDS_BYTES, stream, a);
#endif
}
```

```cpp
#include <hip/hip_runtime.h>
#include <stdint.h>
#include <stdio.h>

#ifndef MK_MULTI
#define MK_MULTI 0
#endif

#define LAS __attribute__((address_space(3)))
#define GAS __attribute__((address_space(1)))
typedef unsigned short bf16_t;
typedef short bf16x8 __attribute__((ext_vector_type(8)));
typedef short s16x4 __attribute__((ext_vector_type(4)));
typedef float f32x2 __attribute__((ext_vector_type(2)));
typedef float f32x4 __attribute__((ext_vector_type(4)));
typedef float f32x16 __attribute__((ext_vector_type(16)));
typedef unsigned u32x2 __attribute__((ext_vector_type(2)));
typedef unsigned u32x4 __attribute__((ext_vector_type(4)));
typedef __bf16 bf16x2_t __attribute__((ext_vector_type(2)));

constexpr int NB = 8, T = 4096, D = 1024, NC = 256;
constexpr int ML = NB * T, MC = NB * NC, M = ML + MC;
constexpr int NP = 3072;
constexpr int PC_QL = 0, PC_KVL = 512, PC_MQ = 768, PC_MK = 1024, PC_MV = 1280, PC_MO = 1536, PC_NQ = 1792, PC_NK = 2176, PC_NV = 2560, PC_KR = 2944, PC_GT = 2976;
constexpr int NQM = 576, NKVM = 768;
constexpr int DFF = 2816, NEXP = 8;
constexpr int NCHK = 68;
constexpr float LOG2E = 1.4426950408889634f;
constexpr float EPS = 1e-6f;

constexpr size_t MiB = 1u << 20;
constexpr size_t WS_CTL = 0, CTL_ZERO_BYTES = 1 * MiB;
constexpr size_t WS_SMALL = 1 * MiB;
constexpr size_t SM_MOD = WS_SMALL;
constexpr size_t SM_ROPE = SM_MOD + 2 * 9 * 6144 * 4;
constexpr size_t SM_STATS = WS_SMALL + 1 * MiB;
constexpr size_t SM_NLOC = WS_SMALL + 5 * MiB;
constexpr size_t SM_NIN = WS_SMALL + 7 * MiB;
constexpr size_t SM_MG = WS_SMALL + 9 * MiB;
constexpr size_t SM_MIN = SM_MG + 256 * 1024;
constexpr size_t SM_TOK = WS_SMALL + 10 * MiB;
constexpr size_t SM_TOKG = SM_TOK + (size_t)ML * 16;
constexpr size_t SM_WGCNT = WS_SMALL + 11 * MiB;
constexpr size_t SM_ROWTOK = SM_WGCNT + 64 * 1024;
constexpr size_t SM_ROWGATE = SM_ROWTOK + (size_t)2 * M * 4;
constexpr size_t SM_TILEEXP = SM_ROWGATE + (size_t)2 * M * 4;
constexpr size_t WS_WSMALL = 17 * MiB;
constexpr size_t W_IN = WS_WSMALL;
constexpr size_t W_OUT = W_IN + (size_t)2 * 3072 * 1024 * 2;
constexpr size_t W_UQ = W_OUT + (size_t)2 * 1024 * 1024 * 2;
constexpr size_t W_UKV = W_UQ + (size_t)2 * 768 * 512 * 2;
constexpr size_t W_F13 = W_UKV + (size_t)2 * 768 * 256 * 2;
constexpr size_t W_F2 = W_F13 + (size_t)5632 * 1024 * 2;
constexpr size_t WS_XC = 52 * MiB;
constexpr size_t WS_H = 60 * MiB;
constexpr size_t WS_P = 128 * MiB;
constexpr size_t WS_QM = 332 * MiB;
constexpr size_t WS_KVM = 371 * MiB;
constexpr size_t WS_CIN = 422 * MiB;
constexpr size_t WS_END_MIX = 456 * MiB;
constexpr size_t WS_WMOE = 17 * MiB;
constexpr size_t WMOE_E = (size_t)5632 * 1024 * 2 + (size_t)1024 * 2816 * 2;
constexpr size_t WS_U = 149 * MiB;
constexpr size_t WS_ASORT = 336 * MiB;
constexpr size_t WS_PBY = 472 * MiB;
constexpr size_t WS_END = 516 * MiB;
constexpr size_t WS_PBF = WS_QM;
constexpr size_t WS_PBW = WS_KVM;
static_assert(W_F2 + (size_t)1024 * 2816 * 2 <= WS_XC, "weights");
static_assert(WS_H + (size_t)M * 1024 * 2 <= WS_P && WS_P + (size_t)M * NP * 2 <= WS_QM && WS_QM + (size_t)M * NQM * 2 <= WS_KVM && WS_KVM + (size_t)M * NKVM * 2 <= WS_CIN, "map");
static_assert(WS_CIN + (size_t)2 * 8 * 4 * NCHK * 4096 * 2 <= WS_END_MIX, "map2");
static_assert(WS_WMOE + 8 * WMOE_E <= WS_U && WS_U + (size_t)M * DFF * 2 <= WS_ASORT && WS_ASORT + (size_t)2 * M * 1024 * 2 <= WS_PBY && WS_PBY + (size_t)11 * 7 * 256 * 1024 * 2 <= WS_END, "map3");
static_assert((size_t)2 * 8 * 4 * NCHK * 4096 * 4 <= (size_t)M * 1024 * 2, "C_LOC overlays BUF_H");
static_assert(SM_TILEEXP + 4096 <= WS_WSMALL && SM_TOKG + (size_t)ML * 8 <= SM_WGCNT && SM_STATS + (size_t)M * 24 * 4 <= SM_NLOC, "small map");

constexpr int CW_BAR = 4096;
constexpr int CW_QUEUE = 8192;
constexpr int CW_REDO2 = 8192 + 2048;
constexpr int CW_REDO = 8192 + 256;

constexpr int LDS_BYTES = 155648;
constexpr int LDS_MISC = 155648 - 256;

#define LDS_WAIT() asm volatile("s_waitcnt lgkmcnt(0)" ::: "memory")
#define VM_WAIT() asm volatile("s_waitcnt vmcnt(0)" ::: "memory")
__device__ __forceinline__ float bf2f(unsigned v) { return __uint_as_float(v << 16); }
__device__ __forceinline__ unsigned pk2(float lo, float hi) { f32x2 v = {lo, hi}; bf16x2_t b = __builtin_convertvector(v, bf16x2_t); return __builtin_bit_cast(unsigned, b); }
__device__ __forceinline__ void unpack8(const u32x4 w, float* f) {
    f[0] = __uint_as_float(w.x << 16); f[1] = __uint_as_float(w.x & 0xffff0000u); f[2] = __uint_as_float(w.y << 16); f[3] = __uint_as_float(w.y & 0xffff0000u);
    f[4] = __uint_as_float(w.z << 16); f[5] = __uint_as_float(w.z & 0xffff0000u); f[6] = __uint_as_float(w.w << 16); f[7] = __uint_as_float(w.w & 0xffff0000u);
}
__device__ __forceinline__ u32x4 pack8(const float* f) { u32x4 w; w.x = pk2(f[0], f[1]); w.y = pk2(f[2], f[3]); w.z = pk2(f[4], f[5]); w.w = pk2(f[6], f[7]); return w; }
__device__ __forceinline__ float wave_sum(float v) {
#pragma unroll
    for (int o = 1; o < 64; o <<= 1) v += __shfl_xor(v, o);
    return v;
}
__device__ __forceinline__ float wave_max(float v) {
#pragma unroll
    for (int o = 1; o < 64; o <<= 1) v = fmaxf(v, __shfl_xor(v, o));
    return v;
}
__device__ __forceinline__ float fexp2(float x) { return __builtin_amdgcn_exp2f(x); }
__device__ __forceinline__ float fexp(float x) { return __builtin_amdgcn_exp2f(x * LOG2E); }
__device__ __forceinline__ float frcp(float x) { return __builtin_amdgcn_rcpf(x); }
__device__ __forceinline__ float silu_f(float x) { return x * frcp(1.0f + fexp(-x)); }
__device__ __forceinline__ float sigmoid_f(float x) { return frcp(1.0f + fexp(-x)); }
__device__ __forceinline__ int fresh_lane() { int l; asm volatile("v_mbcnt_lo_u32_b32 %0, -1, 0\n\tv_mbcnt_hi_u32_b32 %0, -1, %0" : "=v"(l)); return l; }
__device__ __forceinline__ float xhalf(float v) { return __shfl_xor(v, 32); }
__device__ __forceinline__ float half_max(float v) { auto rr = __builtin_amdgcn_permlane32_swap(__float_as_uint(v), __float_as_uint(v), false, false); return fmaxf(__uint_as_float(rr[0]), __uint_as_float(rr[1])); }
__device__ __forceinline__ float half_sum(float v) { auto rr = __builtin_amdgcn_permlane32_swap(__float_as_uint(v), __float_as_uint(v), false, false); return __uint_as_float(rr[0]) + __uint_as_float(rr[1]); }

namespace pg8 {
constexpr int BM = 256, BK = 64, HALF = 128, HTB = HALF * BK * 2, STAGE_BYTES = 8 * HTB, NXCD = 8, WGM = 8;
__host__ __device__ __forceinline__ int lds_byte(int r, int c) { const int st = (r >> 4) * 2 + (c >> 5), rr = r & 15, cc = c & 31, ob = rr * 64 + cc * 2; return st * 1024 + (ob ^ (((ob >> 9) & 1) << 5)); }
__host__ __device__ __forceinline__ void stage_rc(int b, int& R, int& C) { const int st = b / 1024, sb = b % 1024, swz = sb ^ (((sb >> 9) & 1) << 5); R = (st >> 1) * 16 + swz / 64; C = (st & 1) * 32 + (swz % 64) / 2; }
__host__ __device__ __forceinline__ int perm32(int rho) { const int n = rho >> 4, i = rho & 15; return 8 * (i >> 2) + 4 * n + (i & 3); }

struct Unit { int pm, pn, kb, ke, part; };
struct Gemm { const bf16_t* A; int lda; const bf16_t* Bt; int K; };

struct StaticOrder {
    int nM, nN, nwg, G, c, nt;
    __device__ void init(int nM_, int nN_, int G_, int c_, int K_) { nM = nM_; nN = nN_; nwg = nM * nN; G = G_; c = c_; nt = K_ / BK; }
    __device__ __forceinline__ void tile_of(int L, Unit& u) const {
        int wgid = L; { const int q = nwg / NXCD, r = nwg % NXCD, xcd = wgid % NXCD, off = wgid / NXCD; wgid = (xcd < r ? xcd * (q + 1) : r * (q + 1) + (xcd - r) * q) + off; }
        const int nig = WGM * nN, gid = wgid / nig, fm = gid * WGM, gsz = (nM - fm) < WGM ? (nM - fm) : WGM;
        u.pm = fm + ((wgid % nig) % gsz); u.pn = (wgid % nig) / gsz;
    }
    __device__ bool next(int i, Unit& u) const {
        const long L = (long)i * G + c; if (L >= nwg) return false;
        tile_of((int)L, u); u.kb = 0; u.ke = nt; u.part = -1; return true;
    }
    __device__ __forceinline__ const char* a_base(const Gemm& g, const Unit& u) const { return (const char*)g.A + (size_t)u.pm * 256 * g.lda * 2 + (size_t)u.kb * (BK * 2); }
    __device__ __forceinline__ const char* b_base(const Gemm& g, const Unit& u) const { return (const char*)g.Bt + (size_t)u.pn * 256 * g.K * 2 + (size_t)u.kb * (BK * 2); }
};
struct GroupedOrder : StaticOrder {
    const int* tile_exp; size_t estride;
    __device__ __forceinline__ const char* b_base(const Gemm& g, const Unit& u) const { return (const char*)g.Bt + (size_t)tile_exp[u.pm] * estride + (size_t)u.pn * 256 * g.K * 2 + (size_t)u.kb * (BK * 2); }
};
template <class Base> struct TailSplit : Base {
    int nMain, nTail, S;
    __device__ void init_ts(int nMain_, int nTail_, int S_) { nMain = nMain_; nTail = nTail_ < 0 ? 0 : nTail_; S = S_; this->nM = nMain; this->nwg = nMain * this->nN; }
    __device__ bool next(int i, Unit& u) const {
        const long L = (long)i * this->G + this->c;
        if (L < this->nwg) { this->tile_of((int)L, u); u.kb = 0; u.ke = this->nt; u.part = -1; return true; }
        const long j = L - this->nwg; const int ntu = nTail * this->nN;
        if (j >= (long)ntu * S) return false;
        const int t = (int)(j % ntu), p = (int)(j / ntu), np = this->nt / 2;
        u.pm = nMain + t / this->nN; u.pn = t % this->nN; u.kb = 2 * (p * np / S); u.ke = 2 * ((p + 1) * np / S); u.part = p; return true;
    }
};

__device__ __forceinline__ unsigned cvt_pk_bf16(float lo, float hi) { unsigned r; asm volatile("v_cvt_pk_bf16_f32 %0, %1, %2" : "=v"(r) : "v"(lo), "v"(hi)); return r; }

template <class Epi, class Sched, bool ALIGN_EPI>
__device__ __forceinline__ void gemm_phase(LAS unsigned char* lds, const Gemm g, const Sched& S, const Epi& E, const int wid0) {
    const int lane = fresh_lane(), wid = wid0, tid = wid * 64 + lane,
    wr = wid >> 2, wc = wid & 3, fr = lane & 15, fq = lane >> 4;
    const int K = g.K;
    unsigned voffA[2], voffB[2];
#pragma unroll
    for (int i = 0; i < 2; ++i) { int R, C; stage_rc(tid * 16 + i * 8192, R, C); const int Rb = Epi::PERM ? ((R & ~31) + perm32(R & 31)) : R;
        voffA[i] = (unsigned)(R * g.lda + C) * 2u; voffB[i] = (unsigned)(Rb * K + C) * 2u; }
    const size_t kstep = (size_t)(BK * 2);
    const size_t hsA = (size_t)HALF * g.lda * 2, hsB = (size_t)HALF * K * 2;
    const unsigned ldsw = (unsigned)wid * 1024u;
    const int aoff = lds_byte(wr * 64 + fr, fq * 8), boff = lds_byte(wc * 32 + fr, fq * 8);
#define PG8_SA(b, h) (((b) * 2 + (h)) * HTB)
#define PG8_SB(b, h) ((4 + (b) * 2 + (h)) * HTB)
#define PG8_STAGE(bufoff, gbase, voff) do { _Pragma("unroll") for (int _i = 0; _i < 2; ++_i) \
        __builtin_amdgcn_global_load_lds((const unsigned*)((const char*)(gbase) + (voff)[_i]), (LAS unsigned*)(lds + (bufoff) + ldsw + _i * 8192), 16, 0, 0); } while (0)
#define PG8_LDA(dst, b, h) do { _Pragma("unroll") for (int m = 0; m < 4; ++m) _Pragma("unroll") for (int k = 0; k < 2; ++k) dst[m][k] = *(const LAS bf16x8*)(lds + PG8_SA(b, h) + aoff + m * 2048 + k * 1024); } while (0)
#define PG8_LDB(dst, b, h) do { _Pragma("unroll") for (int n = 0; n < 2; ++n) _Pragma("unroll") for (int k = 0; k < 2; ++k) dst[n][k] = *(const LAS bf16x8*)(lds + PG8_SB(b, h) + boff + n * 2048 + k * 1024); } while (0)
#define PG8_MMA(ai, bj, At, Bt) do { __builtin_amdgcn_s_setprio(1); _Pragma("unroll") for (int m = 0; m < 4; ++m) _Pragma("unroll") for (int n = 0; n < 2; ++n) _Pragma("unroll") for (int k = 0; k < 2; ++k) \
        acc[ai][bj][m][n] = __builtin_amdgcn_mfma_f32_16x16x32_bf16(Bt[n][k], At[m][k], acc[ai][bj][m][n], 0, 0, 0); __builtin_amdgcn_s_setprio(0); } while (0)
#define PG8_WAIT_V(n) asm volatile("s_waitcnt vmcnt(" #n ")" ::: "memory")
#define PG8_WAIT_L(n) asm volatile("s_waitcnt lgkmcnt(" #n ")" ::: "memory")
#define PG8_BAR __builtin_amdgcn_s_barrier()
#define PG8_SCHED __builtin_amdgcn_sched_barrier(0)
    Unit cur, nxt; int ui = 0;
    if (!S.next(0, cur)) return;
    f32x4 acc[2][2][4][2];
#pragma unroll
    for (int a = 0; a < 2; ++a)
#pragma unroll
        for (int b = 0; b < 2; ++b)
#pragma unroll
            for (int m = 0; m < 4; ++m)
#pragma unroll
                for (int n = 0; n < 2; ++n) acc[a][b][m][n] = (f32x4){0.f, 0.f, 0.f, 0.f};
    bf16x8 At[4][2], B0[2][2], B1[2][2];
    const char* cA = S.a_base(g, cur); const char* cB = S.b_base(g, cur);
    PG8_STAGE(PG8_SB(0, 0), cB, voffB); PG8_STAGE(PG8_SB(0, 1), cB + hsB, voffB); PG8_STAGE(PG8_SA(0, 0), cA, voffA); PG8_STAGE(PG8_SA(0, 1), cA + hsA, voffA);
    if (wr == 1) PG8_BAR;
    PG8_WAIT_V(2); PG8_BAR;
    PG8_STAGE(PG8_SB(1, 0), cB + kstep, voffB); PG8_STAGE(PG8_SA(1, 0), cA + kstep, voffA); PG8_STAGE(PG8_SB(1, 1), cB + hsB + kstep, voffB);
    PG8_WAIT_V(6); PG8_BAR;
    for (;;) {
        const bool has_next = S.next(ui + 1, nxt);
        const char* nA = has_next ? S.a_base(g, nxt) : cA; const char* nB = has_next ? S.b_base(g, nxt) : cB;
        const int ntc = cur.ke - cur.kb;
#pragma unroll 1
        for (int t = 0; t < ntc; t += 2) {
            const bool last = (t == ntc - 2);
            const char* a1 = cA + (size_t)(t + 1) * kstep;
            const char* a2 = last ? nA : cA + (size_t)(t + 2) * kstep; const char* b2 = last ? nB : cB + (size_t)(t + 2) * kstep;
            const char* a3 = a2 + kstep; const char* b3 = b2 + kstep;
            PG8_LDB(B0, 0, 0); PG8_LDB(B1, 0, 1); PG8_SCHED; PG8_LDA(At, 0, 0); PG8_STAGE(PG8_SA(1, 1), a1 + hsA, voffA);
            PG8_WAIT_V(8); PG8_WAIT_L(0); PG8_BAR; PG8_MMA(0, 0, At, B0); PG8_MMA(0, 1, At, B1); PG8_BAR; PG8_SCHED;
            PG8_LDA(At, 0, 1); PG8_STAGE(PG8_SB(0, 0), b2, voffB); PG8_STAGE(PG8_SB(0, 1), b2 + hsB, voffB); PG8_STAGE(PG8_SA(0, 0), a2, voffA);
            PG8_WAIT_V(8); PG8_WAIT_L(0); PG8_BAR; PG8_MMA(1, 0, At, B0); PG8_MMA(1, 1, At, B1); PG8_BAR; PG8_SCHED;
            PG8_LDB(B0, 1, 0); PG8_LDB(B1, 1, 1); PG8_SCHED; PG8_LDA(At, 1, 0); PG8_STAGE(PG8_SA(0, 1), a2 + hsA, voffA);
            PG8_WAIT_V(8); PG8_WAIT_L(0); PG8_BAR; PG8_MMA(0, 0, At, B0); PG8_MMA(0, 1, At, B1); PG8_BAR; PG8_SCHED;
            PG8_LDA(At, 1, 1); PG8_STAGE(PG8_SB(1, 0), b3, voffB); PG8_STAGE(PG8_SB(1, 1), b3 + hsB, voffB); PG8_STAGE(PG8_SA(1, 0), a3, voffA);
            PG8_WAIT_V(8); PG8_WAIT_L(0); PG8_BAR; PG8_MMA(1, 0, At, B0); PG8_MMA(1, 1, At, B1); PG8_BAR; PG8_SCHED;
        }
        if constexpr (ALIGN_EPI) { if (wr == 0) PG8_BAR; }
        E(acc, cur, wr, wc, fr, fq);
        if (!has_next) break;
#pragma unroll
        for (int a = 0; a < 2; ++a)
#pragma unroll
            for (int b = 0; b < 2; ++b)
#pragma unroll
                for (int m = 0; m < 4; ++m)
#pragma unroll
                    for (int n = 0; n < 2; ++n) acc[a][b][m][n] = (f32x4){0.f, 0.f, 0.f, 0.f};
        cur = nxt; cA = nA; cB = nB; ++ui;
        if constexpr (ALIGN_EPI) { if (wr == 1) PG8_BAR; }
    }
    PG8_WAIT_V(0);
    if constexpr (!ALIGN_EPI) { if (wr == 0) PG8_BAR; }
    PG8_BAR;
#undef PG8_SA
#undef PG8_SB
#undef PG8_STAGE
#undef PG8_LDA
#undef PG8_LDB
#undef PG8_MMA
#undef PG8_WAIT_V
#undef PG8_WAIT_L
#undef PG8_BAR
#undef PG8_SCHED
}

typedef const f32x4 (&AccRef)[2][2][4][2];

__device__ __forceinline__ void rope8(f32x4& v0, f32x4& v1, int fq, int tpos, const float* tab) {
    const int pos = (fq < 2) ? (tpos >> 6) : (tpos & 63);
    const f32x4 c0 = *(const f32x4*)(tab + pos * 8), c1 = *(const f32x4*)(tab + pos * 8 + 4), s0 = *(const f32x4*)(tab + 512 + pos * 8), s1 = *(const f32x4*)(tab + 512 + pos * 8 + 4);
    f32x4 p0, p1;
#pragma unroll
    for (int j = 0; j < 4; ++j) { p0[j] = __shfl_xor(v0[j], 16); p1[j] = __shfl_xor(v1[j], 16); }
    const float sg = (fq & 1) ? 1.f : -1.f;
    v0 = v0 * c0 + sg * (p0 * s0); v1 = v1 * c1 + sg * (p1 * s1);
}

struct EpiP {
    static constexpr bool PERM = true;
    bf16_t* P; float* stats; const float* rope;
    __device__ __forceinline__ void operator()(AccRef acc, const Unit& u, int wr, int wc, int fr, int fq) const {
        const int row0 = u.pm * BM + wr * 64 + fr, col0 = u.pn * BM + wc * 32 + 8 * fq;
        const bool do_stats = u.pn < 3, do_rope = (u.pn == 11) && (wc == 0) && (u.pm < ML / 256);
#pragma unroll
        for (int ai = 0; ai < 2; ++ai)
#pragma unroll
            for (int m = 0; m < 4; ++m) { const int row = row0 + ai * HALF + m * 16; bf16_t* rowp = P + (size_t)row * NP + col0;
#pragma unroll
                for (int bj = 0; bj < 2; ++bj) { f32x4 v0 = acc[ai][bj][m][0], v1 = acc[ai][bj][m][1];
                    if (do_stats) { float ss = (v0[0] * v0[0] + v0[1] * v0[1]) + (v0[2] * v0[2] + v0[3] * v0[3]) + (v1[0] * v1[0] + v1[1] * v1[1]) + (v1[2] * v1[2] + v1[3] * v1[3]);
                        ss += __shfl_xor(ss, 16); ss += __shfl_xor(ss, 32);
                        if (fq == 0) stats[(size_t)row * 24 + u.pn * 8 + bj * 4 + wc] = ss; }
                    if (bj == 1 && do_rope) rope8(v0, v1, fq, row & (T - 1), rope);
                    u32x4 w; w.x = cvt_pk_bf16(v0[0], v0[1]); w.y = cvt_pk_bf16(v0[2], v0[3]); w.z = cvt_pk_bf16(v1[0], v1[1]); w.w = cvt_pk_bf16(v1[2], v1[3]);
                    *(u32x4*)(rowp + bj * HALF) = w; } }
    }
};
template <bool ROPE> struct EpiRS {
    static constexpr bool PERM = true;
    bf16_t* O; int ldc, ncols, rope_c0; const float* stats; int part0, nparts; float invk; const float* rope;
    __device__ __forceinline__ void operator()(AccRef acc, const Unit& u, int wr, int wc, int fr, int fq) const {
        const int row0 = u.pm * BM + wr * 64 + fr, col0 = u.pn * BM + wc * 32 + 8 * fq;
        const int npl = nparts >> 2;
#pragma unroll
        for (int ai = 0; ai < 2; ++ai)
#pragma unroll
            for (int m = 0; m < 4; ++m) { const int row = row0 + ai * HALF + m * 16; bf16_t* rowp = O + (size_t)row * ldc + col0;
                const float* sp = stats + (size_t)row * 24 + part0 + fq * npl; float ss = sp[0] + sp[1]; if (npl == 4) ss += sp[2] + sp[3];
                ss += __shfl_xor(ss, 16); ss += __shfl_xor(ss, 32);
                const float rs = 1.0f / sqrtf(ss * invk + EPS);
#pragma unroll
                for (int bj = 0; bj < 2; ++bj) { const int c = col0 + bj * HALF; f32x4 v0 = acc[ai][bj][m][0] * rs, v1 = acc[ai][bj][m][1] * rs;
                    if (ROPE) { const int cb = u.pn * BM + bj * HALF + wc * 32;
                        if (cb >= rope_c0 && cb < ncols && u.pm < ML / 256) rope8(v0, v1, fq, row & (T - 1), rope); }
                    if (c < ncols) { u32x4 w; w.x = cvt_pk_bf16(v0[0], v0[1]); w.y = cvt_pk_bf16(v0[2], v0[3]); w.z = cvt_pk_bf16(v1[0], v1[1]); w.w = cvt_pk_bf16(v1[2], v1[3]);
                        *(u32x4*)(rowp + bj * HALF) = w; } } }
    }
};
struct EpiDelta {
    static constexpr bool PERM = true;
    bf16_t* O; const float* gate; int gstride;
    bf16_t* Op; size_t pstride; int prow0;
    __device__ __forceinline__ void operator()(AccRef acc, const Unit& u, int wr, int wc, int fr, int fq) const {
        const int row0 = u.pm * BM + wr * 64 + fr - (u.part >= 0 ? prow0 : 0), col0 = u.pn * BM + wc * 32 + 8 * fq;
        bf16_t* const Ob = u.part >= 0 ? Op + (size_t)u.part * pstride : O;
        f32x4 gv[2][2];
#pragma unroll
        for (int bj = 0; bj < 2; ++bj)
#pragma unroll
            for (int n = 0; n < 2; ++n) gv[bj][n] = gate ? *(const f32x4*)(gate + (size_t)(u.pm < ML / 256 ? (u.pm >> 4) : 8) * gstride + col0 + bj * HALF + 4 * n) : (f32x4){1.f, 1.f, 1.f, 1.f};
#pragma unroll
        for (int ai = 0; ai < 2; ++ai)
#pragma unroll
            for (int m = 0; m < 4; ++m) { bf16_t* rowp = Ob + (size_t)(row0 + ai * HALF + m * 16) * D + col0;
#pragma unroll
                for (int bj = 0; bj < 2; ++bj) { const f32x4 v0 = acc[ai][bj][m][0] * gv[bj][0], v1 = acc[ai][bj][m][1] * gv[bj][1];
                    u32x4 w; w.x = cvt_pk_bf16(v0[0], v0[1]); w.y = cvt_pk_bf16(v0[2], v0[3]); w.z = cvt_pk_bf16(v1[0], v1[1]); w.w = cvt_pk_bf16(v1[2], v1[3]);
                    *(u32x4*)(rowp + bj * HALF) = w; } }
    }
};
struct EpiRes2 {
    static constexpr bool PERM = false;
    const float* xin; float* xout; const float* gate; int gstride; bf16_t* Op; size_t pstride; int prow0;
    __device__ __forceinline__ void operator()(AccRef acc, const Unit& u, int wr, int wc, int fr, int fq) const {
        const int row0 = u.pm * BM + wr * 64 + fr, col0 = u.pn * BM + wc * 32 + 4 * fq;
        const float* gp = gate + (size_t)(u.pm < ML / 256 ? (u.pm >> 4) : 8) * gstride + col0;
        f32x4 gv[2][2];
#pragma unroll
        for (int bj = 0; bj < 2; ++bj)
#pragma unroll
            for (int n = 0; n < 2; ++n) gv[bj][n] = *(const f32x4*)(gp + bj * HALF + n * 16);
        if (u.part < 0) {
#pragma unroll
            for (int ai = 0; ai < 2; ++ai)
#pragma unroll
                for (int m = 0; m < 4; ++m) { const size_t off = (size_t)(row0 + ai * HALF + m * 16) * D + col0;
#pragma unroll
                    for (int bj = 0; bj < 2; ++bj)
#pragma unroll
                        for (int n = 0; n < 2; ++n) { const f32x4 xv = *(const f32x4*)(xin + off + bj * HALF + n * 16); *(f32x4*)(xout + off + bj * HALF + n * 16) = xv + gv[bj][n] * acc[ai][bj][m][n]; } }
        } else { bf16_t* ob = Op + (size_t)u.part * pstride;
#pragma unroll
            for (int ai = 0; ai < 2; ++ai)
#pragma unroll
                for (int m = 0; m < 4; ++m) { const size_t off = (size_t)(row0 - prow0 + ai * HALF + m * 16) * D + col0;
#pragma unroll
                    for (int bj = 0; bj < 2; ++bj)
#pragma unroll
                        for (int n = 0; n < 2; ++n) { const f32x4 y = gv[bj][n] * acc[ai][bj][m][n]; u32x2 w; w.x = cvt_pk_bf16(y[0], y[1]); w.y = cvt_pk_bf16(y[2], y[3]); *(u32x2*)(ob + off + bj * HALF + n * 16) = w; } }
        }
    }
};
constexpr int XBP = 2048;
template <bool XF32> struct EpiResB {
    static constexpr bool PERM = true;
    const float* xin; bf16_t* xb; const float* gate; int gstride; bf16_t* Op; size_t pstride; int prow0;
    __device__ __forceinline__ void operator()(AccRef acc, const Unit& u, int wr, int wc, int fr, int fq) const {
        const int row0 = u.pm * BM + wr * 64 + fr, col0 = u.pn * BM + wc * 32 + 8 * fq;
        const float* gp = gate + (size_t)(u.pm < ML / 256 ? (u.pm >> 4) : 8) * gstride + col0;
        f32x4 gv[2][2];
#pragma unroll
        for (int bj = 0; bj < 2; ++bj)
#pragma unroll
            for (int n = 0; n < 2; ++n) gv[bj][n] = *(const f32x4*)(gp + bj * HALF + 4 * n);
        if (u.part < 0) {
#pragma unroll
            for (int ai = 0; ai < 2; ++ai)
#pragma unroll
                for (int m = 0; m < 4; ++m) { const int row = row0 + ai * HALF + m * 16;
#pragma unroll
                    for (int bj = 0; bj < 2; ++bj) { f32x4 x0, x1; bf16_t* xp = xb + (size_t)row * XBP + col0 + bj * HALF;
                        if constexpr (XF32) { const float* xf = xin + (size_t)row * D + col0 + bj * HALF; x0 = *(const f32x4*)xf; x1 = *(const f32x4*)(xf + 4); }
                        else { const u32x4 w = *(const u32x4*)xp; x0 = (f32x4){__uint_as_float(w.x << 16), __uint_as_float(w.x & 0xffff0000u), __uint_as_float(w.y << 16), __uint_as_float(w.y & 0xffff0000u)};
                            x1 = (f32x4){__uint_as_float(w.z << 16), __uint_as_float(w.z & 0xffff0000u), __uint_as_float(w.w << 16), __uint_as_float(w.w & 0xffff0000u)}; }
                        const f32x4 y0 = x0 + gv[bj][0] * acc[ai][bj][m][0], y1 = x1 + gv[bj][1] * acc[ai][bj][m][1];
                        u32x4 o; o.x = cvt_pk_bf16(y0[0], y0[1]); o.y = cvt_pk_bf16(y0[2], y0[3]); o.z = cvt_pk_bf16(y1[0], y1[1]); o.w = cvt_pk_bf16(y1[2], y1[3]);
                        *(u32x4*)xp = o; } }
        } else { bf16_t* ob = Op + (size_t)u.part * pstride;
#pragma unroll
            for (int ai = 0; ai < 2; ++ai)
#pragma unroll
                for (int m = 0; m < 4; ++m) { bf16_t* rowp = ob + (size_t)(row0 - prow0 + ai * HALF + m * 16) * D + col0;
#pragma unroll
                    for (int bj = 0; bj < 2; ++bj) { const f32x4 y0 = gv[bj][0] * acc[ai][bj][m][0], y1 = gv[bj][1] * acc[ai][bj][m][1];
                        u32x4 o; o.x = cvt_pk_bf16(y0[0], y0[1]); o.y = cvt_pk_bf16(y0[2], y0[3]); o.z = cvt_pk_bf16(y1[0], y1[1]); o.w = cvt_pk_bf16(y1[2], y1[3]);
                        *(u32x4*)(rowp + bj * HALF) = o; } }
        }
    }
};
struct EpiSwiglu {
    static constexpr bool PERM = true;
    bf16_t* U; int ldc;
    __device__ __forceinline__ void operator()(AccRef acc, const Unit& u, int wr, int wc, int fr, int fq) const {
        const int row0 = u.pm * BM + wr * 64 + fr, col0 = u.pn * 128 + wc * 32 + 8 * fq;
#pragma unroll
        for (int ai = 0; ai < 2; ++ai)
#pragma unroll
            for (int m = 0; m < 4; ++m) { bf16_t* rowp = U + (size_t)(row0 + ai * HALF + m * 16) * ldc + col0; float o[8];
#pragma unroll
                for (int n = 0; n < 2; ++n)
#pragma unroll
                    for (int j = 0; j < 4; ++j) { const float a = acc[ai][0][m][n][j], b = acc[ai][1][m][n][j]; o[n * 4 + j] = silu_f(a) * b; }
                u32x4 w; w.x = cvt_pk_bf16(o[0], o[1]); w.y = cvt_pk_bf16(o[2], o[3]); w.z = cvt_pk_bf16(o[4], o[5]); w.w = cvt_pk_bf16(o[6], o[7]);
                *(u32x4*)rowp = w; }
    }
};
}

namespace att {
constexpr int VSLOT = 8192, NSLOT = 3;
constexpr int OFF_K = 0;
constexpr int OFF_V = NSLOT * 12 * 1024;
constexpr int OFF_WS = OFF_V + NSLOT * VSLOT;
constexpr int OFF_OST = OFF_WS + 8 * 512;
constexpr int OFF_BIAS = OFF_OST + 8 * 4096;
constexpr int LDS_END = OFF_BIAS + 640 * 4;
__device__ __forceinline__ int crow(int r, int hi) { return (r & 3) + 8 * (r >> 2) + 4 * hi; }
__device__ __forceinline__ void glds16(const void* gsrc, unsigned lds_dst) { unsigned keep;
    asm volatile("s_mov_b32 %0, m0\n\ts_mov_b32 m0, %2\n\ts_nop 0\n\tglobal_load_lds_dwordx4 %1, off\n\ts_mov_b32 m0, %0" : "=&s"(keep) : "v"(gsrc), "s"(lds_dst) : "memory"); }
__device__ __forceinline__ void glds16s(const void* sbase, unsigned voff, unsigned lds_dst) { unsigned keep;
    asm volatile("s_mov_b32 %0, m0\n\ts_mov_b32 m0, %3\n\ts_nop 0\n\tglobal_load_lds_dwordx4 %1, %2\n\ts_mov_b32 m0, %0" : "=&s"(keep) : "v"(voff), "s"(sbase), "s"(lds_dst) : "memory"); }
__device__ __forceinline__ s16x4 vtr(LAS const char* p) { typedef short v4i16_t __attribute__((ext_vector_type(4)));
    return __builtin_bit_cast(s16x4, __builtin_amdgcn_ds_read_tr16_b64_v4i16((LAS v4i16_t*)p)); }

struct Unit {
    const bf16_t* qn; int ldq;
    const bf16_t* qr; int ldqr;
    const bf16_t* kn; int ldk;
    const bf16_t* kr; int ldkr;
    const bf16_t* v; int ldv;
    bf16_t* o; int ldo;
    int na, rowa, rowc;
    int rg, rlo;
};

template <int NCH, bool NA, bool FAST = false>
__device__ __forceinline__ bool attn_unit(LAS char* lds, const Unit& U, const int wid0) {
    const int lane = fresh_lane(), r32 = lane & 31, hi = lane >> 5, wid = wid0, tid = wid * 64 + lane; (void)tid;
    constexpr int KSLOT = NCH * 1024;
    const unsigned lds0 = (unsigned)(uintptr_t)lds;
    LAS float* wsf = (LAS float*)(lds + OFF_WS) + wid * 128;
    const int NT = U.na + 4;
    bf16x8 qf[NCH / 2];
    { const bf16_t* qp = U.qn + (size_t)(wid * 32 + r32) * U.ldq + hi * 8;
#pragma unroll
      for (int d0 = 0; d0 < 4; ++d0) qf[d0] = *(const bf16x8*)(qp + d0 * 16);
      if constexpr (NCH == 12) { const bf16_t* qp2 = U.qr + (size_t)(wid * 32 + r32) * U.ldqr + hi * 8;
#pragma unroll
          for (int d0 = 0; d0 < 2; ++d0) qf[4 + d0] = *(const bf16x8*)(qp2 + d0 * 16); } }
#pragma unroll
    for (int d0 = 0; d0 < NCH / 2; ++d0) asm volatile("" : "+v"(qf[d0]));
    VM_WAIT();
    auto tile_row = [&](int it) -> int { return it < U.na ? U.rowa + 64 * it : U.rowc + 64 * (it - U.na); };
    auto dma = [&](int it, int slot) {
        const int row = tile_row(it);
        glds16(U.v + (size_t)(row + 16 * (wid & 3) + (lane >> 2)) * U.ldv + (wid >> 2) * 32 + (lane & 3) * 8, (unsigned)__builtin_amdgcn_readfirstlane(lds0 + OFF_V + slot * VSLOT + wid * 1024));
        glds16(U.kn + (size_t)(row + lane) * U.ldk + wid * 8, (unsigned)__builtin_amdgcn_readfirstlane(lds0 + OFF_K + slot * KSLOT + wid * 1024));
        if constexpr (NCH == 12) glds16(U.kr + (size_t)(row + lane) * U.ldkr + (wid & 3) * 8, (unsigned)__builtin_amdgcn_readfirstlane(lds0 + OFF_K + slot * KSLOT + (8 + (wid & 3)) * 1024));
    };
    constexpr int NPER = (NCH == 12) ? 3 : 2;
    dma(0, 0); dma(1, 1);
    float mrun = -INFINITY, lrun = 0.f; f32x16 o[2]; o[0] = f32x16{}; o[1] = f32x16{};
    f32x16 lacc = f32x16{}; const bf16x8 ones = (bf16x8){0x3f80, 0x3f80, 0x3f80, 0x3f80, 0x3f80, 0x3f80, 0x3f80, 0x3f80};
    const int grow = NA ? 4 * U.rg + (wid >> 1) : 0, qc = 32 * (wid & 1) + r32;
    const int r0w = NA ? min(max(grow - 4, 0), 56) : 0, c0w = min(max(qc - 8, 0), 48);
    LAS const float* btab = (LAS const float*)(lds + OFF_BIAS);
    const int vaddr = ((lane >> 4) & 1) * 32 + (lane & 3) * 8 + (4 * hi + ((lane & 15) >> 2)) * 64;
    int slot = 0;
    for (int it = 0; it < NT; ++it) {
        if (it + 1 < NT) { if constexpr (NPER == 3) asm volatile("s_waitcnt vmcnt(3)" ::: "memory"); else asm volatile("s_waitcnt vmcnt(2)" ::: "memory"); }
        else asm volatile("s_waitcnt vmcnt(0)" ::: "memory");
        asm volatile("s_barrier" ::: "memory");
        if (it + 2 < NT) { const int s2 = slot >= 1 ? slot - 1 : 2; dma(it + 2, s2); }
        bool active = true; int dr = 0;
        if constexpr (NA) { if (it < U.na) { const int krow = U.rlo + it; active = (krow >= r0w) && (krow < r0w + 8); dr = krow - grow + 7; } }
        if (active) {
            LAS const char* ks = lds + OFF_K + slot * KSLOT + r32 * 16; LAS const char* vs = lds + OFF_V + slot * VSLOT + vaddr;
            f32x16 p0 = f32x16{}, p1 = f32x16{};
            { bf16x8 kf0[NCH / 2], kf1[NCH / 2];
#pragma unroll
              for (int d0 = 0; d0 < NCH / 2; ++d0) { kf0[d0] = *(const LAS bf16x8*)(ks + (2 * d0 + hi) * 1024); kf1[d0] = *(const LAS bf16x8*)(ks + (2 * d0 + hi) * 1024 + 512); }
              __builtin_amdgcn_sched_barrier(0);
#pragma unroll
              for (int d0 = 0; d0 < NCH / 2; ++d0) { p0 = __builtin_amdgcn_mfma_f32_32x32x16_bf16(kf0[d0], qf[d0], p0, 0, 0, 0); p1 = __builtin_amdgcn_mfma_f32_32x32x16_bf16(kf1[d0], qf[d0], p1, 0, 0, 0); } }
            if constexpr (NA) { if (it < U.na) {
                LAS const float* bt = btab + 64 + dr * 31 + 15 - qc;
#pragma unroll
                for (int r = 0; r < 16; ++r) { const int kc = crow(r, hi);
                    p0[r] = ((unsigned)(kc - c0w) < 16u) ? p0[r] + bt[kc] : -INFINITY;
                    p1[r] = ((unsigned)(kc + 32 - c0w) < 16u) ? p1[r] + bt[kc + 32] : -INFINITY; } } }
            if constexpr (FAST) {
#pragma unroll
                for (int r = 0; r < 16; ++r) { p0[r] = fexp2(p0[r]); p1[r] = fexp2(p1[r]); }
            } else {
            float mx = fmaxf(p0[0], p1[0]);
#pragma unroll
            for (int r = 1; r < 16; ++r) mx = fmaxf(mx, fmaxf(p0[r], p1[r]));
            mx = half_max(mx);
            const float mnew = fmaxf(mrun, mx);
            if (__any(mnew > mrun)) {
                const float alpha = fexp2(mrun - mnew);
                lrun *= alpha; if (hi == 0) wsf[r32] = alpha; LDS_WAIT();
#pragma unroll
                for (int r = 0; r < 16; ++r) { const float a = wsf[crow(r, hi)]; o[0][r] *= a; o[1][r] *= a; }
                mrun = mnew;
            }
            float ls = 0.f;
#pragma unroll
            for (int r = 0; r < 16; ++r) { p0[r] = fexp2(p0[r] - mrun); p1[r] = fexp2(p1[r] - mrun); ls += p0[r] + p1[r]; }
            lrun += ls;
            }
            u32x4 pw[4];
#pragma unroll
            for (int j = 0; j < 4; ++j) { pw[0][j] = pk2(p0[2 * j], p0[2 * j + 1]); pw[1][j] = pk2(p0[8 + 2 * j], p0[9 + 2 * j]); pw[2][j] = pk2(p1[2 * j], p1[2 * j + 1]); pw[3][j] = pk2(p1[8 + 2 * j], p1[9 + 2 * j]); }
#pragma unroll
            for (int k = 0; k < 4; ++k)
#pragma unroll
                for (int db = 0; db < 2; ++db) { const s16x4 lo = vtr(vs + db * 4096 + k * 1024), h4 = vtr(vs + db * 4096 + k * 1024 + 512);
                    const bf16x8 vf = (bf16x8){lo[0], lo[1], lo[2], lo[3], h4[0], h4[1], h4[2], h4[3]};
                    o[db] = __builtin_amdgcn_mfma_f32_32x32x16_bf16(__builtin_bit_cast(bf16x8, pw[k]), vf, o[db], 0, 0, 0);
                    if (FAST && db == 1) lacc = __builtin_amdgcn_mfma_f32_32x32x16_bf16(__builtin_bit_cast(bf16x8, pw[k]), ones, lacc, 0, 0, 0); }
        }
        slot = slot == 2 ? 0 : slot + 1;
    }
    LAS bf16_t* stg = (LAS bf16_t*)(lds + OFF_OST) + wid * 2048;
    if constexpr (FAST) {
        bool bad = false;
#pragma unroll
        for (int r = 0; r < 16; ++r) bad |= !(lacc[r] > 1e-30f && lacc[r] < 1e30f);
        LAS int* gf = (LAS int*)(lds + OFF_OST);
        asm volatile("s_waitcnt lgkmcnt(0)\n\ts_barrier" ::: "memory");
        const int ab = __any(bad) ? 1 : 0; if (lane == 0) gf[wid] = ab;
        asm volatile("s_waitcnt lgkmcnt(0)\n\ts_barrier" ::: "memory");
        int anyb = 0;
#pragma unroll
        for (int w = 0; w < 8; ++w) anyb |= gf[w];
        asm volatile("s_waitcnt lgkmcnt(0)\n\ts_barrier" ::: "memory");
        if (__builtin_amdgcn_readfirstlane(anyb)) return false;
#pragma unroll
        for (int r = 0; r < 16; ++r) { const int orow = crow(r, hi); const float il = frcp(lacc[r]);
#pragma unroll
            for (int db = 0; db < 2; ++db) stg[orow * 64 + db * 32 + r32] = (bf16_t)(pk2(o[db][r] * il, 0.f) & 0xffffu); }
    } else {
        lrun = half_sum(lrun);
        if (hi == 0) wsf[32 + r32] = frcp(lrun); LDS_WAIT();
#pragma unroll
        for (int r = 0; r < 16; ++r) { const int orow = crow(r, hi); const float il = wsf[32 + orow];
#pragma unroll
            for (int db = 0; db < 2; ++db) stg[orow * 64 + db * 32 + r32] = (bf16_t)(pk2(o[db][r] * il, 0.f) & 0xffffu); }
    }
    LDS_WAIT();
    bf16_t* Ow = U.o + (size_t)(wid * 32) * U.ldo;
#pragma unroll
    for (int i = 0; i < 4; ++i) { const int row = i * 8 + (lane >> 3), ch = lane & 7; const u32x4 v = *(const LAS u32x4*)(stg + row * 64 + ch * 8); *(u32x4*)(Ow + (size_t)row * U.ldo + ch * 8) = v; }
    asm volatile("s_waitcnt lgkmcnt(0)\n\ts_barrier" ::: "memory");
    return true;
}

__device__ __forceinline__ float rowmax32(const f32x16& p0, const f32x16& p1) {
    float a = __builtin_fmaxf(__builtin_fmaxf(p0[0], p0[1]), p1[0]), b = __builtin_fmaxf(__builtin_fmaxf(p0[2], p0[3]), p1[1]); a = __builtin_fmaxf(__builtin_fmaxf(a, p1[2]), p1[3]);
#pragma unroll
    for (int r = 4; r < 16; r += 4) { a = __builtin_fmaxf(__builtin_fmaxf(a, p0[r]), p0[r + 1]); b = __builtin_fmaxf(__builtin_fmaxf(b, p0[r + 2]), p0[r + 3]); a = __builtin_fmaxf(__builtin_fmaxf(a, p1[r]), p1[r + 1]); b = __builtin_fmaxf(__builtin_fmaxf(b, p1[r + 2]), p1[r + 3]); }
    const float m = __builtin_fmaxf(a, b); return half_max(m);
}
__device__ __forceinline__ void softmax_step(f32x16& p0, f32x16& p1, float& mref, float& lrun, f32x16 (&o)[2], LAS float* wsf, int r32, int hi, bool first, float thr) {
    const float mx = rowmax32(p0, p1);
    if (first || __any(mx > mref + thr)) {
        const float mnew = first ? mx : __builtin_fmaxf(mx, mref);
        if (!first) { const float alpha = fexp2(mref - mnew); lrun *= alpha; if (hi == 0) wsf[r32] = alpha; LDS_WAIT();
#pragma unroll
            for (int r = 0; r < 16; ++r) { const float a = wsf[crow(r, hi)]; o[0][r] *= a; o[1][r] *= a; } }
        mref = mnew;
    }
    float ls = 0.f;
#pragma unroll
    for (int r = 0; r < 16; ++r) { p0[r] = fexp2(p0[r] - mref); p1[r] = fexp2(p1[r] - mref); ls += p0[r] + p1[r]; }
    lrun += ls;
}
__device__ __forceinline__ bool attn_unit64(LAS char* lds, const Unit& U, const int wid0) {
    constexpr int NCH = 12, KSLOT = NCH * 1024;
    const int lane = fresh_lane(), r32 = lane & 31, hi = lane >> 5, wid = wid0;
    const unsigned lds0 = (unsigned)(uintptr_t)lds;
    LAS float* wsf = (LAS float*)(lds + OFF_WS) + wid * 128;
    const int NT = U.na + 4;
    bf16x8 qf[2][6];
#pragma unroll
    for (int qb = 0; qb < 2; ++qb) { const bf16_t* qp = U.qn + (size_t)(wid * 64 + qb * 32 + r32) * U.ldq + hi * 8; const bf16_t* qp2 = U.qr + (size_t)(wid * 64 + qb * 32 + r32) * U.ldqr + hi * 8;
#pragma unroll
        for (int d0 = 0; d0 < 4; ++d0) qf[qb][d0] = *(const bf16x8*)(qp + d0 * 16);
#pragma unroll
        for (int d0 = 0; d0 < 2; ++d0) qf[qb][4 + d0] = *(const bf16x8*)(qp2 + d0 * 16); }
#pragma unroll
    for (int qb = 0; qb < 2; ++qb)
#pragma unroll
        for (int d0 = 0; d0 < 6; ++d0) asm volatile("" : "+v"(qf[qb][d0]));
    VM_WAIT();
    auto tile_row = [&](int it) -> int { return it < U.na ? U.rowa + 64 * it : U.rowc + 64 * (it - U.na); };
    const unsigned offKn = (unsigned)(lane * U.ldk + wid * 8) * 2u, offKr = (unsigned)(lane * U.ldkr + (wid & 3) * 8) * 2u;
    const unsigned offV = (unsigned)((16 * (wid & 3) + (lane >> 2)) * U.ldv + (wid >> 2) * 32 + (lane & 3) * 8) * 2u;
    auto dma = [&](int it, int slot) {
        const int row = tile_row(it);
        glds16s((const char*)U.v + (size_t)row * U.ldv * 2, offV, (unsigned)__builtin_amdgcn_readfirstlane(lds0 + OFF_V + slot * VSLOT + wid * 1024));
        glds16s((const char*)U.kn + (size_t)row * U.ldk * 2, offKn, (unsigned)__builtin_amdgcn_readfirstlane(lds0 + OFF_K + slot * KSLOT + wid * 1024));
        glds16s((const char*)U.kr + (size_t)row * U.ldkr * 2, offKr, (unsigned)__builtin_amdgcn_readfirstlane(lds0 + OFF_K + slot * KSLOT + (8 + (wid & 3)) * 1024));
    };
    dma(0, 0); dma(1, 1);
    f32x16 lAcc = f32x16{}, lBcc = f32x16{};
    const bf16x8 ones = (bf16x8){0x3f80, 0x3f80, 0x3f80, 0x3f80, 0x3f80, 0x3f80, 0x3f80, 0x3f80}; f32x16 oA[2], oB[2]; oA[0] = f32x16{}; oA[1] = f32x16{}; oB[0] = f32x16{}; oB[1] = f32x16{};
    const int vaddr = ((lane >> 4) & 1) * 32 + (lane & 3) * 8 + (4 * hi + ((lane & 15) >> 2)) * 64;
    int slot = 0;
    for (int it = 0; it < NT; ++it) {
        if (it + 1 < NT) asm volatile("s_waitcnt vmcnt(3)" ::: "memory"); else asm volatile("s_waitcnt vmcnt(0)" ::: "memory");
        asm volatile("s_barrier" ::: "memory");
        if (it + 2 < NT) { const int s2 = slot >= 1 ? slot - 1 : 2; dma(it + 2, s2); }
        LAS const char* ks = lds + OFF_K + slot * KSLOT + r32 * 16; LAS const char* vs = lds + OFF_V + slot * VSLOT + vaddr;
        f32x16 pA0 = f32x16{}, pA1 = f32x16{}, pB0 = f32x16{}, pB1 = f32x16{};
        { bf16x8 a0 = *(const LAS bf16x8*)(ks + hi * 1024), a1 = *(const LAS bf16x8*)(ks + hi * 1024 + 512);
#pragma unroll
          for (int d0 = 0; d0 < 6; ++d0) {
            bf16x8 n0 = a0, n1 = a1;
            if (d0 < 5) { n0 = *(const LAS bf16x8*)(ks + (2 * d0 + 2 + hi) * 1024); n1 = *(const LAS bf16x8*)(ks + (2 * d0 + 2 + hi) * 1024 + 512); }
            __builtin_amdgcn_sched_barrier(0);
            pA0 = __builtin_amdgcn_mfma_f32_32x32x16_bf16(a0, qf[0][d0], pA0, 0, 0, 0); pA1 = __builtin_amdgcn_mfma_f32_32x32x16_bf16(a1, qf[0][d0], pA1, 0, 0, 0);
            pB0 = __builtin_amdgcn_mfma_f32_32x32x16_bf16(a0, qf[1][d0], pB0, 0, 0, 0); pB1 = __builtin_amdgcn_mfma_f32_32x32x16_bf16(a1, qf[1][d0], pB1, 0, 0, 0);
            __builtin_amdgcn_sched_barrier(0);
            a0 = n0; a1 = n1; } }
        __builtin_amdgcn_sched_barrier(0);
        { _Pragma("unroll") for (int r = 0; r < 16; ++r) { pA0[r] = fexp2(pA0[r]); pA1[r] = fexp2(pA1[r]); } }
        u32x4 pwA[4];
#pragma unroll
        for (int j = 0; j < 4; ++j) { pwA[0][j] = pk2(pA0[2 * j], pA0[2 * j + 1]); pwA[1][j] = pk2(pA0[8 + 2 * j], pA0[9 + 2 * j]); pwA[2][j] = pk2(pA1[2 * j], pA1[2 * j + 1]); pwA[3][j] = pk2(pA1[8 + 2 * j], pA1[9 + 2 * j]); }
        __builtin_amdgcn_sched_barrier(0);
        { _Pragma("unroll") for (int r = 0; r < 16; ++r) { pB0[r] = fexp2(pB0[r]); pB1[r] = fexp2(pB1[r]); } }
        u32x4 pwB[4];
#pragma unroll
        for (int j = 0; j < 4; ++j) { pwB[0][j] = pk2(pB0[2 * j], pB0[2 * j + 1]); pwB[1][j] = pk2(pB0[8 + 2 * j], pB0[9 + 2 * j]); pwB[2][j] = pk2(pB1[2 * j], pB1[2 * j + 1]); pwB[3][j] = pk2(pB1[8 + 2 * j], pB1[9 + 2 * j]); }
        __builtin_amdgcn_sched_barrier(0);
#pragma unroll
        for (int k = 0; k < 4; ++k)
#pragma unroll
            for (int db = 0; db < 2; ++db) { const s16x4 lo = vtr(vs + db * 4096 + k * 1024), h4 = vtr(vs + db * 4096 + k * 1024 + 512);
                const bf16x8 vf = (bf16x8){lo[0], lo[1], lo[2], lo[3], h4[0], h4[1], h4[2], h4[3]};
                oA[db] = __builtin_amdgcn_mfma_f32_32x32x16_bf16(__builtin_bit_cast(bf16x8, pwA[k]), vf, oA[db], 0, 0, 0);
                oB[db] = __builtin_amdgcn_mfma_f32_32x32x16_bf16(__builtin_bit_cast(bf16x8, pwB[k]), vf, oB[db], 0, 0, 0);
                if (db == 1) { lAcc = __builtin_amdgcn_mfma_f32_32x32x16_bf16(__builtin_bit_cast(bf16x8, pwA[k]), ones, lAcc, 0, 0, 0); lBcc = __builtin_amdgcn_mfma_f32_32x32x16_bf16(__builtin_bit_cast(bf16x8, pwB[k]), ones, lBcc, 0, 0, 0); } }
        slot = slot == 2 ? 0 : slot + 1;
    }
    {
        bool bad = false;
#pragma unroll
        for (int r = 0; r < 16; ++r) bad |= !(lAcc[r] > 1e-30f && lAcc[r] < 1e30f && lBcc[r] > 1e-30f && lBcc[r] < 1e30f);
        LAS int* gf = (LAS int*)(lds + OFF_OST);
        asm volatile("s_waitcnt lgkmcnt(0)\n\ts_barrier" ::: "memory");
        const int ab = __any(bad) ? 1 : 0; if (lane == 0) gf[wid] = ab;
        asm volatile("s_waitcnt lgkmcnt(0)\n\ts_barrier" ::: "memory");
        int anyb = 0;
#pragma unroll
        for (int w = 0; w < 8; ++w) anyb |= gf[w];
        asm volatile("s_waitcnt lgkmcnt(0)\n\ts_barrier" ::: "memory");
        if (__builtin_amdgcn_readfirstlane(anyb)) return false;
    }
    LAS bf16_t* stg = (LAS bf16_t*)(lds + OFF_OST) + wid * 2048;
#pragma unroll
    for (int qb = 0; qb < 2; ++qb) {
        LDS_WAIT();
#pragma unroll
        for (int r = 0; r < 16; ++r) { const int orow = crow(r, hi); const float il = frcp(qb == 0 ? lAcc[r] : lBcc[r]);
#pragma unroll
            for (int db = 0; db < 2; ++db) stg[orow * 64 + db * 32 + r32] = (bf16_t)(pk2((qb == 0 ? oA[db][r] : oB[db][r]) * il, 0.f) & 0xffffu); }
        LDS_WAIT();
        bf16_t* Ow = U.o + (size_t)(wid * 64 + qb * 32) * U.ldo;
#pragma unroll
        for (int i = 0; i < 4; ++i) { const int row = i * 8 + (lane >> 3), ch = lane & 7; const u32x4 v = *(const LAS u32x4*)(stg + row * 64 + ch * 8); *(u32x4*)(Ow + (size_t)row * U.ldo + ch * 8) = v; }
    }
    asm volatile("s_waitcnt lgkmcnt(0)\n\ts_barrier" ::: "memory");
    return true;
}
}

namespace ml {
constexpr int WAVE_LDS = 19328;
constexpr int OFF_VT = 0, OFF_KT = 8192, OFF_TB = 16384;
constexpr int TB_CS = 0, TB_BT = 128, TB_EM = 256, TB_NI = 384, TB_HD = 512, TB_QW = 544;
__device__ __forceinline__ int crow(int r, int hi) { return (r & 3) + 8 * (r >> 2) + 4 * hi; }
__device__ __forceinline__ int chunk_row(int b, int j) { return j < 4 ? ML + b * NC + j * 64 : b * T + (j - 4) * 64; }
__device__ __forceinline__ float prefix_sum(float v, int lane) {
#pragma unroll
    for (int o = 1; o < 64; o <<= 1) { const float t = __shfl_up(v, o); if (lane >= o) v += t; }
    return v;
}
__device__ __forceinline__ float prefix_max(float v, int lane) {
#pragma unroll
    for (int o = 1; o < 64; o <<= 1) { const float t = __shfl_up(v, o); if (lane >= o) v = fmaxf(v, t); }
    return v;
}
__device__ __forceinline__ float suffix_max(float v, int lane) {
#pragma unroll
    for (int o = 1; o < 64; o <<= 1) { const float t = __shfl_down(v, o); if (lane + o < 64) v = fmaxf(v, t); }
    return v;
}
struct Gates { float li[2], bcum[2], g[2]; };
__device__ __forceinline__ void load_gates(const bf16_t* P, int row, int h, const float* igb, const float* fgb, Gates& G, int lane) {
    const bf16_t* gp = P + (size_t)row * NP + PC_GT;
#pragma unroll
    for (int d = 0; d < 2; ++d) {
        const float gi = bf2f(gp[d * 4 + h]) + igb[d * 4 + h], gf = bf2f(gp[8 + d * 4 + h]) + fgb[d * 4 + h];
        const float lf = fminf(gf, 0.f) - log1pf(expf(-fabsf(gf)));
        const float ps = prefix_sum(lf, lane), tot = __shfl(ps, 63);
        G.li[d] = gi; G.g[d] = tot; G.bcum[d] = d == 0 ? ps : tot - ps + lf;
    }
}
__device__ __forceinline__ bf16x8 trfrag(LAS const char* tile, int blk, int ks, int lane) {
    const int hi = lane >> 5, q = (lane & 15) >> 2; LAS const char* p = tile + blk * 4096 + (16 * ks + 8 * hi + q) * 64 + ((lane >> 4) & 1) * 32 + (lane & 3) * 8;
    const s16x4 lo = att::vtr(p), h4 = att::vtr(p + 256);
    return (bf16x8){lo[0], lo[1], lo[2], lo[3], h4[0], h4[1], h4[2], h4[3]};
}
__device__ __forceinline__ void load_vtile(LAS char* vt, const bf16_t* P, int rowbase, int col, int lane) {
#pragma unroll
    for (int i = 0; i < 8; ++i) { const int t = i * 8 + (lane >> 3), c = lane & 7;
        const u32x4 w = *(const u32x4*)(P + (size_t)(rowbase + t) * NP + col + 8 * c); *(LAS u32x4*)(vt + (c >> 2) * 4096 + t * 64 + (c & 3) * 16) = w; }
}
__device__ __forceinline__ void conv8(const bf16_t* P, int row, int col, int pos, int len, const float* w0, const float* w1, const float* w2, float* y) {
    const bf16_t* p = P + (size_t)row * NP + col; float x0[8], x1[8], x2[8];
    unpack8(*(const u32x4*)p, x1);
    if (pos > 0) unpack8(*(const u32x4*)(p - NP), x0); else { for (int e = 0; e < 8; ++e) x0[e] = 0.f; }
    if (pos < len - 1) unpack8(*(const u32x4*)(p + NP), x2); else { for (int e = 0; e < 8; ++e) x2[e] = 0.f; }
#pragma unroll
    for (int e = 0; e < 8; ++e) y[e] = silu_f(x0[e] * w0[e] + x1[e] * w1[e] + x2[e] * w2[e]);
}

__device__ __forceinline__ void chunk_state_unit(LAS char* wl, int b, int h, int j, const bf16_t* P, const float* convw, const float* igb, const float* fgb,
                                                 float* CLOC, float* NLOC, float* MG, int lane) {
    const int r32 = lane & 31, hi = lane >> 5;
    const int rowbase = chunk_row(b, j), len = j < 4 ? NC : T, pos0 = j < 4 ? j * 64 : (j - 4) * 64;
    LAS float* tb = (LAS float*)(wl + OFF_TB);
    u32x4 vraw[8], kr0[8], kr1[8], kr2[8];
    { const int c = lane & 7; const bf16_t* pv = P + (size_t)(rowbase + (lane >> 3)) * NP + PC_MV + h * 64 + 8 * c; const bf16_t* pk = P + (size_t)(rowbase + (lane >> 3)) * NP + PC_MK + h * 64 + 8 * c;
#pragma unroll
      for (int i = 0; i < 8; ++i) { vraw[i] = *(const u32x4*)(pv + (size_t)(8 * i) * NP); kr1[i] = *(const u32x4*)(pk + (size_t)(8 * i) * NP);
          kr0[i] = *(const u32x4*)(pk + (size_t)(8 * i) * NP - NP); kr2[i] = *(const u32x4*)(pk + (size_t)(8 * i) * NP + NP); } }
    Gates G; load_gates(P, rowbase + lane, h, igb, fgb, G, lane);
    float mloc[2];
#pragma unroll
    for (int d = 0; d < 2; ++d) { const float a = G.g[d] - G.bcum[d] + G.li[d]; mloc[d] = wave_max(a); tb[d * 64 + lane] = fexp(a - mloc[d]); }
    { const int c = lane & 7; float w0[8], w1[8], w2[8]; const float* cw = convw + 256 + h * 64 + 8 * c;
#pragma unroll
      for (int e = 0; e < 8; ++e) { w0[e] = cw[e]; w1[e] = cw[512 + e]; w2[e] = cw[1024 + e]; }
#pragma unroll
      for (int i = 0; i < 8; ++i) { const int t = i * 8 + (lane >> 3); float y[8], x0[8], x1[8], x2[8]; unpack8(kr0[i], x0); unpack8(kr1[i], x1); unpack8(kr2[i], x2);
          const bool hp = pos0 + t > 0, hn = pos0 + t < len - 1;
#pragma unroll
          for (int e = 0; e < 8; ++e) y[e] = 0.125f * silu_f((hp ? x0[e] : 0.f) * w0[e] + x1[e] * w1[e] + (hn ? x2[e] : 0.f) * w2[e]);
          *(LAS u32x4*)(wl + OFF_KT + (c >> 2) * 4096 + t * 64 + (c & 3) * 16) = pack8(y); } }
    LDS_WAIT();
#pragma unroll 1
    for (int d = 0; d < 2; ++d) {
        LDS_WAIT();
        { const int c = lane & 7;
#pragma unroll
          for (int i = 0; i < 8; ++i) { const int t = i * 8 + (lane >> 3); const float w = tb[d * 64 + t]; float y[8]; unpack8(vraw[i], y);
#pragma unroll
              for (int e = 0; e < 8; ++e) y[e] *= w;
              *(LAS u32x4*)(wl + OFF_VT + (c >> 2) * 4096 + t * 64 + (c & 3) * 16) = pack8(y); } }
        LDS_WAIT();
        const size_t sidx = ((size_t)((d * NB + b) * 4 + h) * NCHK + j);
        float* cl = CLOC + sidx * 4096;
#pragma unroll
        for (int db = 0; db < 2; ++db) { bf16x8 af[4];
#pragma unroll
            for (int ks = 0; ks < 4; ++ks) af[ks] = trfrag(wl + OFF_VT, db, ks, lane);
#pragma unroll
            for (int dkb = 0; dkb < 2; ++dkb) { f32x16 acc = f32x16{};
#pragma unroll
                for (int ks = 0; ks < 4; ++ks) acc = __builtin_amdgcn_mfma_f32_32x32x16_bf16(af[ks], trfrag(wl + OFF_KT, dkb, ks, lane), acc, 0, 0, 0);
#pragma unroll
                for (int i = 0; i < 16; ++i) cl[(32 * db + crow(i, hi)) * 64 + 32 * dkb + r32] = acc[i]; } }
        { float sacc = 0.f; LAS const bf16_t* kt = (LAS const bf16_t*)(wl + OFF_KT + (lane >> 5) * 4096 + (lane & 31) * 2);
#pragma unroll 8
          for (int t = 0; t < 64; ++t) sacc += bf2f(kt[t * 32]) * tb[d * 64 + t];
          NLOC[sidx * 64 + lane] = sacc; }
        if (lane == 0) { MG[sidx * 2] = d == 0 ? mloc[0] : mloc[1]; MG[sidx * 2 + 1] = d == 0 ? G.g[0] : G.g[1]; }
    }
    LDS_WAIT();
}

__device__ __forceinline__ int step_chunk(int d, int s) { return d == 0 ? s : (s < 4 ? 3 - s : 71 - s); }
__device__ __forceinline__ void scan_item(LAS char* lds, const int wid0, int item, const float* CLOC, const float* NLOC, const float* MG, bf16_t* CIN, float* NIN, float* MIN_) {
    const int tid = wid0 * 64 + fresh_lane(); const int dbh = item >> 2, qd = item & 3, d = dbh >> 5;
    LAS float* mg = (LAS float*)lds; LAS float* wo = mg + 2 * NCHK; LAS float* wn = wo + NCHK;
    __syncthreads();
    if (tid < 2 * NCHK) mg[tid] = MG[(size_t)dbh * NCHK * 2 + tid];
    __syncthreads();
    if (tid == 0) { float m = -INFINITY;
        for (int s = 0; s < NCHK; ++s) { const int j = step_chunk(d, s); const float mj = mg[2 * j], gj = mg[2 * j + 1];
            if (qd == 0) MIN_[(size_t)dbh * NCHK + j] = m;
            const float mn = fmaxf(gj + m, mj); wo[s] = fexp(gj + m - mn); wn[s] = fexp(mj - mn); m = mn; } }
    __syncthreads();
    const float* cl = CLOC + (size_t)dbh * NCHK * 4096; bf16_t* ci = CIN + (size_t)dbh * NCHK * 4096;
    const int e0 = qd * 1024 + tid, e1 = e0 + 512;
    float s0 = 0.f, s1 = 0.f;
    const int en = qd * 16 + (tid & 15); float sn = 0.f; const float* nl = NLOC + (size_t)dbh * NCHK * 64; float* ni = NIN + (size_t)dbh * NCHK * 64;
#pragma unroll 1
    for (int sb = 0; sb < NCHK; sb += 17) { float c0[17], c1[17], cn[17];
#pragma unroll
        for (int i = 0; i < 17; ++i) { const int j = step_chunk(d, sb + i); c0[i] = cl[(size_t)j * 4096 + e0]; c1[i] = cl[(size_t)j * 4096 + e1]; cn[i] = nl[j * 64 + en]; }
#pragma unroll
        for (int i = 0; i < 17; ++i) { const int s = sb + i, j = step_chunk(d, s);
            ci[(size_t)j * 4096 + e0] = (bf16_t)(pk2(s0, 0.f) & 0xffffu); ci[(size_t)j * 4096 + e1] = (bf16_t)(pk2(s1, 0.f) & 0xffffu);
            if (tid < 16) ni[j * 64 + en] = sn;
            s0 = wo[s] * s0 + wn[s] * c0[i]; s1 = wo[s] * s1 + wn[s] * c1[i]; sn = wo[s] * sn + wn[s] * cn[i]; } }
}

__device__ __forceinline__ void out_unit(LAS char* wl, int b, int h, int j, const bf16_t* P, const float* convw, const float* igb, const float* fgb, const float* normw,
                                         const bf16_t* CIN, const float* NIN, const float* MIN_, bf16_t* MIX, int lane) {
    const int r32_ = lane & 31, hi_ = lane >> 5;
    const int rowbase = chunk_row(b, j), len = j < 4 ? NC : T, pos0 = j < 4 ? j * 64 : (j - 4) * 64;
    LAS float* tb = (LAS float*)(wl + OFF_TB);
    float min_d[2];
    { Gates G; load_gates(P, rowbase + lane, h, igb, fgb, G, lane);
#pragma unroll
      for (int d = 0; d < 2; ++d) { const float cs = G.li[d] - G.bcum[d]; const float pm = d == 0 ? prefix_max(cs, lane) : suffix_max(cs, lane);
          const size_t sidx = ((size_t)((d * NB + b) * 4 + h) * NCHK + j);
          const float mi = MIN_[sidx]; min_d[d] = mi;
          const float mt = G.bcum[d] + fmaxf(mi, pm);
          tb[TB_CS + d * 64 + lane] = cs; tb[TB_BT + d * 64 + lane] = G.bcum[d] - mt; tb[TB_EM + d * 64 + lane] = fexp(-mt); tb[TB_NI + d * 64 + lane] = NIN[sidx * 64 + lane]; } }
#pragma unroll
    for (int k = 0; k < 3; ++k) tb[TB_QW + k * 64 + lane] = convw[k * 512 + h * 64 + lane];
    load_vtile(wl + OFF_VT, P, rowbase, PC_MV + h * 64, lane);
    { const int c = lane & 7; float w0[8], w1[8], w2[8]; const float* cw = convw + 256 + h * 64 + 8 * c;
#pragma unroll
      for (int e = 0; e < 8; ++e) { w0[e] = cw[e]; w1[e] = cw[512 + e]; w2[e] = cw[1024 + e]; }
#pragma unroll 2
      for (int i = 0; i < 8; ++i) { const int t = i * 8 + (lane >> 3); float y[8]; conv8(P, rowbase + t, PC_MK + h * 64 + 8 * c, pos0 + t, len, w0, w1, w2, y);
#pragma unroll
          for (int e = 0; e < 8; ++e) y[e] *= 0.125f;
          *(LAS u32x4*)(wl + OFF_KT + c * 1024 + t * 16) = pack8(y); } }
    LDS_WAIT();
#pragma unroll 1
    for (int tbk = 0; tbk < 2; ++tbk) {
        int r32 = r32_, hi = hi_; asm volatile("" : "+v"(r32), "+v"(hi));
        const int t = 32 * tbk + r32;
        const int vaddr = ((lane >> 4) & 1) * 32 + (lane & 3) * 8 + (4 * hi + ((lane & 15) >> 2)) * 64;
        u32x4 qf[4];
#pragma unroll
        for (int d0 = 0; d0 < 4; ++d0) { const int c = 2 * d0 + hi; float w0[8], w1[8], w2[8], y[8];
#pragma unroll
            for (int e = 0; e < 8; ++e) { w0[e] = tb[TB_QW + 8 * c + e]; w1[e] = tb[TB_QW + 64 + 8 * c + e]; w2[e] = tb[TB_QW + 128 + 8 * c + e]; }
            conv8(P, rowbase + t, PC_MQ + h * 64 + 8 * c, pos0 + t, len, w0, w1, w2, y); qf[d0] = pack8(y); }
        f32x16 hs[2]; hs[0] = f32x16{}; hs[1] = f32x16{};
#pragma unroll 1
        for (int d = 0; d < 2; ++d) {
            const size_t sidx = ((size_t)((d * NB + b) * 4 + h) * NCHK + j);
            const float mi = d == 0 ? min_d[0] : min_d[1];
            const float bt = tb[TB_BT + d * 64 + t], em = tb[TB_EM + d * 64 + t];
            const float wi = (mi == -INFINITY) ? 0.f : fexp(bt + mi);
            f32x16 p[2];
#pragma unroll
            for (int sb = 0; sb < 2; ++sb) { p[sb] = f32x16{};
#pragma unroll
                for (int d0 = 0; d0 < 4; ++d0) { const bf16x8 kfr = *(const LAS bf16x8*)(wl + OFF_KT + (2 * d0 + hi) * 1024 + (32 * sb + r32) * 16);
                    p[sb] = __builtin_amdgcn_mfma_f32_32x32x16_bf16(kfr, __builtin_bit_cast(bf16x8, qf[d0]), p[sb], 0, 0, 0); } }
            float ds = 0.f;
#pragma unroll
            for (int sb = 0; sb < 2; ++sb)
#pragma unroll
                for (int i = 0; i < 16; ++i) { const int s_ = 32 * sb + crow(i, hi); const bool valid = d == 0 ? (s_ <= t) : (s_ >= t);
                    const float w = valid ? fexp(bt + tb[TB_CS + d * 64 + s_]) : 0.f; p[sb][i] *= w; ds += p[sb][i]; }
            ds = half_sum(ds);
            float qn = 0.f; u32x4 qw[4];
#pragma unroll
            for (int d0 = 0; d0 < 4; ++d0) { float y[8]; unpack8(qf[d0], y);
#pragma unroll
                for (int e = 0; e < 8; ++e) { qn += y[e] * tb[TB_NI + d * 64 + 16 * d0 + 8 * hi + e]; y[e] *= wi; }
                qw[d0] = pack8(y); }
            qn = half_sum(qn);
            const float den = ds + wi * qn; const float hd = frcp(fmaxf(fabsf(den), em));
            LDS_WAIT();
            if (hi == 0) tb[TB_HD + r32] = hd;
            LDS_WAIT();
            u32x4 pw[4];
#pragma unroll
            for (int jj = 0; jj < 4; ++jj) { pw[0][jj] = pk2(p[0][2 * jj], p[0][2 * jj + 1]); pw[1][jj] = pk2(p[0][8 + 2 * jj], p[0][9 + 2 * jj]); pw[2][jj] = pk2(p[1][2 * jj], p[1][2 * jj + 1]); pw[3][jj] = pk2(p[1][8 + 2 * jj], p[1][9 + 2 * jj]); }
#pragma unroll
            for (int db = 0; db < 2; ++db) { f32x16 acc = f32x16{};
                const bf16_t* cp = CIN + sidx * 4096 + (size_t)(32 * db + r32) * 64 + 8 * hi; bf16x8 cf[4];
#pragma unroll
                for (int d0 = 0; d0 < 4; ++d0) cf[d0] = *(const bf16x8*)(cp + d0 * 16);
#pragma unroll
                for (int k = 0; k < 4; ++k) { LAS const char* vs = wl + OFF_VT + vaddr + db * 4096 + k * 1024; const s16x4 lo = att::vtr(vs), h4 = att::vtr(vs + 512);
                    const bf16x8 vf = (bf16x8){lo[0], lo[1], lo[2], lo[3], h4[0], h4[1], h4[2], h4[3]};
                    acc = __builtin_amdgcn_mfma_f32_32x32x16_bf16(__builtin_bit_cast(bf16x8, pw[k]), vf, acc, 0, 0, 0); }
#pragma unroll
                for (int d0 = 0; d0 < 4; ++d0) acc = __builtin_amdgcn_mfma_f32_32x32x16_bf16(__builtin_bit_cast(bf16x8, qw[d0]), cf[d0], acc, 0, 0, 0);
#pragma unroll
                for (int i = 0; i < 16; ++i) hs[db][i] += acc[i] * tb[TB_HD + crow(i, hi)]; }
        }
        const float nw0 = normw[h * 64 + r32], nw1 = normw[h * 64 + 32 + r32];
        const unsigned offp = (unsigned)((rowbase + 32 * tbk + 4 * hi) * NP + PC_MO + h * 64 + r32) * 2u, offm = (unsigned)((rowbase + 32 * tbk + 4 * hi) * D + h * 64 + r32) * 2u;
#pragma unroll
        for (int i = 0; i < 16; ++i) { float ss = hs[0][i] * hs[0][i] + hs[1][i] * hs[1][i];
            ss += __shfl_xor(ss, 1); ss += __shfl_xor(ss, 2); ss += __shfl_xor(ss, 4); ss += __shfl_xor(ss, 8); ss += __shfl_xor(ss, 16);
            const float sc = 1.0f / sqrtf(ss * (1.0f / 64.0f) + EPS);
            const unsigned ro = (unsigned)((i & 3) + 8 * (i >> 2));
            const bf16_t* op = (const bf16_t*)((const char*)P + (offp + ro * (unsigned)(NP * 2))); bf16_t* mp = (bf16_t*)((char*)MIX + (offm + ro * (unsigned)(D * 2)));
            mp[0] = (bf16_t)(pk2(hs[0][i] * sc * nw0 * sigmoid_f(bf2f(op[0])), 0.f) & 0xffffu);
            mp[32] = (bf16_t)(pk2(hs[1][i] * sc * nw1 * sigmoid_f(bf2f(op[32])), 0.f) & 0xffffu);
            if ((i & 3) == 3) asm volatile("" ::: "memory"); }
    }
    LDS_WAIT();
}
}

#define XB_TMO      128
#define XB_XCNT(j)  (256  + 64 * (j))
#define XB_XSUB(j)  (1280 + 64 * (j))
#define XB_XGEN(j)  (2304 + 64 * (j))
#define XB_TOP      3328
#define XB_TOPGEN   3392
#define XCD_BAR_WORDS 3456
#define XB_SPIN_CAP (1u << 18)
__device__ __forceinline__ unsigned xb_ld(unsigned* p)              { return __hip_atomic_load(p, __ATOMIC_RELAXED, __HIP_MEMORY_SCOPE_AGENT); }
__device__ __forceinline__ unsigned xb_add(unsigned* p, unsigned v) { return __hip_atomic_fetch_add(p, v, __ATOMIC_RELAXED, __HIP_MEMORY_SCOPE_AGENT); }
__device__ __forceinline__ unsigned xb_xcc_id() { return (unsigned)__builtin_amdgcn_s_getreg((3 << 11) | 20) & 0xFu; }
#define XB_SPIN(cond, bar) do { unsigned _sp = 0; while (cond) { __builtin_amdgcn_s_sleep(1); \
    if ((++_sp & 255u) == 0u) { if (xb_ld(&(bar)[XB_TMO])) break; if (_sp > XB_SPIN_CAP) { atomicAdd(&(bar)[XB_TMO], 1u); break; } } } } while (0)
struct XcdBarrier { unsigned* bar; unsigned x; volatile LAS unsigned* st; };
__device__ __forceinline__ XcdBarrier xcd_barrier_post(unsigned* bar, volatile LAS unsigned* st) {
    XcdBarrier b; b.bar = bar; b.x = xb_xcc_id(); b.st = st;
    if (threadIdx.x == 0) (void)xb_add(&bar[XB_XCNT(b.x)], 1u);
    return b;
}
__device__ __forceinline__ void xcd_barrier_complete(unsigned* bar, unsigned x, unsigned& nloc, unsigned& nx) {
    const unsigned G = gridDim.x * gridDim.y * gridDim.z;
    unsigned sum, cnt, mine, sp = 0u;
    for (;;) {
        sum = 0u; cnt = 0u; mine = 0u;
#pragma unroll
        for (unsigned j = 0; j < 16; ++j) { const unsigned c = xb_ld(&bar[XB_XCNT(j)]); sum += c; cnt += (c > 0u) ? 1u : 0u; mine = (j == x) ? c : mine; }
        if (sum == G) break;
        __builtin_amdgcn_s_sleep(1);
        if ((++sp & 255u) == 0u) { if (xb_ld(&bar[XB_TMO])) break; if (sp > XB_SPIN_CAP) { atomicAdd(&bar[XB_TMO], 1u); break; } }
    }
    nloc = mine > 0u ? mine : 1u; nx = cnt > 0u ? cnt : 1u;
}
__device__ __forceinline__ void xcd_barrier(const XcdBarrier& b) {
    asm volatile("s_waitcnt vmcnt(0)" ::: "memory");
    __syncthreads();
    if (threadIdx.x == 0) {
        unsigned* bar = b.bar;
        __builtin_amdgcn_s_waitcnt(0);
        unsigned nloc = b.st[0], nx = b.st[1];
        if (nloc == 0u) { xcd_barrier_complete(bar, b.x, nloc, nx); b.st[0] = nloc; b.st[1] = nx; }
        const unsigned old = xb_add(&bar[XB_XSUB(b.x)], 1u);
        const unsigned gen = old / nloc;
        if (old + 1u == (gen + 1u) * nloc) {
            __builtin_amdgcn_fence(__ATOMIC_RELEASE, "agent");
            asm volatile("s_waitcnt vmcnt(0)" ::: "memory");
            const unsigned og = xb_add(&bar[XB_TOP], 1u);
            const unsigned tg = og / nx;
            if (og + 1u == (tg + 1u) * nx) xb_add(&bar[XB_TOPGEN], 1u);
            else XB_SPIN(xb_ld(&bar[XB_TOPGEN]) == tg, bar);
            __builtin_amdgcn_fence(__ATOMIC_ACQUIRE, "agent");
            xb_add(&bar[XB_XGEN(b.x)], 1u);
            asm volatile("s_waitcnt vmcnt(0)" ::: "memory");
        } else {
            XB_SPIN(xb_ld(&bar[XB_XGEN(b.x)]) == gen, bar);
            __builtin_amdgcn_fence(__ATOMIC_ACQUIRE, "agent");
            asm volatile("s_waitcnt vmcnt(0)" ::: "memory");
        }
    }
    __syncthreads();
}

struct Args { const float* in[27]; float* out; unsigned char* ws; int ph_lo, ph_hi; };
enum { I_X = 0, I_C, I_CTX, I_CCTX, I_ADAW, I_ADAB, I_N1W, I_N2W, I_WIN, I_WOUT, I_CONVW, I_IGB, I_FGB, I_MLNW, I_RPB, I_QNW, I_KVNW, I_WUQ, I_WUKV, I_F1, I_F3, I_F2, I_RW, I_M1, I_M3, I_M2, I_FNW };

struct TrJob { const float* src; const float* src2; int ldn, K, ngrp, kind; bf16_t* dst; const float* ksc; float cs; };
struct TrItem { const float* sp; const float* kp; bf16_t* dp; int ldn, K; float cs; };
__device__ __forceinline__ void tr_resolve(const TrJob& J, int it, int lane, TrItem& T) {
    const int g = it % J.ngrp, kb = it / J.ngrp, c0 = 16 * g, k0 = 64 * kb; const float* src = J.src; int sc0 = c0; float cs = J.cs;
    if (J.kind == 1) {
        if (c0 < 512) sc0 = 2192 + c0; else if (c0 < 768) sc0 = 2704 + (c0 - 512); else if (c0 < 1792) sc0 = c0 - 768;
        else if (c0 < 2944) { sc0 = 1040 + (c0 - 1792); if (c0 < 2176) cs = 0.125f * LOG2E; }
        else if (c0 < 2976) sc0 = 2960 + (c0 - 2944); else if (c0 < 2992) sc0 = 1024 + (c0 - 2976); else { sc0 = 0; cs = 0.f; }
    } else if (J.kind == 2) {
        if (c0 < 384) sc0 = (c0 >> 6) * 96 + (c0 & 63); else { const int r = c0 - 384; sc0 = (r >> 5) * 96 + 64 + (r & 31); }
    } else if (J.kind == 3) {
        const int pn = c0 >> 8, cc = c0 & 255; if (cc >= 128) src = J.src2; sc0 = 128 * pn + (cc & 127);
    }
    T.sp = src + (size_t)(k0 + (lane >> 4)) * J.ldn + sc0 + (lane & 15); T.kp = J.ksc ? J.ksc + k0 + (lane >> 4) : nullptr; T.ldn = J.ldn; T.K = J.K; T.cs = cs;
    T.dp = J.dst + (size_t)c0 * J.K + k0;
}
__device__ __forceinline__ void tr_load(const TrItem& T, float (&v)[16], float (&kv)[16]) {
#pragma unroll
    for (int i = 0; i < 16; ++i) v[i] = T.sp[(size_t)(4 * i) * T.ldn];
    if (T.kp) {
#pragma unroll
        for (int i = 0; i < 16; ++i) kv[i] = T.kp[4 * i]; }
    else {
#pragma unroll
        for (int i = 0; i < 16; ++i) kv[i] = 1.f; }
}
__device__ __forceinline__ void tr_store(const TrItem& T, const float (&v)[16], const float (&kv)[16], LAS float* scr, int lane) {
#pragma unroll
    for (int i = 0; i < 16; ++i) scr[(4 * i + (lane >> 4)) * 17 + (lane & 15)] = v[i] * T.cs * kv[i];
    LDS_WAIT();
#pragma unroll
    for (int j = 0; j < 2; ++j) { const int id = lane + 64 * j, n = id >> 3, c = id & 7; float y[8];
#pragma unroll
        for (int e = 0; e < 8; ++e) y[e] = scr[(8 * c + e) * 17 + n];
        *(u32x4*)(T.dp + (size_t)n * T.K + 8 * c) = pack8(y); }
    LDS_WAIT();
}
template <class R> __device__ __forceinline__ void tr_run(int first, int stride, int total, const R& resolve, LAS float* scr, int lane) {
    int it = first; if (it >= total) return;
    TrItem Tc; float vc[16], kc[16]; resolve(it, Tc); tr_load(Tc, vc, kc);
    for (;;) {
        const int itn = it + stride; const bool hn = itn < total; TrItem Tn = Tc; float vn[16], kn[16];
        if (hn) { resolve(itn, Tn); tr_load(Tn, vn, kn); }
        else {
#pragma unroll
            for (int i = 0; i < 16; ++i) { vn[i] = 0.f; kn[i] = 0.f; } }
        tr_store(Tc, vc, kc, scr, lane);
        if (!hn) break;
        Tc = Tn;
#pragma unroll
        for (int i = 0; i < 16; ++i) { vc[i] = vn[i]; kc[i] = kn[i]; }
        it = itn;
    }
}
__device__ __forceinline__ void tr_load_nk(const TrItem& T, float (&v)[16]) {
#pragma unroll
    for (int i = 0; i < 16; ++i) v[i] = T.sp[(size_t)(4 * i) * T.ldn];
}
__device__ __forceinline__ void tr_store_nk(const TrItem& T, const float (&v)[16], LAS float* scr, int lane) {
#pragma unroll
    for (int i = 0; i < 16; ++i) scr[(4 * i + (lane >> 4)) * 17 + (lane & 15)] = v[i] * T.cs;
    LDS_WAIT();
#pragma unroll
    for (int j = 0; j < 2; ++j) { const int id = lane + 64 * j, n = id >> 3, c = id & 7; float y[8];
#pragma unroll
        for (int e = 0; e < 8; ++e) y[e] = scr[(8 * c + e) * 17 + n];
        *(u32x4*)(T.dp + (size_t)n * T.K + 8 * c) = pack8(y); }
    LDS_WAIT();
}
template <class R> __device__ __forceinline__ void tr_run2(int first, int stride, int total, const R& resolve, LAS float* scr, int lane) {
    int it = first; if (it >= total) return;
    TrItem Ta, Tb; float va[16], vb[16]; bool hb = it + stride < total;
    resolve(it, Ta); tr_load_nk(Ta, va); Tb = Ta;
    if (hb) { resolve(it + stride, Tb); tr_load_nk(Tb, vb); }
    else {
#pragma unroll
        for (int i = 0; i < 16; ++i) vb[i] = 0.f; }
    for (;;) {
        const int itn = it + 2 * stride; const bool hn = itn < total, hnb = itn + stride < total; TrItem Tna = Ta, Tnb = Ta; float vna[16], vnb[16];
        if (hn) { resolve(itn, Tna); tr_load_nk(Tna, vna); }
        else {
#pragma unroll
            for (int i = 0; i < 16; ++i) vna[i] = 0.f; }
        if (hnb) { resolve(itn + stride, Tnb); tr_load_nk(Tnb, vnb); }
        else {
#pragma unroll
            for (int i = 0; i < 16; ++i) vnb[i] = 0.f; }
        tr_store_nk(Ta, va, scr, lane);
        if (hb) tr_store_nk(Tb, vb, scr, lane);
        if (!hn) break;
        Ta = Tna; Tb = Tnb; hb = hnb;
#pragma unroll
        for (int i = 0; i < 16; ++i) { va[i] = vna[i]; vb[i] = vnb[i]; }
        it = itn;
    }
}
__device__ __forceinline__ int tr_job_count(const TrJob& J) { return J.ngrp * (J.K / 64); }

__device__ __forceinline__ void mod_item(LAS char* lds, const int wid0, int item, const float* c, const float* cctx, const float* adaw, const float* adab, float* modv) {
    const int lane = fresh_lane(), wid = wid0, tid = wid * 64 + lane, l = item / 96, ng = item % 96;
    LAS float* sc = (LAS float*)lds;
    LAS float* part = sc + 9 * 1024;
    __syncthreads();
    for (int i = tid; i < 9 * 1024; i += 512) { const float v = i < 8 * 1024 ? c[i] : cctx[i - 8 * 1024]; sc[i] = silu_f(v); }
    __syncthreads();
    float acc[9];
#pragma unroll
    for (int bi = 0; bi < 9; ++bi) acc[bi] = 0.f;
    const float* w = adaw + (size_t)l * 1024 * 6144 + ng * 64 + lane;
#pragma unroll 1
    for (int k0 = wid * 128; k0 < wid * 128 + 128; k0 += 16) { float wv[16];
#pragma unroll
        for (int i = 0; i < 16; ++i) wv[i] = w[(size_t)(k0 + i) * 6144];
#pragma unroll
        for (int i = 0; i < 16; ++i)
#pragma unroll
            for (int bi = 0; bi < 9; ++bi) acc[bi] += sc[bi * 1024 + k0 + i] * wv[i]; }
#pragma unroll
    for (int bi = 0; bi < 9; ++bi) part[(wid * 9 + bi) * 64 + lane] = acc[bi];
    __syncthreads();
    for (int i = tid; i < 9 * 64; i += 512) { const int bi = i >> 6, n = i & 63; float s = adab[l * 6144 + ng * 64 + n];
#pragma unroll
        for (int w8 = 0; w8 < 8; ++w8) s += part[(w8 * 9 + bi) * 64 + n];
        modv[((size_t)l * 9 + bi) * 6144 + ng * 64 + n] = s; }
}

__device__ __forceinline__ void norm_row(const float* xrow, const float* nw, const float* shift, const float* scale, int lane, f32x4 (&v)[4], const bf16_t* dl = nullptr, float* xw = nullptr, int nparts = 1, size_t pstride = 0) {
    float s = 0.f;
#pragma unroll
    for (int j = 0; j < 4; ++j) { v[j] = *(const f32x4*)(xrow + 4 * lane + 256 * j);
        if (dl) { for (int p = 0; p < nparts; ++p) { const u32x2 dw = *(const u32x2*)(dl + (size_t)p * pstride + 4 * lane + 256 * j); v[j].x += bf2f(dw.x & 0xffffu); v[j].y += __uint_as_float(dw.x & 0xffff0000u); v[j].z += bf2f(dw.y & 0xffffu); v[j].w += __uint_as_float(dw.y & 0xffff0000u); }
            *(f32x4*)(xw + 4 * lane + 256 * j) = v[j]; }
        s += (v[j].x * v[j].x + v[j].y * v[j].y) + (v[j].z * v[j].z + v[j].w * v[j].w); }
    const float rs = 1.0f / sqrtf(wave_sum(s) * (1.0f / D) + EPS);
#pragma unroll
    for (int j = 0; j < 4; ++j) { const int c = 4 * lane + 256 * j; const f32x4 w = *(const f32x4*)(nw + c), sh = *(const f32x4*)(shift + c), sc = *(const f32x4*)(scale + c);
        v[j] = (v[j] * rs * w) * (1.0f + sc) + sh; }
}
__device__ __forceinline__ void store_row_bf16(bf16_t* orow, int lane, const f32x4 (&v)[4]) {
#pragma unroll
    for (int j = 0; j < 4; ++j) { u32x2 w; w.x = pk2(v[j].x, v[j].y); w.y = pk2(v[j].z, v[j].w); *(u32x2*)(orow + 4 * lane + 256 * j) = w; }
}

constexpr int XBP = pg8::XBP;
__device__ __forceinline__ void xb_load(const bf16_t* xrow, int lane, u32x4 (&w)[2]) { w[0] = *(const u32x4*)(xrow + 8 * lane); w[1] = *(const u32x4*)(xrow + 8 * lane + 512); }
__device__ __forceinline__ void norm_fin_b(const u32x4 (&w)[2], const float* nw, const float* shift, const float* scale, int lane, float (&v)[16]) {
    unpack8(w[0], v); unpack8(w[1], v + 8);
    float s = 0.f;
#pragma unroll
    for (int e = 0; e < 16; ++e) s += v[e] * v[e];
    const float rs = 1.0f / sqrtf(wave_sum(s) * (1.0f / D) + EPS);
#pragma unroll
    for (int j = 0; j < 2; ++j)
#pragma unroll
        for (int h = 0; h < 2; ++h) { const int c = 8 * lane + 512 * j + 4 * h; const f32x4 wv = *(const f32x4*)(nw + c), sh = *(const f32x4*)(shift + c), sc = *(const f32x4*)(scale + c);
#pragma unroll
            for (int q = 0; q < 4; ++q) v[8 * j + 4 * h + q] = (v[8 * j + 4 * h + q] * rs * wv[q]) * (1.0f + sc[q]) + sh[q]; }
}
__device__ __forceinline__ void store_row_b(bf16_t* orow, int lane, const float (&v)[16]) { *(u32x4*)(orow + 8 * lane) = pack8(v); *(u32x4*)(orow + 8 * lane + 512) = pack8(v + 8); }


#if !MK_MULTI
#define GRID_BAR() do { XcdBarrier b2_ = bar; asm volatile("" : "+s"(b2_.bar)); xcd_barrier(b2_); } while (0)
#define OPQ(x) (x)
#else
#define GRID_BAR() do {} while (0)
#define OPQ(x) ({ int _v = (x); asm volatile("" : "+s"(_v)); _v; })
#endif
#ifndef MK_SITES
#define MK_SITES 0xffffffffu
#endif
#define EN(s) (((MK_SITES) >> (s)) & 1u)
#define IN(k) (OPQ(lo) <= (k) && (k) < OPQ(hi_ph))
#define SEAM(k) do { if (IN(k) && IN((k) + 1)) GRID_BAR(); } while (0)
#define PHASE_WS() GAS unsigned char* ws = (GAS unsigned char*)args.ws; asm volatile("" : "+s"(ws))
#define PHASE_IDS() PHASE_WS(); const int lane = fresh_lane(), wid = wid0, tid = wid * 64 + lane, gw = blockIdx.x * 8 + wid; (void)lane; (void)gw; (void)tid

#define x_in (args.in[I_X])
#define ctx_in (args.in[I_CTX])
#define xout (args.out)
#define XB ((bf16_t*)args.out + 1024)
#define modv ((float*)(ws + SM_MOD))
#define ropet ((float*)(ws + SM_ROPE))
#define stats ((float*)(ws + SM_STATS))
#define NLOC ((float*)(ws + SM_NLOC))
#define NIN ((float*)(ws + SM_NIN))
#define MG ((float*)(ws + SM_MG))
#define MINb ((float*)(ws + SM_MIN))
#define xc ((float*)(ws + WS_XC))
#define BH ((bf16_t*)(ws + WS_H))
#define CLOC ((float*)(ws + WS_H))
#define BP ((bf16_t*)(ws + WS_P))
#define QM ((bf16_t*)(ws + WS_QM))
#define KVM ((bf16_t*)(ws + WS_KVM))
#define CIN ((bf16_t*)(ws + WS_CIN))
#define Win ((bf16_t*)(ws + W_IN))
#define Wout ((bf16_t*)(ws + W_OUT))
#define Wuq ((bf16_t*)(ws + W_UQ))
#define Wukv ((bf16_t*)(ws + W_UKV))
#define Wf13 ((bf16_t*)(ws + W_F13))
#define Wf2 ((bf16_t*)(ws + W_F2))
#define tokinfo ((int*)(ws + SM_TOK))
#define tokg ((float*)(ws + SM_TOKG))
#define wgcnt ((int*)(ws + SM_WGCNT))
#define rowtok ((int*)(ws + SM_ROWTOK))
#define rowgate ((float*)(ws + SM_ROWGATE))
#define tileexp ((int*)(ws + SM_TILEEXP))
#define WMOE ((bf16_t*)(ws + WS_WMOE))
#define UB ((bf16_t*)(ws + WS_U))
#define ASORT ((bf16_t*)(ws + WS_ASORT))
#define PBY ((bf16_t*)(ws + WS_PBY))
#define PBF ((bf16_t*)(ws + WS_PBF))
#define PBW ((bf16_t*)(ws + WS_PBW))

template <int L> __device__ __forceinline__ void layer_phases(const Args& args, LAS unsigned char* lds, const int G, const int NGW, const XcdBarrier& bar, const int lo, const int hi_ph, const int wid0) {
    constexpr int l = L; constexpr int pb = 1 + 10 * l;

#define mod_l (modv + (size_t)l * 9 * 6144)
        if (EN(1) && IN(pb + 0)) { PHASE_IDS();
            const float* nw = args.in[I_N1W] + l * D;
            if (l == 0) {
                for (int r = gw; r < M; r += NGW) { const bool lat = r < ML; const int bi = lat ? (r >> 12) : 8;
                    const float* xr = lat ? (x_in + (size_t)r * D) : (ctx_in + (size_t)(r - ML) * D);
                    f32x4 v[4]; norm_row(xr, nw, mod_l + bi * 6144, mod_l + bi * 6144 + 1024, lane, v); store_row_bf16(BH + (size_t)r * D, lane, v); }
            } else {
                for (int r = gw; r < ML; r += 2 * NGW) { const int rB = r + NGW; const bool hb = rB < ML;
                    u32x4 wa[2], wb[2]; xb_load(XB + (size_t)r * XBP, lane, wa); xb_load(XB + (size_t)(hb ? rB : r) * XBP, lane, wb);
                    float v[16]; norm_fin_b(wa, nw, mod_l + (r >> 12) * 6144, mod_l + (r >> 12) * 6144 + 1024, lane, v); store_row_b(BH + (size_t)r * D, lane, v);
                    if (hb) { norm_fin_b(wb, nw, mod_l + (rB >> 12) * 6144, mod_l + (rB >> 12) * 6144 + 1024, lane, v); store_row_b(BH + (size_t)rB * D, lane, v); } }
                for (int r = ML + gw; r < M; r += NGW) { float* xr = xc + (size_t)(r - ML) * D;
                    f32x4 v[4]; norm_row(xr, nw, mod_l + 8 * 6144, mod_l + 8 * 6144 + 1024, lane, v, PBF + (size_t)(r - ML) * D, xr, 8, (size_t)MC * D); store_row_bf16(BH + (size_t)r * D, lane, v); }
            }
        }
        SEAM(pb + 0);
        if (EN(2) && IN(pb + 1)) { PHASE_WS();
            pg8::Gemm g{BH, D, Win + (size_t)l * 3072 * 1024, D}; pg8::StaticOrder S; S.init(M / 256, NP / 256, G, blockIdx.x, D);
            pg8::EpiP E{BP, stats, ropet};
            pg8::gemm_phase<pg8::EpiP, pg8::StaticOrder, true>(lds, g, S, E, wid0);
        }
        SEAM(pb + 1);
        if (EN(3) && IN(pb + 2)) { PHASE_WS();
            if (EN(18)) { pg8::Gemm g{BP + PC_QL, NP, Wuq + (size_t)l * 768 * 512, 512}; pg8::StaticOrder S; S.init(M / 256, 3, G, blockIdx.x, 512);
              pg8::EpiRS<true> E{QM, NQM, NQM, 384, stats, 0, 16, 1.0f / 512.0f, ropet};
              pg8::gemm_phase<pg8::EpiRS<true>, pg8::StaticOrder, true>(lds, g, S, E, wid0); }
            __syncthreads();
            if (EN(19)) { pg8::Gemm g{BP + PC_KVL, NP, Wukv + (size_t)l * 768 * 256, 256}; pg8::StaticOrder S; S.init(M / 256, 3, G, blockIdx.x, 256);
              pg8::EpiRS<false> E{KVM, NKVM, NKVM, NKVM, stats, 16, 8, 1.0f / 256.0f, ropet};
              pg8::gemm_phase<pg8::EpiRS<false>, pg8::StaticOrder, true>(lds, g, S, E, wid0); }
            __syncthreads();
            { PHASE_IDS();
            const float* convw = args.in[I_CONVW] + (size_t)l * 3 * 512; const float* igb = args.in[I_IGB] + l * 8; const float* fgb = args.in[I_FGB] + l * 8;
            for (int k = 0; ; ++k) { const int u = (k & 1) ? k * NGW + (NGW - 1 - gw) : k * NGW + gw;
                if (u >= NB * 4 * NCHK) { if (k * NGW >= NB * 4 * NCHK) break; else continue; }
                const int j = u % NCHK, bh = u / NCHK; int lane_ = lane; asm volatile("" : "+v"(lane_));
                if (EN(17)) ml::chunk_state_unit((LAS char*)lds + wid * ml::WAVE_LDS, bh >> 2, bh & 3, j, BP, convw, igb, fgb, CLOC, NLOC, MG, lane_); } }
        }
        SEAM(pb + 2);
        if (EN(4) && IN(pb + 3)) { PHASE_WS(); for (int item = blockIdx.x; item < 256; item += G) ml::scan_item((LAS char*)lds, wid0, item, CLOC, NLOC, MG, CIN, NIN, MINb); }
        SEAM(pb + 3);
        if (EN(5) && IN(pb + 4)) { GAS unsigned char* ws_ph = (GAS unsigned char*)args.ws;
            const float* convw = args.in[I_CONVW] + (size_t)l * 3 * 512; const float* igb = args.in[I_IGB] + l * 8; const float* fgb = args.in[I_FGB] + l * 8;
            const float* mnw = args.in[I_MLNW] + l * 256;
#ifndef MK_REP_MLA
#define MK_REP_MLA 1
#endif
#ifndef MK_REP_NA
#define MK_REP_NA 1
#endif
#ifndef MK_REP_ML
#define MK_REP_ML 1
#endif
            constexpr int n_mla1 = NB * 6 * 8, n_na1 = NB * 6 * 16, n_ml1 = (l == 0) ? NB * 4 * NCHK / 8 : NB * 4 * 64 / 8;
            constexpr int n_mla = n_mla1 * MK_REP_MLA, n_na = n_na1 * MK_REP_NA, n_ml = n_ml1 * MK_REP_ML, n_ctx = (l == 0) ? NB * 6 * 2 : 0;
            constexpr int n_items = n_mla + n_na + n_ml + n_ctx;
            volatile LAS int* qslot = (volatile LAS int*)(lds + LDS_MISC + 64);
            for (;;) {
                GAS unsigned char* ws = ws_ph; asm volatile("" : "+s"(ws));
                int wid_i = wid0; asm volatile("" : "+s"(wid_i));
                const int lane = fresh_lane(), tid = wid_i * 64 + lane;
                bf16_t* MIX = BH;
                __syncthreads();
                if (tid == 0) *qslot = (int)__hip_atomic_fetch_add((unsigned*)(ws + WS_CTL) + CW_QUEUE + l * 64, 1u, __ATOMIC_RELAXED, __HIP_MEMORY_SCOPE_AGENT);
                __syncthreads();
                const int u = __builtin_amdgcn_readfirstlane(*qslot);
                if (u >= n_items) break;
                att::Unit U;
                if (u < n_mla) { const int u1 = u % n_mla1; const int qb = u1 & 7, bh = u1 >> 3, b = bh / 6, h = bh % 6; const int row0 = b * T + qb * 512;
                    U.qn = QM + (size_t)row0 * NQM + h * 64; U.ldq = NQM; U.qr = QM + (size_t)row0 * NQM + 384 + h * 32; U.ldqr = NQM;
                    U.kn = KVM + h * 128; U.ldk = NKVM; U.kr = BP + PC_KR; U.ldkr = NP; U.v = KVM + h * 128 + 64; U.ldv = NKVM;
                    U.o = MIX + (size_t)row0 * D + 640 + h * 64; U.ldo = D; U.na = 64; U.rowa = b * T; U.rowc = ML + b * NC; U.rg = 0; U.rlo = 0;
                    if (EN(15)) { const bool ok = att::attn_unit64((LAS char*)lds, U, wid_i);
                        if (!ok && tid == 0) { unsigned* rd = (unsigned*)(ws + WS_CTL) + CW_REDO + l * 512; const unsigned ix = __hip_atomic_fetch_add(rd, 1u, __ATOMIC_RELAXED, __HIP_MEMORY_SCOPE_AGENT); rd[1 + ix] = (unsigned)u; } }
                } else if (u < n_mla + n_na) { const int v = (u - n_mla) % n_na1, rg = v & 15, bh = v >> 4, b = bh / 6, h = bh % 6; const int row0 = b * T + rg * 256;
                    const int rlo = min(max(4 * rg - 4, 0), 56), rhi = min(max(4 * rg - 1, 0), 56) + 7;
                    { LAS float* bt = (LAS float*)(lds + att::OFF_BIAS); const float* rp = args.in[I_RPB] + ((size_t)l * 6 + h) * 15 * 31;
                      for (int i = tid; i < 640; i += 512) { const int k = i - 64; bt[i] = (k >= 0 && k < 465) ? rp[k] * LOG2E : 0.f; } }
                    __syncthreads();
                    U.qn = BP + (size_t)row0 * NP + PC_NQ + h * 64; U.ldq = NP; U.qr = nullptr; U.ldqr = 0;
                    U.kn = BP + PC_NK + h * 64; U.ldk = NP; U.kr = nullptr; U.ldkr = 0; U.v = BP + PC_NV + h * 64; U.ldv = NP;
                    U.o = MIX + (size_t)row0 * D + 256 + h * 64; U.ldo = D; U.na = rhi - rlo + 1; U.rowa = b * T + rlo * 64; U.rowc = ML + b * NC; U.rg = rg; U.rlo = rlo;
                    if (EN(15)) { const bool ok = att::attn_unit<8, true, true>((LAS char*)lds, U, wid_i);
                        if (!ok && tid == 0) { unsigned* rd = (unsigned*)(ws + WS_CTL) + CW_REDO2 + l * 1024; const unsigned ix = __hip_atomic_fetch_add(rd, 1u, __ATOMIC_RELAXED, __HIP_MEMORY_SCOPE_AGENT); rd[1 + ix] = (unsigned)(u - n_mla); } }
                } else if (u < n_mla + n_na + n_ml) { const int id = ((u - n_mla - n_na) % n_ml1) * 8 + wid_i; int lane_ = lane; asm volatile("" : "+v"(lane_));
                    const int bh = (l == 0) ? id / NCHK : id >> 6, j = (l == 0) ? id % NCHK : 4 + (id & 63);
                    if (EN(16)) ml::out_unit((LAS char*)lds + wid_i * ml::WAVE_LDS, bh >> 2, bh & 3, j, BP, convw, igb, fgb, mnw, CIN, NIN, MINb, MIX, lane_);
                } else { const int v = u - n_mla - n_na - n_ml, kind = v & 1, bh = v >> 1, b = bh / 6, h = bh % 6; const int row0 = ML + b * NC;
                    U.na = 0; U.rowa = 0; U.rowc = row0; U.rg = 0; U.rlo = 0; U.ldo = D;
                    if (kind == 0) { U.qn = QM + (size_t)row0 * NQM + h * 64; U.ldq = NQM; U.qr = QM + (size_t)row0 * NQM + 384 + h * 32; U.ldqr = NQM;
                        U.kn = KVM + h * 128; U.ldk = NKVM; U.kr = BP + PC_KR; U.ldkr = NP; U.v = KVM + h * 128 + 64; U.ldv = NKVM; U.o = MIX + (size_t)row0 * D + 640 + h * 64;
                        if (EN(15)) (void)att::attn_unit<12, false>((LAS char*)lds, U, wid_i);
                    } else { U.qn = BP + (size_t)row0 * NP + PC_NQ + h * 64; U.ldq = NP; U.qr = nullptr; U.ldqr = 0;
                        U.kn = BP + PC_NK + h * 64; U.ldk = NP; U.kr = nullptr; U.ldkr = 0; U.v = BP + PC_NV + h * 64; U.ldv = NP; U.o = MIX + (size_t)row0 * D + 256 + h * 64;
                        if (EN(15)) (void)att::attn_unit<8, false>((LAS char*)lds, U, wid_i); }
                }
            }
        }
        SEAM(pb + 4);
        if (EN(6) && IN(pb + 5)) { PHASE_WS();
            {
              unsigned* rd = (unsigned*)(ws + WS_CTL) + CW_REDO + l * 512; const int nredo = (int)__hip_atomic_load(rd, __ATOMIC_RELAXED, __HIP_MEMORY_SCOPE_AGENT);
              unsigned* rd2 = (unsigned*)(ws + WS_CTL) + CW_REDO2 + l * 1024; const int nredo2 = (int)__hip_atomic_load(rd2, __ATOMIC_RELAXED, __HIP_MEMORY_SCOPE_AGENT);
              if (nredo2 > 0) {
                  for (int i = blockIdx.x; i < nredo2; i += G) { const int v = (int)rd2[1 + i] % (NB * 6 * 16), rg = v & 15, bh = v >> 4, b = bh / 6, h = bh % 6; const int row0 = b * T + rg * 256;
                      const int rlo = min(max(4 * rg - 4, 0), 56), rhi = min(max(4 * rg - 1, 0), 56) + 7; const int tid_ = wid0 * 64 + fresh_lane();
                      __syncthreads();
                      { LAS float* bt = (LAS float*)(lds + att::OFF_BIAS); const float* rp = args.in[I_RPB] + ((size_t)l * 6 + h) * 15 * 31;
                        for (int q = tid_; q < 640; q += 512) { const int k = q - 64; bt[q] = (k >= 0 && k < 465) ? rp[k] * LOG2E : 0.f; } }
                      __syncthreads();
                      att::Unit U; U.qn = BP + (size_t)row0 * NP + PC_NQ + h * 64; U.ldq = NP; U.qr = nullptr; U.ldqr = 0;
                      U.kn = BP + PC_NK + h * 64; U.ldk = NP; U.kr = nullptr; U.ldkr = 0; U.v = BP + PC_NV + h * 64; U.ldv = NP;
                      U.o = BH + (size_t)row0 * D + 256 + h * 64; U.ldo = D; U.na = rhi - rlo + 1; U.rowa = b * T + rlo * 64; U.rowc = ML + b * NC; U.rg = rg; U.rlo = rlo;
                      (void)att::attn_unit<8, true>((LAS char*)lds, U, wid0); }
              }
              if (nredo > 0) {
                  for (int i = blockIdx.x; i < 2 * nredo; i += G) { const int u1 = (int)rd[1 + (i >> 1)] % (NB * 6 * 8), hf = i & 1; const int qb = u1 & 7, bh = u1 >> 3, b = bh / 6, h = bh % 6; const int row0 = b * T + qb * 512 + hf * 256;
                      att::Unit U; U.qn = QM + (size_t)row0 * NQM + h * 64; U.ldq = NQM; U.qr = QM + (size_t)row0 * NQM + 384 + h * 32; U.ldqr = NQM;
                      U.kn = KVM + h * 128; U.ldk = NKVM; U.kr = BP + PC_KR; U.ldkr = NP; U.v = KVM + h * 128 + 64; U.ldv = NKVM;
                      U.o = BH + (size_t)row0 * D + 640 + h * 64; U.ldo = D; U.na = 64; U.rowa = b * T; U.rowc = ML + b * NC; U.rg = 0; U.rlo = 0;
                      (void)att::attn_unit<12, false>((LAS char*)lds, U, wid0); }
              }
              if (nredo > 0 || nredo2 > 0) GRID_BAR(); }
            pg8::Gemm g{BH, D, Wout + (size_t)l * 1024 * 1024, D}; pg8::TailSplit<pg8::StaticOrder> S; S.init(ML / 256, 4, G, blockIdx.x, D); S.init_ts(ML / 256, l == 0 ? MC / 256 : 0, 4);
            pg8::EpiResB<(l == 0)> E{x_in, XB, mod_l + 2 * 1024, 6144, PBW, (size_t)MC * D, ML};
            pg8::gemm_phase<pg8::EpiResB<(l == 0)>, pg8::TailSplit<pg8::StaticOrder>, true>(lds, g, S, E, wid0);
        }
        SEAM(pb + 5);
        if (l == 0) {
            if (EN(7) && IN(pb + 6)) { PHASE_IDS();
                const float* nw = args.in[I_N2W] + l * D;
                for (int r = gw; r < ML; r += 2 * NGW) { const int rB = r + NGW; const bool hb = rB < ML;
                    u32x4 wa[2], wb[2]; xb_load(XB + (size_t)r * XBP, lane, wa); xb_load(XB + (size_t)(hb ? rB : r) * XBP, lane, wb);
                    float v[16]; norm_fin_b(wa, nw, mod_l + (r >> 12) * 6144 + 3 * 1024, mod_l + (r >> 12) * 6144 + 4 * 1024, lane, v); store_row_b(BH + (size_t)r * D, lane, v);
                    if (hb) { norm_fin_b(wb, nw, mod_l + (rB >> 12) * 6144 + 3 * 1024, mod_l + (rB >> 12) * 6144 + 4 * 1024, lane, v); store_row_b(BH + (size_t)rB * D, lane, v); } }
                for (int r = ML + gw; r < M; r += NGW) { const float* xr = ctx_in + (size_t)(r - ML) * D; float* xw = xc + (size_t)(r - ML) * D;
                    f32x4 v[4]; norm_row(xr, nw, mod_l + 8 * 6144 + 3 * 1024, mod_l + 8 * 6144 + 4 * 1024, lane, v, PBW + (size_t)(r - ML) * D, xw, 4, (size_t)MC * D); store_row_bf16(BH + (size_t)r * D, lane, v); }
            }
            SEAM(pb + 6);
            if (EN(8) && IN(pb + 7)) { PHASE_WS();
                pg8::Gemm g{BH, D, Wf13, D}; pg8::StaticOrder S; S.init(M / 256, 22, G, blockIdx.x, D);
                pg8::EpiSwiglu E{BP, DFF};
                pg8::gemm_phase<pg8::EpiSwiglu, pg8::StaticOrder, true>(lds, g, S, E, wid0);
            }
            SEAM(pb + 7);
            if (EN(9) && IN(pb + 8)) { PHASE_WS();
                pg8::Gemm g{BP, DFF, Wf2, DFF}; pg8::TailSplit<pg8::StaticOrder> S; S.init(ML / 256, 4, G, blockIdx.x, DFF); S.init_ts(ML / 256, MC / 256, 8);
                pg8::EpiResB<false> E{nullptr, XB, mod_l + 5 * 1024, 6144, PBF, (size_t)MC * D, ML};
                pg8::gemm_phase<pg8::EpiResB<false>, pg8::TailSplit<pg8::StaticOrder>, true>(lds, g, S, E, wid0);
            }
            SEAM(pb + 8);
        } else {
            if (EN(10) && IN(pb + 6)) { PHASE_IDS();
                { LAS float* scr = (LAS float*)(lds + wid * 4352);
                  const int per13 = 352 * 16, per2 = 64 * 44, per = per13 + per2;
                  const float* m1 = args.in[I_M1]; const float* m3 = args.in[I_M3]; const float* m2 = args.in[I_M2]; bf16_t* wm = WMOE;
                  auto resolve = [&](int it, TrItem& T) { const int e = it / per, r = it % per; bf16_t* wb = (bf16_t*)((char*)wm + (size_t)e * WMOE_E);
                      if (r < per13) { TrJob J{m1 + (size_t)e * 1024 * 2816, m3 + (size_t)e * 1024 * 2816, 2816, 1024, 352, 3, wb, nullptr, 1.f}; tr_resolve(J, r, lane, T); }
                      else { TrJob J{m2 + (size_t)e * 2816 * 1024, nullptr, 1024, 2816, 64, 0, wb + (size_t)5632 * 1024, nullptr, 1.f}; tr_resolve(J, r - per13, lane, T); } };
                  tr_run2(gw, NGW, NEXP * per, resolve, scr, lane); }
                __syncthreads();
                LAS int* esel = (LAS int*)(lds + 40960 + 32768);
                float rwr[16][8];
#pragma unroll
                for (int j = 0; j < 2; ++j)
#pragma unroll
                    for (int q = 0; q < 8; ++q) { const float* wp = args.in[I_RW] + (size_t)(8 * lane + 512 * j + q) * 8; const f32x4 w0 = *(const f32x4*)wp, w1 = *(const f32x4*)(wp + 4);
                        rwr[8 * j + q][0] = w0.x; rwr[8 * j + q][1] = w0.y; rwr[8 * j + q][2] = w0.z; rwr[8 * j + q][3] = w0.w; rwr[8 * j + q][4] = w1.x; rwr[8 * j + q][5] = w1.y; rwr[8 * j + q][6] = w1.z; rwr[8 * j + q][7] = w1.w; }
                const float* nw = args.in[I_N2W] + l * D;
                for (int blk = blockIdx.x; blk < ML / 128; blk += G) {
                    u32x4 wnx[2]; xb_load(XB + (size_t)(blk * 128 + wid) * XBP, lane, wnx);
                    for (int rr = wid; rr < 128; rr += 8) { const int r = blk * 128 + rr, bi = r >> 12; float v[16];
                        u32x4 wc[2]; wc[0] = wnx[0]; wc[1] = wnx[1];
                        if (rr + 8 < 128) xb_load(XB + (size_t)(r + 8) * XBP, lane, wnx);
                        norm_fin_b(wc, nw, mod_l + bi * 6144 + 3 * 1024, mod_l + bi * 6144 + 4 * 1024, lane, v);
                        float lg[8];
#pragma unroll
                        for (int e = 0; e < 8; ++e) lg[e] = 0.f;
#pragma unroll
                        for (int j = 0; j < 2; ++j)
#pragma unroll
                            for (int q = 0; q < 8; ++q) { const float hv = v[8 * j + q];
#pragma unroll
                                for (int e = 0; e < 8; ++e) lg[e] += hv * rwr[8 * j + q][e]; }
#pragma unroll
                        for (int e = 0; e < 8; ++e) lg[e] = wave_sum(lg[e]);
                        int e0 = 0; float v0 = lg[0];
#pragma unroll
                        for (int e = 1; e < 8; ++e) if (lg[e] > v0) { v0 = lg[e]; e0 = e; }
                        int e1 = -1; float v1 = -INFINITY;
#pragma unroll
                        for (int e = 0; e < 8; ++e) if (e != e0 && lg[e] > v1) { v1 = lg[e]; e1 = e; }
                        const float g0 = 1.0f / (1.0f + expf(v1 - v0));
                        if (lane == 0) { esel[rr * 2] = e0; esel[rr * 2 + 1] = e1; tokg[(size_t)r * 2] = g0; tokg[(size_t)r * 2 + 1] = 1.0f - g0; } }
                    __syncthreads();
                    if (tid < 128) { const int e0 = esel[tid * 2], e1 = esel[tid * 2 + 1]; int s0 = 0, s1 = 0;
                        for (int q = 0; q < tid; ++q) { s0 += (esel[q * 2] == e0); s1 += (esel[q * 2 + 1] == e1); }
                        int* ti = tokinfo + (size_t)(blk * 128 + tid) * 4; ti[0] = e0; ti[1] = e1; ti[2] = s0; ti[3] = s1; }
                    if (tid < 16) { const int k = tid >> 3, e = tid & 7; int c = 0; for (int q = 0; q < 128; ++q) c += (esel[q * 2 + k] == e); wgcnt[blk * 16 + tid] = c; }
                    __syncthreads();
                }
            }
            SEAM(pb + 6);
            if (EN(11) && IN(pb + 7)) { PHASE_IDS();
                LAS int* tot = (LAS int*)(lds);
                LAS int* offp = tot + 16; LAS int* pre = tot + 32;
                __syncthreads();
                LAS int* segs = pre + 4096;
                for (int i = tid; i < 4096; i += 512) pre[i] = wgcnt[i];
                __syncthreads();
                { const int c = tid & 15, sg = tid >> 4; int sm = 0;
#pragma unroll
                  for (int q = 0; q < 8; ++q) sm += pre[(sg * 8 + q) * 16 + c];
                  segs[sg * 16 + c] = sm; }
                __syncthreads();
                { const int c = tid & 15, sg = tid >> 4; int run = 0; for (int q = 0; q < sg; ++q) run += segs[q * 16 + c];
#pragma unroll
                  for (int q = 0; q < 8; ++q) { const int v = pre[(sg * 8 + q) * 16 + c]; pre[(sg * 8 + q) * 16 + c] = run; run += v; }
                  if (sg == 31) tot[c] = run; }
                __syncthreads();
                if (tid == 0) { int o = 0; for (int e = 0; e < 8; ++e) { offp[e] = o; o += (tot[e] + tot[8 + e] + 255) & ~255; }
                    if (blockIdx.x == 0) { tileexp[320] = o >> 8; for (int e = 0; e < 8; ++e) { const int t0 = offp[e] >> 8, nt = (tot[e] + tot[8 + e] + 255) >> 8; for (int q = 0; q < nt; ++q) tileexp[t0 + q] = e; } } }
                __syncthreads();
                const float* nw = args.in[I_N2W] + l * D;
                for (int blk = blockIdx.x; blk < ML / 128; blk += G) {
                    u32x4 wnx[2]; xb_load(XB + (size_t)(blk * 128 + wid) * XBP, lane, wnx);
                    for (int rr = wid; rr < 128; rr += 8) { const int r = blk * 128 + rr, bi = r >> 12; float v[16];
                        u32x4 wc[2]; wc[0] = wnx[0]; wc[1] = wnx[1];
                        if (rr + 8 < 128) xb_load(XB + (size_t)(r + 8) * XBP, lane, wnx);
                        norm_fin_b(wc, nw, mod_l + bi * 6144 + 3 * 1024, mod_l + bi * 6144 + 4 * 1024, lane, v);
                        const int* ti = tokinfo + (size_t)r * 4;
#pragma unroll
                        for (int k = 0; k < 2; ++k) { const int e = ti[k], pos = offp[e] + (k == 0 ? 0 : tot[e]) + pre[blk * 16 + k * 8 + e] + ti[2 + k];
                            store_row_b(ASORT + (size_t)pos * D, lane, v);
                            if (lane == 0) tokinfo[(size_t)r * 4 + 2 + k] = pos; } }
                }
            }
            SEAM(pb + 7);
            for (int k = 0; k < 2; ++k) {
                if (EN(12) && IN(pb + 8 + 2 * k)) { PHASE_WS();
                    const int ntl = tileexp[320], t0 = k == 0 ? 0 : 128, t1 = k == 0 ? (ntl < 128 ? ntl : 128) : ntl;
                    pg8::Gemm g{ASORT + (size_t)t0 * 256 * D, D, WMOE, D}; pg8::GroupedOrder S; S.init(t1 > t0 ? t1 - t0 : 0, 22, G, blockIdx.x, D); S.tile_exp = tileexp + t0; S.estride = WMOE_E;
                    pg8::EpiSwiglu E{UB, DFF};
                    pg8::gemm_phase<pg8::EpiSwiglu, pg8::GroupedOrder, true>(lds, g, S, E, wid0);
                }
                SEAM(pb + 8 + 2 * k);
                if (EN(13) && IN(pb + 9 + 2 * k)) { PHASE_WS();
                    const int ntl = tileexp[320], t0 = k == 0 ? 0 : 128, t1 = k == 0 ? (ntl < 128 ? ntl : 128) : ntl;
                    const int nmp = t1 > t0 ? t1 - t0 : 0, nmain = nmp < 128 ? nmp : 128;
                    pg8::Gemm g{UB, DFF, WMOE + (size_t)5632 * 1024, DFF}; pg8::TailSplit<pg8::GroupedOrder> S; S.init(nmain, 4, G, blockIdx.x, DFF); S.tile_exp = tileexp + t0; S.estride = WMOE_E; S.init_ts(nmain, nmp - nmain, 11);
                    pg8::EpiDelta E{ASORT + (size_t)t0 * 256 * D, nullptr, 0, PBY, (size_t)7 * 256 * D, 128 * 256};
                    pg8::gemm_phase<pg8::EpiDelta, pg8::TailSplit<pg8::GroupedOrder>, true>(lds, g, S, E, wid0);
                }
                SEAM(pb + 9 + 2 * k);
            }
        }
    }

constexpr int NPHASE = 24;
__global__ void __launch_bounds__(512, 2) mega_fwd(Args args) {
    extern __shared__ __attribute__((aligned(16))) unsigned char lds_raw[];
    LAS unsigned char* lds = (LAS unsigned char*)lds_raw;
    const int G = gridDim.x, NGW = G * 8;
    const int wid0 = __builtin_amdgcn_readfirstlane(threadIdx.x >> 6);
    if (threadIdx.x < 4) ((volatile LAS unsigned*)(lds + LDS_MISC))[threadIdx.x] = 0u;
    __syncthreads();
#if !MK_MULTI
    XcdBarrier bar = xcd_barrier_post((unsigned*)(args.ws + WS_CTL) + CW_BAR, (volatile LAS unsigned*)(lds + LDS_MISC));
    constexpr int lo = 0, hi_ph = 1000;
#else
    XcdBarrier bar; bar.bar = nullptr; bar.x = 0; bar.st = nullptr;
    const int lo = args.ph_lo, hi_ph = args.ph_hi;
#endif
    if (EN(0) && IN(0)) { PHASE_IDS();
        LAS float* scr = (LAS float*)(lds + wid * 4352);
        TrJob jobs[10];
        for (int l = 0; l < 2; ++l) {
            jobs[l * 4 + 0] = TrJob{args.in[I_WIN] + (size_t)l * 1024 * 2992, nullptr, 2992, 1024, 192, 1, Win + (size_t)l * 3072 * 1024, nullptr, 1.f};
            jobs[l * 4 + 1] = TrJob{args.in[I_WOUT] + (size_t)l * 1024 * 1024, nullptr, 1024, 1024, 64, 0, Wout + (size_t)l * 1024 * 1024, nullptr, 1.f};
            jobs[l * 4 + 2] = TrJob{args.in[I_WUQ] + (size_t)l * 512 * 576, nullptr, 576, 512, 36, 2, Wuq + (size_t)l * 768 * 512, args.in[I_QNW] + l * 512, 0.10206207261596577f * LOG2E};
            jobs[l * 4 + 3] = TrJob{args.in[I_WUKV] + (size_t)l * 256 * 768, nullptr, 768, 256, 48, 0, Wukv + (size_t)l * 768 * 256, args.in[I_KVNW] + l * 256, 1.f};
        }
        jobs[8] = TrJob{args.in[I_F1], args.in[I_F3], 2816, 1024, 352, 3, Wf13, nullptr, 1.f};
        jobs[9] = TrJob{args.in[I_F2], nullptr, 1024, 2816, 64, 0, Wf2, nullptr, 1.f};
        int total = 0;
#pragma unroll
        for (int q = 0; q < 10; ++q) total += tr_job_count(jobs[q]);
        { auto resolve = [&](int it, TrItem& T) { int r = it;
#pragma unroll
              for (int q = 0; q < 10; ++q) { const int n = tr_job_count(jobs[q]); if (r >= 0 && r < n) tr_resolve(jobs[q], r, lane, T); r -= n; } };
          tr_run(gw, NGW, total, resolve, scr, lane); }
        for (int item = blockIdx.x; item < 192; item += G) mod_item((LAS char*)lds + 40960, wid0, item, args.in[I_C], args.in[I_CCTX], args.in[I_ADAW], args.in[I_ADAB], modv);
        if (blockIdx.x == G - 1) { const int pos = tid >> 3, jj = tid & 7; const float inv = powf(10000.0f, -(float)jj / 8.0f); const float a = (float)pos * inv; ropet[pos * 8 + jj] = cosf(a); ropet[512 + pos * 8 + jj] = sinf(a); }
    }
    SEAM(0);

    layer_phases<0>(args, lds, G, NGW, bar, lo, hi_ph, wid0);
    layer_phases<1>(args, lds, G, NGW, bar, lo, hi_ph, wid0);
    if (EN(14) && IN(23)) { PHASE_IDS();
        const float* nw = args.in[I_FNW]; const float* g5 = modv + (size_t)9 * 6144 + 5 * 1024;
        auto yslow = [&](int pos, int c, float* y) {
            if (pos < 65536) unpack8(*(const u32x4*)(ASORT + (size_t)pos * D + c), y);
            else { for (int e = 0; e < 8; ++e) y[e] = 0.f;
                for (int p = 0; p < 11; ++p) { float t[8]; unpack8(*(const u32x4*)(PBY + ((size_t)p * 7 * 256 + (pos - 65536)) * D + c), t);
                    for (int e = 0; e < 8; ++e) y[e] += t[e]; } } };
        auto finish = [&](int r, float (&v)[16]) {
            float sq = 0.f;
#pragma unroll
            for (int e = 0; e < 16; ++e) sq += v[e] * v[e];
            const float rs = 1.0f / sqrtf(wave_sum(sq) * (1.0f / D) + EPS);
            float* xr = xout + (size_t)r * D;
#pragma unroll
            for (int j = 0; j < 2; ++j)
#pragma unroll
                for (int h = 0; h < 2; ++h) { const int c = 8 * lane + 512 * j + 4 * h; const f32x4 w = *(const f32x4*)(nw + c);
                    f32x4 o; o.x = v[8 * j + 4 * h] * rs * w.x; o.y = v[8 * j + 4 * h + 1] * rs * w.y; o.z = v[8 * j + 4 * h + 2] * rs * w.z; o.w = v[8 * j + 4 * h + 3] * rs * w.w;
                    *(f32x4*)(xr + c) = o; } };
        auto combine = [&](int r, const u32x4 (&xw)[2], const float (&ya)[16], const float (&yb)[16], float g0, float g1, float (&v)[16]) {
            const float* gp = g5 + (size_t)(r >> 12) * 6144;
            unpack8(xw[0], v); unpack8(xw[1], v + 8);
#pragma unroll
            for (int j = 0; j < 2; ++j)
#pragma unroll
                for (int h = 0; h < 2; ++h) { const int c = 8 * lane + 512 * j + 4 * h; const f32x4 gg = *(const f32x4*)(gp + c);
#pragma unroll
                    for (int q = 0; q < 4; ++q) { const int e = 8 * j + 4 * h + q; v[e] += gg[q] * (ya[e] * g0 + yb[e] * g1); } } };
        auto row_slow = [&](int r) {
            const int p0 = tokinfo[(size_t)r * 4 + 2], p1 = tokinfo[(size_t)r * 4 + 3]; const float g0 = tokg[(size_t)r * 2], g1 = tokg[(size_t)r * 2 + 1];
            u32x4 xw[2]; xb_load(XB + (size_t)r * XBP, lane, xw);
            float ya[16], yb[16], v[16];
            yslow(p0, 8 * lane, ya); yslow(p0, 8 * lane + 512, ya + 8); yslow(p1, 8 * lane, yb); yslow(p1, 8 * lane + 512, yb + 8);
            combine(r, xw, ya, yb, g0, g1, v); finish(r, v); };
        int nA0 = 0, nA1 = 0, nB0 = 0, nB1 = 0; float ngA0 = 0.f, ngA1 = 0.f, ngB0 = 0.f, ngB1 = 0.f;
        auto ld_ti = [&](int rA, int rB) { if (rB < ML) { nA0 = tokinfo[(size_t)rA * 4 + 2]; nA1 = tokinfo[(size_t)rA * 4 + 3]; nB0 = tokinfo[(size_t)rB * 4 + 2]; nB1 = tokinfo[(size_t)rB * 4 + 3];
            ngA0 = tokg[(size_t)rA * 2]; ngA1 = tokg[(size_t)rA * 2 + 1]; ngB0 = tokg[(size_t)rB * 2]; ngB1 = tokg[(size_t)rB * 2 + 1]; } };
        ld_ti(gw, gw + NGW);
        for (int r = gw; r < ML; r += 2 * NGW) { const int rA = r, rB = r + NGW;
            const int pA0 = nA0, pA1 = nA1, pB0 = nB0, pB1 = nB1; const float gA0 = ngA0, gA1 = ngA1, gB0 = ngB0, gB1 = ngB1;
            if (r + 2 * NGW < ML) ld_ti(r + 2 * NGW, r + 3 * NGW);
            if (rB >= ML) { row_slow(rA); continue; }
            if (__builtin_amdgcn_readfirstlane((pA0 | pA1 | pB0 | pB1) >= 65536 ? 1 : 0)) { row_slow(rA); row_slow(rB); continue; }
            u32x4 xa[2], xb2[2], a0[2], a1[2], b0[2], b1[2];
            xb_load(XB + (size_t)rA * XBP, lane, xa); xb_load(XB + (size_t)rB * XBP, lane, xb2);
            xb_load(ASORT + (size_t)pA0 * D, lane, a0); xb_load(ASORT + (size_t)pA1 * D, lane, a1); xb_load(ASORT + (size_t)pB0 * D, lane, b0); xb_load(ASORT + (size_t)pB1 * D, lane, b1);
            float ya[16], yb[16], v[16];
            unpack8(a0[0], ya); unpack8(a0[1], ya + 8); unpack8(a1[0], yb); unpack8(a1[1], yb + 8);
            combine(rA, xa, ya, yb, gA0, gA1, v); finish(rA, v);
            unpack8(b0[0], ya); unpack8(b0[1], ya + 8); unpack8(b1[0], yb); unpack8(b1[1], yb + 8);
            combine(rB, xb2, ya, yb, gB0, gB1, v); finish(rB, v); }
    }
}

extern "C" void kernel_launch(void* const* d_in, const int* in_sizes, int n_in, void* d_out, int out_size, void* d_ws, size_t ws_size, hipStream_t stream) {
    static int grid = 0;
    if (grid == 0) {
        if (n_in != 27 || out_size != ML * D || ws_size < WS_END) { fprintf(stderr, "kernel_launch: unexpected sizes (n_in %d out %d ws %zu need %zu)\n", n_in, out_size, ws_size, (size_t)WS_END); grid = -1; return; }
        int dev = 0, cus = 0;
        if (hipGetDevice(&dev) != hipSuccess || hipDeviceGetAttribute(&cus, hipDeviceAttributeMultiprocessorCount, dev) != hipSuccess) { grid = -1; return; }
        if (hipFuncSetAttribute((const void*)mega_fwd, hipFuncAttributeMaxDynamicSharedMemorySize, LDS_BYTES) != hipSuccess) { fprintf(stderr, "kernel_launch: hipFuncSetAttribute failed\n"); grid = -1; return; }
        int per_cu = 0;
        if (hipOccupancyMaxActiveBlocksPerMultiprocessor(&per_cu, (const void*)mega_fwd, 512, LDS_BYTES) != hipSuccess || per_cu < 1) fprintf(stderr, "kernel_launch: occupancy query says %d\n", per_cu);
        (void)hipGetLastError();
        grid = cus;
    }
    if (grid < 0) return;
    if (hipMemsetAsync((char*)d_ws + WS_CTL, 0, CTL_ZERO_BYTES, stream) != hipSuccess) return;
    Args a{};
    for (int i = 0; i < 27; ++i) a.in[i] = (const float*)d_in[i];
    a.out = (float*)d_out; a.ws = (unsigned char*)d_ws;
#if MK_MULTI
#ifndef MK_DUP0
#define MK_DUP0 -1
#endif
#ifndef MK_DUP1
#define MK_DUP1 -1
#endif
    for (int ph = 0; ph < NPHASE; ++ph) { a.ph_lo = ph; a.ph_hi = ph + 1; const int reps = (ph == MK_DUP0 || ph == MK_DUP1) ? 2 : 1;
        for (int r = 0; r < reps; ++r) hipLaunchKernelGGL(mega_fwd, dim3(grid), dim3(512), LDS_BYTES, stream, a); }
#else
    a.ph_lo = 0; a.ph_hi = NPHASE;
    hipLaunchKernelGGL(mega_fwd, dim3(grid), dim3(512), LDS_BYTES, stream, a);
#endif
}
```

```cpp
#include <hip/hip_runtime.h>
#include <stdint.h>
#include <stdio.h>

#ifndef MK_MULTI
#define MK_MULTI 0
#endif

#define LAS __attribute__((address_space(3)))
#define GAS __attribute__((address_space(1)))
typedef unsigned short bf16_t;
typedef short bf16x8 __attribute__((ext_vector_type(8)));
typedef short s16x4 __attribute__((ext_vector_type(4)));
typedef float f32x2 __attribute__((ext_vector_type(2)));
typedef float f32x4 __attribute__((ext_vector_type(4)));
typedef float f32x16 __attribute__((ext_vector_type(16)));
typedef unsigned u32x2 __attribute__((ext_vector_type(2)));
typedef unsigned u32x4 __attribute__((ext_vector_type(4)));
typedef __bf16 bf16x2_t __attribute__((ext_vector_type(2)));

constexpr int NB = 8, T = 4096, D = 1024, NC = 256;
constexpr int ML = NB * T, MC = NB * NC, M = ML + MC;
constexpr int NP = 3072;
constexpr int PC_QL = 0, PC_KVL = 512, PC_MQ = 768, PC_MK = 1024, PC_MV = 1280, PC_MO = 1536, PC_NQ = 1792, PC_NK = 2176, PC_NV = 2560, PC_KR = 2944, PC_GT = 2976;
constexpr int NQM = 576, NKVM = 768;
constexpr int DFF = 2816, NEXP = 8;
constexpr int NCHK = 68;
constexpr float LOG2E = 1.4426950408889634f;
constexpr float EPS = 1e-6f;

constexpr size_t MiB = 1u << 20;
constexpr size_t WS_CTL = 0, CTL_ZERO_BYTES = 1 * MiB;
constexpr size_t WS_SMALL = 1 * MiB;
constexpr size_t SM_MOD = WS_SMALL;
constexpr size_t SM_ROPE = SM_MOD + 2 * 9 * 6144 * 4;
constexpr size_t SM_STATS = WS_SMALL + 1 * MiB;
constexpr size_t SM_NLOC = WS_SMALL + 5 * MiB;
constexpr size_t SM_NIN = WS_SMALL + 7 * MiB;
constexpr size_t SM_MG = WS_SMALL + 9 * MiB;
constexpr size_t SM_MIN = SM_MG + 256 * 1024;
constexpr size_t SM_TOK = WS_SMALL + 10 * MiB;
constexpr size_t SM_TOKG = SM_TOK + (size_t)ML * 16;
constexpr size_t SM_WGCNT = WS_SMALL + 11 * MiB;
constexpr size_t SM_ROWTOK = SM_WGCNT + 64 * 1024;
constexpr size_t SM_ROWGATE = SM_ROWTOK + (size_t)2 * M * 4;
constexpr size_t SM_TILEEXP = SM_ROWGATE + (size_t)2 * M * 4;
constexpr size_t WS_WSMALL = 17 * MiB;
constexpr size_t W_IN = WS_WSMALL;
constexpr size_t W_OUT = W_IN + (size_t)2 * 3072 * 1024 * 2;
constexpr size_t W_UQ = W_OUT + (size_t)2 * 1024 * 1024 * 2;
constexpr size_t W_UKV = W_UQ + (size_t)2 * 768 * 512 * 2;
constexpr size_t W_F13 = W_UKV + (size_t)2 * 768 * 256 * 2;
constexpr size_t W_F2 = W_F13 + (size_t)5632 * 1024 * 2;
constexpr size_t WS_XC = 52 * MiB;
constexpr size_t WS_H = 60 * MiB;
constexpr size_t WS_P = 128 * MiB;
constexpr size_t WS_QM = 332 * MiB;
constexpr size_t WS_KVM = 371 * MiB;
constexpr size_t WS_CIN = 422 * MiB;
constexpr size_t WS_END_MIX = 456 * MiB;
constexpr size_t WS_WMOE = 17 * MiB;
constexpr size_t WMOE_E = (size_t)5632 * 1024 + (size_t)1024 * 2816;
constexpr size_t WS_A8 = 83 * MiB;
constexpr size_t WS_U = 149 * MiB;
constexpr size_t WS_ASORT = 336 * MiB;
constexpr size_t WS_PBY = 472 * MiB;
constexpr size_t WS_END = 516 * MiB;
constexpr size_t WS_PBF = WS_QM;
constexpr size_t WS_PBW = WS_KVM;
static_assert(W_F2 + (size_t)1024 * 2816 * 2 <= WS_XC, "weights");
static_assert(WS_H + (size_t)M * 1024 * 2 <= WS_P && WS_P + (size_t)M * NP * 2 <= WS_QM && WS_QM + (size_t)M * NQM * 2 <= WS_KVM && WS_KVM + (size_t)M * NKVM * 2 <= WS_CIN, "map");
static_assert(WS_CIN + (size_t)2 * 8 * 4 * NCHK * 4096 * 2 <= WS_END_MIX, "map2");
static_assert(WS_WMOE + 8 * WMOE_E <= WS_A8 && WS_A8 + (size_t)67584 * 1024 <= WS_U && WS_U + (size_t)M * DFF * 2 <= WS_ASORT && WS_ASORT + (size_t)2 * M * 1024 * 2 <= WS_PBY && WS_PBY + (size_t)11 * 7 * 256 * 1024 * 2 <= WS_END, "map3");
static_assert((size_t)2 * 8 * 4 * NCHK * 4096 * 4 <= (size_t)M * 1024 * 2, "C_LOC overlays BUF_H");
static_assert(SM_TILEEXP + 4096 <= WS_WSMALL && SM_TOKG + (size_t)ML * 8 <= SM_WGCNT && SM_STATS + (size_t)M * 24 * 4 <= SM_NLOC, "small map");

constexpr int CW_BAR = 4096;
constexpr int CW_QUEUE = 8192;
constexpr int CW_REDO2 = 8192 + 2048;
constexpr int CW_REDO = 8192 + 256;

constexpr int LDS_BYTES = 155648;
constexpr int LDS_MISC = 155648 - 256;

#define LDS_WAIT() asm volatile("s_waitcnt lgkmcnt(0)" ::: "memory")
#define VM_WAIT() asm volatile("s_waitcnt vmcnt(0)" ::: "memory")
__device__ __forceinline__ float bf2f(unsigned v) { return __uint_as_float(v << 16); }
__device__ __forceinline__ unsigned pk2(float lo, float hi) { f32x2 v = {lo, hi}; bf16x2_t b = __builtin_convertvector(v, bf16x2_t); return __builtin_bit_cast(unsigned, b); }
__device__ __forceinline__ void unpack8(const u32x4 w, float* f) {
    f[0] = __uint_as_float(w.x << 16); f[1] = __uint_as_float(w.x & 0xffff0000u); f[2] = __uint_as_float(w.y << 16); f[3] = __uint_as_float(w.y & 0xffff0000u);
    f[4] = __uint_as_float(w.z << 16); f[5] = __uint_as_float(w.z & 0xffff0000u); f[6] = __uint_as_float(w.w << 16); f[7] = __uint_as_float(w.w & 0xffff0000u);
}
__device__ __forceinline__ u32x4 pack8(const float* f) { u32x4 w; w.x = pk2(f[0], f[1]); w.y = pk2(f[2], f[3]); w.z = pk2(f[4], f[5]); w.w = pk2(f[6], f[7]); return w; }
__device__ __forceinline__ u32x2 pack8_f8(const float* f) { u32x2 w;
    w.x = (unsigned)__builtin_amdgcn_cvt_pk_fp8_f32(f[0], f[1], 0, false); w.x = (unsigned)__builtin_amdgcn_cvt_pk_fp8_f32(f[2], f[3], (int)w.x, true);
    w.y = (unsigned)__builtin_amdgcn_cvt_pk_fp8_f32(f[4], f[5], 0, false); w.y = (unsigned)__builtin_amdgcn_cvt_pk_fp8_f32(f[6], f[7], (int)w.y, true); return w; }
__device__ __forceinline__ float wave_sum(float v) {
#pragma unroll
    for (int o = 1; o < 64; o <<= 1) v += __shfl_xor(v, o);
    return v;
}
__device__ __forceinline__ float wave_max(float v) {
#pragma unroll
    for (int o = 1; o < 64; o <<= 1) v = fmaxf(v, __shfl_xor(v, o));
    return v;
}
__device__ __forceinline__ float fexp2(float x) { return __builtin_amdgcn_exp2f(x); }
__device__ __forceinline__ float fexp(float x) { return __builtin_amdgcn_exp2f(x * LOG2E); }
__device__ __forceinline__ float frcp(float x) { return __builtin_amdgcn_rcpf(x); }
__device__ __forceinline__ float silu_f(float x) { return x * frcp(1.0f + fexp(-x)); }
__device__ __forceinline__ float sigmoid_f(float x) { return frcp(1.0f + fexp(-x)); }
__device__ __forceinline__ int fresh_lane() { int l; asm volatile("v_mbcnt_lo_u32_b32 %0, -1, 0\n\tv_mbcnt_hi_u32_b32 %0, -1, %0" : "=v"(l)); return l; }
__device__ __forceinline__ float xhalf(float v) { return __shfl_xor(v, 32); }
__device__ __forceinline__ float half_max(float v) { auto rr = __builtin_amdgcn_permlane32_swap(__float_as_uint(v), __float_as_uint(v), false, false); return fmaxf(__uint_as_float(rr[0]), __uint_as_float(rr[1])); }
__device__ __forceinline__ float half_sum(float v) { auto rr = __builtin_amdgcn_permlane32_swap(__float_as_uint(v), __float_as_uint(v), false, false); return __uint_as_float(rr[0]) + __uint_as_float(rr[1]); }

namespace pg8 {
constexpr int BM = 256, BK = 64, HALF = 128, HTB = HALF * BK * 2, STAGE_BYTES = 8 * HTB, NXCD = 8, WGM = 8;
__host__ __device__ __forceinline__ int lds_byte(int r, int c) { const int st = (r >> 4) * 2 + (c >> 5), rr = r & 15, cc = c & 31, ob = rr * 64 + cc * 2; return st * 1024 + (ob ^ (((ob >> 9) & 1) << 5)); }
__host__ __device__ __forceinline__ void stage_rc(int b, int& R, int& C) { const int st = b / 1024, sb = b % 1024, swz = sb ^ (((sb >> 9) & 1) << 5); R = (st >> 1) * 16 + swz / 64; C = (st & 1) * 32 + (swz % 64) / 2; }
__host__ __device__ __forceinline__ int perm32(int rho) { const int n = rho >> 4, i = rho & 15; return 8 * (i >> 2) + 4 * n + (i & 3); }

struct Unit { int pm, pn, kb, ke, part; };
struct Gemm { const bf16_t* A; int lda; const bf16_t* Bt; int K; };

struct StaticOrder {
    int nM, nN, nwg, G, c, nt;
    __device__ void init(int nM_, int nN_, int G_, int c_, int K_) { nM = nM_; nN = nN_; nwg = nM * nN; G = G_; c = c_; nt = K_ / BK; }
    __device__ __forceinline__ void tile_of(int L, Unit& u) const {
        int wgid = L; { const int q = nwg / NXCD, r = nwg % NXCD, xcd = wgid % NXCD, off = wgid / NXCD; wgid = (xcd < r ? xcd * (q + 1) : r * (q + 1) + (xcd - r) * q) + off; }
        const int nig = WGM * nN, gid = wgid / nig, fm = gid * WGM, gsz = (nM - fm) < WGM ? (nM - fm) : WGM;
        u.pm = fm + ((wgid % nig) % gsz); u.pn = (wgid % nig) / gsz;
    }
    __device__ bool next(int i, Unit& u) const {
        const long L = (long)i * G + c; if (L >= nwg) return false;
        tile_of((int)L, u); u.kb = 0; u.ke = nt; u.part = -1; return true;
    }
    __device__ __forceinline__ const char* a_base(const Gemm& g, const Unit& u) const { return (const char*)g.A + (size_t)u.pm * 256 * g.lda * 2 + (size_t)u.kb * (BK * 2); }
    __device__ __forceinline__ const char* b_base(const Gemm& g, const Unit& u) const { return (const char*)g.Bt + (size_t)u.pn * 256 * g.K * 2 + (size_t)u.kb * (BK * 2); }
};
struct GroupedOrder : StaticOrder {
    const int* tile_exp; size_t estride;
    __device__ __forceinline__ const char* b_base(const Gemm& g, const Unit& u) const { return (const char*)g.Bt + (size_t)tile_exp[u.pm] * estride + (size_t)u.pn * 256 * g.K * 2 + (size_t)u.kb * (BK * 2); }
};
template <class Base> struct TailSplit : Base {
    int nMain, nTail, S;
    __device__ void init_ts(int nMain_, int nTail_, int S_) { nMain = nMain_; nTail = nTail_ < 0 ? 0 : nTail_; S = S_; this->nM = nMain; this->nwg = nMain * this->nN; }
    __device__ bool next(int i, Unit& u) const {
        const long L = (long)i * this->G + this->c;
        if (L < this->nwg) { this->tile_of((int)L, u); u.kb = 0; u.ke = this->nt; u.part = -1; return true; }
        const long j = L - this->nwg; const int ntu = nTail * this->nN;
        if (j >= (long)ntu * S) return false;
        const int t = (int)(j % ntu), p = (int)(j / ntu), np = this->nt / 2;
        u.pm = nMain + t / this->nN; u.pn = t % this->nN; u.kb = 2 * (p * np / S); u.ke = 2 * ((p + 1) * np / S); u.part = p; return true;
    }
};

__device__ __forceinline__ unsigned cvt_pk_bf16(float lo, float hi) { unsigned r; asm volatile("v_cvt_pk_bf16_f32 %0, %1, %2" : "=v"(r) : "v"(lo), "v"(hi)); return r; }

typedef int v4i_t __attribute__((ext_vector_type(4)));
typedef int v8i_t __attribute__((ext_vector_type(8)));
__device__ __forceinline__ v8i_t cat8(const bf16x8 lo, const bf16x8 hi) { const v4i_t a = __builtin_bit_cast(v4i_t, lo), b = __builtin_bit_cast(v4i_t, hi); return __builtin_shufflevector(a, b, 0, 1, 2, 3, 4, 5, 6, 7); }
template <class Epi, class Sched, bool ALIGN_EPI, bool F8 = false>
__device__ __forceinline__ void gemm_phase(LAS unsigned char* lds, const Gemm g, const Sched& S, const Epi& E, const int wid0) {
    const int lane = fresh_lane(), wid = wid0, tid = wid * 64 + lane,
    wr = wid >> 2, wc = wid & 3, fr = lane & 15, fq = lane >> 4;
    const int K = g.K;
    unsigned voffA[2], voffB[2];
#pragma unroll
    for (int i = 0; i < 2; ++i) { int R, C; stage_rc(tid * 16 + i * 8192, R, C); const int Rb = Epi::PERM ? ((R & ~31) + perm32(R & 31)) : R;
        voffA[i] = (unsigned)(R * g.lda + C) * 2u; voffB[i] = (unsigned)(Rb * K + C) * 2u; }
    const size_t kstep = (size_t)(BK * 2);
    const size_t hsA = (size_t)HALF * g.lda * 2, hsB = (size_t)HALF * K * 2;
    const unsigned ldsw = (unsigned)wid * 1024u;
    const int aoff = lds_byte(wr * 64 + fr, fq * 8), boff = lds_byte(wc * 32 + fr, fq * 8);
#define PG8_SA(b, h) (((b) * 2 + (h)) * HTB)
#define PG8_SB(b, h) ((4 + (b) * 2 + (h)) * HTB)
#define PG8_STAGE(bufoff, gbase, voff) do { _Pragma("unroll") for (int _i = 0; _i < 2; ++_i) \
        __builtin_amdgcn_global_load_lds((const unsigned*)((const char*)(gbase) + (voff)[_i]), (LAS unsigned*)(lds + (bufoff) + ldsw + _i * 8192), 16, 0, 0); } while (0)
#define PG8_LDA(dst, b, h) do { if constexpr (F8) { _Pragma("unroll") for (int m = 0; m < 4; ++m) dst##8[m] = cat8(*(const LAS bf16x8*)(lds + PG8_SA(b, h) + aoff + m * 2048), *(const LAS bf16x8*)(lds + PG8_SA(b, h) + aoff + m * 2048 + 1024)); } \
        else { _Pragma("unroll") for (int m = 0; m < 4; ++m) _Pragma("unroll") for (int k = 0; k < 2; ++k) dst[m][k] = *(const LAS bf16x8*)(lds + PG8_SA(b, h) + aoff + m * 2048 + k * 1024); } } while (0)
#define PG8_LDB(dst, b, h) do { if constexpr (F8) { _Pragma("unroll") for (int n = 0; n < 2; ++n) dst##8[n] = cat8(*(const LAS bf16x8*)(lds + PG8_SB(b, h) + boff + n * 2048), *(const LAS bf16x8*)(lds + PG8_SB(b, h) + boff + n * 2048 + 1024)); } \
        else { _Pragma("unroll") for (int n = 0; n < 2; ++n) _Pragma("unroll") for (int k = 0; k < 2; ++k) dst[n][k] = *(const LAS bf16x8*)(lds + PG8_SB(b, h) + boff + n * 2048 + k * 1024); } } while (0)
#define PG8_MMA(ai, bj, At, Bt) do { __builtin_amdgcn_s_setprio(1); \
        if constexpr (F8) { _Pragma("unroll") for (int m = 0; m < 4; ++m) _Pragma("unroll") for (int n = 0; n < 2; ++n) \
            asm volatile("v_mfma_scale_f32_16x16x128_f8f6f4 %0, %1, %2, %0, %3, %4 op_sel_hi:[0,0,0]" : "+v"(acc[ai][bj][m][n]) : "v"(Bt##8[n]), "v"(At##8[m]), "v"(sc_w), "v"(sc_1)); } \
        else { _Pragma("unroll") for (int m = 0; m < 4; ++m) _Pragma("unroll") for (int n = 0; n < 2; ++n) _Pragma("unroll") for (int k = 0; k < 2; ++k) \
            acc[ai][bj][m][n] = __builtin_amdgcn_mfma_f32_16x16x32_bf16(Bt[n][k], At[m][k], acc[ai][bj][m][n], 0, 0, 0); } \
        __builtin_amdgcn_s_setprio(0); } while (0)
#define PG8_WAIT_V(n) asm volatile("s_waitcnt vmcnt(" #n ")" ::: "memory")
#define PG8_WAIT_L(n) asm volatile("s_waitcnt lgkmcnt(" #n ")" ::: "memory")
#define PG8_BAR __builtin_amdgcn_s_barrier()
#define PG8_SCHED __builtin_amdgcn_sched_barrier(0)
    Unit cur, nxt; int ui = 0;
    if (!S.next(0, cur)) return;
    f32x4 acc[2][2][4][2];
#pragma unroll
    for (int a = 0; a < 2; ++a)
#pragma unroll
        for (int b = 0; b < 2; ++b)
#pragma unroll
            for (int m = 0; m < 4; ++m)
#pragma unroll
                for (int n = 0; n < 2; ++n) acc[a][b][m][n] = (f32x4){0.f, 0.f, 0.f, 0.f};
    bf16x8 At[4][2], B0[2][2], B1[2][2]; v8i_t At8[4], B08[2], B18[2];
    int sc_w = 0x79797979, sc_1 = 0x7f7f7f7f; asm volatile("" : "+v"(sc_w), "+v"(sc_1));
    const char* cA = S.a_base(g, cur); const char* cB = S.b_base(g, cur);
    PG8_STAGE(PG8_SB(0, 0), cB, voffB); PG8_STAGE(PG8_SB(0, 1), cB + hsB, voffB); PG8_STAGE(PG8_SA(0, 0), cA, voffA); PG8_STAGE(PG8_SA(0, 1), cA + hsA, voffA);
    if (wr == 1) PG8_BAR;
    PG8_WAIT_V(2); PG8_BAR;
    PG8_STAGE(PG8_SB(1, 0), cB + kstep, voffB); PG8_STAGE(PG8_SA(1, 0), cA + kstep, voffA); PG8_STAGE(PG8_SB(1, 1), cB + hsB + kstep, voffB);
    PG8_WAIT_V(6); PG8_BAR;
    for (;;) {
        const bool has_next = S.next(ui + 1, nxt);
        const char* nA = has_next ? S.a_base(g, nxt) : cA; const char* nB = has_next ? S.b_base(g, nxt) : cB;
        const int ntc = cur.ke - cur.kb;
#pragma unroll 1
        for (int t = 0; t < ntc; t += 2) {
            const bool last = (t == ntc - 2);
            const char* a1 = cA + (size_t)(t + 1) * kstep;
            const char* a2 = last ? nA : cA + (size_t)(t + 2) * kstep; const char* b2 = last ? nB : cB + (size_t)(t + 2) * kstep;
            const char* a3 = a2 + kstep; const char* b3 = b2 + kstep;
            PG8_LDB(B0, 0, 0); PG8_LDB(B1, 0, 1); PG8_SCHED; PG8_LDA(At, 0, 0); PG8_STAGE(PG8_SA(1, 1), a1 + hsA, voffA);
            PG8_WAIT_V(8); PG8_WAIT_L(0); PG8_BAR; PG8_MMA(0, 0, At, B0); PG8_MMA(0, 1, At, B1); PG8_BAR; PG8_SCHED;
            PG8_LDA(At, 0, 1); PG8_STAGE(PG8_SB(0, 0), b2, voffB); PG8_STAGE(PG8_SB(0, 1), b2 + hsB, voffB); PG8_STAGE(PG8_SA(0, 0), a2, voffA);
            PG8_WAIT_V(8); PG8_WAIT_L(0); PG8_BAR; PG8_MMA(1, 0, At, B0); PG8_MMA(1, 1, At, B1); PG8_BAR; PG8_SCHED;
            PG8_LDB(B0, 1, 0); PG8_LDB(B1, 1, 1); PG8_SCHED; PG8_LDA(At, 1, 0); PG8_STAGE(PG8_SA(0, 1), a2 + hsA, voffA);
            PG8_WAIT_V(8); PG8_WAIT_L(0); PG8_BAR; PG8_MMA(0, 0, At, B0); PG8_MMA(0, 1, At, B1); PG8_BAR; PG8_SCHED;
            PG8_LDA(At, 1, 1); PG8_STAGE(PG8_SB(1, 0), b3, voffB); PG8_STAGE(PG8_SB(1, 1), b3 + hsB, voffB); PG8_STAGE(PG8_SA(1, 0), a3, voffA);
            PG8_WAIT_V(8); PG8_WAIT_L(0); PG8_BAR; PG8_MMA(1, 0, At, B0); PG8_MMA(1, 1, At, B1); PG8_BAR; PG8_SCHED;
        }
        if constexpr (ALIGN_EPI) { if (wr == 0) PG8_BAR; }
        if constexpr (F8) asm volatile("s_nop 7\n\ts_nop 7\n\ts_nop 7" ::: "memory");
        E(acc, cur, wr, wc, fr, fq);
        if (!has_next) break;
#pragma unroll
        for (int a = 0; a < 2; ++a)
#pragma unroll
            for (int b = 0; b < 2; ++b)
#pragma unroll
                for (int m = 0; m < 4; ++m)
#pragma unroll
                    for (int n = 0; n < 2; ++n) acc[a][b][m][n] = (f32x4){0.f, 0.f, 0.f, 0.f};
        cur = nxt; cA = nA; cB = nB; ++ui;
        if constexpr (ALIGN_EPI) { if (wr == 1) PG8_BAR; }
    }
    PG8_WAIT_V(0);
    if constexpr (!ALIGN_EPI) { if (wr == 0) PG8_BAR; }
    PG8_BAR;
#undef PG8_SA
#undef PG8_SB
#undef PG8_STAGE
#undef PG8_LDA
#undef PG8_LDB
#undef PG8_MMA
#undef PG8_WAIT_V
#undef PG8_WAIT_L
#undef PG8_BAR
#undef PG8_SCHED
}

typedef const f32x4 (&AccRef)[2][2][4][2];

__device__ __forceinline__ void rope8(f32x4& v0, f32x4& v1, int fq, int tpos, const float* tab) {
    const int pos = (fq < 2) ? (tpos >> 6) : (tpos & 63);
    const f32x4 c0 = *(const f32x4*)(tab + pos * 8), c1 = *(const f32x4*)(tab + pos * 8 + 4), s0 = *(const f32x4*)(tab + 512 + pos * 8), s1 = *(const f32x4*)(tab + 512 + pos * 8 + 4);
    f32x4 p0, p1;
#pragma unroll
    for (int j = 0; j < 4; ++j) { p0[j] = __shfl_xor(v0[j], 16); p1[j] = __shfl_xor(v1[j], 16); }
    const float sg = (fq & 1) ? 1.f : -1.f;
    v0 = v0 * c0 + sg * (p0 * s0); v1 = v1 * c1 + sg * (p1 * s1);
}

struct EpiP {
    static constexpr bool PERM = true;
    bf16_t* P; float* stats; const float* rope;
    __device__ __forceinline__ void operator()(AccRef acc, const Unit& u, int wr, int wc, int fr, int fq) const {
        const int row0 = u.pm * BM + wr * 64 + fr, col0 = u.pn * BM + wc * 32 + 8 * fq;
        const bool do_stats = u.pn < 3, do_rope = (u.pn == 11) && (wc == 0) && (u.pm < ML / 256);
#pragma unroll
        for (int ai = 0; ai < 2; ++ai)
#pragma unroll
            for (int m = 0; m < 4; ++m) { const int row = row0 + ai * HALF + m * 16; bf16_t* rowp = P + (size_t)row * NP + col0;
#pragma unroll
                for (int bj = 0; bj < 2; ++bj) { f32x4 v0 = acc[ai][bj][m][0], v1 = acc[ai][bj][m][1];
                    if (do_stats) { float ss = (v0[0] * v0[0] + v0[1] * v0[1]) + (v0[2] * v0[2] + v0[3] * v0[3]) + (v1[0] * v1[0] + v1[1] * v1[1]) + (v1[2] * v1[2] + v1[3] * v1[3]);
                        ss += __shfl_xor(ss, 16); ss += __shfl_xor(ss, 32);
                        if (fq == 0) stats[(size_t)row * 24 + u.pn * 8 + bj * 4 + wc] = ss; }
                    if (bj == 1 && do_rope) rope8(v0, v1, fq, row & (T - 1), rope);
                    u32x4 w; w.x = cvt_pk_bf16(v0[0], v0[1]); w.y = cvt_pk_bf16(v0[2], v0[3]); w.z = cvt_pk_bf16(v1[0], v1[1]); w.w = cvt_pk_bf16(v1[2], v1[3]);
                    *(u32x4*)(rowp + bj * HALF) = w; } }
    }
};
template <bool ROPE> struct EpiRS {
    static constexpr bool PERM = true;
    bf16_t* O; int ldc, ncols, rope_c0; const float* stats; int part0, nparts; float invk; const float* rope;
    __device__ __forceinline__ void operator()(AccRef acc, const Unit& u, int wr, int wc, int fr, int fq) const {
        const int row0 = u.pm * BM + wr * 64 + fr, col0 = u.pn * BM + wc * 32 + 8 * fq;
        const int npl = nparts >> 2;
#pragma unroll
        for (int ai = 0; ai < 2; ++ai)
#pragma unroll
            for (int m = 0; m < 4; ++m) { const int row = row0 + ai * HALF + m * 16; bf16_t* rowp = O + (size_t)row * ldc + col0;
                const float* sp = stats + (size_t)row * 24 + part0 + fq * npl; float ss = sp[0] + sp[1]; if (npl == 4) ss += sp[2] + sp[3];
                ss += __shfl_xor(ss, 16); ss += __shfl_xor(ss, 32);
                const float rs = 1.0f / sqrtf(ss * invk + EPS);
#pragma unroll
                for (int bj = 0; bj < 2; ++bj) { const int c = col0 + bj * HALF; f32x4 v0 = acc[ai][bj][m][0] * rs, v1 = acc[ai][bj][m][1] * rs;
                    if (ROPE) { const int cb = u.pn * BM + bj * HALF + wc * 32;
                        if (cb >= rope_c0 && cb < ncols && u.pm < ML / 256) rope8(v0, v1, fq, row & (T - 1), rope); }
                    if (c < ncols) { u32x4 w; w.x = cvt_pk_bf16(v0[0], v0[1]); w.y = cvt_pk_bf16(v0[2], v0[3]); w.z = cvt_pk_bf16(v1[0], v1[1]); w.w = cvt_pk_bf16(v1[2], v1[3]);
                        *(u32x4*)(rowp + bj * HALF) = w; } } }
    }
};
struct EpiDelta {
    static constexpr bool PERM = true;
    bf16_t* O; const float* gate; int gstride;
    bf16_t* Op; size_t pstride; int prow0;
    __device__ __forceinline__ void operator()(AccRef acc, const Unit& u, int wr, int wc, int fr, int fq) const {
        const int row0 = u.pm * BM + wr * 64 + fr - (u.part >= 0 ? prow0 : 0), col0 = u.pn * BM + wc * 32 + 8 * fq;
        bf16_t* const Ob = u.part >= 0 ? Op + (size_t)u.part * pstride : O;
        f32x4 gv[2][2];
#pragma unroll
        for (int bj = 0; bj < 2; ++bj)
#pragma unroll
            for (int n = 0; n < 2; ++n) gv[bj][n] = gate ? *(const f32x4*)(gate + (size_t)(u.pm < ML / 256 ? (u.pm >> 4) : 8) * gstride + col0 + bj * HALF + 4 * n) : (f32x4){1.f, 1.f, 1.f, 1.f};
#pragma unroll
        for (int ai = 0; ai < 2; ++ai)
#pragma unroll
            for (int m = 0; m < 4; ++m) { bf16_t* rowp = Ob + (size_t)(row0 + ai * HALF + m * 16) * D + col0;
#pragma unroll
                for (int bj = 0; bj < 2; ++bj) { const f32x4 v0 = acc[ai][bj][m][0] * gv[bj][0], v1 = acc[ai][bj][m][1] * gv[bj][1];
                    u32x4 w; w.x = cvt_pk_bf16(v0[0], v0[1]); w.y = cvt_pk_bf16(v0[2], v0[3]); w.z = cvt_pk_bf16(v1[0], v1[1]); w.w = cvt_pk_bf16(v1[2], v1[3]);
                    *(u32x4*)(rowp + bj * HALF) = w; } }
    }
};
struct EpiRes2 {
    static constexpr bool PERM = false;
    const float* xin; float* xout; const float* gate; int gstride; bf16_t* Op; size_t pstride; int prow0;
    __device__ __forceinline__ void operator()(AccRef acc, const Unit& u, int wr, int wc, int fr, int fq) const {
        const int row0 = u.pm * BM + wr * 64 + fr, col0 = u.pn * BM + wc * 32 + 4 * fq;
        const float* gp = gate + (size_t)(u.pm < ML / 256 ? (u.pm >> 4) : 8) * gstride + col0;
        f32x4 gv[2][2];
#pragma unroll
        for (int bj = 0; bj < 2; ++bj)
#pragma unroll
            for (int n = 0; n < 2; ++n) gv[bj][n] = *(const f32x4*)(gp + bj * HALF + n * 16);
        if (u.part < 0) {
#pragma unroll
            for (int ai = 0; ai < 2; ++ai)
#pragma unroll
                for (int m = 0; m < 4; ++m) { const size_t off = (size_t)(row0 + ai * HALF + m * 16) * D + col0;
#pragma unroll
                    for (int bj = 0; bj < 2; ++bj)
#pragma unroll
                        for (int n = 0; n < 2; ++n) { const f32x4 xv = *(const f32x4*)(xin + off + bj * HALF + n * 16); *(f32x4*)(xout + off + bj * HALF + n * 16) = xv + gv[bj][n] * acc[ai][bj][m][n]; } }
        } else { bf16_t* ob = Op + (size_t)u.part * pstride;
#pragma unroll
            for (int ai = 0; ai < 2; ++ai)
#pragma unroll
                for (int m = 0; m < 4; ++m) { const size_t off = (size_t)(row0 - prow0 + ai * HALF + m * 16) * D + col0;
#pragma unroll
                    for (int bj = 0; bj < 2; ++bj)
#pragma unroll
                        for (int n = 0; n < 2; ++n) { const f32x4 y = gv[bj][n] * acc[ai][bj][m][n]; u32x2 w; w.x = cvt_pk_bf16(y[0], y[1]); w.y = cvt_pk_bf16(y[2], y[3]); *(u32x2*)(ob + off + bj * HALF + n * 16) = w; } }
        }
    }
};
constexpr int XBP = 2048;
template <bool XF32> struct EpiResB {
    static constexpr bool PERM = true;
    const float* xin; bf16_t* xb; const float* gate; int gstride; bf16_t* Op; size_t pstride; int prow0;
    __device__ __forceinline__ void operator()(AccRef acc, const Unit& u, int wr, int wc, int fr, int fq) const {
        const int row0 = u.pm * BM + wr * 64 + fr, col0 = u.pn * BM + wc * 32 + 8 * fq;
        const float* gp = gate + (size_t)(u.pm < ML / 256 ? (u.pm >> 4) : 8) * gstride + col0;
        f32x4 gv[2][2];
#pragma unroll
        for (int bj = 0; bj < 2; ++bj)
#pragma unroll
            for (int n = 0; n < 2; ++n) gv[bj][n] = *(const f32x4*)(gp + bj * HALF + 4 * n);
        if (u.part < 0) {
#pragma unroll
            for (int ai = 0; ai < 2; ++ai)
#pragma unroll
                for (int m = 0; m < 4; ++m) { const int row = row0 + ai * HALF + m * 16;
#pragma unroll
                    for (int bj = 0; bj < 2; ++bj) { f32x4 x0, x1; bf16_t* xp = xb + (size_t)row * XBP + col0 + bj * HALF;
                        if constexpr (XF32) { const float* xf = xin + (size_t)row * D + col0 + bj * HALF; x0 = *(const f32x4*)xf; x1 = *(const f32x4*)(xf + 4); }
                        else { const u32x4 w = *(const u32x4*)xp; x0 = (f32x4){__uint_as_float(w.x << 16), __uint_as_float(w.x & 0xffff0000u), __uint_as_float(w.y << 16), __uint_as_float(w.y & 0xffff0000u)};
                            x1 = (f32x4){__uint_as_float(w.z << 16), __uint_as_float(w.z & 0xffff0000u), __uint_as_float(w.w << 16), __uint_as_float(w.w & 0xffff0000u)}; }
                        const f32x4 y0 = x0 + gv[bj][0] * acc[ai][bj][m][0], y1 = x1 + gv[bj][1] * acc[ai][bj][m][1];
                        u32x4 o; o.x = cvt_pk_bf16(y0[0], y0[1]); o.y = cvt_pk_bf16(y0[2], y0[3]); o.z = cvt_pk_bf16(y1[0], y1[1]); o.w = cvt_pk_bf16(y1[2], y1[3]);
                        *(u32x4*)xp = o; } }
        } else { bf16_t* ob = Op + (size_t)u.part * pstride;
#pragma unroll
            for (int ai = 0; ai < 2; ++ai)
#pragma unroll
                for (int m = 0; m < 4; ++m) { bf16_t* rowp = ob + (size_t)(row0 - prow0 + ai * HALF + m * 16) * D + col0;
#pragma unroll
                    for (int bj = 0; bj < 2; ++bj) { const f32x4 y0 = gv[bj][0] * acc[ai][bj][m][0], y1 = gv[bj][1] * acc[ai][bj][m][1];
                        u32x4 o; o.x = cvt_pk_bf16(y0[0], y0[1]); o.y = cvt_pk_bf16(y0[2], y0[3]); o.z = cvt_pk_bf16(y1[0], y1[1]); o.w = cvt_pk_bf16(y1[2], y1[3]);
                        *(u32x4*)(rowp + bj * HALF) = o; } }
        }
    }
};
struct EpiSwiglu {
    static constexpr bool PERM = true;
    bf16_t* U; int ldc;
    __device__ __forceinline__ void operator()(AccRef acc, const Unit& u, int wr, int wc, int fr, int fq) const {
        const int row0 = u.pm * BM + wr * 64 + fr, col0 = u.pn * 128 + wc * 32 + 8 * fq;
#pragma unroll
        for (int ai = 0; ai < 2; ++ai)
#pragma unroll
            for (int m = 0; m < 4; ++m) { bf16_t* rowp = U + (size_t)(row0 + ai * HALF + m * 16) * ldc + col0; float o[8];
#pragma unroll
                for (int n = 0; n < 2; ++n)
#pragma unroll
                    for (int j = 0; j < 4; ++j) { const float a = acc[ai][0][m][n][j], b = acc[ai][1][m][n][j]; o[n * 4 + j] = silu_f(a) * b; }
                u32x4 w; w.x = cvt_pk_bf16(o[0], o[1]); w.y = cvt_pk_bf16(o[2], o[3]); w.z = cvt_pk_bf16(o[4], o[5]); w.w = cvt_pk_bf16(o[6], o[7]);
                *(u32x4*)rowp = w; }
    }
};
struct EpiSwiglu8 {
    static constexpr bool PERM = true;
    unsigned char* U; int ldc;
    __device__ __forceinline__ void operator()(AccRef acc, const Unit& u, int wr, int wc, int fr, int fq) const {
        const int row0 = u.pm * BM + wr * 64 + fr, col0 = u.pn * 128 + wc * 32 + 8 * fq;
#pragma unroll
        for (int ai = 0; ai < 2; ++ai)
#pragma unroll
            for (int m = 0; m < 4; ++m) { unsigned char* rowp = U + (size_t)(row0 + ai * HALF + m * 16) * ldc + col0; float o[8];
#pragma unroll
                for (int n = 0; n < 2; ++n)
#pragma unroll
                    for (int j = 0; j < 4; ++j) { const float a = acc[ai][0][m][n][j], b = acc[ai][1][m][n][j]; o[n * 4 + j] = silu_f(a) * b; }
                *(u32x2*)rowp = pack8_f8(o); }
    }
};
}

namespace att {
constexpr int VSLOT = 8192, NSLOT = 3;
constexpr int OFF_K = 0;
constexpr int OFF_V = NSLOT * 12 * 1024;
constexpr int OFF_WS = OFF_V + NSLOT * VSLOT;
constexpr int OFF_OST = OFF_WS + 8 * 512;
constexpr int OFF_BIAS = OFF_OST + 8 * 4096;
constexpr int LDS_END = OFF_BIAS + 640 * 4;
__device__ __forceinline__ int crow(int r, int hi) { return (r & 3) + 8 * (r >> 2) + 4 * hi; }
__device__ __forceinline__ void glds16(const void* gsrc, unsigned lds_dst) { unsigned keep;
    asm volatile("s_mov_b32 %0, m0\n\ts_mov_b32 m0, %2\n\ts_nop 0\n\tglobal_load_lds_dwordx4 %1, off\n\ts_mov_b32 m0, %0" : "=&s"(keep) : "v"(gsrc), "s"(lds_dst) : "memory"); }
__device__ __forceinline__ void glds16s(const void* sbase, unsigned voff, unsigned lds_dst) { unsigned keep;
    asm volatile("s_mov_b32 %0, m0\n\ts_mov_b32 m0, %3\n\ts_nop 0\n\tglobal_load_lds_dwordx4 %1, %2\n\ts_mov_b32 m0, %0" : "=&s"(keep) : "v"(voff), "s"(sbase), "s"(lds_dst) : "memory"); }
__device__ __forceinline__ s16x4 vtr(LAS const char* p) { typedef short v4i16_t __attribute__((ext_vector_type(4)));
    return __builtin_bit_cast(s16x4, __builtin_amdgcn_ds_read_tr16_b64_v4i16((LAS v4i16_t*)p)); }

struct Unit {
    const bf16_t* qn; int ldq;
    const bf16_t* qr; int ldqr;
    const bf16_t* kn; int ldk;
    const bf16_t* kr; int ldkr;
    const bf16_t* v; int ldv;
    bf16_t* o; int ldo;
    int na, rowa, rowc;
    int rg, rlo;
};

template <int NCH, bool NA, bool FAST = false>
__device__ __forceinline__ bool attn_unit(LAS char* lds, const Unit& U, const int wid0) {
    const int lane = fresh_lane(), r32 = lane & 31, hi = lane >> 5, wid = wid0, tid = wid * 64 + lane; (void)tid;
    constexpr int KSLOT = NCH * 1024;
    const unsigned lds0 = (unsigned)(uintptr_t)lds;
    LAS float* wsf = (LAS float*)(lds + OFF_WS) + wid * 128;
    const int NT = U.na + 4;
    bf16x8 qf[NCH / 2];
    { const bf16_t* qp = U.qn + (size_t)(wid * 32 + r32) * U.ldq + hi * 8;
#pragma unroll
      for (int d0 = 0; d0 < 4; ++d0) qf[d0] = *(const bf16x8*)(qp + d0 * 16);
      if constexpr (NCH == 12) { const bf16_t* qp2 = U.qr + (size_t)(wid * 32 + r32) * U.ldqr + hi * 8;
#pragma unroll
          for (int d0 = 0; d0 < 2; ++d0) qf[4 + d0] = *(const bf16x8*)(qp2 + d0 * 16); } }
#pragma unroll
    for (int d0 = 0; d0 < NCH / 2; ++d0) asm volatile("" : "+v"(qf[d0]));
    VM_WAIT();
    auto tile_row = [&](int it) -> int { return it < U.na ? U.rowa + 64 * it : U.rowc + 64 * (it - U.na); };
    auto dma = [&](int it, int slot) {
        const int row = tile_row(it);
        glds16(U.v + (size_t)(row + 16 * (wid & 3) + (lane >> 2)) * U.ldv + (wid >> 2) * 32 + (lane & 3) * 8, (unsigned)__builtin_amdgcn_readfirstlane(lds0 + OFF_V + slot * VSLOT + wid * 1024));
        glds16(U.kn + (size_t)(row + lane) * U.ldk + wid * 8, (unsigned)__builtin_amdgcn_readfirstlane(lds0 + OFF_K + slot * KSLOT + wid * 1024));
        if constexpr (NCH == 12) glds16(U.kr + (size_t)(row + lane) * U.ldkr + (wid & 3) * 8, (unsigned)__builtin_amdgcn_readfirstlane(lds0 + OFF_K + slot * KSLOT + (8 + (wid & 3)) * 1024));
    };
    constexpr int NPER = (NCH == 12) ? 3 : 2;
    dma(0, 0); dma(1, 1);
    float mrun = -INFINITY, lrun = 0.f; f32x16 o[2]; o[0] = f32x16{}; o[1] = f32x16{};
    f32x16 lacc = f32x16{}; const bf16x8 ones = (bf16x8){0x3f80, 0x3f80, 0x3f80, 0x3f80, 0x3f80, 0x3f80, 0x3f80, 0x3f80};
    const int grow = NA ? 4 * U.rg + (wid >> 1) : 0, qc = 32 * (wid & 1) + r32;
    const int r0w = NA ? min(max(grow - 4, 0), 56) : 0, c0w = min(max(qc - 8, 0), 48);
    LAS const float* btab = (LAS const float*)(lds + OFF_BIAS);
    const int vaddr = ((lane >> 4) & 1) * 32 + (lane & 3) * 8 + (4 * hi + ((lane & 15) >> 2)) * 64;
    int slot = 0;
    for (int it = 0; it < NT; ++it) {
        if (it + 1 < NT) { if constexpr (NPER == 3) asm volatile("s_waitcnt vmcnt(3)" ::: "memory"); else asm volatile("s_waitcnt vmcnt(2)" ::: "memory"); }
        else asm volatile("s_waitcnt vmcnt(0)" ::: "memory");
        asm volatile("s_barrier" ::: "memory");
        if (it + 2 < NT) { const int s2 = slot >= 1 ? slot - 1 : 2; dma(it + 2, s2); }
        bool active = true; int dr = 0;
        if constexpr (NA) { if (it < U.na) { const int krow = U.rlo + it; active = (krow >= r0w) && (krow < r0w + 8); dr = krow - grow + 7; } }
        if (active) {
            LAS const char* ks = lds + OFF_K + slot * KSLOT + r32 * 16; LAS const char* vs = lds + OFF_V + slot * VSLOT + vaddr;
            f32x16 p0 = f32x16{}, p1 = f32x16{};
            { bf16x8 kf0[NCH / 2], kf1[NCH / 2];
#pragma unroll
              for (int d0 = 0; d0 < NCH / 2; ++d0) { kf0[d0] = *(const LAS bf16x8*)(ks + (2 * d0 + hi) * 1024); kf1[d0] = *(const LAS bf16x8*)(ks + (2 * d0 + hi) * 1024 + 512); }
              __builtin_amdgcn_sched_barrier(0);
#pragma unroll
              for (int d0 = 0; d0 < NCH / 2; ++d0) { p0 = __builtin_amdgcn_mfma_f32_32x32x16_bf16(kf0[d0], qf[d0], p0, 0, 0, 0); p1 = __builtin_amdgcn_mfma_f32_32x32x16_bf16(kf1[d0], qf[d0], p1, 0, 0, 0); } }
            if constexpr (NA) { if (it < U.na) {
                LAS const float* bt = btab + 64 + dr * 31 + 15 - qc;
#pragma unroll
                for (int r = 0; r < 16; ++r) { const int kc = crow(r, hi);
                    p0[r] = ((unsigned)(kc - c0w) < 16u) ? p0[r] + bt[kc] : -INFINITY;
                    p1[r] = ((unsigned)(kc + 32 - c0w) < 16u) ? p1[r] + bt[kc + 32] : -INFINITY; } } }
            if constexpr (FAST) {
#pragma unroll
                for (int r = 0; r < 16; ++r) { p0[r] = fexp2(p0[r]); p1[r] = fexp2(p1[r]); }
            } else {
            float mx = fmaxf(p0[0], p1[0]);
#pragma unroll
            for (int r = 1; r < 16; ++r) mx = fmaxf(mx, fmaxf(p0[r], p1[r]));
            mx = half_max(mx);
            const float mnew = fmaxf(mrun, mx);
            if (__any(mnew > mrun)) {
                const float alpha = fexp2(mrun - mnew);
                lrun *= alpha; if (hi == 0) wsf[r32] = alpha; LDS_WAIT();
#pragma unroll
                for (int r = 0; r < 16; ++r) { const float a = wsf[crow(r, hi)]; o[0][r] *= a; o[1][r] *= a; }
                mrun = mnew;
            }
            float ls = 0.f;
#pragma unroll
            for (int r = 0; r < 16; ++r) { p0[r] = fexp2(p0[r] - mrun); p1[r] = fexp2(p1[r] - mrun); ls += p0[r] + p1[r]; }
            lrun += ls;
            }
            u32x4 pw[4];
#pragma unroll
            for (int j = 0; j < 4; ++j) { pw[0][j] = pk2(p0[2 * j], p0[2 * j + 1]); pw[1][j] = pk2(p0[8 + 2 * j], p0[9 + 2 * j]); pw[2][j] = pk2(p1[2 * j], p1[2 * j + 1]); pw[3][j] = pk2(p1[8 + 2 * j], p1[9 + 2 * j]); }
#pragma unroll
            for (int k = 0; k < 4; ++k)
#pragma unroll
                for (int db = 0; db < 2; ++db) { const s16x4 lo = vtr(vs + db * 4096 + k * 1024), h4 = vtr(vs + db * 4096 + k * 1024 + 512);
                    const bf16x8 vf = (bf16x8){lo[0], lo[1], lo[2], lo[3], h4[0], h4[1], h4[2], h4[3]};
                    o[db] = __builtin_amdgcn_mfma_f32_32x32x16_bf16(__builtin_bit_cast(bf16x8, pw[k]), vf, o[db], 0, 0, 0);
                    if (FAST && db == 1) lacc = __builtin_amdgcn_mfma_f32_32x32x16_bf16(__builtin_bit_cast(bf16x8, pw[k]), ones, lacc, 0, 0, 0); }
        }
        slot = slot == 2 ? 0 : slot + 1;
    }
    LAS bf16_t* stg = (LAS bf16_t*)(lds + OFF_OST) + wid * 2048;
    if constexpr (FAST) {
        bool bad = false;
#pragma unroll
        for (int r = 0; r < 16; ++r) bad |= !(lacc[r] > 1e-30f && lacc[r] < 1e30f);
        LAS int* gf = (LAS int*)(lds + OFF_OST);
        asm volatile("s_waitcnt lgkmcnt(0)\n\ts_barrier" ::: "memory");
        const int ab = __any(bad) ? 1 : 0; if (lane == 0) gf[wid] = ab;
        asm volatile("s_waitcnt lgkmcnt(0)\n\ts_barrier" ::: "memory");
        int anyb = 0;
#pragma unroll
        for (int w = 0; w < 8; ++w) anyb |= gf[w];
        asm volatile("s_waitcnt lgkmcnt(0)\n\ts_barrier" ::: "memory");
        if (__builtin_amdgcn_readfirstlane(anyb)) return false;
#pragma unroll
        for (int r = 0; r < 16; ++r) { const int orow = crow(r, hi); const float il = frcp(lacc[r]);
#pragma unroll
            for (int db = 0; db < 2; ++db) stg[orow * 64 + db * 32 + r32] = (bf16_t)(pk2(o[db][r] * il, 0.f) & 0xffffu); }
    } else {
        lrun = half_sum(lrun);
        if (hi == 0) wsf[32 + r32] = frcp(lrun); LDS_WAIT();
#pragma unroll
        for (int r = 0; r < 16; ++r) { const int orow = crow(r, hi); const float il = wsf[32 + orow];
#pragma unroll
            for (int db = 0; db < 2; ++db) stg[orow * 64 + db * 32 + r32] = (bf16_t)(pk2(o[db][r] * il, 0.f) & 0xffffu); }
    }
    LDS_WAIT();
    bf16_t* Ow = U.o + (size_t)(wid * 32) * U.ldo;
#pragma unroll
    for (int i = 0; i < 4; ++i) { const int row = i * 8 + (lane >> 3), ch = lane & 7; const u32x4 v = *(const LAS u32x4*)(stg + row * 64 + ch * 8); *(u32x4*)(Ow + (size_t)row * U.ldo + ch * 8) = v; }
    asm volatile("s_waitcnt lgkmcnt(0)\n\ts_barrier" ::: "memory");
    return true;
}

__device__ __forceinline__ float rowmax32(const f32x16& p0, const f32x16& p1) {
    float a = __builtin_fmaxf(__builtin_fmaxf(p0[0], p0[1]), p1[0]), b = __builtin_fmaxf(__builtin_fmaxf(p0[2], p0[3]), p1[1]); a = __builtin_fmaxf(__builtin_fmaxf(a, p1[2]), p1[3]);
#pragma unroll
    for (int r = 4; r < 16; r += 4) { a = __builtin_fmaxf(__builtin_fmaxf(a, p0[r]), p0[r + 1]); b = __builtin_fmaxf(__builtin_fmaxf(b, p0[r + 2]), p0[r + 3]); a = __builtin_fmaxf(__builtin_fmaxf(a, p1[r]), p1[r + 1]); b = __builtin_fmaxf(__builtin_fmaxf(b, p1[r + 2]), p1[r + 3]); }
    const float m = __builtin_fmaxf(a, b); return half_max(m);
}
__device__ __forceinline__ void softmax_step(f32x16& p0, f32x16& p1, float& mref, float& lrun, f32x16 (&o)[2], LAS float* wsf, int r32, int hi, bool first, float thr) {
    const float mx = rowmax32(p0, p1);
    if (first || __any(mx > mref + thr)) {
        const float mnew = first ? mx : __builtin_fmaxf(mx, mref);
        if (!first) { const float alpha = fexp2(mref - mnew); lrun *= alpha; if (hi == 0) wsf[r32] = alpha; LDS_WAIT();
#pragma unroll
            for (int r = 0; r < 16; ++r) { const float a = wsf[crow(r, hi)]; o[0][r] *= a; o[1][r] *= a; } }
        mref = mnew;
    }
    float ls = 0.f;
#pragma unroll
    for (int r = 0; r < 16; ++r) { p0[r] = fexp2(p0[r] - mref); p1[r] = fexp2(p1[r] - mref); ls += p0[r] + p1[r]; }
    lrun += ls;
}
__device__ __forceinline__ bool attn_unit64(LAS char* lds, const Unit& U, const int wid0) {
    constexpr int NCH = 12, KSLOT = NCH * 1024;
    const int lane = fresh_lane(), r32 = lane & 31, hi = lane >> 5, wid = wid0;
    const unsigned lds0 = (unsigned)(uintptr_t)lds;
    LAS float* wsf = (LAS float*)(lds + OFF_WS) + wid * 128;
    const int NT = U.na + 4;
    bf16x8 qf[2][6];
#pragma unroll
    for (int qb = 0; qb < 2; ++qb) { const bf16_t* qp = U.qn + (size_t)(wid * 64 + qb * 32 + r32) * U.ldq + hi * 8; const bf16_t* qp2 = U.qr + (size_t)(wid * 64 + qb * 32 + r32) * U.ldqr + hi * 8;
#pragma unroll
        for (int d0 = 0; d0 < 4; ++d0) qf[qb][d0] = *(const bf16x8*)(qp + d0 * 16);
#pragma unroll
        for (int d0 = 0; d0 < 2; ++d0) qf[qb][4 + d0] = *(const bf16x8*)(qp2 + d0 * 16); }
#pragma unroll
    for (int qb = 0; qb < 2; ++qb)
#pragma unroll
        for (int d0 = 0; d0 < 6; ++d0) asm volatile("" : "+v"(qf[qb][d0]));
    VM_WAIT();
    auto tile_row = [&](int it) -> int { return it < U.na ? U.rowa + 64 * it : U.rowc + 64 * (it - U.na); };
    const unsigned offKn = (unsigned)(lane * U.ldk + wid * 8) * 2u, offKr = (unsigned)(lane * U.ldkr + (wid & 3) * 8) * 2u;
    const unsigned offV = (unsigned)((16 * (wid & 3) + (lane >> 2)) * U.ldv + (wid >> 2) * 32 + (lane & 3) * 8) * 2u;
    auto dma = [&](int it, int slot) {
        const int row = tile_row(it);
        glds16s((const char*)U.v + (size_t)row * U.ldv * 2, offV, (unsigned)__builtin_amdgcn_readfirstlane(lds0 + OFF_V + slot * VSLOT + wid * 1024));
        glds16s((const char*)U.kn + (size_t)row * U.ldk * 2, offKn, (unsigned)__builtin_amdgcn_readfirstlane(lds0 + OFF_K + slot * KSLOT + wid * 1024));
        glds16s((const char*)U.kr + (size_t)row * U.ldkr * 2, offKr, (unsigned)__builtin_amdgcn_readfirstlane(lds0 + OFF_K + slot * KSLOT + (8 + (wid & 3)) * 1024));
    };
    dma(0, 0); dma(1, 1);
    f32x16 lAcc = f32x16{}, lBcc = f32x16{};
    const bf16x8 ones = (bf16x8){0x3f80, 0x3f80, 0x3f80, 0x3f80, 0x3f80, 0x3f80, 0x3f80, 0x3f80}; f32x16 oA[2], oB[2]; oA[0] = f32x16{}; oA[1] = f32x16{}; oB[0] = f32x16{}; oB[1] = f32x16{};
    const int vaddr = ((lane >> 4) & 1) * 32 + (lane & 3) * 8 + (4 * hi + ((lane & 15) >> 2)) * 64;
    int slot = 0;
    for (int it = 0; it < NT; ++it) {
        if (it + 1 < NT) asm volatile("s_waitcnt vmcnt(3)" ::: "memory"); else asm volatile("s_waitcnt vmcnt(0)" ::: "memory");
        asm volatile("s_barrier" ::: "memory");
        if (it + 2 < NT) { const int s2 = slot >= 1 ? slot - 1 : 2; dma(it + 2, s2); }
        LAS const char* ks = lds + OFF_K + slot * KSLOT + r32 * 16; LAS const char* vs = lds + OFF_V + slot * VSLOT + vaddr;
        f32x16 pA0 = f32x16{}, pA1 = f32x16{}, pB0 = f32x16{}, pB1 = f32x16{};
        { bf16x8 a0 = *(const LAS bf16x8*)(ks + hi * 1024), a1 = *(const LAS bf16x8*)(ks + hi * 1024 + 512);
#pragma unroll
          for (int d0 = 0; d0 < 6; ++d0) {
            bf16x8 n0 = a0, n1 = a1;
            if (d0 < 5) { n0 = *(const LAS bf16x8*)(ks + (2 * d0 + 2 + hi) * 1024); n1 = *(const LAS bf16x8*)(ks + (2 * d0 + 2 + hi) * 1024 + 512); }
            __builtin_amdgcn_sched_barrier(0);
            pA0 = __builtin_amdgcn_mfma_f32_32x32x16_bf16(a0, qf[0][d0], pA0, 0, 0, 0); pA1 = __builtin_amdgcn_mfma_f32_32x32x16_bf16(a1, qf[0][d0], pA1, 0, 0, 0);
            pB0 = __builtin_amdgcn_mfma_f32_32x32x16_bf16(a0, qf[1][d0], pB0, 0, 0, 0); pB1 = __builtin_amdgcn_mfma_f32_32x32x16_bf16(a1, qf[1][d0], pB1, 0, 0, 0);
            __builtin_amdgcn_sched_barrier(0);
            a0 = n0; a1 = n1; } }
        __builtin_amdgcn_sched_barrier(0);
        { _Pragma("unroll") for (int r = 0; r < 16; ++r) { pA0[r] = fexp2(pA0[r]); pA1[r] = fexp2(pA1[r]); } }
        u32x4 pwA[4];
#pragma unroll
        for (int j = 0; j < 4; ++j) { pwA[0][j] = pk2(pA0[2 * j], pA0[2 * j + 1]); pwA[1][j] = pk2(pA0[8 + 2 * j], pA0[9 + 2 * j]); pwA[2][j] = pk2(pA1[2 * j], pA1[2 * j + 1]); pwA[3][j] = pk2(pA1[8 + 2 * j], pA1[9 + 2 * j]); }
        __builtin_amdgcn_sched_barrier(0);
        { _Pragma("unroll") for (int r = 0; r < 16; ++r) { pB0[r] = fexp2(pB0[r]); pB1[r] = fexp2(pB1[r]); } }
        u32x4 pwB[4];
#pragma unroll
        for (int j = 0; j < 4; ++j) { pwB[0][j] = pk2(pB0[2 * j], pB0[2 * j + 1]); pwB[1][j] = pk2(pB0[8 + 2 * j], pB0[9 + 2 * j]); pwB[2][j] = pk2(pB1[2 * j], pB1[2 * j + 1]); pwB[3][j] = pk2(pB1[8 + 2 * j], pB1[9 + 2 * j]); }
        __builtin_amdgcn_sched_barrier(0);
#pragma unroll
        for (int k = 0; k < 4; ++k)
#pragma unroll
            for (int db = 0; db < 2; ++db) { const s16x4 lo = vtr(vs + db * 4096 + k * 1024), h4 = vtr(vs + db * 4096 + k * 1024 + 512);
                const bf16x8 vf = (bf16x8){lo[0], lo[1], lo[2], lo[3], h4[0], h4[1], h4[2], h4[3]};
                oA[db] = __builtin_amdgcn_mfma_f32_32x32x16_bf16(__builtin_bit_cast(bf16x8, pwA[k]), vf, oA[db], 0, 0, 0);
                oB[db] = __builtin_amdgcn_mfma_f32_32x32x16_bf16(__builtin_bit_cast(bf16x8, pwB[k]), vf, oB[db], 0, 0, 0);
                if (db == 1) { lAcc = __builtin_amdgcn_mfma_f32_32x32x16_bf16(__builtin_bit_cast(bf16x8, pwA[k]), ones, lAcc, 0, 0, 0); lBcc = __builtin_amdgcn_mfma_f32_32x32x16_bf16(__builtin_bit_cast(bf16x8, pwB[k]), ones, lBcc, 0, 0, 0); } }
        slot = slot == 2 ? 0 : slot + 1;
    }
    {
        bool bad = false;
#pragma unroll
        for (int r = 0; r < 16; ++r) bad |= !(lAcc[r] > 1e-30f && lAcc[r] < 1e30f && lBcc[r] > 1e-30f && lBcc[r] < 1e30f);
        LAS int* gf = (LAS int*)(lds + OFF_OST);
        asm volatile("s_waitcnt lgkmcnt(0)\n\ts_barrier" ::: "memory");
        const int ab = __any(bad) ? 1 : 0; if (lane == 0) gf[wid] = ab;
        asm volatile("s_waitcnt lgkmcnt(0)\n\ts_barrier" ::: "memory");
        int anyb = 0;
#pragma unroll
        for (int w = 0; w < 8; ++w) anyb |= gf[w];
        asm volatile("s_waitcnt lgkmcnt(0)\n\ts_barrier" ::: "memory");
        if (__builtin_amdgcn_readfirstlane(anyb)) return false;
    }
    LAS bf16_t* stg = (LAS bf16_t*)(lds + OFF_OST) + wid * 2048;
#pragma unroll
    for (int qb = 0; qb < 2; ++qb) {
        LDS_WAIT();
#pragma unroll
        for (int r = 0; r < 16; ++r) { const int orow = crow(r, hi); const float il = frcp(qb == 0 ? lAcc[r] : lBcc[r]);
#pragma unroll
            for (int db = 0; db < 2; ++db) stg[orow * 64 + db * 32 + r32] = (bf16_t)(pk2((qb == 0 ? oA[db][r] : oB[db][r]) * il, 0.f) & 0xffffu); }
        LDS_WAIT();
        bf16_t* Ow = U.o + (size_t)(wid * 64 + qb * 32) * U.ldo;
#pragma unroll
        for (int i = 0; i < 4; ++i) { const int row = i * 8 + (lane >> 3), ch = lane & 7; const u32x4 v = *(const LAS u32x4*)(stg + row * 64 + ch * 8); *(u32x4*)(Ow + (size_t)row * U.ldo + ch * 8) = v; }
    }
    asm volatile("s_waitcnt lgkmcnt(0)\n\ts_barrier" ::: "memory");
    return true;
}
}

namespace ml {
constexpr int WAVE_LDS = 19328;
constexpr int OFF_VT = 0, OFF_KT = 8192, OFF_TB = 16384;
constexpr int TB_CS = 0, TB_BT = 128, TB_EM = 256, TB_NI = 384, TB_HD = 512, TB_QW = 544;
__device__ __forceinline__ int crow(int r, int hi) { return (r & 3) + 8 * (r >> 2) + 4 * hi; }
__device__ __forceinline__ int chunk_row(int b, int j) { return j < 4 ? ML + b * NC + j * 64 : b * T + (j - 4) * 64; }
__device__ __forceinline__ float prefix_sum(float v, int lane) {
#pragma unroll
    for (int o = 1; o < 64; o <<= 1) { const float t = __shfl_up(v, o); if (lane >= o) v += t; }
    return v;
}
__device__ __forceinline__ float prefix_max(float v, int lane) {
#pragma unroll
    for (int o = 1; o < 64; o <<= 1) { const float t = __shfl_up(v, o); if (lane >= o) v = fmaxf(v, t); }
    return v;
}
__device__ __forceinline__ float suffix_max(float v, int lane) {
#pragma unroll
    for (int o = 1; o < 64; o <<= 1) { const float t = __shfl_down(v, o); if (lane + o < 64) v = fmaxf(v, t); }
    return v;
}
struct Gates { float li[2], bcum[2], g[2]; };
__device__ __forceinline__ void load_gates(const bf16_t* P, int row, int h, const float* igb, const float* fgb, Gates& G, int lane) {
    const bf16_t* gp = P + (size_t)row * NP + PC_GT;
#pragma unroll
    for (int d = 0; d < 2; ++d) {
        const float gi = bf2f(gp[d * 4 + h]) + igb[d * 4 + h], gf = bf2f(gp[8 + d * 4 + h]) + fgb[d * 4 + h];
        const float lf = fminf(gf, 0.f) - log1pf(expf(-fabsf(gf)));
        const float ps = prefix_sum(lf, lane), tot = __shfl(ps, 63);
        G.li[d] = gi; G.g[d] = tot; G.bcum[d] = d == 0 ? ps : tot - ps + lf;
    }
}
__device__ __forceinline__ bf16x8 trfrag(LAS const char* tile, int blk, int ks, int lane) {
    const int hi = lane >> 5, q = (lane & 15) >> 2; LAS const char* p = tile + blk * 4096 + (16 * ks + 8 * hi + q) * 64 + ((lane >> 4) & 1) * 32 + (lane & 3) * 8;
    const s16x4 lo = att::vtr(p), h4 = att::vtr(p + 256);
    return (bf16x8){lo[0], lo[1], lo[2], lo[3], h4[0], h4[1], h4[2], h4[3]};
}
__device__ __forceinline__ void load_vtile(LAS char* vt, const bf16_t* P, int rowbase, int col, int lane) {
#pragma unroll
    for (int i = 0; i < 8; ++i) { const int t = i * 8 + (lane >> 3), c = lane & 7;
        const u32x4 w = *(const u32x4*)(P + (size_t)(rowbase + t) * NP + col + 8 * c); *(LAS u32x4*)(vt + (c >> 2) * 4096 + t * 64 + (c & 3) * 16) = w; }
}
__device__ __forceinline__ void conv8(const bf16_t* P, int row, int col, int pos, int len, const float* w0, const float* w1, const float* w2, float* y) {
    const bf16_t* p = P + (size_t)row * NP + col; float x0[8], x1[8], x2[8];
    unpack8(*(const u32x4*)p, x1);
    if (pos > 0) unpack8(*(const u32x4*)(p - NP), x0); else { for (int e = 0; e < 8; ++e) x0[e] = 0.f; }
    if (pos < len - 1) unpack8(*(const u32x4*)(p + NP), x2); else { for (int e = 0; e < 8; ++e) x2[e] = 0.f; }
#pragma unroll
    for (int e = 0; e < 8; ++e) y[e] = silu_f(x0[e] * w0[e] + x1[e] * w1[e] + x2[e] * w2[e]);
}

__device__ __forceinline__ void chunk_state_unit(LAS char* wl, int b, int h, int j, const bf16_t* P, const float* convw, const float* igb, const float* fgb,
                                                 float* CLOC, float* NLOC, float* MG, int lane) {
    const int r32 = lane & 31, hi = lane >> 5;
    const int rowbase = chunk_row(b, j), len = j < 4 ? NC : T, pos0 = j < 4 ? j * 64 : (j - 4) * 64;
    LAS float* tb = (LAS float*)(wl + OFF_TB);
    u32x4 vraw[8], kr0[8], kr1[8], kr2[8];
    { const int c = lane & 7; const bf16_t* pv = P + (size_t)(rowbase + (lane >> 3)) * NP + PC_MV + h * 64 + 8 * c; const bf16_t* pk = P + (size_t)(rowbase + (lane >> 3)) * NP + PC_MK + h * 64 + 8 * c;
#pragma unroll
      for (int i = 0; i < 8; ++i) { vraw[i] = *(const u32x4*)(pv + (size_t)(8 * i) * NP); kr1[i] = *(const u32x4*)(pk + (size_t)(8 * i) * NP);
          kr0[i] = *(const u32x4*)(pk + (size_t)(8 * i) * NP - NP); kr2[i] = *(const u32x4*)(pk + (size_t)(8 * i) * NP + NP); } }
    Gates G; load_gates(P, rowbase + lane, h, igb, fgb, G, lane);
    float mloc[2];
#pragma unroll
    for (int d = 0; d < 2; ++d) { const float a = G.g[d] - G.bcum[d] + G.li[d]; mloc[d] = wave_max(a); tb[d * 64 + lane] = fexp(a - mloc[d]); }
    { const int c = lane & 7; float w0[8], w1[8], w2[8]; const float* cw = convw + 256 + h * 64 + 8 * c;
#pragma unroll
      for (int e = 0; e < 8; ++e) { w0[e] = cw[e]; w1[e] = cw[512 + e]; w2[e] = cw[1024 + e]; }
#pragma unroll
      for (int i = 0; i < 8; ++i) { const int t = i * 8 + (lane >> 3); float y[8], x0[8], x1[8], x2[8]; unpack8(kr0[i], x0); unpack8(kr1[i], x1); unpack8(kr2[i], x2);
          const bool hp = pos0 + t > 0, hn = pos0 + t < len - 1;
#pragma unroll
          for (int e = 0; e < 8; ++e) y[e] = 0.125f * silu_f((hp ? x0[e] : 0.f) * w0[e] + x1[e] * w1[e] + (hn ? x2[e] : 0.f) * w2[e]);
          *(LAS u32x4*)(wl + OFF_KT + (c >> 2) * 4096 + t * 64 + (c & 3) * 16) = pack8(y); } }
    LDS_WAIT();
#pragma unroll 1
    for (int d = 0; d < 2; ++d) {
        LDS_WAIT();
        { const int c = lane & 7;
#pragma unroll
          for (int i = 0; i < 8; ++i) { const int t = i * 8 + (lane >> 3); const float w = tb[d * 64 + t]; float y[8]; unpack8(vraw[i], y);
#pragma unroll
              for (int e = 0; e < 8; ++e) y[e] *= w;
              *(LAS u32x4*)(wl + OFF_VT + (c >> 2) * 4096 + t * 64 + (c & 3) * 16) = pack8(y); } }
        LDS_WAIT();
        const size_t sidx = ((size_t)((d * NB + b) * 4 + h) * NCHK + j);
        float* cl = CLOC + sidx * 4096;
#pragma unroll
        for (int db = 0; db < 2; ++db) { bf16x8 af[4];
#pragma unroll
            for (int ks = 0; ks < 4; ++ks) af[ks] = trfrag(wl + OFF_VT, db, ks, lane);
#pragma unroll
            for (int dkb = 0; dkb < 2; ++dkb) { f32x16 acc = f32x16{};
#pragma unroll
                for (int ks = 0; ks < 4; ++ks) acc = __builtin_amdgcn_mfma_f32_32x32x16_bf16(af[ks], trfrag(wl + OFF_KT, dkb, ks, lane), acc, 0, 0, 0);
#pragma unroll
                for (int i = 0; i < 16; ++i) cl[(32 * db + crow(i, hi)) * 64 + 32 * dkb + r32] = acc[i]; } }
        { float sacc = 0.f; LAS const bf16_t* kt = (LAS const bf16_t*)(wl + OFF_KT + (lane >> 5) * 4096 + (lane & 31) * 2);
#pragma unroll 8
          for (int t = 0; t < 64; ++t) sacc += bf2f(kt[t * 32]) * tb[d * 64 + t];
          NLOC[sidx * 64 + lane] = sacc; }
        if (lane == 0) { MG[sidx * 2] = d == 0 ? mloc[0] : mloc[1]; MG[sidx * 2 + 1] = d == 0 ? G.g[0] : G.g[1]; }
    }
    LDS_WAIT();
}

__device__ __forceinline__ int step_chunk(int d, int s) { return d == 0 ? s : (s < 4 ? 3 - s : 71 - s); }
__device__ __forceinline__ void scan_item(LAS char* lds, const int wid0, int item, const float* CLOC, const float* NLOC, const float* MG, bf16_t* CIN, float* NIN, float* MIN_) {
    const int tid = wid0 * 64 + fresh_lane(); const int dbh = item >> 2, qd = item & 3, d = dbh >> 5;
    LAS float* mg = (LAS float*)lds; LAS float* wo = mg + 2 * NCHK; LAS float* wn = wo + NCHK;
    __syncthreads();
    if (tid < 2 * NCHK) mg[tid] = MG[(size_t)dbh * NCHK * 2 + tid];
    __syncthreads();
    if (tid == 0) { float m = -INFINITY;
        for (int s = 0; s < NCHK; ++s) { const int j = step_chunk(d, s); const float mj = mg[2 * j], gj = mg[2 * j + 1];
            if (qd == 0) MIN_[(size_t)dbh * NCHK + j] = m;
            const float mn = fmaxf(gj + m, mj); wo[s] = fexp(gj + m - mn); wn[s] = fexp(mj - mn); m = mn; } }
    __syncthreads();
    const float* cl = CLOC + (size_t)dbh * NCHK * 4096; bf16_t* ci = CIN + (size_t)dbh * NCHK * 4096;
    const int e0 = qd * 1024 + tid, e1 = e0 + 512;
    float s0 = 0.f, s1 = 0.f;
    const int en = qd * 16 + (tid & 15); float sn = 0.f; const float* nl = NLOC + (size_t)dbh * NCHK * 64; float* ni = NIN + (size_t)dbh * NCHK * 64;
#pragma unroll 1
    for (int sb = 0; sb < NCHK; sb += 17) { float c0[17], c1[17], cn[17];
#pragma unroll
        for (int i = 0; i < 17; ++i) { const int j = step_chunk(d, sb + i); c0[i] = cl[(size_t)j * 4096 + e0]; c1[i] = cl[(size_t)j * 4096 + e1]; cn[i] = nl[j * 64 + en]; }
#pragma unroll
        for (int i = 0; i < 17; ++i) { const int s = sb + i, j = step_chunk(d, s);
            ci[(size_t)j * 4096 + e0] = (bf16_t)(pk2(s0, 0.f) & 0xffffu); ci[(size_t)j * 4096 + e1] = (bf16_t)(pk2(s1, 0.f) & 0xffffu);
            if (tid < 16) ni[j * 64 + en] = sn;
            s0 = wo[s] * s0 + wn[s] * c0[i]; s1 = wo[s] * s1 + wn[s] * c1[i]; sn = wo[s] * sn + wn[s] * cn[i]; } }
}

__device__ __forceinline__ void out_unit(LAS char* wl, int b, int h, int j, const bf16_t* P, const float* convw, const float* igb, const float* fgb, const float* normw,
                                         const bf16_t* CIN, const float* NIN, const float* MIN_, bf16_t* MIX, int lane) {
    const int r32_ = lane & 31, hi_ = lane >> 5;
    const int rowbase = chunk_row(b, j), len = j < 4 ? NC : T, pos0 = j < 4 ? j * 64 : (j - 4) * 64;
    LAS float* tb = (LAS float*)(wl + OFF_TB);
    float min_d[2];
    { Gates G; load_gates(P, rowbase + lane, h, igb, fgb, G, lane);
#pragma unroll
      for (int d = 0; d < 2; ++d) { const float cs = G.li[d] - G.bcum[d]; const float pm = d == 0 ? prefix_max(cs, lane) : suffix_max(cs, lane);
          const size_t sidx = ((size_t)((d * NB + b) * 4 + h) * NCHK + j);
          const float mi = MIN_[sidx]; min_d[d] = mi;
          const float mt = G.bcum[d] + fmaxf(mi, pm);
          tb[TB_CS + d * 64 + lane] = cs; tb[TB_BT + d * 64 + lane] = G.bcum[d] - mt; tb[TB_EM + d * 64 + lane] = fexp(-mt); tb[TB_NI + d * 64 + lane] = NIN[sidx * 64 + lane]; } }
#pragma unroll
    for (int k = 0; k < 3; ++k) tb[TB_QW + k * 64 + lane] = convw[k * 512 + h * 64 + lane];
    load_vtile(wl + OFF_VT, P, rowbase, PC_MV + h * 64, lane);
    { const int c = lane & 7; float w0[8], w1[8], w2[8]; const float* cw = convw + 256 + h * 64 + 8 * c;
#pragma unroll
      for (int e = 0; e < 8; ++e) { w0[e] = cw[e]; w1[e] = cw[512 + e]; w2[e] = cw[1024 + e]; }
#pragma unroll 2
      for (int i = 0; i < 8; ++i) { const int t = i * 8 + (lane >> 3); float y[8]; conv8(P, rowbase + t, PC_MK + h * 64 + 8 * c, pos0 + t, len, w0, w1, w2, y);
#pragma unroll
          for (int e = 0; e < 8; ++e) y[e] *= 0.125f;
          *(LAS u32x4*)(wl + OFF_KT + c * 1024 + t * 16) = pack8(y); } }
    LDS_WAIT();
#pragma unroll 1
    for (int tbk = 0; tbk < 2; ++tbk) {
        int r32 = r32_, hi = hi_; asm volatile("" : "+v"(r32), "+v"(hi));
        const int t = 32 * tbk + r32;
        const int vaddr = ((lane >> 4) & 1) * 32 + (lane & 3) * 8 + (4 * hi + ((lane & 15) >> 2)) * 64;
        u32x4 qf[4];
#pragma unroll
        for (int d0 = 0; d0 < 4; ++d0) { const int c = 2 * d0 + hi; float w0[8], w1[8], w2[8], y[8];
#pragma unroll
            for (int e = 0; e < 8; ++e) { w0[e] = tb[TB_QW + 8 * c + e]; w1[e] = tb[TB_QW + 64 + 8 * c + e]; w2[e] = tb[TB_QW + 128 + 8 * c + e]; }
            conv8(P, rowbase + t, PC_MQ + h * 64 + 8 * c, pos0 + t, len, w0, w1, w2, y); qf[d0] = pack8(y); }
        f32x16 hs[2]; hs[0] = f32x16{}; hs[1] = f32x16{};
#pragma unroll 1
        for (int d = 0; d < 2; ++d) {
            const size_t sidx = ((size_t)((d * NB + b) * 4 + h) * NCHK + j);
            const float mi = d == 0 ? min_d[0] : min_d[1];
            const float bt = tb[TB_BT + d * 64 + t], em = tb[TB_EM + d * 64 + t];
            const float wi = (mi == -INFINITY) ? 0.f : fexp(bt + mi);
            f32x16 p[2];
#pragma unroll
            for (int sb = 0; sb < 2; ++sb) { p[sb] = f32x16{};
#pragma unroll
                for (int d0 = 0; d0 < 4; ++d0) { const bf16x8 kfr = *(const LAS bf16x8*)(wl + OFF_KT + (2 * d0 + hi) * 1024 + (32 * sb + r32) * 16);
                    p[sb] = __builtin_amdgcn_mfma_f32_32x32x16_bf16(kfr, __builtin_bit_cast(bf16x8, qf[d0]), p[sb], 0, 0, 0); } }
            float ds = 0.f;
#pragma unroll
            for (int sb = 0; sb < 2; ++sb)
#pragma unroll
                for (int i = 0; i < 16; ++i) { const int s_ = 32 * sb + crow(i, hi); const bool valid = d == 0 ? (s_ <= t) : (s_ >= t);
                    const float w = valid ? fexp(bt + tb[TB_CS + d * 64 + s_]) : 0.f; p[sb][i] *= w; ds += p[sb][i]; }
            ds = half_sum(ds);
            float qn = 0.f; u32x4 qw[4];
#pragma unroll
            for (int d0 = 0; d0 < 4; ++d0) { float y[8]; unpack8(qf[d0], y);
#pragma unroll
                for (int e = 0; e < 8; ++e) { qn += y[e] * tb[TB_NI + d * 64 + 16 * d0 + 8 * hi + e]; y[e] *= wi; }
                qw[d0] = pack8(y); }
            qn = half_sum(qn);
            const float den = ds + wi * qn; const float hd = frcp(fmaxf(fabsf(den), em));
            LDS_WAIT();
            if (hi == 0) tb[TB_HD + r32] = hd;
            LDS_WAIT();
            u32x4 pw[4];
#pragma unroll
            for (int jj = 0; jj < 4; ++jj) { pw[0][jj] = pk2(p[0][2 * jj], p[0][2 * jj + 1]); pw[1][jj] = pk2(p[0][8 + 2 * jj], p[0][9 + 2 * jj]); pw[2][jj] = pk2(p[1][2 * jj], p[1][2 * jj + 1]); pw[3][jj] = pk2(p[1][8 + 2 * jj], p[1][9 + 2 * jj]); }
#pragma unroll
            for (int db = 0; db < 2; ++db) { f32x16 acc = f32x16{};
                const bf16_t* cp = CIN + sidx * 4096 + (size_t)(32 * db + r32) * 64 + 8 * hi; bf16x8 cf[4];
#pragma unroll
                for (int d0 = 0; d0 < 4; ++d0) cf[d0] = *(const bf16x8*)(cp + d0 * 16);
#pragma unroll
                for (int k = 0; k < 4; ++k) { LAS const char* vs = wl + OFF_VT + vaddr + db * 4096 + k * 1024; const s16x4 lo = att::vtr(vs), h4 = att::vtr(vs + 512);
                    const bf16x8 vf = (bf16x8){lo[0], lo[1], lo[2], lo[3], h4[0], h4[1], h4[2], h4[3]};
                    acc = __builtin_amdgcn_mfma_f32_32x32x16_bf16(__builtin_bit_cast(bf16x8, pw[k]), vf, acc, 0, 0, 0); }
#pragma unroll
                for (int d0 = 0; d0 < 4; ++d0) acc = __builtin_amdgcn_mfma_f32_32x32x16_bf16(__builtin_bit_cast(bf16x8, qw[d0]), cf[d0], acc, 0, 0, 0);
#pragma unroll
                for (int i = 0; i < 16; ++i) hs[db][i] += acc[i] * tb[TB_HD + crow(i, hi)]; }
        }
        const float nw0 = normw[h * 64 + r32], nw1 = normw[h * 64 + 32 + r32];
        const unsigned offp = (unsigned)((rowbase + 32 * tbk + 4 * hi) * NP + PC_MO + h * 64 + r32) * 2u, offm = (unsigned)((rowbase + 32 * tbk + 4 * hi) * D + h * 64 + r32) * 2u;
#pragma unroll
        for (int i = 0; i < 16; ++i) { float ss = hs[0][i] * hs[0][i] + hs[1][i] * hs[1][i];
            ss += __shfl_xor(ss, 1); ss += __shfl_xor(ss, 2); ss += __shfl_xor(ss, 4); ss += __shfl_xor(ss, 8); ss += __shfl_xor(ss, 16);
            const float sc = 1.0f / sqrtf(ss * (1.0f / 64.0f) + EPS);
            const unsigned ro = (unsigned)((i & 3) + 8 * (i >> 2));
            const bf16_t* op = (const bf16_t*)((const char*)P + (offp + ro * (unsigned)(NP * 2))); bf16_t* mp = (bf16_t*)((char*)MIX + (offm + ro * (unsigned)(D * 2)));
            mp[0] = (bf16_t)(pk2(hs[0][i] * sc * nw0 * sigmoid_f(bf2f(op[0])), 0.f) & 0xffffu);
            mp[32] = (bf16_t)(pk2(hs[1][i] * sc * nw1 * sigmoid_f(bf2f(op[32])), 0.f) & 0xffffu);
            if ((i & 3) == 3) asm volatile("" ::: "memory"); }
    }
    LDS_WAIT();
}
}

#define XB_TMO      128
#define XB_XCNT(j)  (256  + 64 * (j))
#define XB_XSUB(j)  (1280 + 64 * (j))
#define XB_XGEN(j)  (2304 + 64 * (j))
#define XB_TOP      3328
#define XB_TOPGEN   3392
#define XCD_BAR_WORDS 3456
#define XB_SPIN_CAP (1u << 18)
__device__ __forceinline__ unsigned xb_ld(unsigned* p)              { return __hip_atomic_load(p, __ATOMIC_RELAXED, __HIP_MEMORY_SCOPE_AGENT); }
__device__ __forceinline__ unsigned xb_add(unsigned* p, unsigned v) { return __hip_atomic_fetch_add(p, v, __ATOMIC_RELAXED, __HIP_MEMORY_SCOPE_AGENT); }
__device__ __forceinline__ unsigned xb_xcc_id() { return (unsigned)__builtin_amdgcn_s_getreg((3 << 11) | 20) & 0xFu; }
#define XB_SPIN(cond, bar) do { unsigned _sp = 0; while (cond) { __builtin_amdgcn_s_sleep(1); \
    if ((++_sp & 255u) == 0u) { if (xb_ld(&(bar)[XB_TMO])) break; if (_sp > XB_SPIN_CAP) { atomicAdd(&(bar)[XB_TMO], 1u); break; } } } } while (0)
struct XcdBarrier { unsigned* bar; unsigned x; volatile LAS unsigned* st; };
__device__ __forceinline__ XcdBarrier xcd_barrier_post(unsigned* bar, volatile LAS unsigned* st) {
    XcdBarrier b; b.bar = bar; b.x = xb_xcc_id(); b.st = st;
    if (threadIdx.x == 0) (void)xb_add(&bar[XB_XCNT(b.x)], 1u);
    return b;
}
__device__ __forceinline__ void xcd_barrier_complete(unsigned* bar, unsigned x, unsigned& nloc, unsigned& nx) {
    const unsigned G = gridDim.x * gridDim.y * gridDim.z;
    unsigned sum, cnt, mine, sp = 0u;
    for (;;) {
        sum = 0u; cnt = 0u; mine = 0u;
#pragma unroll
        for (unsigned j = 0; j < 16; ++j) { const unsigned c = xb_ld(&bar[XB_XCNT(j)]); sum += c; cnt += (c > 0u) ? 1u : 0u; mine = (j == x) ? c : mine; }
        if (sum == G) break;
        __builtin_amdgcn_s_sleep(1);
        if ((++sp & 255u) == 0u) { if (xb_ld(&bar[XB_TMO])) break; if (sp > XB_SPIN_CAP) { atomicAdd(&bar[XB_TMO], 1u); break; } }
    }
    nloc = mine > 0u ? mine : 1u; nx = cnt > 0u ? cnt : 1u;
}
__device__ __forceinline__ void xcd_barrier(const XcdBarrier& b) {
    asm volatile("s_waitcnt vmcnt(0)" ::: "memory");
    __syncthreads();
    if (threadIdx.x == 0) {
        unsigned* bar = b.bar;
        __builtin_amdgcn_s_waitcnt(0);
        unsigned nloc = b.st[0], nx = b.st[1];
        if (nloc == 0u) { xcd_barrier_complete(bar, b.x, nloc, nx); b.st[0] = nloc; b.st[1] = nx; }
        const unsigned old = xb_add(&bar[XB_XSUB(b.x)], 1u);
        const unsigned gen = old / nloc;
        if (old + 1u == (gen + 1u) * nloc) {
            __builtin_amdgcn_fence(__ATOMIC_RELEASE, "agent");
            asm volatile("s_waitcnt vmcnt(0)" ::: "memory");
            const unsigned og = xb_add(&bar[XB_TOP], 1u);
            const unsigned tg = og / nx;
            if (og + 1u == (tg + 1u) * nx) xb_add(&bar[XB_TOPGEN], 1u);
            else XB_SPIN(xb_ld(&bar[XB_TOPGEN]) == tg, bar);
            __builtin_amdgcn_fence(__ATOMIC_ACQUIRE, "agent");
            xb_add(&bar[XB_XGEN(b.x)], 1u);
            asm volatile("s_waitcnt vmcnt(0)" ::: "memory");
        } else {
            XB_SPIN(xb_ld(&bar[XB_XGEN(b.x)]) == gen, bar);
            __builtin_amdgcn_fence(__ATOMIC_ACQUIRE, "agent");
            asm volatile("s_waitcnt vmcnt(0)" ::: "memory");
        }
    }
    __syncthreads();
}

struct Args { const float* in[27]; float* out; unsigned char* ws; int ph_lo, ph_hi; };
enum { I_X = 0, I_C, I_CTX, I_CCTX, I_ADAW, I_ADAB, I_N1W, I_N2W, I_WIN, I_WOUT, I_CONVW, I_IGB, I_FGB, I_MLNW, I_RPB, I_QNW, I_KVNW, I_WUQ, I_WUKV, I_F1, I_F3, I_F2, I_RW, I_M1, I_M3, I_M2, I_FNW };

struct TrJob { const float* src; const float* src2; int ldn, K, ngrp, kind; bf16_t* dst; const float* ksc; float cs; };
struct TrItem { const float* sp; const float* kp; bf16_t* dp; int ldn, K; float cs; };
__device__ __forceinline__ void tr_resolve(const TrJob& J, int it, int lane, TrItem& T) {
    const int g = it % J.ngrp, kb = it / J.ngrp, c0 = 16 * g, k0 = 64 * kb; const float* src = J.src; int sc0 = c0; float cs = J.cs;
    if (J.kind == 1) {
        if (c0 < 512) sc0 = 2192 + c0; else if (c0 < 768) sc0 = 2704 + (c0 - 512); else if (c0 < 1792) sc0 = c0 - 768;
        else if (c0 < 2944) { sc0 = 1040 + (c0 - 1792); if (c0 < 2176) cs = 0.125f * LOG2E; }
        else if (c0 < 2976) sc0 = 2960 + (c0 - 2944); else if (c0 < 2992) sc0 = 1024 + (c0 - 2976); else { sc0 = 0; cs = 0.f; }
    } else if (J.kind == 2) {
        if (c0 < 384) sc0 = (c0 >> 6) * 96 + (c0 & 63); else { const int r = c0 - 384; sc0 = (r >> 5) * 96 + 64 + (r & 31); }
    } else if (J.kind == 3) {
        const int pn = c0 >> 8, cc = c0 & 255; if (cc >= 128) src = J.src2; sc0 = 128 * pn + (cc & 127);
    }
    T.sp = src + (size_t)(k0 + (lane >> 4)) * J.ldn + sc0 + (lane & 15); T.kp = J.ksc ? J.ksc + k0 + (lane >> 4) : nullptr; T.ldn = J.ldn; T.K = J.K; T.cs = cs;
    T.dp = J.dst + (size_t)c0 * J.K + k0;
}
__device__ __forceinline__ void tr_load(const TrItem& T, float (&v)[16], float (&kv)[16]) {
#pragma unroll
    for (int i = 0; i < 16; ++i) v[i] = T.sp[(size_t)(4 * i) * T.ldn];
    if (T.kp) {
#pragma unroll
        for (int i = 0; i < 16; ++i) kv[i] = T.kp[4 * i]; }
    else {
#pragma unroll
        for (int i = 0; i < 16; ++i) kv[i] = 1.f; }
}
__device__ __forceinline__ void tr_store(const TrItem& T, const float (&v)[16], const float (&kv)[16], LAS float* scr, int lane) {
#pragma unroll
    for (int i = 0; i < 16; ++i) scr[(4 * i + (lane >> 4)) * 17 + (lane & 15)] = v[i] * T.cs * kv[i];
    LDS_WAIT();
#pragma unroll
    for (int j = 0; j < 2; ++j) { const int id = lane + 64 * j, n = id >> 3, c = id & 7; float y[8];
#pragma unroll
        for (int e = 0; e < 8; ++e) y[e] = scr[(8 * c + e) * 17 + n];
        *(u32x4*)(T.dp + (size_t)n * T.K + 8 * c) = pack8(y); }
    LDS_WAIT();
}
template <class R> __device__ __forceinline__ void tr_run(int first, int stride, int total, const R& resolve, LAS float* scr, int lane) {
    int it = first; if (it >= total) return;
    TrItem Tc; float vc[16], kc[16]; resolve(it, Tc); tr_load(Tc, vc, kc);
    for (;;) {
        const int itn = it + stride; const bool hn = itn < total; TrItem Tn = Tc; float vn[16], kn[16];
        if (hn) { resolve(itn, Tn); tr_load(Tn, vn, kn); }
        else {
#pragma unroll
            for (int i = 0; i < 16; ++i) { vn[i] = 0.f; kn[i] = 0.f; } }
        tr_store(Tc, vc, kc, scr, lane);
        if (!hn) break;
        Tc = Tn;
#pragma unroll
        for (int i = 0; i < 16; ++i) { vc[i] = vn[i]; kc[i] = kn[i]; }
        it = itn;
    }
}
__device__ __forceinline__ void tr_load_nk(const TrItem& T, float (&v)[16]) {
#pragma unroll
    for (int i = 0; i < 16; ++i) v[i] = T.sp[(size_t)(4 * i) * T.ldn];
}
__device__ __forceinline__ void tr_store_nk(const TrItem& T, const float (&v)[16], LAS float* scr, int lane) {
#pragma unroll
    for (int i = 0; i < 16; ++i) scr[(4 * i + (lane >> 4)) * 17 + (lane & 15)] = v[i] * T.cs;
    LDS_WAIT();
#pragma unroll
    for (int j = 0; j < 2; ++j) { const int id = lane + 64 * j, n = id >> 3, c = id & 7; float y[8];
#pragma unroll
        for (int e = 0; e < 8; ++e) y[e] = scr[(8 * c + e) * 17 + n];
        *(u32x2*)((unsigned char*)T.dp + (size_t)n * T.K + 8 * c) = pack8_f8(y); }
    LDS_WAIT();
}
template <class R> __device__ __forceinline__ void tr_run2(int first, int stride, int total, const R& resolve, LAS float* scr, int lane) {
    int it = first; if (it >= total) return;
    TrItem Ta, Tb; float va[16], vb[16]; bool hb = it + stride < total;
    resolve(it, Ta); tr_load_nk(Ta, va); Tb = Ta;
    if (hb) { resolve(it + stride, Tb); tr_load_nk(Tb, vb); }
    else {
#pragma unroll
        for (int i = 0; i < 16; ++i) vb[i] = 0.f; }
    for (;;) {
        const int itn = it + 2 * stride; const bool hn = itn < total, hnb = itn + stride < total; TrItem Tna = Ta, Tnb = Ta; float vna[16], vnb[16];
        if (hn) { resolve(itn, Tna); tr_load_nk(Tna, vna); }
        else {
#pragma unroll
            for (int i = 0; i < 16; ++i) vna[i] = 0.f; }
        if (hnb) { resolve(itn + stride, Tnb); tr_load_nk(Tnb, vnb); }
        else {
#pragma unroll
            for (int i = 0; i < 16; ++i) vnb[i] = 0.f; }
        tr_store_nk(Ta, va, scr, lane);
        if (hb) tr_store_nk(Tb, vb, scr, lane);
        if (!hn) break;
        Ta = Tna; Tb = Tnb; hb = hnb;
#pragma unroll
        for (int i = 0; i < 16; ++i) { va[i] = vna[i]; vb[i] = vnb[i]; }
        it = itn;
    }
}
__device__ __forceinline__ int tr_job_count(const TrJob& J) { return J.ngrp * (J.K / 64); }

__device__ __forceinline__ void mod_item(LAS char* lds, const int wid0, int item, const float* c, const float* cctx, const float* adaw, const float* adab, float* modv) {
    const int lane = fresh_lane(), wid = wid0, tid = wid * 64 + lane, l = item / 96, ng = item % 96;
    LAS float* sc = (LAS float*)lds;
    LAS float* part = sc + 9 * 1024;
    __syncthreads();
    for (int i = tid; i < 9 * 1024; i += 512) { const float v = i < 8 * 1024 ? c[i] : cctx[i - 8 * 1024]; sc[i] = silu_f(v); }
    __syncthreads();
    float acc[9];
#pragma unroll
    for (int bi = 0; bi < 9; ++bi) acc[bi] = 0.f;
    const float* w = adaw + (size_t)l * 1024 * 6144 + ng * 64 + lane;
#pragma unroll 1
    for (int k0 = wid * 128; k0 < wid * 128 + 128; k0 += 16) { float wv[16];
#pragma unroll
        for (int i = 0; i < 16; ++i) wv[i] = w[(size_t)(k0 + i) * 6144];
#pragma unroll
        for (int i = 0; i < 16; ++i)
#pragma unroll
            for (int bi = 0; bi < 9; ++bi) acc[bi] += sc[bi * 1024 + k0 + i] * wv[i]; }
#pragma unroll
    for (int bi = 0; bi < 9; ++bi) part[(wid * 9 + bi) * 64 + lane] = acc[bi];
    __syncthreads();
    for (int i = tid; i < 9 * 64; i += 512) { const int bi = i >> 6, n = i & 63; float s = adab[l * 6144 + ng * 64 + n];
#pragma unroll
        for (int w8 = 0; w8 < 8; ++w8) s += part[(w8 * 9 + bi) * 64 + n];
        modv[((size_t)l * 9 + bi) * 6144 + ng * 64 + n] = s; }
}

__device__ __forceinline__ void norm_row(const float* xrow, const float* nw, const float* shift, const float* scale, int lane, f32x4 (&v)[4], const bf16_t* dl = nullptr, float* xw = nullptr, int nparts = 1, size_t pstride = 0) {
    float s = 0.f;
#pragma unroll
    for (int j = 0; j < 4; ++j) { v[j] = *(const f32x4*)(xrow + 4 * lane + 256 * j);
        if (dl) { for (int p = 0; p < nparts; ++p) { const u32x2 dw = *(const u32x2*)(dl + (size_t)p * pstride + 4 * lane + 256 * j); v[j].x += bf2f(dw.x & 0xffffu); v[j].y += __uint_as_float(dw.x & 0xffff0000u); v[j].z += bf2f(dw.y & 0xffffu); v[j].w += __uint_as_float(dw.y & 0xffff0000u); }
            *(f32x4*)(xw + 4 * lane + 256 * j) = v[j]; }
        s += (v[j].x * v[j].x + v[j].y * v[j].y) + (v[j].z * v[j].z + v[j].w * v[j].w); }
    const float rs = 1.0f / sqrtf(wave_sum(s) * (1.0f / D) + EPS);
#pragma unroll
    for (int j = 0; j < 4; ++j) { const int c = 4 * lane + 256 * j; const f32x4 w = *(const f32x4*)(nw + c), sh = *(const f32x4*)(shift + c), sc = *(const f32x4*)(scale + c);
        v[j] = (v[j] * rs * w) * (1.0f + sc) + sh; }
}
__device__ __forceinline__ void store_row_bf16(bf16_t* orow, int lane, const f32x4 (&v)[4]) {
#pragma unroll
    for (int j = 0; j < 4; ++j) { u32x2 w; w.x = pk2(v[j].x, v[j].y); w.y = pk2(v[j].z, v[j].w); *(u32x2*)(orow + 4 * lane + 256 * j) = w; }
}

constexpr int XBP = pg8::XBP;
__device__ __forceinline__ void xb_load(const bf16_t* xrow, int lane, u32x4 (&w)[2]) { w[0] = *(const u32x4*)(xrow + 8 * lane); w[1] = *(const u32x4*)(xrow + 8 * lane + 512); }
__device__ __forceinline__ void norm_fin_b(const u32x4 (&w)[2], const float* nw, const float* shift, const float* scale, int lane, float (&v)[16]) {
    unpack8(w[0], v); unpack8(w[1], v + 8);
    float s = 0.f;
#pragma unroll
    for (int e = 0; e < 16; ++e) s += v[e] * v[e];
    const float rs = 1.0f / sqrtf(wave_sum(s) * (1.0f / D) + EPS);
#pragma unroll
    for (int j = 0; j < 2; ++j)
#pragma unroll
        for (int h = 0; h < 2; ++h) { const int c = 8 * lane + 512 * j + 4 * h; const f32x4 wv = *(const f32x4*)(nw + c), sh = *(const f32x4*)(shift + c), sc = *(const f32x4*)(scale + c);
#pragma unroll
            for (int q = 0; q < 4; ++q) v[8 * j + 4 * h + q] = (v[8 * j + 4 * h + q] * rs * wv[q]) * (1.0f + sc[q]) + sh[q]; }
}
__device__ __forceinline__ void store_row_b(bf16_t* orow, int lane, const float (&v)[16]) { *(u32x4*)(orow + 8 * lane) = pack8(v); *(u32x4*)(orow + 8 * lane + 512) = pack8(v + 8); }


#if !MK_MULTI
#define GRID_BAR() do { XcdBarrier b2_ = bar; asm volatile("" : "+s"(b2_.bar)); xcd_barrier(b2_); } while (0)
#define OPQ(x) (x)
#else
#define GRID_BAR() do {} while (0)
#define OPQ(x) ({ int _v = (x); asm volatile("" : "+s"(_v)); _v; })
#endif
#ifndef MK_SITES
#define MK_SITES 0xffffffffu
#endif
#define EN(s) (((MK_SITES) >> (s)) & 1u)
#define IN(k) (OPQ(lo) <= (k) && (k) < OPQ(hi_ph))
#define SEAM(k) do { if (IN(k) && IN((k) + 1)) GRID_BAR(); } while (0)
#define PHASE_WS() GAS unsigned char* ws = (GAS unsigned char*)args.ws; asm volatile("" : "+s"(ws))
#define PHASE_IDS() PHASE_WS(); const int lane = fresh_lane(), wid = wid0, tid = wid * 64 + lane, gw = blockIdx.x * 8 + wid; (void)lane; (void)gw; (void)tid

#define x_in (args.in[I_X])
#define ctx_in (args.in[I_CTX])
#define xout (args.out)
#define XB ((bf16_t*)args.out + 1024)
#define modv ((float*)(ws + SM_MOD))
#define ropet ((float*)(ws + SM_ROPE))
#define stats ((float*)(ws + SM_STATS))
#define NLOC ((float*)(ws + SM_NLOC))
#define NIN ((float*)(ws + SM_NIN))
#define MG ((float*)(ws + SM_MG))
#define MINb ((float*)(ws + SM_MIN))
#define xc ((float*)(ws + WS_XC))
#define BH ((bf16_t*)(ws + WS_H))
#define CLOC ((float*)(ws + WS_H))
#define BP ((bf16_t*)(ws + WS_P))
#define QM ((bf16_t*)(ws + WS_QM))
#define KVM ((bf16_t*)(ws + WS_KVM))
#define CIN ((bf16_t*)(ws + WS_CIN))
#define Win ((bf16_t*)(ws + W_IN))
#define Wout ((bf16_t*)(ws + W_OUT))
#define Wuq ((bf16_t*)(ws + W_UQ))
#define Wukv ((bf16_t*)(ws + W_UKV))
#define Wf13 ((bf16_t*)(ws + W_F13))
#define Wf2 ((bf16_t*)(ws + W_F2))
#define tokinfo ((int*)(ws + SM_TOK))
#define tokg ((float*)(ws + SM_TOKG))
#define wgcnt ((int*)(ws + SM_WGCNT))
#define rowtok ((int*)(ws + SM_ROWTOK))
#define rowgate ((float*)(ws + SM_ROWGATE))
#define tileexp ((int*)(ws + SM_TILEEXP))
#define WMOE ((bf16_t*)(ws + WS_WMOE))
#define UB ((bf16_t*)(ws + WS_U))
#define A8 ((unsigned char*)(ws + WS_A8))
#define ASORT ((bf16_t*)(ws + WS_ASORT))
#define PBY ((bf16_t*)(ws + WS_PBY))
#define PBF ((bf16_t*)(ws + WS_PBF))
#define PBW ((bf16_t*)(ws + WS_PBW))

template <int L> __device__ __forceinline__ void layer_phases(const Args& args, LAS unsigned char* lds, const int G, const int NGW, const XcdBarrier& bar, const int lo, const int hi_ph, const int wid0) {
    constexpr int l = L; constexpr int pb = 1 + 10 * l;

#define mod_l (modv + (size_t)l * 9 * 6144)
        if (EN(1) && IN(pb + 0)) { PHASE_IDS();
            const float* nw = args.in[I_N1W] + l * D;
            if (l == 0) {
                for (int r = gw; r < M; r += NGW) { const bool lat = r < ML; const int bi = lat ? (r >> 12) : 8;
                    const float* xr = lat ? (x_in + (size_t)r * D) : (ctx_in + (size_t)(r - ML) * D);
                    f32x4 v[4]; norm_row(xr, nw, mod_l + bi * 6144, mod_l + bi * 6144 + 1024, lane, v); store_row_bf16(BH + (size_t)r * D, lane, v); }
            } else {
                for (int r = gw; r < ML; r += 2 * NGW) { const int rB = r + NGW; const bool hb = rB < ML;
                    u32x4 wa[2], wb[2]; xb_load(XB + (size_t)r * XBP, lane, wa); xb_load(XB + (size_t)(hb ? rB : r) * XBP, lane, wb);
                    float v[16]; norm_fin_b(wa, nw, mod_l + (r >> 12) * 6144, mod_l + (r >> 12) * 6144 + 1024, lane, v); store_row_b(BH + (size_t)r * D, lane, v);
                    if (hb) { norm_fin_b(wb, nw, mod_l + (rB >> 12) * 6144, mod_l + (rB >> 12) * 6144 + 1024, lane, v); store_row_b(BH + (size_t)rB * D, lane, v); } }
                for (int r = ML + gw; r < M; r += NGW) { float* xr = xc + (size_t)(r - ML) * D;
                    f32x4 v[4]; norm_row(xr, nw, mod_l + 8 * 6144, mod_l + 8 * 6144 + 1024, lane, v, PBF + (size_t)(r - ML) * D, xr, 8, (size_t)MC * D); store_row_bf16(BH + (size_t)r * D, lane, v); }
            }
        }
        SEAM(pb + 0);
        if (EN(2) && IN(pb + 1)) { PHASE_WS();
            pg8::Gemm g{BH, D, Win + (size_t)l * 3072 * 1024, D}; pg8::StaticOrder S; S.init(M / 256, NP / 256, G, blockIdx.x, D);
            pg8::EpiP E{BP, stats, ropet};
            pg8::gemm_phase<pg8::EpiP, pg8::StaticOrder, true>(lds, g, S, E, wid0);
        }
        SEAM(pb + 1);
        if (EN(3) && IN(pb + 2)) { PHASE_WS();
            if (EN(18)) { pg8::Gemm g{BP + PC_QL, NP, Wuq + (size_t)l * 768 * 512, 512}; pg8::StaticOrder S; S.init(M / 256, 3, G, blockIdx.x, 512);
              pg8::EpiRS<true> E{QM, NQM, NQM, 384, stats, 0, 16, 1.0f / 512.0f, ropet};
              pg8::gemm_phase<pg8::EpiRS<true>, pg8::StaticOrder, true>(lds, g, S, E, wid0); }
            __syncthreads();
            if (EN(19)) { pg8::Gemm g{BP + PC_KVL, NP, Wukv + (size_t)l * 768 * 256, 256}; pg8::StaticOrder S; S.init(M / 256, 3, G, blockIdx.x, 256);
              pg8::EpiRS<false> E{KVM, NKVM, NKVM, NKVM, stats, 16, 8, 1.0f / 256.0f, ropet};
              pg8::gemm_phase<pg8::EpiRS<false>, pg8::StaticOrder, true>(lds, g, S, E, wid0); }
            __syncthreads();
            { PHASE_IDS();
            const float* convw = args.in[I_CONVW] + (size_t)l * 3 * 512; const float* igb = args.in[I_IGB] + l * 8; const float* fgb = args.in[I_FGB] + l * 8;
            for (int k = 0; ; ++k) { const int u = (k & 1) ? k * NGW + (NGW - 1 - gw) : k * NGW + gw;
                if (u >= NB * 4 * NCHK) { if (k * NGW >= NB * 4 * NCHK) break; else continue; }
                const int j = u % NCHK, bh = u / NCHK; int lane_ = lane; asm volatile("" : "+v"(lane_));
                if (EN(17)) ml::chunk_state_unit((LAS char*)lds + wid * ml::WAVE_LDS, bh >> 2, bh & 3, j, BP, convw, igb, fgb, CLOC, NLOC, MG, lane_); } }
        }
        SEAM(pb + 2);
        if (EN(4) && IN(pb + 3)) { PHASE_WS(); for (int item = blockIdx.x; item < 256; item += G) ml::scan_item((LAS char*)lds, wid0, item, CLOC, NLOC, MG, CIN, NIN, MINb); }
        SEAM(pb + 3);
        if (EN(5) && IN(pb + 4)) { GAS unsigned char* ws_ph = (GAS unsigned char*)args.ws;
            const float* convw = args.in[I_CONVW] + (size_t)l * 3 * 512; const float* igb = args.in[I_IGB] + l * 8; const float* fgb = args.in[I_FGB] + l * 8;
            const float* mnw = args.in[I_MLNW] + l * 256;
#ifndef MK_REP_MLA
#define MK_REP_MLA 1
#endif
#ifndef MK_REP_NA
#define MK_REP_NA 1
#endif
#ifndef MK_REP_ML
#define MK_REP_ML 1
#endif
            constexpr int n_mla1 = NB * 6 * 8, n_na1 = NB * 6 * 16, n_ml1 = (l == 0) ? NB * 4 * NCHK / 8 : NB * 4 * 64 / 8;
            constexpr int n_mla = n_mla1 * MK_REP_MLA, n_na = n_na1 * MK_REP_NA, n_ml = n_ml1 * MK_REP_ML, n_ctx = (l == 0) ? NB * 6 * 2 : 0;
            constexpr int n_items = n_mla + n_na + n_ml + n_ctx;
            volatile LAS int* qslot = (volatile LAS int*)(lds + LDS_MISC + 64);
            for (;;) {
                GAS unsigned char* ws = ws_ph; asm volatile("" : "+s"(ws));
                int wid_i = wid0; asm volatile("" : "+s"(wid_i));
                const int lane = fresh_lane(), tid = wid_i * 64 + lane;
                bf16_t* MIX = BH;
                __syncthreads();
                if (tid == 0) *qslot = (int)__hip_atomic_fetch_add((unsigned*)(ws + WS_CTL) + CW_QUEUE + l * 64, 1u, __ATOMIC_RELAXED, __HIP_MEMORY_SCOPE_AGENT);
                __syncthreads();
                const int u = __builtin_amdgcn_readfirstlane(*qslot);
                if (u >= n_items) break;
                att::Unit U;
                if (u < n_mla) { const int u1 = u % n_mla1; const int qb = u1 & 7, bh = u1 >> 3, b = bh / 6, h = bh % 6; const int row0 = b * T + qb * 512;
                    U.qn = QM + (size_t)row0 * NQM + h * 64; U.ldq = NQM; U.qr = QM + (size_t)row0 * NQM + 384 + h * 32; U.ldqr = NQM;
                    U.kn = KVM + h * 128; U.ldk = NKVM; U.kr = BP + PC_KR; U.ldkr = NP; U.v = KVM + h * 128 + 64; U.ldv = NKVM;
                    U.o = MIX + (size_t)row0 * D + 640 + h * 64; U.ldo = D; U.na = 64; U.rowa = b * T; U.rowc = ML + b * NC; U.rg = 0; U.rlo = 0;
                    if (EN(15)) { const bool ok = att::attn_unit64((LAS char*)lds, U, wid_i);
                        if (!ok && tid == 0) { unsigned* rd = (unsigned*)(ws + WS_CTL) + CW_REDO + l * 512; const unsigned ix = __hip_atomic_fetch_add(rd, 1u, __ATOMIC_RELAXED, __HIP_MEMORY_SCOPE_AGENT); rd[1 + ix] = (unsigned)u; } }
                } else if (u < n_mla + n_na) { const int v = (u - n_mla) % n_na1, rg = v & 15, bh = v >> 4, b = bh / 6, h = bh % 6; const int row0 = b * T + rg * 256;
                    const int rlo = min(max(4 * rg - 4, 0), 56), rhi = min(max(4 * rg - 1, 0), 56) + 7;
                    { LAS float* bt = (LAS float*)(lds + att::OFF_BIAS); const float* rp = args.in[I_RPB] + ((size_t)l * 6 + h) * 15 * 31;
                      for (int i = tid; i < 640; i += 512) { const int k = i - 64; bt[i] = (k >= 0 && k < 465) ? rp[k] * LOG2E : 0.f; } }
                    __syncthreads();
                    U.qn = BP + (size_t)row0 * NP + PC_NQ + h * 64; U.ldq = NP; U.qr = nullptr; U.ldqr = 0;
                    U.kn = BP + PC_NK + h * 64; U.ldk = NP; U.kr = nullptr; U.ldkr = 0; U.v = BP + PC_NV + h * 64; U.ldv = NP;
                    U.o = MIX + (size_t)row0 * D + 256 + h * 64; U.ldo = D; U.na = rhi - rlo + 1; U.rowa = b * T + rlo * 64; U.rowc = ML + b * NC; U.rg = rg; U.rlo = rlo;
                    if (EN(15)) { const bool ok = att::attn_unit<8, true, true>((LAS char*)lds, U, wid_i);
                        if (!ok && tid == 0) { unsigned* rd = (unsigned*)(ws + WS_CTL) + CW_REDO2 + l * 1024; const unsigned ix = __hip_atomic_fetch_add(rd, 1u, __ATOMIC_RELAXED, __HIP_MEMORY_SCOPE_AGENT); rd[1 + ix] = (unsigned)(u - n_mla); } }
                } else if (u < n_mla + n_na + n_ml) { const int id = ((u - n_mla - n_na) % n_ml1) * 8 + wid_i; int lane_ = lane; asm volatile("" : "+v"(lane_));
                    const int bh = (l == 0) ? id / NCHK : id >> 6, j = (l == 0) ? id % NCHK : 4 + (id & 63);
                    if (EN(16)) ml::out_unit((LAS char*)lds + wid_i * ml::WAVE_LDS, bh >> 2, bh & 3, j, BP, convw, igb, fgb, mnw, CIN, NIN, MINb, MIX, lane_);
                } else { const int v = u - n_mla - n_na - n_ml, kind = v & 1, bh = v >> 1, b = bh / 6, h = bh % 6; const int row0 = ML + b * NC;
                    U.na = 0; U.rowa = 0; U.rowc = row0; U.rg = 0; U.rlo = 0; U.ldo = D;
                    if (kind == 0) { U.qn = QM + (size_t)row0 * NQM + h * 64; U.ldq = NQM; U.qr = QM + (size_t)row0 * NQM + 384 + h * 32; U.ldqr = NQM;
                        U.kn = KVM + h * 128; U.ldk = NKVM; U.kr = BP + PC_KR; U.ldkr = NP; U.v = KVM + h * 128 + 64; U.ldv = NKVM; U.o = MIX + (size_t)row0 * D + 640 + h * 64;
                        if (EN(15)) (void)att::attn_unit<12, false>((LAS char*)lds, U, wid_i);
                    } else { U.qn = BP + (size_t)row0 * NP + PC_NQ + h * 64; U.ldq = NP; U.qr = nullptr; U.ldqr = 0;
                        U.kn = BP + PC_NK + h * 64; U.ldk = NP; U.kr = nullptr; U.ldkr = 0; U.v = BP + PC_NV + h * 64; U.ldv = NP; U.o = MIX + (size_t)row0 * D + 256 + h * 64;
                        if (EN(15)) (void)att::attn_unit<8, false>((LAS char*)lds, U, wid_i); }
                }
            }
        }
        SEAM(pb + 4);
        if (EN(6) && IN(pb + 5)) { PHASE_WS();
            {
              unsigned* rd = (unsigned*)(ws + WS_CTL) + CW_REDO + l * 512; const int nredo = (int)__hip_atomic_load(rd, __ATOMIC_RELAXED, __HIP_MEMORY_SCOPE_AGENT);
              unsigned* rd2 = (unsigned*)(ws + WS_CTL) + CW_REDO2 + l * 1024; const int nredo2 = (int)__hip_atomic_load(rd2, __ATOMIC_RELAXED, __HIP_MEMORY_SCOPE_AGENT);
              if (nredo2 > 0) {
                  for (int i = blockIdx.x; i < nredo2; i += G) { const int v = (int)rd2[1 + i] % (NB * 6 * 16), rg = v & 15, bh = v >> 4, b = bh / 6, h = bh % 6; const int row0 = b * T + rg * 256;
                      const int rlo = min(max(4 * rg - 4, 0), 56), rhi = min(max(4 * rg - 1, 0), 56) + 7; const int tid_ = wid0 * 64 + fresh_lane();
                      __syncthreads();
                      { LAS float* bt = (LAS float*)(lds + att::OFF_BIAS); const float* rp = args.in[I_RPB] + ((size_t)l * 6 + h) * 15 * 31;
                        for (int q = tid_; q < 640; q += 512) { const int k = q - 64; bt[q] = (k >= 0 && k < 465) ? rp[k] * LOG2E : 0.f; } }
                      __syncthreads();
                      att::Unit U; U.qn = BP + (size_t)row0 * NP + PC_NQ + h * 64; U.ldq = NP; U.qr = nullptr; U.ldqr = 0;
                      U.kn = BP + PC_NK + h * 64; U.ldk = NP; U.kr = nullptr; U.ldkr = 0; U.v = BP + PC_NV + h * 64; U.ldv = NP;
                      U.o = BH + (size_t)row0 * D + 256 + h * 64; U.ldo = D; U.na = rhi - rlo + 1; U.rowa = b * T + rlo * 64; U.rowc = ML + b * NC; U.rg = rg; U.rlo = rlo;
                      (void)att::attn_unit<8, true>((LAS char*)lds, U, wid0); }
              }
              if (nredo > 0) {
                  for (int i = blockIdx.x; i < 2 * nredo; i += G) { const int u1 = (int)rd[1 + (i >> 1)] % (NB * 6 * 8), hf = i & 1; const int qb = u1 & 7, bh = u1 >> 3, b = bh / 6, h = bh % 6; const int row0 = b * T + qb * 512 + hf * 256;
                      att::Unit U; U.qn = QM + (size_t)row0 * NQM + h * 64; U.ldq = NQM; U.qr = QM + (size_t)row0 * NQM + 384 + h * 32; U.ldqr = NQM;
                      U.kn = KVM + h * 128; U.ldk = NKVM; U.kr = BP + PC_KR; U.ldkr = NP; U.v = KVM + h * 128 + 64; U.ldv = NKVM;
                      U.o = BH + (size_t)row0 * D + 640 + h * 64; U.ldo = D; U.na = 64; U.rowa = b * T; U.rowc = ML + b * NC; U.rg = 0; U.rlo = 0;
                      (void)att::attn_unit<12, false>((LAS char*)lds, U, wid0); }
              }
              if (nredo > 0 || nredo2 > 0) GRID_BAR(); }
            pg8::Gemm g{BH, D, Wout + (size_t)l * 1024 * 1024, D}; pg8::TailSplit<pg8::StaticOrder> S; S.init(ML / 256, 4, G, blockIdx.x, D); S.init_ts(ML / 256, l == 0 ? MC / 256 : 0, 4);
            pg8::EpiResB<(l == 0)> E{x_in, XB, mod_l + 2 * 1024, 6144, PBW, (size_t)MC * D, ML};
            pg8::gemm_phase<pg8::EpiResB<(l == 0)>, pg8::TailSplit<pg8::StaticOrder>, true>(lds, g, S, E, wid0);
        }
        SEAM(pb + 5);
        if (l == 0) {
            if (EN(7) && IN(pb + 6)) { PHASE_IDS();
                const float* nw = args.in[I_N2W] + l * D;
                for (int r = gw; r < ML; r += 2 * NGW) { const int rB = r + NGW; const bool hb = rB < ML;
                    u32x4 wa[2], wb[2]; xb_load(XB + (size_t)r * XBP, lane, wa); xb_load(XB + (size_t)(hb ? rB : r) * XBP, lane, wb);
                    float v[16]; norm_fin_b(wa, nw, mod_l + (r >> 12) * 6144 + 3 * 1024, mod_l + (r >> 12) * 6144 + 4 * 1024, lane, v); store_row_b(BH + (size_t)r * D, lane, v);
                    if (hb) { norm_fin_b(wb, nw, mod_l + (rB >> 12) * 6144 + 3 * 1024, mod_l + (rB >> 12) * 6144 + 4 * 1024, lane, v); store_row_b(BH + (size_t)rB * D, lane, v); } }
                for (int r = ML + gw; r < M; r += NGW) { const float* xr = ctx_in + (size_t)(r - ML) * D; float* xw = xc + (size_t)(r - ML) * D;
                    f32x4 v[4]; norm_row(xr, nw, mod_l + 8 * 6144 + 3 * 1024, mod_l + 8 * 6144 + 4 * 1024, lane, v, PBW + (size_t)(r - ML) * D, xw, 4, (size_t)MC * D); store_row_bf16(BH + (size_t)r * D, lane, v); }
            }
            SEAM(pb + 6);
            if (EN(8) && IN(pb + 7)) { PHASE_WS();
                pg8::Gemm g{BH, D, Wf13, D}; pg8::StaticOrder S; S.init(M / 256, 22, G, blockIdx.x, D);
                pg8::EpiSwiglu E{BP, DFF};
                pg8::gemm_phase<pg8::EpiSwiglu, pg8::StaticOrder, true>(lds, g, S, E, wid0);
            }
            SEAM(pb + 7);
            if (EN(9) && IN(pb + 8)) { PHASE_WS();
                pg8::Gemm g{BP, DFF, Wf2, DFF}; pg8::TailSplit<pg8::StaticOrder> S; S.init(ML / 256, 4, G, blockIdx.x, DFF); S.init_ts(ML / 256, MC / 256, 8);
                pg8::EpiResB<false> E{nullptr, XB, mod_l + 5 * 1024, 6144, PBF, (size_t)MC * D, ML};
                pg8::gemm_phase<pg8::EpiResB<false>, pg8::TailSplit<pg8::StaticOrder>, true>(lds, g, S, E, wid0);
            }
            SEAM(pb + 8);
        } else {
            if (EN(10) && IN(pb + 6)) { PHASE_IDS();
                { LAS float* scr = (LAS float*)(lds + wid * 4352);
                  const int per13 = 352 * 16, per2 = 64 * 44, per = per13 + per2;
                  const float* m1 = args.in[I_M1]; const float* m3 = args.in[I_M3]; const float* m2 = args.in[I_M2]; bf16_t* wm = WMOE;
                  auto resolve = [&](int it, TrItem& T) { const int e = it / per, r = it % per; unsigned char* wb = (unsigned char*)wm + (size_t)e * WMOE_E;
                      if (r < per13) { TrJob J{m1 + (size_t)e * 1024 * 2816, m3 + (size_t)e * 1024 * 2816, 2816, 1024, 352, 3, (bf16_t*)wb, nullptr, 64.f}; tr_resolve(J, r, lane, T);
                          T.dp = (bf16_t*)(wb + (size_t)(16 * (r % 352)) * 1024 + 64 * (r / 352)); }
                      else { const int r2 = r - per13; TrJob J{m2 + (size_t)e * 2816 * 1024, nullptr, 1024, 2816, 64, 0, (bf16_t*)wb, nullptr, 64.f}; tr_resolve(J, r2, lane, T);
                          T.dp = (bf16_t*)(wb + (size_t)5632 * 1024 + (size_t)(16 * (r2 % 64)) * 2816 + 64 * (r2 / 64)); } };
                  tr_run2(gw, NGW, NEXP * per, resolve, scr, lane); }
                __syncthreads();
                LAS int* esel = (LAS int*)(lds + 40960 + 32768);
                float rwr[16][8];
#pragma unroll
                for (int j = 0; j < 2; ++j)
#pragma unroll
                    for (int q = 0; q < 8; ++q) { const float* wp = args.in[I_RW] + (size_t)(8 * lane + 512 * j + q) * 8; const f32x4 w0 = *(const f32x4*)wp, w1 = *(const f32x4*)(wp + 4);
                        rwr[8 * j + q][0] = w0.x; rwr[8 * j + q][1] = w0.y; rwr[8 * j + q][2] = w0.z; rwr[8 * j + q][3] = w0.w; rwr[8 * j + q][4] = w1.x; rwr[8 * j + q][5] = w1.y; rwr[8 * j + q][6] = w1.z; rwr[8 * j + q][7] = w1.w; }
                const float* nw = args.in[I_N2W] + l * D;
                for (int blk = blockIdx.x; blk < ML / 128; blk += G) {
                    u32x4 wnx[2]; xb_load(XB + (size_t)(blk * 128 + wid) * XBP, lane, wnx);
                    for (int rr = wid; rr < 128; rr += 8) { const int r = blk * 128 + rr, bi = r >> 12; float v[16];
                        u32x4 wc[2]; wc[0] = wnx[0]; wc[1] = wnx[1];
                        if (rr + 8 < 128) xb_load(XB + (size_t)(r + 8) * XBP, lane, wnx);
                        norm_fin_b(wc, nw, mod_l + bi * 6144 + 3 * 1024, mod_l + bi * 6144 + 4 * 1024, lane, v);
                        float lg[8];
#pragma unroll
                        for (int e = 0; e < 8; ++e) lg[e] = 0.f;
#pragma unroll
                        for (int j = 0; j < 2; ++j)
#pragma unroll
                            for (int q = 0; q < 8; ++q) { const float hv = v[8 * j + q];
#pragma unroll
                                for (int e = 0; e < 8; ++e) lg[e] += hv * rwr[8 * j + q][e]; }
#pragma unroll
                        for (int e = 0; e < 8; ++e) lg[e] = wave_sum(lg[e]);
                        int e0 = 0; float v0 = lg[0];
#pragma unroll
                        for (int e = 1; e < 8; ++e) if (lg[e] > v0) { v0 = lg[e]; e0 = e; }
                        int e1 = -1; float v1 = -INFINITY;
#pragma unroll
                        for (int e = 0; e < 8; ++e) if (e != e0 && lg[e] > v1) { v1 = lg[e]; e1 = e; }
                        const float g0 = 1.0f / (1.0f + expf(v1 - v0));
                        if (lane == 0) { esel[rr * 2] = e0; esel[rr * 2 + 1] = e1; tokg[(size_t)r * 2] = g0; tokg[(size_t)r * 2 + 1] = 1.0f - g0; } }
                    __syncthreads();
                    if (tid < 128) { const int e0 = esel[tid * 2], e1 = esel[tid * 2 + 1]; int s0 = 0, s1 = 0;
                        for (int q = 0; q < tid; ++q) { s0 += (esel[q * 2] == e0); s1 += (esel[q * 2 + 1] == e1); }
                        int* ti = tokinfo + (size_t)(blk * 128 + tid) * 4; ti[0] = e0; ti[1] = e1; ti[2] = s0; ti[3] = s1; }
                    if (tid < 16) { const int k = tid >> 3, e = tid & 7; int c = 0; for (int q = 0; q < 128; ++q) c += (esel[q * 2 + k] == e); wgcnt[blk * 16 + tid] = c; }
                    __syncthreads();
                }
            }
            SEAM(pb + 6);
            if (EN(11) && IN(pb + 7)) { PHASE_IDS();
                LAS int* tot = (LAS int*)(lds);
                LAS int* offp = tot + 16; LAS int* pre = tot + 32;
                __syncthreads();
                LAS int* segs = pre + 4096;
                for (int i = tid; i < 4096; i += 512) pre[i] = wgcnt[i];
                __syncthreads();
                { const int c = tid & 15, sg = tid >> 4; int sm = 0;
#pragma unroll
                  for (int q = 0; q < 8; ++q) sm += pre[(sg * 8 + q) * 16 + c];
                  segs[sg * 16 + c] = sm; }
                __syncthreads();
                { const int c = tid & 15, sg = tid >> 4; int run = 0; for (int q = 0; q < sg; ++q) run += segs[q * 16 + c];
#pragma unroll
                  for (int q = 0; q < 8; ++q) { const int v = pre[(sg * 8 + q) * 16 + c]; pre[(sg * 8 + q) * 16 + c] = run; run += v; }
                  if (sg == 31) tot[c] = run; }
                __syncthreads();
                if (tid == 0) { int o = 0; for (int e = 0; e < 8; ++e) { offp[e] = o; o += (tot[e] + tot[8 + e] + 255) & ~255; }
                    if (blockIdx.x == 0) { tileexp[320] = o >> 8; for (int e = 0; e < 8; ++e) { const int t0 = offp[e] >> 8, nt = (tot[e] + tot[8 + e] + 255) >> 8; for (int q = 0; q < nt; ++q) tileexp[t0 + q] = e; } } }
                __syncthreads();
                const float* nw = args.in[I_N2W] + l * D;
                for (int blk = blockIdx.x; blk < ML / 128; blk += G) {
                    u32x4 wnx[2]; xb_load(XB + (size_t)(blk * 128 + wid) * XBP, lane, wnx);
                    for (int rr = wid; rr < 128; rr += 8) { const int r = blk * 128 + rr, bi = r >> 12; float v[16];
                        u32x4 wc[2]; wc[0] = wnx[0]; wc[1] = wnx[1];
                        if (rr + 8 < 128) xb_load(XB + (size_t)(r + 8) * XBP, lane, wnx);
                        norm_fin_b(wc, nw, mod_l + bi * 6144 + 3 * 1024, mod_l + bi * 6144 + 4 * 1024, lane, v);
                        const int* ti = tokinfo + (size_t)r * 4;
#pragma unroll
                        for (int k = 0; k < 2; ++k) { const int e = ti[k], pos = offp[e] + (k == 0 ? 0 : tot[e]) + pre[blk * 16 + k * 8 + e] + ti[2 + k];
                            { unsigned char* ar = A8 + (size_t)pos * 1024 + 8 * lane; *(u32x2*)ar = pack8_f8(v); *(u32x2*)(ar + 512) = pack8_f8(v + 8); }
                            if (lane == 0) tokinfo[(size_t)r * 4 + 2 + k] = pos; } }
                }
            }
            SEAM(pb + 7);
            for (int k = 0; k < 2; ++k) {
                if (EN(12) && IN(pb + 8 + 2 * k)) { PHASE_WS();
                    const int ntl = tileexp[320], t0 = k == 0 ? 0 : 128, t1 = k == 0 ? (ntl < 128 ? ntl : 128) : ntl;
                    pg8::Gemm g{(const bf16_t*)(A8 + (size_t)t0 * 256 * 1024), 512, WMOE, 512}; pg8::GroupedOrder S; S.init(t1 > t0 ? t1 - t0 : 0, 22, G, blockIdx.x, 512); S.tile_exp = tileexp + t0; S.estride = WMOE_E;
                    pg8::EpiSwiglu8 E{(unsigned char*)UB, DFF};
                    pg8::gemm_phase<pg8::EpiSwiglu8, pg8::GroupedOrder, true, true>(lds, g, S, E, wid0);
                }
                SEAM(pb + 8 + 2 * k);
                if (EN(13) && IN(pb + 9 + 2 * k)) { PHASE_WS();
                    const int ntl = tileexp[320], t0 = k == 0 ? 0 : 128, t1 = k == 0 ? (ntl < 128 ? ntl : 128) : ntl;
                    const int nmp = t1 > t0 ? t1 - t0 : 0, nmain = nmp < 128 ? nmp : 128;
                    pg8::Gemm g{UB, DFF / 2, (const bf16_t*)((const unsigned char*)WMOE + (size_t)5632 * 1024), DFF / 2}; pg8::TailSplit<pg8::GroupedOrder> S; S.init(nmain, 4, G, blockIdx.x, DFF / 2); S.tile_exp = tileexp + t0; S.estride = WMOE_E; S.init_ts(nmain, nmp - nmain, 5);
                    pg8::EpiDelta E{ASORT + (size_t)t0 * 256 * D, nullptr, 0, PBY, (size_t)7 * 256 * D, 128 * 256};
                    pg8::gemm_phase<pg8::EpiDelta, pg8::TailSplit<pg8::GroupedOrder>, true, true>(lds, g, S, E, wid0);
                }
                SEAM(pb + 9 + 2 * k);
            }
        }
    }

constexpr int NPHASE = 24;
__global__ void __launch_bounds__(512, 2) mega_fwd(Args args) {
    extern __shared__ __attribute__((aligned(16))) unsigned char lds_raw[];
    LAS unsigned char* lds = (LAS unsigned char*)lds_raw;
    const int G = gridDim.x, NGW = G * 8;
    const int wid0 = __builtin_amdgcn_readfirstlane(threadIdx.x >> 6);
    if (threadIdx.x < 4) ((volatile LAS unsigned*)(lds + LDS_MISC))[threadIdx.x] = 0u;
    __syncthreads();
#if !MK_MULTI
    XcdBarrier bar = xcd_barrier_post((unsigned*)(args.ws + WS_CTL) + CW_BAR, (volatile LAS unsigned*)(lds + LDS_MISC));
    constexpr int lo = 0, hi_ph = 1000;
#else
    XcdBarrier bar; bar.bar = nullptr; bar.x = 0; bar.st = nullptr;
    const int lo = args.ph_lo, hi_ph = args.ph_hi;
#endif
    if (EN(0) && IN(0)) { PHASE_IDS();
        LAS float* scr = (LAS float*)(lds + wid * 4352);
        TrJob jobs[10];
        for (int l = 0; l < 2; ++l) {
            jobs[l * 4 + 0] = TrJob{args.in[I_WIN] + (size_t)l * 1024 * 2992, nullptr, 2992, 1024, 192, 1, Win + (size_t)l * 3072 * 1024, nullptr, 1.f};
            jobs[l * 4 + 1] = TrJob{args.in[I_WOUT] + (size_t)l * 1024 * 1024, nullptr, 1024, 1024, 64, 0, Wout + (size_t)l * 1024 * 1024, nullptr, 1.f};
            jobs[l * 4 + 2] = TrJob{args.in[I_WUQ] + (size_t)l * 512 * 576, nullptr, 576, 512, 36, 2, Wuq + (size_t)l * 768 * 512, args.in[I_QNW] + l * 512, 0.10206207261596577f * LOG2E};
            jobs[l * 4 + 3] = TrJob{args.in[I_WUKV] + (size_t)l * 256 * 768, nullptr, 768, 256, 48, 0, Wukv + (size_t)l * 768 * 256, args.in[I_KVNW] + l * 256, 1.f};
        }
        jobs[8] = TrJob{args.in[I_F1], args.in[I_F3], 2816, 1024, 352, 3, Wf13, nullptr, 1.f};
        jobs[9] = TrJob{args.in[I_F2], nullptr, 1024, 2816, 64, 0, Wf2, nullptr, 1.f};
        int total = 0;
#pragma unroll
        for (int q = 0; q < 10; ++q) total += tr_job_count(jobs[q]);
        { auto resolve = [&](int it, TrItem& T) { int r = it;
#pragma unroll
              for (int q = 0; q < 10; ++q) { const int n = tr_job_count(jobs[q]); if (r >= 0 && r < n) tr_resolve(jobs[q], r, lane, T); r -= n; } };
          tr_run(gw, NGW, total, resolve, scr, lane); }
        for (int item = blockIdx.x; item < 192; item += G) mod_item((LAS char*)lds + 40960, wid0, item, args.in[I_C], args.in[I_CCTX], args.in[I_ADAW], args.in[I_ADAB], modv);
        if (blockIdx.x == G - 1) { const int pos = tid >> 3, jj = tid & 7; const float inv = powf(10000.0f, -(float)jj / 8.0f); const float a = (float)pos * inv; ropet[pos * 8 + jj] = cosf(a); ropet[512 + pos * 8 + jj] = sinf(a); }
    }
    SEAM(0);

    layer_phases<0>(args, lds, G, NGW, bar, lo, hi_ph, wid0);
    layer_phases<1>(args, lds, G, NGW, bar, lo, hi_ph, wid0);
    if (EN(14) && IN(23)) { PHASE_IDS();
        const float* nw = args.in[I_FNW]; const float* g5 = modv + (size_t)9 * 6144 + 5 * 1024;
        auto yslow = [&](int pos, int c, float* y) {
            if (pos < 65536) unpack8(*(const u32x4*)(ASORT + (size_t)pos * D + c), y);
            else { for (int e = 0; e < 8; ++e) y[e] = 0.f;
                for (int p = 0; p < 5; ++p) { float t[8]; unpack8(*(const u32x4*)(PBY + ((size_t)p * 7 * 256 + (pos - 65536)) * D + c), t);
                    for (int e = 0; e < 8; ++e) y[e] += t[e]; } } };
        auto finish = [&](int r, float (&v)[16]) {
            float sq = 0.f;
#pragma unroll
            for (int e = 0; e < 16; ++e) sq += v[e] * v[e];
            const float rs = 1.0f / sqrtf(wave_sum(sq) * (1.0f / D) + EPS);
            float* xr = xout + (size_t)r * D;
#pragma unroll
            for (int j = 0; j < 2; ++j)
#pragma unroll
                for (int h = 0; h < 2; ++h) { const int c = 8 * lane + 512 * j + 4 * h; const f32x4 w = *(const f32x4*)(nw + c);
                    f32x4 o; o.x = v[8 * j + 4 * h] * rs * w.x; o.y = v[8 * j + 4 * h + 1] * rs * w.y; o.z = v[8 * j + 4 * h + 2] * rs * w.z; o.w = v[8 * j + 4 * h + 3] * rs * w.w;
                    *(f32x4*)(xr + c) = o; } };
        auto combine = [&](int r, const u32x4 (&xw)[2], const float (&ya)[16], const float (&yb)[16], float g0, float g1, float (&v)[16]) {
            const float* gp = g5 + (size_t)(r >> 12) * 6144;
            unpack8(xw[0], v); unpack8(xw[1], v + 8);
#pragma unroll
            for (int j = 0; j < 2; ++j)
#pragma unroll
                for (int h = 0; h < 2; ++h) { const int c = 8 * lane + 512 * j + 4 * h; const f32x4 gg = *(const f32x4*)(gp + c);
#pragma unroll
                    for (int q = 0; q < 4; ++q) { const int e = 8 * j + 4 * h + q; v[e] += gg[q] * (ya[e] * g0 + yb[e] * g1); } } };
        auto row_slow = [&](int r) {
            const int p0 = tokinfo[(size_t)r * 4 + 2], p1 = tokinfo[(size_t)r * 4 + 3]; const float g0 = tokg[(size_t)r * 2], g1 = tokg[(size_t)r * 2 + 1];
            u32x4 xw[2]; xb_load(XB + (size_t)r * XBP, lane, xw);
            float ya[16], yb[16], v[16];
            yslow(p0, 8 * lane, ya); yslow(p0, 8 * lane + 512, ya + 8); yslow(p1, 8 * lane, yb); yslow(p1, 8 * lane + 512, yb + 8);
            combine(r, xw, ya, yb, g0, g1, v); finish(r, v); };
        int nA0 = 0, nA1 = 0, nB0 = 0, nB1 = 0; float ngA0 = 0.f, ngA1 = 0.f, ngB0 = 0.f, ngB1 = 0.f;
        auto ld_ti = [&](int rA, int rB) { if (rB < ML) { nA0 = tokinfo[(size_t)rA * 4 + 2]; nA1 = tokinfo[(size_t)rA * 4 + 3]; nB0 = tokinfo[(size_t)rB * 4 + 2]; nB1 = tokinfo[(size_t)rB * 4 + 3];
            ngA0 = tokg[(size_t)rA * 2]; ngA1 = tokg[(size_t)rA * 2 + 1]; ngB0 = tokg[(size_t)rB * 2]; ngB1 = tokg[(size_t)rB * 2 + 1]; } };
        ld_ti(gw, gw + NGW);
        for (int r = gw; r < ML; r += 2 * NGW) { const int rA = r, rB = r + NGW;
            const int pA0 = nA0, pA1 = nA1, pB0 = nB0, pB1 = nB1; const float gA0 = ngA0, gA1 = ngA1, gB0 = ngB0, gB1 = ngB1;
            if (r + 2 * NGW < ML) ld_ti(r + 2 * NGW, r + 3 * NGW);
            if (rB >= ML) { row_slow(rA); continue; }
            if (__builtin_amdgcn_readfirstlane((pA0 | pA1 | pB0 | pB1) >= 65536 ? 1 : 0)) { row_slow(rA); row_slow(rB); continue; }
            u32x4 xa[2], xb2[2], a0[2], a1[2], b0[2], b1[2];
            xb_load(XB + (size_t)rA * XBP, lane, xa); xb_load(XB + (size_t)rB * XBP, lane, xb2);
            xb_load(ASORT + (size_t)pA0 * D, lane, a0); xb_load(ASORT + (size_t)pA1 * D, lane, a1); xb_load(ASORT + (size_t)pB0 * D, lane, b0); xb_load(ASORT + (size_t)pB1 * D, lane, b1);
            float ya[16], yb[16], v[16];
            unpack8(a0[0], ya); unpack8(a0[1], ya + 8); unpack8(a1[0], yb); unpack8(a1[1], yb + 8);
            combine(rA, xa, ya, yb, gA0, gA1, v); finish(rA, v);
            unpack8(b0[0], ya); unpack8(b0[1], ya + 8); unpack8(b1[0], yb); unpack8(b1[1], yb + 8);
            combine(rB, xb2, ya, yb, gB0, gB1, v); finish(rB, v); }
    }
}

extern "C" void kernel_launch(void* const* d_in, const int* in_sizes, int n_in, void* d_out, int out_size, void* d_ws, size_t ws_size, hipStream_t stream) {
    static int grid = 0;
    if (grid == 0) {
        if (n_in != 27 || out_size != ML * D || ws_size < WS_END) { fprintf(stderr, "kernel_launch: unexpected sizes (n_in %d out %d ws %zu need %zu)\n", n_in, out_size, ws_size, (size_t)WS_END); grid = -1; return; }
        int dev = 0, cus = 0;
        if (hipGetDevice(&dev) != hipSuccess || hipDeviceGetAttribute(&cus, hipDeviceAttributeMultiprocessorCount, dev) != hipSuccess) { grid = -1; return; }
        if (hipFuncSetAttribute((const void*)mega_fwd, hipFuncAttributeMaxDynamicSharedMemorySize, LDS_BYTES) != hipSuccess) { fprintf(stderr, "kernel_launch: hipFuncSetAttribute failed\n"); grid = -1; return; }
        int per_cu = 0;
        if (hipOccupancyMaxActiveBlocksPerMultiprocessor(&per_cu, (const void*)mega_fwd, 512, LDS_BYTES) != hipSuccess || per_cu < 1) fprintf(stderr, "kernel_launch: occupancy query says %d\n", per_cu);
        (void)hipGetLastError();
        grid = cus;
    }
    if (grid < 0) return;
    if (hipMemsetAsync((char*)d_ws + WS_CTL, 0, CTL_ZERO_BYTES, stream) != hipSuccess) return;
    Args a{};
    for (int i = 0; i < 27; ++i) a.in[i] = (const float*)d_in[i];
    a.out = (float*)d_out; a.ws = (unsigned char*)d_ws;
#if MK_MULTI
#ifndef MK_DUP0
#define MK_DUP0 -1
#endif
#ifndef MK_DUP1
#define MK_DUP1 -1
#endif
    for (int ph = 0; ph < NPHASE; ++ph) { a.ph_lo = ph; a.ph_hi = ph + 1; const int reps = (ph == MK_DUP0 || ph == MK_DUP1) ? 2 : 1;
        for (int r = 0; r < reps; ++r) hipLaunchKernelGGL(mega_fwd, dim3(grid), dim3(512), LDS_BYTES, stream, a); }
#else
    a.ph_lo = 0; a.ph_hi = NPHASE;
    hipLaunchKernelGGL(mega_fwd, dim3(grid), dim3(512), LDS_BYTES, stream, a);
#endif
}
```

```cpp
#include <hip/hip_runtime.h>
#include <stdint.h>
#include <stdio.h>

#ifndef MK_MULTI
#define MK_MULTI 0
#endif

#define LAS __attribute__((address_space(3)))
#define GAS __attribute__((address_space(1)))
typedef unsigned short bf16_t;
typedef short bf16x8 __attribute__((ext_vector_type(8)));
typedef short s16x4 __attribute__((ext_vector_type(4)));
typedef float f32x2 __attribute__((ext_vector_type(2)));
typedef float f32x4 __attribute__((ext_vector_type(4)));
typedef float f32x16 __attribute__((ext_vector_type(16)));
typedef unsigned u32x2 __attribute__((ext_vector_type(2)));
typedef unsigned u32x4 __attribute__((ext_vector_type(4)));
typedef __bf16 bf16x2_t __attribute__((ext_vector_type(2)));

constexpr int NB = 8, T = 4096, D = 1024, NC = 256;
constexpr int ML = NB * T, MC = NB * NC, M = ML + MC;
constexpr int NP = 3072;
constexpr int PC_QL = 0, PC_KVL = 512, PC_MQ = 768, PC_MK = 1024, PC_MV = 1280, PC_MO = 1536, PC_NQ = 1792, PC_NK = 2176, PC_NV = 2560, PC_KR = 2944, PC_GT = 2976;
constexpr int NQM = 576, NKVM = 768;
constexpr int DFF = 2816, NEXP = 8;
constexpr int NCHK = 68;
constexpr float LOG2E = 1.4426950408889634f;
constexpr float EPS = 1e-6f;

constexpr size_t MiB = 1u << 20;
constexpr size_t WS_CTL = 0, CTL_ZERO_BYTES = 1 * MiB;
constexpr size_t WS_SMALL = 1 * MiB;
constexpr size_t SM_MOD = WS_SMALL;
constexpr size_t SM_ROPE = SM_MOD + 2 * 9 * 6144 * 4;
constexpr size_t SM_STATS = WS_SMALL + 1 * MiB;
constexpr size_t SM_NLOC = WS_SMALL + 5 * MiB;
constexpr size_t SM_NIN = WS_SMALL + 7 * MiB;
constexpr size_t SM_MG = WS_SMALL + 9 * MiB;
constexpr size_t SM_MIN = SM_MG + 256 * 1024;
constexpr size_t SM_TOK = WS_SMALL + 10 * MiB;
constexpr size_t SM_TOKG = SM_TOK + (size_t)ML * 16;
constexpr size_t SM_WGCNT = WS_SMALL + 11 * MiB;
constexpr size_t SM_ROWTOK = SM_WGCNT + 64 * 1024;
constexpr size_t SM_ROWGATE = SM_ROWTOK + (size_t)2 * M * 4;
constexpr size_t SM_TILEEXP = SM_ROWGATE + (size_t)2 * M * 4;
constexpr size_t WS_WSMALL = 17 * MiB;
constexpr size_t W_IN = WS_WSMALL;
constexpr size_t W_OUT = W_IN + (size_t)2 * 3072 * 1024 * 2;
constexpr size_t W_UQ = W_OUT + (size_t)2 * 1024 * 1024 * 2;
constexpr size_t W_UKV = W_UQ + (size_t)2 * 768 * 512 * 2;
constexpr size_t W_F13 = W_UKV + (size_t)2 * 768 * 256 * 2;
constexpr size_t W_F2 = W_F13 + (size_t)5632 * 1024 * 2;
constexpr size_t WS_XC = 52 * MiB;
constexpr size_t WS_H = 60 * MiB;
constexpr size_t WS_P = 128 * MiB;
constexpr size_t WS_QM = 332 * MiB;
constexpr size_t WS_KVM = 371 * MiB;
constexpr size_t WS_CIN = 422 * MiB;
constexpr size_t WS_END_MIX = 456 * MiB;
constexpr size_t WS_WMOE = 17 * MiB;
constexpr size_t WMOE_E = (size_t)5632 * 1024 + (size_t)1024 * 2816;
constexpr size_t WS_A8 = 83 * MiB;
constexpr size_t WS_U = 149 * MiB;
constexpr size_t WS_ASORT = 336 * MiB;
constexpr size_t WS_PBY = 472 * MiB;
constexpr size_t WS_END = 516 * MiB;
constexpr size_t WS_PBF = WS_QM;
constexpr size_t WS_PBW = WS_KVM;
static_assert(W_F2 + (size_t)1024 * 2816 * 2 <= WS_XC, "weights");
static_assert(WS_H + (size_t)M * 1024 * 2 <= WS_P && WS_P + (size_t)M * NP * 2 <= WS_QM && WS_QM + (size_t)M * NQM * 2 <= WS_KVM && WS_KVM + (size_t)M * NKVM * 2 <= WS_CIN, "map");
static_assert(WS_CIN + (size_t)2 * 8 * 4 * NCHK * 4096 * 2 <= WS_END_MIX, "map2");
static_assert(WS_WMOE + 8 * WMOE_E <= WS_A8 && WS_A8 + (size_t)67584 * 1024 <= WS_U && WS_U + (size_t)M * DFF * 2 <= WS_ASORT && WS_ASORT + (size_t)2 * M * 1024 * 2 <= WS_PBY && WS_PBY + (size_t)11 * 7 * 256 * 1024 * 2 <= WS_END, "map3");
static_assert((size_t)2 * 8 * 4 * NCHK * 4096 * 4 <= (size_t)M * 1024 * 2, "C_LOC overlays BUF_H");
static_assert(SM_TILEEXP + 4096 <= WS_WSMALL && SM_TOKG + (size_t)ML * 8 <= SM_WGCNT && SM_STATS + (size_t)M * 24 * 4 <= SM_NLOC, "small map");

constexpr int CW_BAR = 4096;
constexpr int CW_QUEUE = 8192;
constexpr int CW_REDO2 = 8192 + 2048;
constexpr int CW_REDO = 8192 + 256;

constexpr int LDS_BYTES = 155648;
constexpr int LDS_MISC = 155648 - 256;

#define LDS_WAIT() asm volatile("s_waitcnt lgkmcnt(0)" ::: "memory")
#define VM_WAIT() asm volatile("s_waitcnt vmcnt(0)" ::: "memory")
__device__ __forceinline__ float bf2f(unsigned v) { return __uint_as_float(v << 16); }
__device__ __forceinline__ unsigned pk2(float lo, float hi) { f32x2 v = {lo, hi}; bf16x2_t b = __builtin_convertvector(v, bf16x2_t); return __builtin_bit_cast(unsigned, b); }
__device__ __forceinline__ void unpack8(const u32x4 w, float* f) {
    f[0] = __uint_as_float(w.x << 16); f[1] = __uint_as_float(w.x & 0xffff0000u); f[2] = __uint_as_float(w.y << 16); f[3] = __uint_as_float(w.y & 0xffff0000u);
    f[4] = __uint_as_float(w.z << 16); f[5] = __uint_as_float(w.z & 0xffff0000u); f[6] = __uint_as_float(w.w << 16); f[7] = __uint_as_float(w.w & 0xffff0000u);
}
__device__ __forceinline__ u32x4 pack8(const float* f) { u32x4 w; w.x = pk2(f[0], f[1]); w.y = pk2(f[2], f[3]); w.z = pk2(f[4], f[5]); w.w = pk2(f[6], f[7]); return w; }
__device__ __forceinline__ u32x2 pack8_f8(const float* f) { u32x2 w;
    w.x = (unsigned)__builtin_amdgcn_cvt_pk_fp8_f32(f[0], f[1], 0, false); w.x = (unsigned)__builtin_amdgcn_cvt_pk_fp8_f32(f[2], f[3], (int)w.x, true);
    w.y = (unsigned)__builtin_amdgcn_cvt_pk_fp8_f32(f[4], f[5], 0, false); w.y = (unsigned)__builtin_amdgcn_cvt_pk_fp8_f32(f[6], f[7], (int)w.y, true); return w; }
__device__ __forceinline__ float wave_sum(float v) {
#pragma unroll
    for (int o = 1; o < 64; o <<= 1) v += __shfl_xor(v, o);
    return v;
}
__device__ __forceinline__ float wave_max(float v) {
#pragma unroll
    for (int o = 1; o < 64; o <<= 1) v = fmaxf(v, __shfl_xor(v, o));
    return v;
}
__device__ __forceinline__ float fexp2(float x) { return __builtin_amdgcn_exp2f(x); }
__device__ __forceinline__ float fexp(float x) { return __builtin_amdgcn_exp2f(x * LOG2E); }
__device__ __forceinline__ float frcp(float x) { return __builtin_amdgcn_rcpf(x); }
__device__ __forceinline__ float silu_f(float x) { return x * frcp(1.0f + fexp(-x)); }
__device__ __forceinline__ float sigmoid_f(float x) { return frcp(1.0f + fexp(-x)); }
__device__ __forceinline__ int fresh_lane() { int l; asm volatile("v_mbcnt_lo_u32_b32 %0, -1, 0\n\tv_mbcnt_hi_u32_b32 %0, -1, %0" : "=v"(l)); return l; }
__device__ __forceinline__ float xhalf(float v) { return __shfl_xor(v, 32); }
__device__ __forceinline__ float half_max(float v) { auto rr = __builtin_amdgcn_permlane32_swap(__float_as_uint(v), __float_as_uint(v), false, false); return fmaxf(__uint_as_float(rr[0]), __uint_as_float(rr[1])); }
__device__ __forceinline__ float half_sum(float v) { auto rr = __builtin_amdgcn_permlane32_swap(__float_as_uint(v), __float_as_uint(v), false, false); return __uint_as_float(rr[0]) + __uint_as_float(rr[1]); }

namespace pg8 {
constexpr int BM = 256, BK = 64, HALF = 128, HTB = HALF * BK * 2, STAGE_BYTES = 8 * HTB, NXCD = 8, WGM = 8;
__host__ __device__ __forceinline__ int lds_byte(int r, int c) { const int st = (r >> 4) * 2 + (c >> 5), rr = r & 15, cc = c & 31, ob = rr * 64 + cc * 2; return st * 1024 + (ob ^ (((ob >> 9) & 1) << 5)); }
__host__ __device__ __forceinline__ void stage_rc(int b, int& R, int& C) { const int st = b / 1024, sb = b % 1024, swz = sb ^ (((sb >> 9) & 1) << 5); R = (st >> 1) * 16 + swz / 64; C = (st & 1) * 32 + (swz % 64) / 2; }
__host__ __device__ __forceinline__ int perm32(int rho) { const int n = rho >> 4, i = rho & 15; return 8 * (i >> 2) + 4 * n + (i & 3); }

struct Unit { int pm, pn, kb, ke, part; };
struct Gemm { const bf16_t* A; int lda; const bf16_t* Bt; int K; };

struct StaticOrder {
    int nM, nN, nwg, G, c, nt;
    __device__ void init(int nM_, int nN_, int G_, int c_, int K_) { nM = nM_; nN = nN_; nwg = nM * nN; G = G_; c = c_; nt = K_ / BK; }
    __device__ __forceinline__ void tile_of(int L, Unit& u) const {
        int wgid = L; { const int q = nwg / NXCD, r = nwg % NXCD, xcd = wgid % NXCD, off = wgid / NXCD; wgid = (xcd < r ? xcd * (q + 1) : r * (q + 1) + (xcd - r) * q) + off; }
        const int nig = WGM * nN, gid = wgid / nig, fm = gid * WGM, gsz = (nM - fm) < WGM ? (nM - fm) : WGM;
        u.pm = fm + ((wgid % nig) % gsz); u.pn = (wgid % nig) / gsz;
    }
    __device__ bool next(int i, Unit& u) const {
        const long L = (long)i * G + c; if (L >= nwg) return false;
        tile_of((int)L, u); u.kb = 0; u.ke = nt; u.part = -1; return true;
    }
    __device__ __forceinline__ const char* a_base(const Gemm& g, const Unit& u) const { return (const char*)g.A + (size_t)u.pm * 256 * g.lda * 2 + (size_t)u.kb * (BK * 2); }
    __device__ __forceinline__ const char* b_base(const Gemm& g, const Unit& u) const { return (const char*)g.Bt + (size_t)u.pn * 256 * g.K * 2 + (size_t)u.kb * (BK * 2); }
};
struct GroupedOrder : StaticOrder {
    const int* tile_exp; size_t estride;
    __device__ __forceinline__ const char* b_base(const Gemm& g, const Unit& u) const { return (const char*)g.Bt + (size_t)tile_exp[u.pm] * estride + (size_t)u.pn * 256 * g.K * 2 + (size_t)u.kb * (BK * 2); }
};
template <class Base> struct TailSplit : Base {
    int nMain, nTail, S;
    __device__ void init_ts(int nMain_, int nTail_, int S_) { nMain = nMain_; nTail = nTail_ < 0 ? 0 : nTail_; S = S_; this->nM = nMain; this->nwg = nMain * this->nN; }
    __device__ bool next(int i, Unit& u) const {
        const long L = (long)i * this->G + this->c;
        if (L < this->nwg) { this->tile_of((int)L, u); u.kb = 0; u.ke = this->nt; u.part = -1; return true; }
        const long j = L - this->nwg; const int ntu = nTail * this->nN;
        if (j >= (long)ntu * S) return false;
        const int t = (int)(j % ntu), p = (int)(j / ntu), np = this->nt / 2;
        u.pm = nMain + t / this->nN; u.pn = t % this->nN; u.kb = 2 * (p * np / S); u.ke = 2 * ((p + 1) * np / S); u.part = p; return true;
    }
};

__device__ __forceinline__ unsigned cvt_pk_bf16(float lo, float hi) { unsigned r; asm volatile("v_cvt_pk_bf16_f32 %0, %1, %2" : "=v"(r) : "v"(lo), "v"(hi)); return r; }

typedef int v4i_t __attribute__((ext_vector_type(4)));
typedef int v8i_t __attribute__((ext_vector_type(8)));
__device__ __forceinline__ v8i_t cat8(const bf16x8 lo, const bf16x8 hi) { const v4i_t a = __builtin_bit_cast(v4i_t, lo), b = __builtin_bit_cast(v4i_t, hi); return __builtin_shufflevector(a, b, 0, 1, 2, 3, 4, 5, 6, 7); }
template <class Epi, class Sched, bool ALIGN_EPI, bool F8 = false>
__device__ __forceinline__ void gemm_phase(LAS unsigned char* lds, const Gemm g, const Sched& S, const Epi& E, const int wid0) {
    const int lane = fresh_lane(), wid = wid0, tid = wid * 64 + lane,
    wr = wid >> 2, wc = wid & 3, fr = lane & 15, fq = lane >> 4;
    const int K = g.K;
    unsigned voffA[2], voffB[2];
#pragma unroll
    for (int i = 0; i < 2; ++i) { int R, C; stage_rc(tid * 16 + i * 8192, R, C); const int Rb = Epi::PERM ? ((R & ~31) + perm32(R & 31)) : R;
        voffA[i] = (unsigned)(R * g.lda + C) * 2u; voffB[i] = (unsigned)(Rb * K + C) * 2u; }
    const size_t kstep = (size_t)(BK * 2);
    const size_t hsA = (size_t)HALF * g.lda * 2, hsB = (size_t)HALF * K * 2;
    const unsigned ldsw = (unsigned)wid * 1024u;
    const int aoff = lds_byte(wr * 64 + fr, fq * 8), boff = lds_byte(wc * 32 + fr, fq * 8);
#define PG8_SA(b, h) (((b) * 2 + (h)) * HTB)
#define PG8_SB(b, h) ((4 + (b) * 2 + (h)) * HTB)
#define PG8_STAGE(bufoff, gbase, voff) do { _Pragma("unroll") for (int _i = 0; _i < 2; ++_i) \
        __builtin_amdgcn_global_load_lds((const unsigned*)((const char*)(gbase) + (voff)[_i]), (LAS unsigned*)(lds + (bufoff) + ldsw + _i * 8192), 16, 0, 0); } while (0)
#define PG8_LDA(dst, b, h) do { if constexpr (F8) { _Pragma("unroll") for (int m = 0; m < 4; ++m) dst##8[m] = cat8(*(const LAS bf16x8*)(lds + PG8_SA(b, h) + aoff + m * 2048), *(const LAS bf16x8*)(lds + PG8_SA(b, h) + aoff + m * 2048 + 1024)); } \
        else { _Pragma("unroll") for (int m = 0; m < 4; ++m) _Pragma("unroll") for (int k = 0; k < 2; ++k) dst[m][k] = *(const LAS bf16x8*)(lds + PG8_SA(b, h) + aoff + m * 2048 + k * 1024); } } while (0)
#define PG8_LDB(dst, b, h) do { if constexpr (F8) { _Pragma("unroll") for (int n = 0; n < 2; ++n) dst##8[n] = cat8(*(const LAS bf16x8*)(lds + PG8_SB(b, h) + boff + n * 2048), *(const LAS bf16x8*)(lds + PG8_SB(b, h) + boff + n * 2048 + 1024)); } \
        else { _Pragma("unroll") for (int n = 0; n < 2; ++n) _Pragma("unroll") for (int k = 0; k < 2; ++k) dst[n][k] = *(const LAS bf16x8*)(lds + PG8_SB(b, h) + boff + n * 2048 + k * 1024); } } while (0)
#define PG8_MMA(ai, bj, At, Bt) do { __builtin_amdgcn_s_setprio(1); \
        if constexpr (F8) { _Pragma("unroll") for (int m = 0; m < 4; ++m) _Pragma("unroll") for (int n = 0; n < 2; ++n) \
            asm volatile("v_mfma_scale_f32_16x16x128_f8f6f4 %0, %1, %2, %0, %3, %4 op_sel_hi:[0,0,0]" : "+v"(acc[ai][bj][m][n]) : "v"(Bt##8[n]), "v"(At##8[m]), "v"(sc_w), "v"(sc_1)); } \
        else { _Pragma("unroll") for (int m = 0; m < 4; ++m) _Pragma("unroll") for (int n = 0; n < 2; ++n) _Pragma("unroll") for (int k = 0; k < 2; ++k) \
            acc[ai][bj][m][n] = __builtin_amdgcn_mfma_f32_16x16x32_bf16(Bt[n][k], At[m][k], acc[ai][bj][m][n], 0, 0, 0); } \
        __builtin_amdgcn_s_setprio(0); } while (0)
#define PG8_WAIT_V(n) asm volatile("s_waitcnt vmcnt(" #n ")" ::: "memory")
#define PG8_WAIT_L(n) asm volatile("s_waitcnt lgkmcnt(" #n ")" ::: "memory")
#define PG8_BAR __builtin_amdgcn_s_barrier()
#define PG8_SCHED __builtin_amdgcn_sched_barrier(0)
    Unit cur, nxt; int ui = 0;
    if (!S.next(0, cur)) return;
    f32x4 acc[2][2][4][2];
#pragma unroll
    for (int a = 0; a < 2; ++a)
#pragma unroll
        for (int b = 0; b < 2; ++b)
#pragma unroll
            for (int m = 0; m < 4; ++m)
#pragma unroll
                for (int n = 0; n < 2; ++n) acc[a][b][m][n] = (f32x4){0.f, 0.f, 0.f, 0.f};
    bf16x8 At[4][2], B0[2][2], B1[2][2]; v8i_t At8[4], B08[2], B18[2];
    int sc_w = 0x79797979, sc_1 = 0x7f7f7f7f; asm volatile("" : "+v"(sc_w), "+v"(sc_1));
    const char* cA = S.a_base(g, cur); const char* cB = S.b_base(g, cur);
    PG8_STAGE(PG8_SB(0, 0), cB, voffB); PG8_STAGE(PG8_SB(0, 1), cB + hsB, voffB); PG8_STAGE(PG8_SA(0, 0), cA, voffA); PG8_STAGE(PG8_SA(0, 1), cA + hsA, voffA);
    if (wr == 1) PG8_BAR;
    PG8_WAIT_V(2); PG8_BAR;
    PG8_STAGE(PG8_SB(1, 0), cB + kstep, voffB); PG8_STAGE(PG8_SA(1, 0), cA + kstep, voffA); PG8_STAGE(PG8_SB(1, 1), cB + hsB + kstep, voffB);
    PG8_WAIT_V(6); PG8_BAR;
    for (;;) {
        const bool has_next = S.next(ui + 1, nxt);
        const char* nA = has_next ? S.a_base(g, nxt) : cA; const char* nB = has_next ? S.b_base(g, nxt) : cB;
        const int ntc = cur.ke - cur.kb;
#pragma unroll 1
        for (int t = 0; t < ntc; t += 2) {
            const bool last = (t == ntc - 2);
            const char* a1 = cA + (size_t)(t + 1) * kstep;
            const char* a2 = last ? nA : cA + (size_t)(t + 2) * kstep; const char* b2 = last ? nB : cB + (size_t)(t + 2) * kstep;
            const char* a3 = a2 + kstep; const char* b3 = b2 + kstep;
            PG8_LDB(B0, 0, 0); PG8_LDB(B1, 0, 1); PG8_SCHED; PG8_LDA(At, 0, 0); PG8_STAGE(PG8_SA(1, 1), a1 + hsA, voffA);
            PG8_WAIT_V(8); PG8_WAIT_L(0); PG8_BAR; PG8_MMA(0, 0, At, B0); PG8_MMA(0, 1, At, B1); PG8_BAR; PG8_SCHED;
            PG8_LDA(At, 0, 1); PG8_STAGE(PG8_SB(0, 0), b2, voffB); PG8_STAGE(PG8_SB(0, 1), b2 + hsB, voffB); PG8_STAGE(PG8_SA(0, 0), a2, voffA);
            PG8_WAIT_V(8); PG8_WAIT_L(0); PG8_BAR; PG8_MMA(1, 0, At, B0); PG8_MMA(1, 1, At, B1); PG8_BAR; PG8_SCHED;
            PG8_LDB(B0, 1, 0); PG8_LDB(B1, 1, 1); PG8_SCHED; PG8_LDA(At, 1, 0); PG8_STAGE(PG8_SA(0, 1), a2 + hsA, voffA);
            PG8_WAIT_V(8); PG8_WAIT_L(0); PG8_BAR; PG8_MMA(0, 0, At, B0); PG8_MMA(0, 1, At, B1); PG8_BAR; PG8_SCHED;
            PG8_LDA(At, 1, 1); PG8_STAGE(PG8_SB(1, 0), b3, voffB); PG8_STAGE(PG8_SB(1, 1), b3 + hsB, voffB); PG8_STAGE(PG8_SA(1, 0), a3, voffA);
            PG8_WAIT_V(8); PG8_WAIT_L(0); PG8_BAR; PG8_MMA(1, 0, At, B0); PG8_MMA(1, 1, At, B1); PG8_BAR; PG8_SCHED;
        }
        if constexpr (ALIGN_EPI) { if (wr == 0) PG8_BAR; }
        if constexpr (F8) asm volatile("s_nop 7\n\ts_nop 7\n\ts_nop 7" ::: "memory");
        E(acc, cur, wr, wc, fr, fq);
        if (!has_next) break;
#pragma unroll
        for (int a = 0; a < 2; ++a)
#pragma unroll
            for (int b = 0; b < 2; ++b)
#pragma unroll
                for (int m = 0; m < 4; ++m)
#pragma unroll
                    for (int n = 0; n < 2; ++n) acc[a][b][m][n] = (f32x4){0.f, 0.f, 0.f, 0.f};
        cur = nxt; cA = nA; cB = nB; ++ui;
        if constexpr (ALIGN_EPI) { if (wr == 1) PG8_BAR; }
    }
    PG8_WAIT_V(0);
    if constexpr (!ALIGN_EPI) { if (wr == 0) PG8_BAR; }
    PG8_BAR;
#undef PG8_SA
#undef PG8_SB
#undef PG8_STAGE
#undef PG8_LDA
#undef PG8_LDB
#undef PG8_MMA
#undef PG8_WAIT_V
#undef PG8_WAIT_L
#undef PG8_BAR
#undef PG8_SCHED
}

typedef const f32x4 (&AccRef)[2][2][4][2];

__device__ __forceinline__ void rope8(f32x4& v0, f32x4& v1, int fq, int tpos, const float* tab) {
    const int pos = (fq < 2) ? (tpos >> 6) : (tpos & 63);
    const f32x4 c0 = *(const f32x4*)(tab + pos * 8), c1 = *(const f32x4*)(tab + pos * 8 + 4), s0 = *(const f32x4*)(tab + 512 + pos * 8), s1 = *(const f32x4*)(tab + 512 + pos * 8 + 4);
    f32x4 p0, p1;
#pragma unroll
    for (int j = 0; j < 4; ++j) { p0[j] = __shfl_xor(v0[j], 16); p1[j] = __shfl_xor(v1[j], 16); }
    const float sg = (fq & 1) ? 1.f : -1.f;
    v0 = v0 * c0 + sg * (p0 * s0); v1 = v1 * c1 + sg * (p1 * s1);
}

struct EpiP {
    static constexpr bool PERM = true;
    bf16_t* P; float* stats; const float* rope;
    __device__ __forceinline__ void operator()(AccRef acc, const Unit& u, int wr, int wc, int fr, int fq) const {
        const int row0 = u.pm * BM + wr * 64 + fr, col0 = u.pn * BM + wc * 32 + 8 * fq;
        const bool do_stats = u.pn < 3, do_rope = (u.pn == 11) && (wc == 0) && (u.pm < ML / 256);
#pragma unroll
        for (int ai = 0; ai < 2; ++ai)
#pragma unroll
            for (int m = 0; m < 4; ++m) { const int row = row0 + ai * HALF + m * 16; bf16_t* rowp = P + (size_t)row * NP + col0;
#pragma unroll
                for (int bj = 0; bj < 2; ++bj) { f32x4 v0 = acc[ai][bj][m][0], v1 = acc[ai][bj][m][1];
                    if (do_stats) { float ss = (v0[0] * v0[0] + v0[1] * v0[1]) + (v0[2] * v0[2] + v0[3] * v0[3]) + (v1[0] * v1[0] + v1[1] * v1[1]) + (v1[2] * v1[2] + v1[3] * v1[3]);
                        ss += __shfl_xor(ss, 16); ss += __shfl_xor(ss, 32);
                        if (fq == 0) stats[(size_t)row * 24 + u.pn * 8 + bj * 4 + wc] = ss; }
                    if (bj == 1 && do_rope) rope8(v0, v1, fq, row & (T - 1), rope);
                    u32x4 w; w.x = cvt_pk_bf16(v0[0], v0[1]); w.y = cvt_pk_bf16(v0[2], v0[3]); w.z = cvt_pk_bf16(v1[0], v1[1]); w.w = cvt_pk_bf16(v1[2], v1[3]);
                    *(u32x4*)(rowp + bj * HALF) = w; } }
    }
};
template <bool ROPE> struct EpiRS {
    static constexpr bool PERM = true;
    bf16_t* O; int ldc, ncols, rope_c0; const float* stats; int part0, nparts; float invk; const float* rope;
    __device__ __forceinline__ void operator()(AccRef acc, const Unit& u, int wr, int wc, int fr, int fq) const {
        const int row0 = u.pm * BM + wr * 64 + fr, col0 = u.pn * BM + wc * 32 + 8 * fq;
        const int npl = nparts >> 2;
#pragma unroll
        for (int ai = 0; ai < 2; ++ai)
#pragma unroll
            for (int m = 0; m < 4; ++m) { const int row = row0 + ai * HALF + m * 16; bf16_t* rowp = O + (size_t)row * ldc + col0;
                const float* sp = stats + (size_t)row * 24 + part0 + fq * npl; float ss = sp[0] + sp[1]; if (npl == 4) ss += sp[2] + sp[3];
                ss += __shfl_xor(ss, 16); ss += __shfl_xor(ss, 32);
                const float rs = 1.0f / sqrtf(ss * invk + EPS);
#pragma unroll
                for (int bj = 0; bj < 2; ++bj) { const int c = col0 + bj * HALF; f32x4 v0 = acc[ai][bj][m][0] * rs, v1 = acc[ai][bj][m][1] * rs;
                    if (ROPE) { const int cb = u.pn * BM + bj * HALF + wc * 32;
                        if (cb >= rope_c0 && cb < ncols && u.pm < ML / 256) rope8(v0, v1, fq, row & (T - 1), rope); }
                    if (c < ncols) { u32x4 w; w.x = cvt_pk_bf16(v0[0], v0[1]); w.y = cvt_pk_bf16(v0[2], v0[3]); w.z = cvt_pk_bf16(v1[0], v1[1]); w.w = cvt_pk_bf16(v1[2], v1[3]);
                        *(u32x4*)(rowp + bj * HALF) = w; } } }
    }
};
struct EpiDelta {
    static constexpr bool PERM = true;
    bf16_t* O; const float* gate; int gstride;
    bf16_t* Op; size_t pstride; int prow0;
    __device__ __forceinline__ void operator()(AccRef acc, const Unit& u, int wr, int wc, int fr, int fq) const {
        const int row0 = u.pm * BM + wr * 64 + fr - (u.part >= 0 ? prow0 : 0), col0 = u.pn * BM + wc * 32 + 8 * fq;
        bf16_t* const Ob = u.part >= 0 ? Op + (size_t)u.part * pstride : O;
        f32x4 gv[2][2];
#pragma unroll
        for (int bj = 0; bj < 2; ++bj)
#pragma unroll
            for (int n = 0; n < 2; ++n) gv[bj][n] = gate ? *(const f32x4*)(gate + (size_t)(u.pm < ML / 256 ? (u.pm >> 4) : 8) * gstride + col0 + bj * HALF + 4 * n) : (f32x4){1.f, 1.f, 1.f, 1.f};
#pragma unroll
        for (int ai = 0; ai < 2; ++ai)
#pragma unroll
            for (int m = 0; m < 4; ++m) { bf16_t* rowp = Ob + (size_t)(row0 + ai * HALF + m * 16) * D + col0;
#pragma unroll
                for (int bj = 0; bj < 2; ++bj) { const f32x4 v0 = acc[ai][bj][m][0] * gv[bj][0], v1 = acc[ai][bj][m][1] * gv[bj][1];
                    u32x4 w; w.x = cvt_pk_bf16(v0[0], v0[1]); w.y = cvt_pk_bf16(v0[2], v0[3]); w.z = cvt_pk_bf16(v1[0], v1[1]); w.w = cvt_pk_bf16(v1[2], v1[3]);
                    *(u32x4*)(rowp + bj * HALF) = w; } }
    }
};
struct EpiRes2 {
    static constexpr bool PERM = false;
    const float* xin; float* xout; const float* gate; int gstride; bf16_t* Op; size_t pstride; int prow0;
    __device__ __forceinline__ void operator()(AccRef acc, const Unit& u, int wr, int wc, int fr, int fq) const {
        const int row0 = u.pm * BM + wr * 64 + fr, col0 = u.pn * BM + wc * 32 + 4 * fq;
        const float* gp = gate + (size_t)(u.pm < ML / 256 ? (u.pm >> 4) : 8) * gstride + col0;
        f32x4 gv[2][2];
#pragma unroll
        for (int bj = 0; bj < 2; ++bj)
#pragma unroll
            for (int n = 0; n < 2; ++n) gv[bj][n] = *(const f32x4*)(gp + bj * HALF + n * 16);
        if (u.part < 0) {
#pragma unroll
            for (int ai = 0; ai < 2; ++ai)
#pragma unroll
                for (int m = 0; m < 4; ++m) { const size_t off = (size_t)(row0 + ai * HALF + m * 16) * D + col0;
#pragma unroll
                    for (int bj = 0; bj < 2; ++bj)
#pragma unroll
                        for (int n = 0; n < 2; ++n) { const f32x4 xv = *(const f32x4*)(xin + off + bj * HALF + n * 16); *(f32x4*)(xout + off + bj * HALF + n * 16) = xv + gv[bj][n] * acc[ai][bj][m][n]; } }
        } else { bf16_t* ob = Op + (size_t)u.part * pstride;
#pragma unroll
            for (int ai = 0; ai < 2; ++ai)
#pragma unroll
                for (int m = 0; m < 4; ++m) { const size_t off = (size_t)(row0 - prow0 + ai * HALF + m * 16) * D + col0;
#pragma unroll
                    for (int bj = 0; bj < 2; ++bj)
#pragma unroll
                        for (int n = 0; n < 2; ++n) { const f32x4 y = gv[bj][n] * acc[ai][bj][m][n]; u32x2 w; w.x = cvt_pk_bf16(y[0], y[1]); w.y = cvt_pk_bf16(y[2], y[3]); *(u32x2*)(ob + off + bj * HALF + n * 16) = w; } }
        }
    }
};
constexpr int XBP = 2048;
template <bool XF32> struct EpiResB {
    static constexpr bool PERM = true;
    const float* xin; bf16_t* xb; const float* gate; int gstride; bf16_t* Op; size_t pstride; int prow0;
    __device__ __forceinline__ void operator()(AccRef acc, const Unit& u, int wr, int wc, int fr, int fq) const {
        const int row0 = u.pm * BM + wr * 64 + fr, col0 = u.pn * BM + wc * 32 + 8 * fq;
        const float* gp = gate + (size_t)(u.pm < ML / 256 ? (u.pm >> 4) : 8) * gstride + col0;
        f32x4 gv[2][2];
#pragma unroll
        for (int bj = 0; bj < 2; ++bj)
#pragma unroll
            for (int n = 0; n < 2; ++n) gv[bj][n] = *(const f32x4*)(gp + bj * HALF + 4 * n);
        if (u.part < 0) {
#pragma unroll
            for (int ai = 0; ai < 2; ++ai)
#pragma unroll
                for (int m = 0; m < 4; ++m) { const int row = row0 + ai * HALF + m * 16;
#pragma unroll
                    for (int bj = 0; bj < 2; ++bj) { f32x4 x0, x1; bf16_t* xp = xb + (size_t)row * XBP + col0 + bj * HALF;
                        if constexpr (XF32) { const float* xf = xin + (size_t)row * D + col0 + bj * HALF; x0 = *(const f32x4*)xf; x1 = *(const f32x4*)(xf + 4); }
                        else { const u32x4 w = *(const u32x4*)xp; x0 = (f32x4){__uint_as_float(w.x << 16), __uint_as_float(w.x & 0xffff0000u), __uint_as_float(w.y << 16), __uint_as_float(w.y & 0xffff0000u)};
                            x1 = (f32x4){__uint_as_float(w.z << 16), __uint_as_float(w.z & 0xffff0000u), __uint_as_float(w.w << 16), __uint_as_float(w.w & 0xffff0000u)}; }
                        const f32x4 y0 = x0 + gv[bj][0] * acc[ai][bj][m][0], y1 = x1 + gv[bj][1] * acc[ai][bj][m][1];
                        u32x4 o; o.x = cvt_pk_bf16(y0[0], y0[1]); o.y = cvt_pk_bf16(y0[2], y0[3]); o.z = cvt_pk_bf16(y1[0], y1[1]); o.w = cvt_pk_bf16(y1[2], y1[3]);
                        *(u32x4*)xp = o; } }
        } else { bf16_t* ob = Op + (size_t)u.part * pstride;
#pragma unroll
            for (int ai = 0; ai < 2; ++ai)
#pragma unroll
                for (int m = 0; m < 4; ++m) { bf16_t* rowp = ob + (size_t)(row0 - prow0 + ai * HALF + m * 16) * D + col0;
#pragma unroll
                    for (int bj = 0; bj < 2; ++bj) { const f32x4 y0 = gv[bj][0] * acc[ai][bj][m][0], y1 = gv[bj][1] * acc[ai][bj][m][1];
                        u32x4 o; o.x = cvt_pk_bf16(y0[0], y0[1]); o.y = cvt_pk_bf16(y0[2], y0[3]); o.z = cvt_pk_bf16(y1[0], y1[1]); o.w = cvt_pk_bf16(y1[2], y1[3]);
                        *(u32x4*)(rowp + bj * HALF) = o; } }
        }
    }
};
struct EpiSwiglu {
    static constexpr bool PERM = true;
    bf16_t* U; int ldc;
    __device__ __forceinline__ void operator()(AccRef acc, const Unit& u, int wr, int wc, int fr, int fq) const {
        const int row0 = u.pm * BM + wr * 64 + fr, col0 = u.pn * 128 + wc * 32 + 8 * fq;
#pragma unroll
        for (int ai = 0; ai < 2; ++ai)
#pragma unroll
            for (int m = 0; m < 4; ++m) { bf16_t* rowp = U + (size_t)(row0 + ai * HALF + m * 16) * ldc + col0; float o[8];
#pragma unroll
                for (int n = 0; n < 2; ++n)
#pragma unroll
                    for (int j = 0; j < 4; ++j) { const float a = acc[ai][0][m][n][j], b = acc[ai][1][m][n][j]; o[n * 4 + j] = silu_f(a) * b; }
                u32x4 w; w.x = cvt_pk_bf16(o[0], o[1]); w.y = cvt_pk_bf16(o[2], o[3]); w.z = cvt_pk_bf16(o[4], o[5]); w.w = cvt_pk_bf16(o[6], o[7]);
                *(u32x4*)rowp = w; }
    }
};
struct EpiSwiglu8 {
    static constexpr bool PERM = true;
    unsigned char* U; int ldc;
    __device__ __forceinline__ void operator()(AccRef acc, const Unit& u, int wr, int wc, int fr, int fq) const {
        const int row0 = u.pm * BM + wr * 64 + fr, col0 = u.pn * 128 + wc * 32 + 8 * fq;
#pragma unroll
        for (int ai = 0; ai < 2; ++ai)
#pragma unroll
            for (int m = 0; m < 4; ++m) { unsigned char* rowp = U + (size_t)(row0 + ai * HALF + m * 16) * ldc + col0; float o[8];
#pragma unroll
                for (int n = 0; n < 2; ++n)
#pragma unroll
                    for (int j = 0; j < 4; ++j) { const float a = acc[ai][0][m][n][j], b = acc[ai][1][m][n][j]; o[n * 4 + j] = silu_f(a) * b; }
                *(u32x2*)rowp = pack8_f8(o); }
    }
};
}

namespace att {
constexpr int VSLOT = 8192, NSLOT = 3;
constexpr int OFF_K = 0;
constexpr int OFF_V = NSLOT * 12 * 1024;
constexpr int OFF_WS = OFF_V + NSLOT * VSLOT;
constexpr int OFF_OST = OFF_WS + 8 * 512;
constexpr int OFF_BIAS = OFF_OST + 8 * 4096;
constexpr int LDS_END = OFF_BIAS + 640 * 4;
__device__ __forceinline__ int crow(int r, int hi) { return (r & 3) + 8 * (r >> 2) + 4 * hi; }
__device__ __forceinline__ void glds16(const void* gsrc, unsigned lds_dst) { unsigned keep;
    asm volatile("s_mov_b32 %0, m0\n\ts_mov_b32 m0, %2\n\ts_nop 0\n\tglobal_load_lds_dwordx4 %1, off\n\ts_mov_b32 m0, %0" : "=&s"(keep) : "v"(gsrc), "s"(lds_dst) : "memory"); }
__device__ __forceinline__ void glds16s(const void* sbase, unsigned voff, unsigned lds_dst) { unsigned keep;
    asm volatile("s_mov_b32 %0, m0\n\ts_mov_b32 m0, %3\n\ts_nop 0\n\tglobal_load_lds_dwordx4 %1, %2\n\ts_mov_b32 m0, %0" : "=&s"(keep) : "v"(voff), "s"(sbase), "s"(lds_dst) : "memory"); }
__device__ __forceinline__ s16x4 vtr(LAS const char* p) { typedef short v4i16_t __attribute__((ext_vector_type(4)));
    return __builtin_bit_cast(s16x4, __builtin_amdgcn_ds_read_tr16_b64_v4i16((LAS v4i16_t*)p)); }

struct Unit {
    const bf16_t* qn; int ldq;
    const bf16_t* qr; int ldqr;
    const bf16_t* kn; int ldk;
    const bf16_t* kr; int ldkr;
    const bf16_t* v; int ldv;
    bf16_t* o; int ldo;
    int na, rowa, rowc;
    int rg, rlo;
};

template <int NCH, bool NA, bool FAST = false>
__device__ __forceinline__ bool attn_unit(LAS char* lds, const Unit& U, const int wid0) {
    const int lane = fresh_lane(), r32 = lane & 31, hi = lane >> 5, wid = wid0, tid = wid * 64 + lane; (void)tid;
    constexpr int KSLOT = NCH * 1024;
    const unsigned lds0 = (unsigned)(uintptr_t)lds;
    LAS float* wsf = (LAS float*)(lds + OFF_WS) + wid * 128;
    const int NT = U.na + 4;
    bf16x8 qf[NCH / 2];
    const int qrow = NA ? ((wid >> 2) * 2 + (r32 >> 4)) * 64 + (wid & 3) * 16 + (r32 & 15) : wid * 32 + r32;
    { const bf16_t* qp = U.qn + (size_t)qrow * U.ldq + hi * 8;
#pragma unroll
      for (int d0 = 0; d0 < 4; ++d0) qf[d0] = *(const bf16x8*)(qp + d0 * 16);
      if constexpr (NCH == 12) { const bf16_t* qp2 = U.qr + (size_t)qrow * U.ldqr + hi * 8;
#pragma unroll
          for (int d0 = 0; d0 < 2; ++d0) qf[4 + d0] = *(const bf16x8*)(qp2 + d0 * 16); } }
#pragma unroll
    for (int d0 = 0; d0 < NCH / 2; ++d0) asm volatile("" : "+v"(qf[d0]));
    VM_WAIT();
    auto tile_row = [&](int it) -> int { return it < U.na ? U.rowa + 64 * it : U.rowc + 64 * (it - U.na); };
    auto dma = [&](int it, int slot) {
        const int row = tile_row(it);
        glds16(U.v + (size_t)(row + 16 * (wid & 3) + (lane >> 2)) * U.ldv + (wid >> 2) * 32 + (lane & 3) * 8, (unsigned)__builtin_amdgcn_readfirstlane(lds0 + OFF_V + slot * VSLOT + wid * 1024));
        glds16(U.kn + (size_t)(row + lane) * U.ldk + wid * 8, (unsigned)__builtin_amdgcn_readfirstlane(lds0 + OFF_K + slot * KSLOT + wid * 1024));
        if constexpr (NCH == 12) glds16(U.kr + (size_t)(row + lane) * U.ldkr + (wid & 3) * 8, (unsigned)__builtin_amdgcn_readfirstlane(lds0 + OFF_K + slot * KSLOT + (8 + (wid & 3)) * 1024));
    };
    constexpr int NPER = (NCH == 12) ? 3 : 2;
    dma(0, 0); dma(1, 1);
    float mrun = -INFINITY, lrun = 0.f; f32x16 o[2]; o[0] = f32x16{}; o[1] = f32x16{};
    f32x16 lacc = f32x16{}; const bf16x8 ones = (bf16x8){0x3f80, 0x3f80, 0x3f80, 0x3f80, 0x3f80, 0x3f80, 0x3f80, 0x3f80};
    const int R0 = NA ? 4 * U.rg + 2 * (wid >> 2) : 0, grow = R0 + (r32 >> 4), qc = 16 * (wid & 3) + (r32 & 15);
    const int r0q = min(max(grow - 4, 0), 56), c0w = min(max(qc - 8, 0), 48);
    const int r0lo = min(max(R0 - 4, 0), 56), r0hi = min(max(R0 - 3, 0), 56);
    const int kb = NA ? min(max(16 * (wid & 3) - 8, 0), 32) : 0;
    LAS const float* btab = (LAS const float*)(lds + OFF_BIAS);
    const int vaddr = ((lane >> 4) & 1) * 32 + (lane & 3) * 8 + (4 * hi + ((lane & 15) >> 2)) * 64;
    int slot = 0;
    for (int it = 0; it < NT; ++it) {
        if (it + 1 < NT) { if constexpr (NPER == 3) asm volatile("s_waitcnt vmcnt(3)" ::: "memory"); else asm volatile("s_waitcnt vmcnt(2)" ::: "memory"); }
        else asm volatile("s_waitcnt vmcnt(0)" ::: "memory");
        asm volatile("s_barrier" ::: "memory");
        if (it + 2 < NT) { const int s2 = slot >= 1 ? slot - 1 : 2; dma(it + 2, s2); }
        bool active = true, band = false; int krow = 0;
        if constexpr (NA) { if (it < U.na) { band = true; krow = U.rlo + it; active = (krow >= r0lo) && (krow < r0hi + 8); } }
        if (active) {
            LAS const char* ks = lds + OFF_K + slot * KSLOT + r32 * 16 + (band ? kb * 16 : 0); LAS const char* vs = lds + OFF_V + slot * VSLOT + vaddr + (band ? kb * 64 : 0);
            f32x16 p0 = f32x16{}, p1 = f32x16{};
            if (band) {
              bf16x8 kf0[NCH / 2];
#pragma unroll
              for (int d0 = 0; d0 < NCH / 2; ++d0) kf0[d0] = *(const LAS bf16x8*)(ks + (2 * d0 + hi) * 1024);
              __builtin_amdgcn_sched_barrier(0);
#pragma unroll
              for (int d0 = 0; d0 < NCH / 2; ++d0) p0 = __builtin_amdgcn_mfma_f32_32x32x16_bf16(kf0[d0], qf[d0], p0, 0, 0, 0);
              const bool rowok = (krow >= r0q) && (krow < r0q + 8);
              LAS const float* bt = btab + 64 + (krow - grow + 7) * 31 + 15 - qc;
#pragma unroll
              for (int r = 0; r < 16; ++r) { const int kc = kb + crow(r, hi);
                  p0[r] = (rowok && (unsigned)(kc - c0w) < 16u) ? p0[r] + bt[kc] : -INFINITY; p1[r] = -INFINITY; }
            } else {
              bf16x8 kf0[NCH / 2], kf1[NCH / 2];
#pragma unroll
              for (int d0 = 0; d0 < NCH / 2; ++d0) { kf0[d0] = *(const LAS bf16x8*)(ks + (2 * d0 + hi) * 1024); kf1[d0] = *(const LAS bf16x8*)(ks + (2 * d0 + hi) * 1024 + 512); }
              __builtin_amdgcn_sched_barrier(0);
#pragma unroll
              for (int d0 = 0; d0 < NCH / 2; ++d0) { p0 = __builtin_amdgcn_mfma_f32_32x32x16_bf16(kf0[d0], qf[d0], p0, 0, 0, 0); p1 = __builtin_amdgcn_mfma_f32_32x32x16_bf16(kf1[d0], qf[d0], p1, 0, 0, 0); } }
            if constexpr (FAST) {
#pragma unroll
                for (int r = 0; r < 16; ++r) p0[r] = fexp2(p0[r]);
                if (!band) {
#pragma unroll
                    for (int r = 0; r < 16; ++r) p1[r] = fexp2(p1[r]); }
            } else {
            float mx = fmaxf(p0[0], p1[0]);
#pragma unroll
            for (int r = 1; r < 16; ++r) mx = fmaxf(mx, fmaxf(p0[r], p1[r]));
            mx = half_max(mx);
            const float mnew = fmaxf(mrun, mx);
            if (__any(mnew > mrun)) {
                const float alpha = (mnew == -INFINITY) ? 1.f : fexp2(mrun - mnew);
                lrun *= alpha; if (hi == 0) wsf[r32] = alpha; LDS_WAIT();
#pragma unroll
                for (int r = 0; r < 16; ++r) { const float a = wsf[crow(r, hi)]; o[0][r] *= a; o[1][r] *= a; }
                mrun = mnew;
            }
            float ls = 0.f; const float msub = (mrun == -INFINITY) ? 0.f : mrun;
#pragma unroll
            for (int r = 0; r < 16; ++r) { p0[r] = fexp2(p0[r] - msub); p1[r] = fexp2(p1[r] - msub); ls += p0[r] + p1[r]; }
            lrun += ls;
            }
            u32x4 pw[4];
#pragma unroll
            for (int j = 0; j < 4; ++j) { pw[0][j] = pk2(p0[2 * j], p0[2 * j + 1]); pw[1][j] = pk2(p0[8 + 2 * j], p0[9 + 2 * j]); pw[2][j] = pk2(p1[2 * j], p1[2 * j + 1]); pw[3][j] = pk2(p1[8 + 2 * j], p1[9 + 2 * j]); }
#pragma unroll
            for (int k = 0; k < 4; ++k) { if (k >= 2 && band) break;
#pragma unroll
                for (int db = 0; db < 2; ++db) { const s16x4 lo = vtr(vs + db * 4096 + k * 1024), h4 = vtr(vs + db * 4096 + k * 1024 + 512);
                    const bf16x8 vf = (bf16x8){lo[0], lo[1], lo[2], lo[3], h4[0], h4[1], h4[2], h4[3]};
                    o[db] = __builtin_amdgcn_mfma_f32_32x32x16_bf16(__builtin_bit_cast(bf16x8, pw[k]), vf, o[db], 0, 0, 0);
                    if (FAST && db == 1) lacc = __builtin_amdgcn_mfma_f32_32x32x16_bf16(__builtin_bit_cast(bf16x8, pw[k]), ones, lacc, 0, 0, 0); } }
        }
        slot = slot == 2 ? 0 : slot + 1;
    }
    LAS bf16_t* stg = (LAS bf16_t*)(lds + OFF_OST) + wid * 2048;
    if constexpr (FAST) {
        bool bad = false;
#pragma unroll
        for (int r = 0; r < 16; ++r) bad |= !(lacc[r] > 1e-30f && lacc[r] < 1e30f);
        LAS int* gf = (LAS int*)(lds + OFF_OST);
        asm volatile("s_waitcnt lgkmcnt(0)\n\ts_barrier" ::: "memory");
        const int ab = __any(bad) ? 1 : 0; if (lane == 0) gf[wid] = ab;
        asm volatile("s_waitcnt lgkmcnt(0)\n\ts_barrier" ::: "memory");
        int anyb = 0;
#pragma unroll
        for (int w = 0; w < 8; ++w) anyb |= gf[w];
        asm volatile("s_waitcnt lgkmcnt(0)\n\ts_barrier" ::: "memory");
        if (__builtin_amdgcn_readfirstlane(anyb)) return false;
#pragma unroll
        for (int r = 0; r < 16; ++r) { const int orow = crow(r, hi); const float il = frcp(lacc[r]);
#pragma unroll
            for (int db = 0; db < 2; ++db) stg[orow * 64 + db * 32 + r32] = (bf16_t)(pk2(o[db][r] * il, 0.f) & 0xffffu); }
    } else {
        lrun = half_sum(lrun);
        if (hi == 0) wsf[32 + r32] = frcp(lrun); LDS_WAIT();
#pragma unroll
        for (int r = 0; r < 16; ++r) { const int orow = crow(r, hi); const float il = wsf[32 + orow];
#pragma unroll
            for (int db = 0; db < 2; ++db) stg[orow * 64 + db * 32 + r32] = (bf16_t)(pk2(o[db][r] * il, 0.f) & 0xffffu); }
    }
    LDS_WAIT();
#pragma unroll
    for (int i = 0; i < 4; ++i) { const int row = i * 8 + (lane >> 3), ch = lane & 7; const u32x4 v = *(const LAS u32x4*)(stg + row * 64 + ch * 8);
        const int orow_g = NA ? ((wid >> 2) * 2 + (row >> 4)) * 64 + (wid & 3) * 16 + (row & 15) : wid * 32 + row;
        *(u32x4*)(U.o + (size_t)orow_g * U.ldo + ch * 8) = v; }
    asm volatile("s_waitcnt lgkmcnt(0)\n\ts_barrier" ::: "memory");
    return true;
}

__device__ __forceinline__ float rowmax32(const f32x16& p0, const f32x16& p1) {
    float a = __builtin_fmaxf(__builtin_fmaxf(p0[0], p0[1]), p1[0]), b = __builtin_fmaxf(__builtin_fmaxf(p0[2], p0[3]), p1[1]); a = __builtin_fmaxf(__builtin_fmaxf(a, p1[2]), p1[3]);
#pragma unroll
    for (int r = 4; r < 16; r += 4) { a = __builtin_fmaxf(__builtin_fmaxf(a, p0[r]), p0[r + 1]); b = __builtin_fmaxf(__builtin_fmaxf(b, p0[r + 2]), p0[r + 3]); a = __builtin_fmaxf(__builtin_fmaxf(a, p1[r]), p1[r + 1]); b = __builtin_fmaxf(__builtin_fmaxf(b, p1[r + 2]), p1[r + 3]); }
    const float m = __builtin_fmaxf(a, b); return half_max(m);
}
__device__ __forceinline__ void softmax_step(f32x16& p0, f32x16& p1, float& mref, float& lrun, f32x16 (&o)[2], LAS float* wsf, int r32, int hi, bool first, float thr) {
    const float mx = rowmax32(p0, p1);
    if (first || __any(mx > mref + thr)) {
        const float mnew = first ? mx : __builtin_fmaxf(mx, mref);
        if (!first) { const float alpha = fexp2(mref - mnew); lrun *= alpha; if (hi == 0) wsf[r32] = alpha; LDS_WAIT();
#pragma unroll
            for (int r = 0; r < 16; ++r) { const float a = wsf[crow(r, hi)]; o[0][r] *= a; o[1][r] *= a; } }
        mref = mnew;
    }
    float ls = 0.f;
#pragma unroll
    for (int r = 0; r < 16; ++r) { p0[r] = fexp2(p0[r] - mref); p1[r] = fexp2(p1[r] - mref); ls += p0[r] + p1[r]; }
    lrun += ls;
}
__device__ __forceinline__ bool attn_unit64(LAS char* lds, const Unit& U, const int wid0) {
    constexpr int NCH = 12, KSLOT = NCH * 1024;
    const int lane = fresh_lane(), r32 = lane & 31, hi = lane >> 5, wid = wid0;
    const unsigned lds0 = (unsigned)(uintptr_t)lds;
    LAS float* wsf = (LAS float*)(lds + OFF_WS) + wid * 128;
    const int NT = U.na + 4;
    bf16x8 qf[2][6];
#pragma unroll
    for (int qb = 0; qb < 2; ++qb) { const bf16_t* qp = U.qn + (size_t)(wid * 64 + qb * 32 + r32) * U.ldq + hi * 8; const bf16_t* qp2 = U.qr + (size_t)(wid * 64 + qb * 32 + r32) * U.ldqr + hi * 8;
#pragma unroll
        for (int d0 = 0; d0 < 4; ++d0) qf[qb][d0] = *(const bf16x8*)(qp + d0 * 16);
#pragma unroll
        for (int d0 = 0; d0 < 2; ++d0) qf[qb][4 + d0] = *(const bf16x8*)(qp2 + d0 * 16); }
#pragma unroll
    for (int qb = 0; qb < 2; ++qb)
#pragma unroll
        for (int d0 = 0; d0 < 6; ++d0) asm volatile("" : "+v"(qf[qb][d0]));
    VM_WAIT();
    auto tile_row = [&](int it) -> int { return it < U.na ? U.rowa + 64 * it : U.rowc + 64 * (it - U.na); };
    const unsigned offKn = (unsigned)(lane * U.ldk + wid * 8) * 2u, offKr = (unsigned)(lane * U.ldkr + (wid & 3) * 8) * 2u;
    const unsigned offV = (unsigned)((16 * (wid & 3) + (lane >> 2)) * U.ldv + (wid >> 2) * 32 + (lane & 3) * 8) * 2u;
    auto dma = [&](int it, int slot) {
        const int row = tile_row(it);
        glds16s((const char*)U.v + (size_t)row * U.ldv * 2, offV, (unsigned)__builtin_amdgcn_readfirstlane(lds0 + OFF_V + slot * VSLOT + wid * 1024));
        glds16s((const char*)U.kn + (size_t)row * U.ldk * 2, offKn, (unsigned)__builtin_amdgcn_readfirstlane(lds0 + OFF_K + slot * KSLOT + wid * 1024));
        glds16s((const char*)U.kr + (size_t)row * U.ldkr * 2, offKr, (unsigned)__builtin_amdgcn_readfirstlane(lds0 + OFF_K + slot * KSLOT + (8 + (wid & 3)) * 1024));
    };
    dma(0, 0); dma(1, 1);
    f32x16 lAcc = f32x16{}, lBcc = f32x16{};
    const bf16x8 ones = (bf16x8){0x3f80, 0x3f80, 0x3f80, 0x3f80, 0x3f80, 0x3f80, 0x3f80, 0x3f80}; f32x16 oA[2], oB[2]; oA[0] = f32x16{}; oA[1] = f32x16{}; oB[0] = f32x16{}; oB[1] = f32x16{};
    const int vaddr = ((lane >> 4) & 1) * 32 + (lane & 3) * 8 + (4 * hi + ((lane & 15) >> 2)) * 64;
    int slot = 0;
    for (int it = 0; it < NT; ++it) {
        if (it + 1 < NT) asm volatile("s_waitcnt vmcnt(3)" ::: "memory"); else asm volatile("s_waitcnt vmcnt(0)" ::: "memory");
        asm volatile("s_barrier" ::: "memory");
        if (it + 2 < NT) { const int s2 = slot >= 1 ? slot - 1 : 2; dma(it + 2, s2); }
        LAS const char* ks = lds + OFF_K + slot * KSLOT + r32 * 16; LAS const char* vs = lds + OFF_V + slot * VSLOT + vaddr;
        f32x16 pA0 = f32x16{}, pA1 = f32x16{}, pB0 = f32x16{}, pB1 = f32x16{};
        { bf16x8 a0 = *(const LAS bf16x8*)(ks + hi * 1024), a1 = *(const LAS bf16x8*)(ks + hi * 1024 + 512);
#pragma unroll
          for (int d0 = 0; d0 < 6; ++d0) {
            bf16x8 n0 = a0, n1 = a1;
            if (d0 < 5) { n0 = *(const LAS bf16x8*)(ks + (2 * d0 + 2 + hi) * 1024); n1 = *(const LAS bf16x8*)(ks + (2 * d0 + 2 + hi) * 1024 + 512); }
            __builtin_amdgcn_sched_barrier(0);
            pA0 = __builtin_amdgcn_mfma_f32_32x32x16_bf16(a0, qf[0][d0], pA0, 0, 0, 0); pA1 = __builtin_amdgcn_mfma_f32_32x32x16_bf16(a1, qf[0][d0], pA1, 0, 0, 0);
            pB0 = __builtin_amdgcn_mfma_f32_32x32x16_bf16(a0, qf[1][d0], pB0, 0, 0, 0); pB1 = __builtin_amdgcn_mfma_f32_32x32x16_bf16(a1, qf[1][d0], pB1, 0, 0, 0);
            __builtin_amdgcn_sched_barrier(0);
            a0 = n0; a1 = n1; } }
        __builtin_amdgcn_sched_barrier(0);
        { _Pragma("unroll") for (int r = 0; r < 16; ++r) { pA0[r] = fexp2(pA0[r]); pA1[r] = fexp2(pA1[r]); } }
        u32x4 pwA[4];
#pragma unroll
        for (int j = 0; j < 4; ++j) { pwA[0][j] = pk2(pA0[2 * j], pA0[2 * j + 1]); pwA[1][j] = pk2(pA0[8 + 2 * j], pA0[9 + 2 * j]); pwA[2][j] = pk2(pA1[2 * j], pA1[2 * j + 1]); pwA[3][j] = pk2(pA1[8 + 2 * j], pA1[9 + 2 * j]); }
        __builtin_amdgcn_sched_barrier(0);
        { _Pragma("unroll") for (int r = 0; r < 16; ++r) { pB0[r] = fexp2(pB0[r]); pB1[r] = fexp2(pB1[r]); } }
        u32x4 pwB[4];
#pragma unroll
        for (int j = 0; j < 4; ++j) { pwB[0][j] = pk2(pB0[2 * j], pB0[2 * j + 1]); pwB[1][j] = pk2(pB0[8 + 2 * j], pB0[9 + 2 * j]); pwB[2][j] = pk2(pB1[2 * j], pB1[2 * j + 1]); pwB[3][j] = pk2(pB1[8 + 2 * j], pB1[9 + 2 * j]); }
        __builtin_amdgcn_sched_barrier(0);
#pragma unroll
        for (int k = 0; k < 4; ++k)
#pragma unroll
            for (int db = 0; db < 2; ++db) { const s16x4 lo = vtr(vs + db * 4096 + k * 1024), h4 = vtr(vs + db * 4096 + k * 1024 + 512);
                const bf16x8 vf = (bf16x8){lo[0], lo[1], lo[2], lo[3], h4[0], h4[1], h4[2], h4[3]};
                oA[db] = __builtin_amdgcn_mfma_f32_32x32x16_bf16(__builtin_bit_cast(bf16x8, pwA[k]), vf, oA[db], 0, 0, 0);
                oB[db] = __builtin_amdgcn_mfma_f32_32x32x16_bf16(__builtin_bit_cast(bf16x8, pwB[k]), vf, oB[db], 0, 0, 0);
                if (db == 1) { lAcc = __builtin_amdgcn_mfma_f32_32x32x16_bf16(__builtin_bit_cast(bf16x8, pwA[k]), ones, lAcc, 0, 0, 0); lBcc = __builtin_amdgcn_mfma_f32_32x32x16_bf16(__builtin_bit_cast(bf16x8, pwB[k]), ones, lBcc, 0, 0, 0); } }
        slot = slot == 2 ? 0 : slot + 1;
    }
    {
        bool bad = false;
#pragma unroll
        for (int r = 0; r < 16; ++r) bad |= !(lAcc[r] > 1e-30f && lAcc[r] < 1e30f && lBcc[r] > 1e-30f && lBcc[r] < 1e30f);
        LAS int* gf = (LAS int*)(lds + OFF_OST);
        asm volatile("s_waitcnt lgkmcnt(0)\n\ts_barrier" ::: "memory");
        const int ab = __any(bad) ? 1 : 0; if (lane == 0) gf[wid] = ab;
        asm volatile("s_waitcnt lgkmcnt(0)\n\ts_barrier" ::: "memory");
        int anyb = 0;
#pragma unroll
        for (int w = 0; w < 8; ++w) anyb |= gf[w];
        asm volatile("s_waitcnt lgkmcnt(0)\n\ts_barrier" ::: "memory");
        if (__builtin_amdgcn_readfirstlane(anyb)) return false;
    }
    LAS bf16_t* stg = (LAS bf16_t*)(lds + OFF_OST) + wid * 2048;
#pragma unroll
    for (int qb = 0; qb < 2; ++qb) {
        LDS_WAIT();
#pragma unroll
        for (int r = 0; r < 16; ++r) { const int orow = crow(r, hi); const float il = frcp(qb == 0 ? lAcc[r] : lBcc[r]);
#pragma unroll
            for (int db = 0; db < 2; ++db) stg[orow * 64 + db * 32 + r32] = (bf16_t)(pk2((qb == 0 ? oA[db][r] : oB[db][r]) * il, 0.f) & 0xffffu); }
        LDS_WAIT();
        bf16_t* Ow = U.o + (size_t)(wid * 64 + qb * 32) * U.ldo;
#pragma unroll
        for (int i = 0; i < 4; ++i) { const int row = i * 8 + (lane >> 3), ch = lane & 7; const u32x4 v = *(const LAS u32x4*)(stg + row * 64 + ch * 8); *(u32x4*)(Ow + (size_t)row * U.ldo + ch * 8) = v; }
    }
    asm volatile("s_waitcnt lgkmcnt(0)\n\ts_barrier" ::: "memory");
    return true;
}
}

namespace ml {
constexpr int WAVE_LDS = 19328;
constexpr int OFF_VT = 0, OFF_KT = 8192, OFF_TB = 16384;
constexpr int TB_CS = 0, TB_BT = 128, TB_EM = 256, TB_NI = 384, TB_HD = 512, TB_QW = 544;
__device__ __forceinline__ int crow(int r, int hi) { return (r & 3) + 8 * (r >> 2) + 4 * hi; }
__device__ __forceinline__ int chunk_row(int b, int j) { return j < 4 ? ML + b * NC + j * 64 : b * T + (j - 4) * 64; }
__device__ __forceinline__ float prefix_sum(float v, int lane) {
#pragma unroll
    for (int o = 1; o < 64; o <<= 1) { const float t = __shfl_up(v, o); if (lane >= o) v += t; }
    return v;
}
__device__ __forceinline__ float prefix_max(float v, int lane) {
#pragma unroll
    for (int o = 1; o < 64; o <<= 1) { const float t = __shfl_up(v, o); if (lane >= o) v = fmaxf(v, t); }
    return v;
}
__device__ __forceinline__ float suffix_max(float v, int lane) {
#pragma unroll
    for (int o = 1; o < 64; o <<= 1) { const float t = __shfl_down(v, o); if (lane + o < 64) v = fmaxf(v, t); }
    return v;
}
struct Gates { float li[2], bcum[2], g[2]; };
__device__ __forceinline__ void load_gates(const bf16_t* P, int row, int h, const float* igb, const float* fgb, Gates& G, int lane) {
    const bf16_t* gp = P + (size_t)row * NP + PC_GT;
#pragma unroll
    for (int d = 0; d < 2; ++d) {
        const float gi = bf2f(gp[d * 4 + h]) + igb[d * 4 + h], gf = bf2f(gp[8 + d * 4 + h]) + fgb[d * 4 + h];
        const float lf = fminf(gf, 0.f) - log1pf(expf(-fabsf(gf)));
        const float ps = prefix_sum(lf, lane), tot = __shfl(ps, 63);
        G.li[d] = gi; G.g[d] = tot; G.bcum[d] = d == 0 ? ps : tot - ps + lf;
    }
}
__device__ __forceinline__ bf16x8 trfrag(LAS const char* tile, int blk, int ks, int lane) {
    const int hi = lane >> 5, q = (lane & 15) >> 2; LAS const char* p = tile + blk * 4096 + (16 * ks + 8 * hi + q) * 64 + ((lane >> 4) & 1) * 32 + (lane & 3) * 8;
    const s16x4 lo = att::vtr(p), h4 = att::vtr(p + 256);
    return (bf16x8){lo[0], lo[1], lo[2], lo[3], h4[0], h4[1], h4[2], h4[3]};
}
__device__ __forceinline__ void load_vtile(LAS char* vt, const bf16_t* P, int rowbase, int col, int lane) {
#pragma unroll
    for (int i = 0; i < 8; ++i) { const int t = i * 8 + (lane >> 3), c = lane & 7;
        const u32x4 w = *(const u32x4*)(P + (size_t)(rowbase + t) * NP + col + 8 * c); *(LAS u32x4*)(vt + (c >> 2) * 4096 + t * 64 + (c & 3) * 16) = w; }
}
__device__ __forceinline__ void conv8(const bf16_t* P, int row, int col, int pos, int len, const float* w0, const float* w1, const float* w2, float* y) {
    const bf16_t* p = P + (size_t)row * NP + col; float x0[8], x1[8], x2[8];
    unpack8(*(const u32x4*)p, x1);
    if (pos > 0) unpack8(*(const u32x4*)(p - NP), x0); else { for (int e = 0; e < 8; ++e) x0[e] = 0.f; }
    if (pos < len - 1) unpack8(*(const u32x4*)(p + NP), x2); else { for (int e = 0; e < 8; ++e) x2[e] = 0.f; }
#pragma unroll
    for (int e = 0; e < 8; ++e) y[e] = silu_f(x0[e] * w0[e] + x1[e] * w1[e] + x2[e] * w2[e]);
}

__device__ __forceinline__ void chunk_state_unit(LAS char* wl, int b, int h, int j, const bf16_t* P, const float* convw, const float* igb, const float* fgb,
                                                 float* CLOC, float* NLOC, float* MG, int lane) {
    const int r32 = lane & 31, hi = lane >> 5;
    const int rowbase = chunk_row(b, j), len = j < 4 ? NC : T, pos0 = j < 4 ? j * 64 : (j - 4) * 64;
    LAS float* tb = (LAS float*)(wl + OFF_TB);
    u32x4 vraw[8], kr0[8], kr1[8], kr2[8];
    { const int c = lane & 7; const bf16_t* pv = P + (size_t)(rowbase + (lane >> 3)) * NP + PC_MV + h * 64 + 8 * c; const bf16_t* pk = P + (size_t)(rowbase + (lane >> 3)) * NP + PC_MK + h * 64 + 8 * c;
#pragma unroll
      for (int i = 0; i < 8; ++i) { vraw[i] = *(const u32x4*)(pv + (size_t)(8 * i) * NP); kr1[i] = *(const u32x4*)(pk + (size_t)(8 * i) * NP);
          kr0[i] = *(const u32x4*)(pk + (size_t)(8 * i) * NP - NP); kr2[i] = *(const u32x4*)(pk + (size_t)(8 * i) * NP + NP); } }
    Gates G; load_gates(P, rowbase + lane, h, igb, fgb, G, lane);
    float mloc[2];
#pragma unroll
    for (int d = 0; d < 2; ++d) { const float a = G.g[d] - G.bcum[d] + G.li[d]; mloc[d] = wave_max(a); tb[d * 64 + lane] = fexp(a - mloc[d]); }
    { const int c = lane & 7; float w0[8], w1[8], w2[8]; const float* cw = convw + 256 + h * 64 + 8 * c;
#pragma unroll
      for (int e = 0; e < 8; ++e) { w0[e] = cw[e]; w1[e] = cw[512 + e]; w2[e] = cw[1024 + e]; }
#pragma unroll
      for (int i = 0; i < 8; ++i) { const int t = i * 8 + (lane >> 3); float y[8], x0[8], x1[8], x2[8]; unpack8(kr0[i], x0); unpack8(kr1[i], x1); unpack8(kr2[i], x2);
          const bool hp = pos0 + t > 0, hn = pos0 + t < len - 1;
#pragma unroll
          for (int e = 0; e < 8; ++e) y[e] = 0.125f * silu_f((hp ? x0[e] : 0.f) * w0[e] + x1[e] * w1[e] + (hn ? x2[e] : 0.f) * w2[e]);
          *(LAS u32x4*)(wl + OFF_KT + (c >> 2) * 4096 + t * 64 + (c & 3) * 16) = pack8(y); } }
    LDS_WAIT();
#pragma unroll 1
    for (int d = 0; d < 2; ++d) {
        LDS_WAIT();
        { const int c = lane & 7;
#pragma unroll
          for (int i = 0; i < 8; ++i) { const int t = i * 8 + (lane >> 3); const float w = tb[d * 64 + t]; float y[8]; unpack8(vraw[i], y);
#pragma unroll
              for (int e = 0; e < 8; ++e) y[e] *= w;
              *(LAS u32x4*)(wl + OFF_VT + (c >> 2) * 4096 + t * 64 + (c & 3) * 16) = pack8(y); } }
        LDS_WAIT();
        const size_t sidx = ((size_t)((d * NB + b) * 4 + h) * NCHK + j);
        float* cl = CLOC + sidx * 4096;
#pragma unroll
        for (int db = 0; db < 2; ++db) { bf16x8 af[4];
#pragma unroll
            for (int ks = 0; ks < 4; ++ks) af[ks] = trfrag(wl + OFF_VT, db, ks, lane);
#pragma unroll
            for (int dkb = 0; dkb < 2; ++dkb) { f32x16 acc = f32x16{};
#pragma unroll
                for (int ks = 0; ks < 4; ++ks) acc = __builtin_amdgcn_mfma_f32_32x32x16_bf16(af[ks], trfrag(wl + OFF_KT, dkb, ks, lane), acc, 0, 0, 0);
#pragma unroll
                for (int i = 0; i < 16; ++i) cl[(32 * db + crow(i, hi)) * 64 + 32 * dkb + r32] = acc[i]; } }
        { float sacc = 0.f; LAS const bf16_t* kt = (LAS const bf16_t*)(wl + OFF_KT + (lane >> 5) * 4096 + (lane & 31) * 2);
#pragma unroll 8
          for (int t = 0; t < 64; ++t) sacc += bf2f(kt[t * 32]) * tb[d * 64 + t];
          NLOC[sidx * 64 + lane] = sacc; }
        if (lane == 0) { MG[sidx * 2] = d == 0 ? mloc[0] : mloc[1]; MG[sidx * 2 + 1] = d == 0 ? G.g[0] : G.g[1]; }
    }
    LDS_WAIT();
}

__device__ __forceinline__ int step_chunk(int d, int s) { return d == 0 ? s : (s < 4 ? 3 - s : 71 - s); }
__device__ __forceinline__ void scan_item(LAS char* lds, const int wid0, int item, const float* CLOC, const float* NLOC, const float* MG, bf16_t* CIN, float* NIN, float* MIN_) {
    const int tid = wid0 * 64 + fresh_lane(); const int dbh = item >> 2, qd = item & 3, d = dbh >> 5;
    LAS float* mg = (LAS float*)lds; LAS float* wo = mg + 2 * NCHK; LAS float* wn = wo + NCHK;
    __syncthreads();
    if (tid < 2 * NCHK) mg[tid] = MG[(size_t)dbh * NCHK * 2 + tid];
    __syncthreads();
    if (tid == 0) { float m = -INFINITY;
        for (int s = 0; s < NCHK; ++s) { const int j = step_chunk(d, s); const float mj = mg[2 * j], gj = mg[2 * j + 1];
            if (qd == 0) MIN_[(size_t)dbh * NCHK + j] = m;
            const float mn = fmaxf(gj + m, mj); wo[s] = fexp(gj + m - mn); wn[s] = fexp(mj - mn); m = mn; } }
    __syncthreads();
    const float* cl = CLOC + (size_t)dbh * NCHK * 4096; bf16_t* ci = CIN + (size_t)dbh * NCHK * 4096;
    const int e0 = qd * 1024 + tid, e1 = e0 + 512;
    float s0 = 0.f, s1 = 0.f;
    const int en = qd * 16 + (tid & 15); float sn = 0.f; const float* nl = NLOC + (size_t)dbh * NCHK * 64; float* ni = NIN + (size_t)dbh * NCHK * 64;
#pragma unroll 1
    for (int sb = 0; sb < NCHK; sb += 17) { float c0[17], c1[17], cn[17];
#pragma unroll
        for (int i = 0; i < 17; ++i) { const int j = step_chunk(d, sb + i); c0[i] = cl[(size_t)j * 4096 + e0]; c1[i] = cl[(size_t)j * 4096 + e1]; cn[i] = nl[j * 64 + en]; }
#pragma unroll
        for (int i = 0; i < 17; ++i) { const int s = sb + i, j = step_chunk(d, s);
            ci[(size_t)j * 4096 + e0] = (bf16_t)(pk2(s0, 0.f) & 0xffffu); ci[(size_t)j * 4096 + e1] = (bf16_t)(pk2(s1, 0.f) & 0xffffu);
            if (tid < 16) ni[j * 64 + en] = sn;
            s0 = wo[s] * s0 + wn[s] * c0[i]; s1 = wo[s] * s1 + wn[s] * c1[i]; sn = wo[s] * sn + wn[s] * cn[i]; } }
}

__device__ __forceinline__ void out_unit(LAS char* wl, int b, int h, int j, const bf16_t* P, const float* convw, const float* igb, const float* fgb, const float* normw,
                                         const bf16_t* CIN, const float* NIN, const float* MIN_, bf16_t* MIX, int lane) {
    const int r32_ = lane & 31, hi_ = lane >> 5;
    const int rowbase = chunk_row(b, j), len = j < 4 ? NC : T, pos0 = j < 4 ? j * 64 : (j - 4) * 64;
    LAS float* tb = (LAS float*)(wl + OFF_TB);
    float min_d[2];
    { Gates G; load_gates(P, rowbase + lane, h, igb, fgb, G, lane);
#pragma unroll
      for (int d = 0; d < 2; ++d) { const float cs = G.li[d] - G.bcum[d]; const float pm = d == 0 ? prefix_max(cs, lane) : suffix_max(cs, lane);
          const size_t sidx = ((size_t)((d * NB + b) * 4 + h) * NCHK + j);
          const float mi = MIN_[sidx]; min_d[d] = mi;
          const float mt = G.bcum[d] + fmaxf(mi, pm);
          tb[TB_CS + d * 64 + lane] = cs; tb[TB_BT + d * 64 + lane] = G.bcum[d] - mt; tb[TB_EM + d * 64 + lane] = fexp(-mt); tb[TB_NI + d * 64 + lane] = NIN[sidx * 64 + lane]; } }
#pragma unroll
    for (int k = 0; k < 3; ++k) tb[TB_QW + k * 64 + lane] = convw[k * 512 + h * 64 + lane];
    load_vtile(wl + OFF_VT, P, rowbase, PC_MV + h * 64, lane);
    { const int c = lane & 7; float w0[8], w1[8], w2[8]; const float* cw = convw + 256 + h * 64 + 8 * c;
#pragma unroll
      for (int e = 0; e < 8; ++e) { w0[e] = cw[e]; w1[e] = cw[512 + e]; w2[e] = cw[1024 + e]; }
#pragma unroll 2
      for (int i = 0; i < 8; ++i) { const int t = i * 8 + (lane >> 3); float y[8]; conv8(P, rowbase + t, PC_MK + h * 64 + 8 * c, pos0 + t, len, w0, w1, w2, y);
#pragma unroll
          for (int e = 0; e < 8; ++e) y[e] *= 0.125f;
          *(LAS u32x4*)(wl + OFF_KT + c * 1024 + t * 16) = pack8(y); } }
    LDS_WAIT();
#pragma unroll 1
    for (int tbk = 0; tbk < 2; ++tbk) {
        int r32 = r32_, hi = hi_; asm volatile("" : "+v"(r32), "+v"(hi));
        const int t = 32 * tbk + r32;
        const int vaddr = ((lane >> 4) & 1) * 32 + (lane & 3) * 8 + (4 * hi + ((lane & 15) >> 2)) * 64;
        u32x4 qf[4];
#pragma unroll
        for (int d0 = 0; d0 < 4; ++d0) { const int c = 2 * d0 + hi; float w0[8], w1[8], w2[8], y[8];
#pragma unroll
            for (int e = 0; e < 8; ++e) { w0[e] = tb[TB_QW + 8 * c + e]; w1[e] = tb[TB_QW + 64 + 8 * c + e]; w2[e] = tb[TB_QW + 128 + 8 * c + e]; }
            conv8(P, rowbase + t, PC_MQ + h * 64 + 8 * c, pos0 + t, len, w0, w1, w2, y); qf[d0] = pack8(y); }
        f32x16 hs[2]; hs[0] = f32x16{}; hs[1] = f32x16{};
#pragma unroll 1
        for (int d = 0; d < 2; ++d) {
            const size_t sidx = ((size_t)((d * NB + b) * 4 + h) * NCHK + j);
            const float mi = d == 0 ? min_d[0] : min_d[1];
            const float bt = tb[TB_BT + d * 64 + t], em = tb[TB_EM + d * 64 + t];
            const float wi = (mi == -INFINITY) ? 0.f : fexp(bt + mi);
            f32x16 p[2];
#pragma unroll
            for (int sb = 0; sb < 2; ++sb) { p[sb] = f32x16{};
#pragma unroll
                for (int d0 = 0; d0 < 4; ++d0) { const bf16x8 kfr = *(const LAS bf16x8*)(wl + OFF_KT + (2 * d0 + hi) * 1024 + (32 * sb + r32) * 16);
                    p[sb] = __builtin_amdgcn_mfma_f32_32x32x16_bf16(kfr, __builtin_bit_cast(bf16x8, qf[d0]), p[sb], 0, 0, 0); } }
            float ds = 0.f;
#pragma unroll
            for (int sb = 0; sb < 2; ++sb)
#pragma unroll
                for (int i = 0; i < 16; ++i) { const int s_ = 32 * sb + crow(i, hi); const bool valid = d == 0 ? (s_ <= t) : (s_ >= t);
                    const float w = valid ? fexp(bt + tb[TB_CS + d * 64 + s_]) : 0.f; p[sb][i] *= w; ds += p[sb][i]; }
            ds = half_sum(ds);
            float qn = 0.f; u32x4 qw[4];
#pragma unroll
            for (int d0 = 0; d0 < 4; ++d0) { float y[8]; unpack8(qf[d0], y);
#pragma unroll
                for (int e = 0; e < 8; ++e) { qn += y[e] * tb[TB_NI + d * 64 + 16 * d0 + 8 * hi + e]; y[e] *= wi; }
                qw[d0] = pack8(y); }
            qn = half_sum(qn);
            const float den = ds + wi * qn; const float hd = frcp(fmaxf(fabsf(den), em));
            LDS_WAIT();
            if (hi == 0) tb[TB_HD + r32] = hd;
            LDS_WAIT();
            u32x4 pw[4];
#pragma unroll
            for (int jj = 0; jj < 4; ++jj) { pw[0][jj] = pk2(p[0][2 * jj], p[0][2 * jj + 1]); pw[1][jj] = pk2(p[0][8 + 2 * jj], p[0][9 + 2 * jj]); pw[2][jj] = pk2(p[1][2 * jj], p[1][2 * jj + 1]); pw[3][jj] = pk2(p[1][8 + 2 * jj], p[1][9 + 2 * jj]); }
#pragma unroll
            for (int db = 0; db < 2; ++db) { f32x16 acc = f32x16{};
                const bf16_t* cp = CIN + sidx * 4096 + (size_t)(32 * db + r32) * 64 + 8 * hi; bf16x8 cf[4];
#pragma unroll
                for (int d0 = 0; d0 < 4; ++d0) cf[d0] = *(const bf16x8*)(cp + d0 * 16);
#pragma unroll
                for (int k = 0; k < 4; ++k) { LAS const char* vs = wl + OFF_VT + vaddr + db * 4096 + k * 1024; const s16x4 lo = att::vtr(vs), h4 = att::vtr(vs + 512);
                    const bf16x8 vf = (bf16x8){lo[0], lo[1], lo[2], lo[3], h4[0], h4[1], h4[2], h4[3]};
                    acc = __builtin_amdgcn_mfma_f32_32x32x16_bf16(__builtin_bit_cast(bf16x8, pw[k]), vf, acc, 0, 0, 0); }
#pragma unroll
                for (int d0 = 0; d0 < 4; ++d0) acc = __builtin_amdgcn_mfma_f32_32x32x16_bf16(__builtin_bit_cast(bf16x8, qw[d0]), cf[d0], acc, 0, 0, 0);
#pragma unroll
                for (int i = 0; i < 16; ++i) hs[db][i] += acc[i] * tb[TB_HD + crow(i, hi)]; }
        }
        const float nw0 = normw[h * 64 + r32], nw1 = normw[h * 64 + 32 + r32];
        const unsigned offp = (unsigned)((rowbase + 32 * tbk + 4 * hi) * NP + PC_MO + h * 64 + r32) * 2u, offm = (unsigned)((rowbase + 32 * tbk + 4 * hi) * D + h * 64 + r32) * 2u;
#pragma unroll
        for (int i = 0; i < 16; ++i) { float ss = hs[0][i] * hs[0][i] + hs[1][i] * hs[1][i];
            ss += __shfl_xor(ss, 1); ss += __shfl_xor(ss, 2); ss += __shfl_xor(ss, 4); ss += __shfl_xor(ss, 8); ss += __shfl_xor(ss, 16);
            const float sc = 1.0f / sqrtf(ss * (1.0f / 64.0f) + EPS);
            const unsigned ro = (unsigned)((i & 3) + 8 * (i >> 2));
            const bf16_t* op = (const bf16_t*)((const char*)P + (offp + ro * (unsigned)(NP * 2))); bf16_t* mp = (bf16_t*)((char*)MIX + (offm + ro * (unsigned)(D * 2)));
            mp[0] = (bf16_t)(pk2(hs[0][i] * sc * nw0 * sigmoid_f(bf2f(op[0])), 0.f) & 0xffffu);
            mp[32] = (bf16_t)(pk2(hs[1][i] * sc * nw1 * sigmoid_f(bf2f(op[32])), 0.f) & 0xffffu);
            if ((i & 3) == 3) asm volatile("" ::: "memory"); }
    }
    LDS_WAIT();
}
}

#define XB_TMO      128
#define XB_XCNT(j)  (256  + 64 * (j))
#define XB_XSUB(j)  (1280 + 64 * (j))
#define XB_XGEN(j)  (2304 + 64 * (j))
#define XB_TOP      3328
#define XB_TOPGEN   3392
#define XCD_BAR_WORDS 3456
#define XB_SPIN_CAP (1u << 18)
__device__ __forceinline__ unsigned xb_ld(unsigned* p)              { return __hip_atomic_load(p, __ATOMIC_RELAXED, __HIP_MEMORY_SCOPE_AGENT); }
__device__ __forceinline__ unsigned xb_add(unsigned* p, unsigned v) { return __hip_atomic_fetch_add(p, v, __ATOMIC_RELAXED, __HIP_MEMORY_SCOPE_AGENT); }
__device__ __forceinline__ unsigned xb_xcc_id() { return (unsigned)__builtin_amdgcn_s_getreg((3 << 11) | 20) & 0xFu; }
#define XB_SPIN(cond, bar) do { unsigned _sp = 0; while (cond) { __builtin_amdgcn_s_sleep(1); \
    if ((++_sp & 255u) == 0u) { if (xb_ld(&(bar)[XB_TMO])) break; if (_sp > XB_SPIN_CAP) { atomicAdd(&(bar)[XB_TMO], 1u); break; } } } } while (0)
struct XcdBarrier { unsigned* bar; unsigned x; volatile LAS unsigned* st; };
__device__ __forceinline__ XcdBarrier xcd_barrier_post(unsigned* bar, volatile LAS unsigned* st) {
    XcdBarrier b; b.bar = bar; b.x = xb_xcc_id(); b.st = st;
    if (threadIdx.x == 0) (void)xb_add(&bar[XB_XCNT(b.x)], 1u);
    return b;
}
__device__ __forceinline__ void xcd_barrier_complete(unsigned* bar, unsigned x, unsigned& nloc, unsigned& nx) {
    const unsigned G = gridDim.x * gridDim.y * gridDim.z;
    unsigned sum, cnt, mine, sp = 0u;
    for (;;) {
        sum = 0u; cnt = 0u; mine = 0u;
#pragma unroll
        for (unsigned j = 0; j < 16; ++j) { const unsigned c = xb_ld(&bar[XB_XCNT(j)]); sum += c; cnt += (c > 0u) ? 1u : 0u; mine = (j == x) ? c : mine; }
        if (sum == G) break;
        __builtin_amdgcn_s_sleep(1);
        if ((++sp & 255u) == 0u) { if (xb_ld(&bar[XB_TMO])) break; if (sp > XB_SPIN_CAP) { atomicAdd(&bar[XB_TMO], 1u); break; } }
    }
    nloc = mine > 0u ? mine : 1u; nx = cnt > 0u ? cnt : 1u;
}
__device__ __forceinline__ void xcd_barrier(const XcdBarrier& b) {
    asm volatile("s_waitcnt vmcnt(0)" ::: "memory");
    __syncthreads();
    if (threadIdx.x == 0) {
        unsigned* bar = b.bar;
        __builtin_amdgcn_s_waitcnt(0);
        unsigned nloc = b.st[0], nx = b.st[1];
        if (nloc == 0u) { xcd_barrier_complete(bar, b.x, nloc, nx); b.st[0] = nloc; b.st[1] = nx; }
        const unsigned old = xb_add(&bar[XB_XSUB(b.x)], 1u);
        const unsigned gen = old / nloc;
        if (old + 1u == (gen + 1u) * nloc) {
            __builtin_amdgcn_fence(__ATOMIC_RELEASE, "agent");
            asm volatile("s_waitcnt vmcnt(0)" ::: "memory");
            const unsigned og = xb_add(&bar[XB_TOP], 1u);
            const unsigned tg = og / nx;
            if (og + 1u == (tg + 1u) * nx) xb_add(&bar[XB_TOPGEN], 1u);
            else XB_SPIN(xb_ld(&bar[XB_TOPGEN]) == tg, bar);
            __builtin_amdgcn_fence(__ATOMIC_ACQUIRE, "agent");
            xb_add(&bar[XB_XGEN(b.x)], 1u);
            asm volatile("s_waitcnt vmcnt(0)" ::: "memory");
        } else {
            XB_SPIN(xb_ld(&bar[XB_XGEN(b.x)]) == gen, bar);
            __builtin_amdgcn_fence(__ATOMIC_ACQUIRE, "agent");
            asm volatile("s_waitcnt vmcnt(0)" ::: "memory");
        }
    }
    __syncthreads();
}

struct Args { const float* in[27]; float* out; unsigned char* ws; int ph_lo, ph_hi; };
enum { I_X = 0, I_C, I_CTX, I_CCTX, I_ADAW, I_ADAB, I_N1W, I_N2W, I_WIN, I_WOUT, I_CONVW, I_IGB, I_FGB, I_MLNW, I_RPB, I_QNW, I_KVNW, I_WUQ, I_WUKV, I_F1, I_F3, I_F2, I_RW, I_M1, I_M3, I_M2, I_FNW };

struct TrJob { const float* src; const float* src2; int ldn, K, ngrp, kind; bf16_t* dst; const float* ksc; float cs; };
struct TrItem { const float* sp; const float* kp; bf16_t* dp; int ldn, K; float cs; };
__device__ __forceinline__ void tr_resolve(const TrJob& J, int it, int lane, TrItem& T) {
    const int g = it % J.ngrp, kb = it / J.ngrp, c0 = 16 * g, k0 = 64 * kb; const float* src = J.src; int sc0 = c0; float cs = J.cs;
    if (J.kind == 1) {
        if (c0 < 512) sc0 = 2192 + c0; else if (c0 < 768) sc0 = 2704 + (c0 - 512); else if (c0 < 1792) sc0 = c0 - 768;
        else if (c0 < 2944) { sc0 = 1040 + (c0 - 1792); if (c0 < 2176) cs = 0.125f * LOG2E; }
        else if (c0 < 2976) sc0 = 2960 + (c0 - 2944); else if (c0 < 2992) sc0 = 1024 + (c0 - 2976); else { sc0 = 0; cs = 0.f; }
    } else if (J.kind == 2) {
        if (c0 < 384) sc0 = (c0 >> 6) * 96 + (c0 & 63); else { const int r = c0 - 384; sc0 = (r >> 5) * 96 + 64 + (r & 31); }
    } else if (J.kind == 3) {
        const int pn = c0 >> 8, cc = c0 & 255; if (cc >= 128) src = J.src2; sc0 = 128 * pn + (cc & 127);
    }
    T.sp = src + (size_t)(k0 + (lane >> 4)) * J.ldn + sc0 + (lane & 15); T.kp = J.ksc ? J.ksc + k0 + (lane >> 4) : nullptr; T.ldn = J.ldn; T.K = J.K; T.cs = cs;
    T.dp = J.dst + (size_t)c0 * J.K + k0;
}
__device__ __forceinline__ void tr_load(const TrItem& T, float (&v)[16], float (&kv)[16]) {
#pragma unroll
    for (int i = 0; i < 16; ++i) v[i] = T.sp[(size_t)(4 * i) * T.ldn];
    if (T.kp) {
#pragma unroll
        for (int i = 0; i < 16; ++i) kv[i] = T.kp[4 * i]; }
    else {
#pragma unroll
        for (int i = 0; i < 16; ++i) kv[i] = 1.f; }
}
__device__ __forceinline__ void tr_store(const TrItem& T, const float (&v)[16], const float (&kv)[16], LAS float* scr, int lane) {
#pragma unroll
    for (int i = 0; i < 16; ++i) scr[(4 * i + (lane >> 4)) * 17 + (lane & 15)] = v[i] * T.cs * kv[i];
    LDS_WAIT();
#pragma unroll
    for (int j = 0; j < 2; ++j) { const int id = lane + 64 * j, n = id >> 3, c = id & 7; float y[8];
#pragma unroll
        for (int e = 0; e < 8; ++e) y[e] = scr[(8 * c + e) * 17 + n];
        *(u32x4*)(T.dp + (size_t)n * T.K + 8 * c) = pack8(y); }
    LDS_WAIT();
}
template <class R> __device__ __forceinline__ void tr_run(int first, int stride, int total, const R& resolve, LAS float* scr, int lane) {
    int it = first; if (it >= total) return;
    TrItem Tc; float vc[16], kc[16]; resolve(it, Tc); tr_load(Tc, vc, kc);
    for (;;) {
        const int itn = it + stride; const bool hn = itn < total; TrItem Tn = Tc; float vn[16], kn[16];
        if (hn) { resolve(itn, Tn); tr_load(Tn, vn, kn); }
        else {
#pragma unroll
            for (int i = 0; i < 16; ++i) { vn[i] = 0.f; kn[i] = 0.f; } }
        tr_store(Tc, vc, kc, scr, lane);
        if (!hn) break;
        Tc = Tn;
#pragma unroll
        for (int i = 0; i < 16; ++i) { vc[i] = vn[i]; kc[i] = kn[i]; }
        it = itn;
    }
}
__device__ __forceinline__ void tr_load_nk(const TrItem& T, float (&v)[16]) {
#pragma unroll
    for (int i = 0; i < 16; ++i) v[i] = T.sp[(size_t)(4 * i) * T.ldn];
}
__device__ __forceinline__ void tr_store_nk(const TrItem& T, const float (&v)[16], LAS float* scr, int lane) {
#pragma unroll
    for (int i = 0; i < 16; ++i) scr[(4 * i + (lane >> 4)) * 17 + (lane & 15)] = v[i] * T.cs;
    LDS_WAIT();
#pragma unroll
    for (int j = 0; j < 2; ++j) { const int id = lane + 64 * j, n = id >> 3, c = id & 7; float y[8];
#pragma unroll
        for (int e = 0; e < 8; ++e) y[e] = scr[(8 * c + e) * 17 + n];
        *(u32x2*)((unsigned char*)T.dp + (size_t)n * T.K + 8 * c) = pack8_f8(y); }
    LDS_WAIT();
}
template <class R> __device__ __forceinline__ void tr_run2(int first, int stride, int total, const R& resolve, LAS float* scr, int lane) {
    int it = first; if (it >= total) return;
    TrItem Ta, Tb; float va[16], vb[16]; bool hb = it + stride < total;
    resolve(it, Ta); tr_load_nk(Ta, va); Tb = Ta;
    if (hb) { resolve(it + stride, Tb); tr_load_nk(Tb, vb); }
    else {
#pragma unroll
        for (int i = 0; i < 16; ++i) vb[i] = 0.f; }
    for (;;) {
        const int itn = it + 2 * stride; const bool hn = itn < total, hnb = itn + stride < total; TrItem Tna = Ta, Tnb = Ta; float vna[16], vnb[16];
        if (hn) { resolve(itn, Tna); tr_load_nk(Tna, vna); }
        else {
#pragma unroll
            for (int i = 0; i < 16; ++i) vna[i] = 0.f; }
        if (hnb) { resolve(itn + stride, Tnb); tr_load_nk(Tnb, vnb); }
        else {
#pragma unroll
            for (int i = 0; i < 16; ++i) vnb[i] = 0.f; }
        tr_store_nk(Ta, va, scr, lane);
        if (hb) tr_store_nk(Tb, vb, scr, lane);
        if (!hn) break;
        Ta = Tna; Tb = Tnb; hb = hnb;
#pragma unroll
        for (int i = 0; i < 16; ++i) { va[i] = vna[i]; vb[i] = vnb[i]; }
        it = itn;
    }
}
__device__ __forceinline__ int tr_job_count(const TrJob& J) { return J.ngrp * (J.K / 64); }

__device__ __forceinline__ void mod_item(LAS char* lds, const int wid0, int item, const float* c, const float* cctx, const float* adaw, const float* adab, float* modv) {
    const int lane = fresh_lane(), wid = wid0, tid = wid * 64 + lane, l = item / 96, ng = item % 96;
    LAS float* sc = (LAS float*)lds;
    LAS float* part = sc + 9 * 1024;
    __syncthreads();
    for (int i = tid; i < 9 * 1024; i += 512) { const float v = i < 8 * 1024 ? c[i] : cctx[i - 8 * 1024]; sc[i] = silu_f(v); }
    __syncthreads();
    float acc[9];
#pragma unroll
    for (int bi = 0; bi < 9; ++bi) acc[bi] = 0.f;
    const float* w = adaw + (size_t)l * 1024 * 6144 + ng * 64 + lane;
#pragma unroll 1
    for (int k0 = wid * 128; k0 < wid * 128 + 128; k0 += 16) { float wv[16];
#pragma unroll
        for (int i = 0; i < 16; ++i) wv[i] = w[(size_t)(k0 + i) * 6144];
#pragma unroll
        for (int i = 0; i < 16; ++i)
#pragma unroll
            for (int bi = 0; bi < 9; ++bi) acc[bi] += sc[bi * 1024 + k0 + i] * wv[i]; }
#pragma unroll
    for (int bi = 0; bi < 9; ++bi) part[(wid * 9 + bi) * 64 + lane] = acc[bi];
    __syncthreads();
    for (int i = tid; i < 9 * 64; i += 512) { const int bi = i >> 6, n = i & 63; float s = adab[l * 6144 + ng * 64 + n];
#pragma unroll
        for (int w8 = 0; w8 < 8; ++w8) s += part[(w8 * 9 + bi) * 64 + n];
        modv[((size_t)l * 9 + bi) * 6144 + ng * 64 + n] = s; }
}

__device__ __forceinline__ void norm_row(const float* xrow, const float* nw, const float* shift, const float* scale, int lane, f32x4 (&v)[4], const bf16_t* dl = nullptr, float* xw = nullptr, int nparts = 1, size_t pstride = 0) {
    float s = 0.f;
#pragma unroll
    for (int j = 0; j < 4; ++j) { v[j] = *(const f32x4*)(xrow + 4 * lane + 256 * j);
        if (dl) { for (int p = 0; p < nparts; ++p) { const u32x2 dw = *(const u32x2*)(dl + (size_t)p * pstride + 4 * lane + 256 * j); v[j].x += bf2f(dw.x & 0xffffu); v[j].y += __uint_as_float(dw.x & 0xffff0000u); v[j].z += bf2f(dw.y & 0xffffu); v[j].w += __uint_as_float(dw.y & 0xffff0000u); }
            *(f32x4*)(xw + 4 * lane + 256 * j) = v[j]; }
        s += (v[j].x * v[j].x + v[j].y * v[j].y) + (v[j].z * v[j].z + v[j].w * v[j].w); }
    const float rs = 1.0f / sqrtf(wave_sum(s) * (1.0f / D) + EPS);
#pragma unroll
    for (int j = 0; j < 4; ++j) { const int c = 4 * lane + 256 * j; const f32x4 w = *(const f32x4*)(nw + c), sh = *(const f32x4*)(shift + c), sc = *(const f32x4*)(scale + c);
        v[j] = (v[j] * rs * w) * (1.0f + sc) + sh; }
}
__device__ __forceinline__ void store_row_bf16(bf16_t* orow, int lane, const f32x4 (&v)[4]) {
#pragma unroll
    for (int j = 0; j < 4; ++j) { u32x2 w; w.x = pk2(v[j].x, v[j].y); w.y = pk2(v[j].z, v[j].w); *(u32x2*)(orow + 4 * lane + 256 * j) = w; }
}

constexpr int XBP = pg8::XBP;
__device__ __forceinline__ void xb_load(const bf16_t* xrow, int lane, u32x4 (&w)[2]) { w[0] = *(const u32x4*)(xrow + 8 * lane); w[1] = *(const u32x4*)(xrow + 8 * lane + 512); }
__device__ __forceinline__ void norm_fin_b(const u32x4 (&w)[2], const float* nw, const float* shift, const float* scale, int lane, float (&v)[16]) {
    unpack8(w[0], v); unpack8(w[1], v + 8);
    float s = 0.f;
#pragma unroll
    for (int e = 0; e < 16; ++e) s += v[e] * v[e];
    const float rs = 1.0f / sqrtf(wave_sum(s) * (1.0f / D) + EPS);
#pragma unroll
    for (int j = 0; j < 2; ++j)
#pragma unroll
        for (int h = 0; h < 2; ++h) { const int c = 8 * lane + 512 * j + 4 * h; const f32x4 wv = *(const f32x4*)(nw + c), sh = *(const f32x4*)(shift + c), sc = *(const f32x4*)(scale + c);
#pragma unroll
            for (int q = 0; q < 4; ++q) v[8 * j + 4 * h + q] = (v[8 * j + 4 * h + q] * rs * wv[q]) * (1.0f + sc[q]) + sh[q]; }
}
__device__ __forceinline__ void store_row_b(bf16_t* orow, int lane, const float (&v)[16]) { *(u32x4*)(orow + 8 * lane) = pack8(v); *(u32x4*)(orow + 8 * lane + 512) = pack8(v + 8); }


#if !MK_MULTI
#define GRID_BAR() do { XcdBarrier b2_ = bar; asm volatile("" : "+s"(b2_.bar)); xcd_barrier(b2_); } while (0)
#define OPQ(x) (x)
#else
#define GRID_BAR() do {} while (0)
#define OPQ(x) ({ int _v = (x); asm volatile("" : "+s"(_v)); _v; })
#endif
#ifndef MK_SITES
#define MK_SITES 0xffffffffu
#endif
#define EN(s) (((MK_SITES) >> (s)) & 1u)
#define IN(k) (OPQ(lo) <= (k) && (k) < OPQ(hi_ph))
#define SEAM(k) do { if (IN(k) && IN((k) + 1)) GRID_BAR(); } while (0)
#define PHASE_WS() GAS unsigned char* ws = (GAS unsigned char*)args.ws; asm volatile("" : "+s"(ws))
#define PHASE_IDS() PHASE_WS(); const int lane = fresh_lane(), wid = wid0, tid = wid * 64 + lane, gw = blockIdx.x * 8 + wid; (void)lane; (void)gw; (void)tid

#define x_in (args.in[I_X])
#define ctx_in (args.in[I_CTX])
#define xout (args.out)
#define XB ((bf16_t*)args.out + 1024)
#define modv ((float*)(ws + SM_MOD))
#define ropet ((float*)(ws + SM_ROPE))
#define stats ((float*)(ws + SM_STATS))
#define NLOC ((float*)(ws + SM_NLOC))
#define NIN ((float*)(ws + SM_NIN))
#define MG ((float*)(ws + SM_MG))
#define MINb ((float*)(ws + SM_MIN))
#define xc ((float*)(ws + WS_XC))
#define BH ((bf16_t*)(ws + WS_H))
#define CLOC ((float*)(ws + WS_H))
#define BP ((bf16_t*)(ws + WS_P))
#define QM ((bf16_t*)(ws + WS_QM))
#define KVM ((bf16_t*)(ws + WS_KVM))
#define CIN ((bf16_t*)(ws + WS_CIN))
#define Win ((bf16_t*)(ws + W_IN))
#define Wout ((bf16_t*)(ws + W_OUT))
#define Wuq ((bf16_t*)(ws + W_UQ))
#define Wukv ((bf16_t*)(ws + W_UKV))
#define Wf13 ((bf16_t*)(ws + W_F13))
#define Wf2 ((bf16_t*)(ws + W_F2))
#define tokinfo ((int*)(ws + SM_TOK))
#define tokg ((float*)(ws + SM_TOKG))
#define wgcnt ((int*)(ws + SM_WGCNT))
#define rowtok ((int*)(ws + SM_ROWTOK))
#define rowgate ((float*)(ws + SM_ROWGATE))
#define tileexp ((int*)(ws + SM_TILEEXP))
#define WMOE ((bf16_t*)(ws + WS_WMOE))
#define UB ((bf16_t*)(ws + WS_U))
#define A8 ((unsigned char*)(ws + WS_A8))
#define ASORT ((bf16_t*)(ws + WS_ASORT))
#define PBY ((bf16_t*)(ws + WS_PBY))
#define PBF ((bf16_t*)(ws + WS_PBF))
#define PBW ((bf16_t*)(ws + WS_PBW))

template <int L> __device__ __forceinline__ void layer_phases(const Args& args, LAS unsigned char* lds, const int G, const int NGW, const XcdBarrier& bar, const int lo, const int hi_ph, const int wid0) {
    constexpr int l = L; constexpr int pb = 1 + 10 * l;

#define mod_l (modv + (size_t)l * 9 * 6144)
        if (EN(1) && IN(pb + 0)) { PHASE_IDS();
            const float* nw = args.in[I_N1W] + l * D;
            if (l == 0) {
                for (int r = gw; r < M; r += NGW) { const bool lat = r < ML; const int bi = lat ? (r >> 12) : 8;
                    const float* xr = lat ? (x_in + (size_t)r * D) : (ctx_in + (size_t)(r - ML) * D);
                    f32x4 v[4]; norm_row(xr, nw, mod_l + bi * 6144, mod_l + bi * 6144 + 1024, lane, v); store_row_bf16(BH + (size_t)r * D, lane, v); }
            } else {
                for (int r = gw; r < ML; r += 2 * NGW) { const int rB = r + NGW; const bool hb = rB < ML;
                    u32x4 wa[2], wb[2]; xb_load(XB + (size_t)r * XBP, lane, wa); xb_load(XB + (size_t)(hb ? rB : r) * XBP, lane, wb);
                    float v[16]; norm_fin_b(wa, nw, mod_l + (r >> 12) * 6144, mod_l + (r >> 12) * 6144 + 1024, lane, v); store_row_b(BH + (size_t)r * D, lane, v);
                    if (hb) { norm_fin_b(wb, nw, mod_l + (rB >> 12) * 6144, mod_l + (rB >> 12) * 6144 + 1024, lane, v); store_row_b(BH + (size_t)rB * D, lane, v); } }
                for (int r = ML + gw; r < M; r += NGW) { float* xr = xc + (size_t)(r - ML) * D;
                    f32x4 v[4]; norm_row(xr, nw, mod_l + 8 * 6144, mod_l + 8 * 6144 + 1024, lane, v, PBF + (size_t)(r - ML) * D, xr, 8, (size_t)MC * D); store_row_bf16(BH + (size_t)r * D, lane, v); }
            }
        }
        SEAM(pb + 0);
        if (EN(2) && IN(pb + 1)) { PHASE_WS();
            pg8::Gemm g{BH, D, Win + (size_t)l * 3072 * 1024, D}; pg8::StaticOrder S; S.init(M / 256, NP / 256, G, blockIdx.x, D);
            pg8::EpiP E{BP, stats, ropet};
            pg8::gemm_phase<pg8::EpiP, pg8::StaticOrder, true>(lds, g, S, E, wid0);
        }
        SEAM(pb + 1);
        if (EN(3) && IN(pb + 2)) { PHASE_WS();
            if (EN(18)) { pg8::Gemm g{BP + PC_QL, NP, Wuq + (size_t)l * 768 * 512, 512}; pg8::StaticOrder S; S.init(M / 256, 3, G, blockIdx.x, 512);
              pg8::EpiRS<true> E{QM, NQM, NQM, 384, stats, 0, 16, 1.0f / 512.0f, ropet};
              pg8::gemm_phase<pg8::EpiRS<true>, pg8::StaticOrder, true>(lds, g, S, E, wid0); }
            __syncthreads();
            if (EN(19)) { pg8::Gemm g{BP + PC_KVL, NP, Wukv + (size_t)l * 768 * 256, 256}; pg8::StaticOrder S; S.init(M / 256, 3, G, blockIdx.x, 256);
              pg8::EpiRS<false> E{KVM, NKVM, NKVM, NKVM, stats, 16, 8, 1.0f / 256.0f, ropet};
              pg8::gemm_phase<pg8::EpiRS<false>, pg8::StaticOrder, true>(lds, g, S, E, wid0); }
            __syncthreads();
            { PHASE_IDS();
            const float* convw = args.in[I_CONVW] + (size_t)l * 3 * 512; const float* igb = args.in[I_IGB] + l * 8; const float* fgb = args.in[I_FGB] + l * 8;
            for (int k = 0; ; ++k) { const int u = (k & 1) ? k * NGW + (NGW - 1 - gw) : k * NGW + gw;
                if (u >= NB * 4 * NCHK) { if (k * NGW >= NB * 4 * NCHK) break; else continue; }
                const int j = u % NCHK, bh = u / NCHK; int lane_ = lane; asm volatile("" : "+v"(lane_));
                if (EN(17)) ml::chunk_state_unit((LAS char*)lds + wid * ml::WAVE_LDS, bh >> 2, bh & 3, j, BP, convw, igb, fgb, CLOC, NLOC, MG, lane_); } }
        }
        SEAM(pb + 2);
        if (EN(4) && IN(pb + 3)) { PHASE_WS(); for (int item = blockIdx.x; item < 256; item += G) ml::scan_item((LAS char*)lds, wid0, item, CLOC, NLOC, MG, CIN, NIN, MINb); }
        SEAM(pb + 3);
        if (EN(5) && IN(pb + 4)) { GAS unsigned char* ws_ph = (GAS unsigned char*)args.ws;
            const float* convw = args.in[I_CONVW] + (size_t)l * 3 * 512; const float* igb = args.in[I_IGB] + l * 8; const float* fgb = args.in[I_FGB] + l * 8;
            const float* mnw = args.in[I_MLNW] + l * 256;
#ifndef MK_REP_MLA
#define MK_REP_MLA 1
#endif
#ifndef MK_REP_NA
#define MK_REP_NA 1
#endif
#ifndef MK_REP_ML
#define MK_REP_ML 1
#endif
            constexpr int n_mla1 = NB * 6 * 8, n_na1 = NB * 6 * 16, n_ml1 = (l == 0) ? NB * 4 * NCHK / 8 : NB * 4 * 64 / 8;
            constexpr int n_mla = n_mla1 * MK_REP_MLA, n_na = n_na1 * MK_REP_NA, n_ml = n_ml1 * MK_REP_ML, n_ctx = (l == 0) ? NB * 6 * 2 : 0;
            constexpr int n_items = n_mla + n_na + n_ml + n_ctx;
            volatile LAS int* qslot = (volatile LAS int*)(lds + LDS_MISC + 64);
            for (;;) {
                GAS unsigned char* ws = ws_ph; asm volatile("" : "+s"(ws));
                int wid_i = wid0; asm volatile("" : "+s"(wid_i));
                const int lane = fresh_lane(), tid = wid_i * 64 + lane;
                bf16_t* MIX = BH;
                __syncthreads();
                if (tid == 0) *qslot = (int)__hip_atomic_fetch_add((unsigned*)(ws + WS_CTL) + CW_QUEUE + l * 64, 1u, __ATOMIC_RELAXED, __HIP_MEMORY_SCOPE_AGENT);
                __syncthreads();
                const int u = __builtin_amdgcn_readfirstlane(*qslot);
                if (u >= n_items) break;
                att::Unit U;
                if (u < n_mla) { const int u1 = u % n_mla1; const int qb = u1 & 7, bh = u1 >> 3, b = bh / 6, h = bh % 6; const int row0 = b * T + qb * 512;
                    U.qn = QM + (size_t)row0 * NQM + h * 64; U.ldq = NQM; U.qr = QM + (size_t)row0 * NQM + 384 + h * 32; U.ldqr = NQM;
                    U.kn = KVM + h * 128; U.ldk = NKVM; U.kr = BP + PC_KR; U.ldkr = NP; U.v = KVM + h * 128 + 64; U.ldv = NKVM;
                    U.o = MIX + (size_t)row0 * D + 640 + h * 64; U.ldo = D; U.na = 64; U.rowa = b * T; U.rowc = ML + b * NC; U.rg = 0; U.rlo = 0;
                    if (EN(15)) { const bool ok = att::attn_unit64((LAS char*)lds, U, wid_i);
                        if (!ok && tid == 0) { unsigned* rd = (unsigned*)(ws + WS_CTL) + CW_REDO + l * 512; const unsigned ix = __hip_atomic_fetch_add(rd, 1u, __ATOMIC_RELAXED, __HIP_MEMORY_SCOPE_AGENT); rd[1 + ix] = (unsigned)u; } }
                } else if (u < n_mla + n_na) { const int v = (u - n_mla) % n_na1, rg = v & 15, bh = v >> 4, b = bh / 6, h = bh % 6; const int row0 = b * T + rg * 256;
                    const int rlo = min(max(4 * rg - 4, 0), 56), rhi = min(max(4 * rg - 1, 0), 56) + 7;
                    { LAS float* bt = (LAS float*)(lds + att::OFF_BIAS); const float* rp = args.in[I_RPB] + ((size_t)l * 6 + h) * 15 * 31;
                      for (int i = tid; i < 640; i += 512) { const int k = i - 64; bt[i] = (k >= 0 && k < 465) ? rp[k] * LOG2E : 0.f; } }
                    __syncthreads();
                    U.qn = BP + (size_t)row0 * NP + PC_NQ + h * 64; U.ldq = NP; U.qr = nullptr; U.ldqr = 0;
                    U.kn = BP + PC_NK + h * 64; U.ldk = NP; U.kr = nullptr; U.ldkr = 0; U.v = BP + PC_NV + h * 64; U.ldv = NP;
                    U.o = MIX + (size_t)row0 * D + 256 + h * 64; U.ldo = D; U.na = rhi - rlo + 1; U.rowa = b * T + rlo * 64; U.rowc = ML + b * NC; U.rg = rg; U.rlo = rlo;
                    if (EN(15)) { const bool ok = att::attn_unit<8, true, true>((LAS char*)lds, U, wid_i);
                        if (!ok && tid == 0) { unsigned* rd = (unsigned*)(ws + WS_CTL) + CW_REDO2 + l * 1024; const unsigned ix = __hip_atomic_fetch_add(rd, 1u, __ATOMIC_RELAXED, __HIP_MEMORY_SCOPE_AGENT); rd[1 + ix] = (unsigned)(u - n_mla); } }
                } else if (u < n_mla + n_na + n_ml) { const int id = ((u - n_mla - n_na) % n_ml1) * 8 + wid_i; int lane_ = lane; asm volatile("" : "+v"(lane_));
                    const int bh = (l == 0) ? id / NCHK : id >> 6, j = (l == 0) ? id % NCHK : 4 + (id & 63);
                    if (EN(16)) ml::out_unit((LAS char*)lds + wid_i * ml::WAVE_LDS, bh >> 2, bh & 3, j, BP, convw, igb, fgb, mnw, CIN, NIN, MINb, MIX, lane_);
                } else { const int v = u - n_mla - n_na - n_ml, kind = v & 1, bh = v >> 1, b = bh / 6, h = bh % 6; const int row0 = ML + b * NC;
                    U.na = 0; U.rowa = 0; U.rowc = row0; U.rg = 0; U.rlo = 0; U.ldo = D;
                    if (kind == 0) { U.qn = QM + (size_t)row0 * NQM + h * 64; U.ldq = NQM; U.qr = QM + (size_t)row0 * NQM + 384 + h * 32; U.ldqr = NQM;
                        U.kn = KVM + h * 128; U.ldk = NKVM; U.kr = BP + PC_KR; U.ldkr = NP; U.v = KVM + h * 128 + 64; U.ldv = NKVM; U.o = MIX + (size_t)row0 * D + 640 + h * 64;
                        if (EN(15)) (void)att::attn_unit<12, false>((LAS char*)lds, U, wid_i);
                    } else { U.qn = BP + (size_t)row0 * NP + PC_NQ + h * 64; U.ldq = NP; U.qr = nullptr; U.ldqr = 0;
                        U.kn = BP + PC_NK + h * 64; U.ldk = NP; U.kr = nullptr; U.ldkr = 0; U.v = BP + PC_NV + h * 64; U.ldv = NP; U.o = MIX + (size_t)row0 * D + 256 + h * 64;
                        if (EN(15)) (void)att::attn_unit<8, false>((LAS char*)lds, U, wid_i); }
                }
            }
        }
        SEAM(pb + 4);
        if (EN(6) && IN(pb + 5)) { PHASE_WS();
            {
              unsigned* rd = (unsigned*)(ws + WS_CTL) + CW_REDO + l * 512; const int nredo = (int)__hip_atomic_load(rd, __ATOMIC_RELAXED, __HIP_MEMORY_SCOPE_AGENT);
              unsigned* rd2 = (unsigned*)(ws + WS_CTL) + CW_REDO2 + l * 1024; const int nredo2 = (int)__hip_atomic_load(rd2, __ATOMIC_RELAXED, __HIP_MEMORY_SCOPE_AGENT);
              if (nredo2 > 0) {
                  for (int i = blockIdx.x; i < nredo2; i += G) { const int v = (int)rd2[1 + i] % (NB * 6 * 16), rg = v & 15, bh = v >> 4, b = bh / 6, h = bh % 6; const int row0 = b * T + rg * 256;
                      const int rlo = min(max(4 * rg - 4, 0), 56), rhi = min(max(4 * rg - 1, 0), 56) + 7; const int tid_ = wid0 * 64 + fresh_lane();
                      __syncthreads();
                      { LAS float* bt = (LAS float*)(lds + att::OFF_BIAS); const float* rp = args.in[I_RPB] + ((size_t)l * 6 + h) * 15 * 31;
                        for (int q = tid_; q < 640; q += 512) { const int k = q - 64; bt[q] = (k >= 0 && k < 465) ? rp[k] * LOG2E : 0.f; } }
                      __syncthreads();
                      att::Unit U; U.qn = BP + (size_t)row0 * NP + PC_NQ + h * 64; U.ldq = NP; U.qr = nullptr; U.ldqr = 0;
                      U.kn = BP + PC_NK + h * 64; U.ldk = NP; U.kr = nullptr; U.ldkr = 0; U.v = BP + PC_NV + h * 64; U.ldv = NP;
                      U.o = BH + (size_t)row0 * D + 256 + h * 64; U.ldo = D; U.na = rhi - rlo + 1; U.rowa = b * T + rlo * 64; U.rowc = ML + b * NC; U.rg = rg; U.rlo = rlo;
                      (void)att::attn_unit<8, true>((LAS char*)lds, U, wid0); }
              }
              if (nredo > 0) {
                  for (int i = blockIdx.x; i < 2 * nredo; i += G) { const int u1 = (int)rd[1 + (i >> 1)] % (NB * 6 * 8), hf = i & 1; const int qb = u1 & 7, bh = u1 >> 3, b = bh / 6, h = bh % 6; const int row0 = b * T + qb * 512 + hf * 256;
                      att::Unit U; U.qn = QM + (size_t)row0 * NQM + h * 64; U.ldq = NQM; U.qr = QM + (size_t)row0 * NQM + 384 + h * 32; U.ldqr = NQM;
                      U.kn = KVM + h * 128; U.ldk = NKVM; U.kr = BP + PC_KR; U.ldkr = NP; U.v = KVM + h * 128 + 64; U.ldv = NKVM;
                      U.o = BH + (size_t)row0 * D + 640 + h * 64; U.ldo = D; U.na = 64; U.rowa = b * T; U.rowc = ML + b * NC; U.rg = 0; U.rlo = 0;
                      (void)att::attn_unit<12, false>((LAS char*)lds, U, wid0); }
              }
              if (nredo > 0 || nredo2 > 0) GRID_BAR(); }
            pg8::Gemm g{BH, D, Wout + (size_t)l * 1024 * 1024, D}; pg8::TailSplit<pg8::StaticOrder> S; S.init(ML / 256, 4, G, blockIdx.x, D); S.init_ts(ML / 256, l == 0 ? MC / 256 : 0, 4);
            pg8::EpiResB<(l == 0)> E{x_in, XB, mod_l + 2 * 1024, 6144, PBW, (size_t)MC * D, ML};
            pg8::gemm_phase<pg8::EpiResB<(l == 0)>, pg8::TailSplit<pg8::StaticOrder>, true>(lds, g, S, E, wid0);
        }
        SEAM(pb + 5);
        if (l == 0) {
            if (EN(7) && IN(pb + 6)) { PHASE_IDS();
                const float* nw = args.in[I_N2W] + l * D;
                for (int r = gw; r < ML; r += 2 * NGW) { const int rB = r + NGW; const bool hb = rB < ML;
                    u32x4 wa[2], wb[2]; xb_load(XB + (size_t)r * XBP, lane, wa); xb_load(XB + (size_t)(hb ? rB : r) * XBP, lane, wb);
                    float v[16]; norm_fin_b(wa, nw, mod_l + (r >> 12) * 6144 + 3 * 1024, mod_l + (r >> 12) * 6144 + 4 * 1024, lane, v); store_row_b(BH + (size_t)r * D, lane, v);
                    if (hb) { norm_fin_b(wb, nw, mod_l + (rB >> 12) * 6144 + 3 * 1024, mod_l + (rB >> 12) * 6144 + 4 * 1024, lane, v); store_row_b(BH + (size_t)rB * D, lane, v); } }
                for (int r = ML + gw; r < M; r += NGW) { const float* xr = ctx_in + (size_t)(r - ML) * D; float* xw = xc + (size_t)(r - ML) * D;
                    f32x4 v[4]; norm_row(xr, nw, mod_l + 8 * 6144 + 3 * 1024, mod_l + 8 * 6144 + 4 * 1024, lane, v, PBW + (size_t)(r - ML) * D, xw, 4, (size_t)MC * D); store_row_bf16(BH + (size_t)r * D, lane, v); }
            }
            SEAM(pb + 6);
            if (EN(8) && IN(pb + 7)) { PHASE_WS();
                pg8::Gemm g{BH, D, Wf13, D}; pg8::StaticOrder S; S.init(M / 256, 22, G, blockIdx.x, D);
                pg8::EpiSwiglu E{BP, DFF};
                pg8::gemm_phase<pg8::EpiSwiglu, pg8::StaticOrder, true>(lds, g, S, E, wid0);
            }
            SEAM(pb + 7);
            if (EN(9) && IN(pb + 8)) { PHASE_WS();
                pg8::Gemm g{BP, DFF, Wf2, DFF}; pg8::TailSplit<pg8::StaticOrder> S; S.init(ML / 256, 4, G, blockIdx.x, DFF); S.init_ts(ML / 256, MC / 256, 8);
                pg8::EpiResB<false> E{nullptr, XB, mod_l + 5 * 1024, 6144, PBF, (size_t)MC * D, ML};
                pg8::gemm_phase<pg8::EpiResB<false>, pg8::TailSplit<pg8::StaticOrder>, true>(lds, g, S, E, wid0);
            }
            SEAM(pb + 8);
        } else {
            if (EN(10) && IN(pb + 6)) { PHASE_IDS();
                { LAS float* scr = (LAS float*)(lds + wid * 4352);
                  const int per13 = 352 * 16, per2 = 64 * 44, per = per13 + per2;
                  const float* m1 = args.in[I_M1]; const float* m3 = args.in[I_M3]; const float* m2 = args.in[I_M2]; bf16_t* wm = WMOE;
                  auto resolve = [&](int it, TrItem& T) { const int e = it / per, r = it % per; unsigned char* wb = (unsigned char*)wm + (size_t)e * WMOE_E;
                      if (r < per13) { TrJob J{m1 + (size_t)e * 1024 * 2816, m3 + (size_t)e * 1024 * 2816, 2816, 1024, 352, 3, (bf16_t*)wb, nullptr, 64.f}; tr_resolve(J, r, lane, T);
                          T.dp = (bf16_t*)(wb + (size_t)(16 * (r % 352)) * 1024 + 64 * (r / 352)); }
                      else { const int r2 = r - per13; TrJob J{m2 + (size_t)e * 2816 * 1024, nullptr, 1024, 2816, 64, 0, (bf16_t*)wb, nullptr, 64.f}; tr_resolve(J, r2, lane, T);
                          T.dp = (bf16_t*)(wb + (size_t)5632 * 1024 + (size_t)(16 * (r2 % 64)) * 2816 + 64 * (r2 / 64)); } };
                  tr_run2(gw, NGW, NEXP * per, resolve, scr, lane); }
                __syncthreads();
                LAS int* esel = (LAS int*)(lds + 40960 + 32768);
                float rwr[16][8];
#pragma unroll
                for (int j = 0; j < 2; ++j)
#pragma unroll
                    for (int q = 0; q < 8; ++q) { const float* wp = args.in[I_RW] + (size_t)(8 * lane + 512 * j + q) * 8; const f32x4 w0 = *(const f32x4*)wp, w1 = *(const f32x4*)(wp + 4);
                        rwr[8 * j + q][0] = w0.x; rwr[8 * j + q][1] = w0.y; rwr[8 * j + q][2] = w0.z; rwr[8 * j + q][3] = w0.w; rwr[8 * j + q][4] = w1.x; rwr[8 * j + q][5] = w1.y; rwr[8 * j + q][6] = w1.z; rwr[8 * j + q][7] = w1.w; }
                const float* nw = args.in[I_N2W] + l * D;
                for (int blk = blockIdx.x; blk < ML / 128; blk += G) {
                    u32x4 wnx[2]; xb_load(XB + (size_t)(blk * 128 + wid) * XBP, lane, wnx);
                    for (int rr = wid; rr < 128; rr += 8) { const int r = blk * 128 + rr, bi = r >> 12; float v[16];
                        u32x4 wc[2]; wc[0] = wnx[0]; wc[1] = wnx[1];
                        if (rr + 8 < 128) xb_load(XB + (size_t)(r + 8) * XBP, lane, wnx);
                        norm_fin_b(wc, nw, mod_l + bi * 6144 + 3 * 1024, mod_l + bi * 6144 + 4 * 1024, lane, v);
                        float lg[8];
#pragma unroll
                        for (int e = 0; e < 8; ++e) lg[e] = 0.f;
#pragma unroll
                        for (int j = 0; j < 2; ++j)
#pragma unroll
                            for (int q = 0; q < 8; ++q) { const float hv = v[8 * j + q];
#pragma unroll
                                for (int e = 0; e < 8; ++e) lg[e] += hv * rwr[8 * j + q][e]; }
#pragma unroll
                        for (int e = 0; e < 8; ++e) lg[e] = wave_sum(lg[e]);
                        int e0 = 0; float v0 = lg[0];
#pragma unroll
                        for (int e = 1; e < 8; ++e) if (lg[e] > v0) { v0 = lg[e]; e0 = e; }
                        int e1 = -1; float v1 = -INFINITY;
#pragma unroll
                        for (int e = 0; e < 8; ++e) if (e != e0 && lg[e] > v1) { v1 = lg[e]; e1 = e; }
                        const float g0 = 1.0f / (1.0f + expf(v1 - v0));
                        if (lane == 0) { esel[rr * 2] = e0; esel[rr * 2 + 1] = e1; tokg[(size_t)r * 2] = g0; tokg[(size_t)r * 2 + 1] = 1.0f - g0; } }
                    __syncthreads();
                    if (tid < 128) { const int e0 = esel[tid * 2], e1 = esel[tid * 2 + 1]; int s0 = 0, s1 = 0;
                        for (int q = 0; q < tid; ++q) { s0 += (esel[q * 2] == e0); s1 += (esel[q * 2 + 1] == e1); }
                        int* ti = tokinfo + (size_t)(blk * 128 + tid) * 4; ti[0] = e0; ti[1] = e1; ti[2] = s0; ti[3] = s1; }
                    if (tid < 16) { const int k = tid >> 3, e = tid & 7; int c = 0; for (int q = 0; q < 128; ++q) c += (esel[q * 2 + k] == e); wgcnt[blk * 16 + tid] = c; }
                    __syncthreads();
                }
            }
            SEAM(pb + 6);
            if (EN(11) && IN(pb + 7)) { PHASE_IDS();
                LAS int* tot = (LAS int*)(lds);
                LAS int* offp = tot + 16; LAS int* pre = tot + 32;
                __syncthreads();
                LAS int* segs = pre + 4096;
                for (int i = tid; i < 4096; i += 512) pre[i] = wgcnt[i];
                __syncthreads();
                { const int c = tid & 15, sg = tid >> 4; int sm = 0;
#pragma unroll
                  for (int q = 0; q < 8; ++q) sm += pre[(sg * 8 + q) * 16 + c];
                  segs[sg * 16 + c] = sm; }
                __syncthreads();
                { const int c = tid & 15, sg = tid >> 4; int run = 0; for (int q = 0; q < sg; ++q) run += segs[q * 16 + c];
#pragma unroll
                  for (int q = 0; q < 8; ++q) { const int v = pre[(sg * 8 + q) * 16 + c]; pre[(sg * 8 + q) * 16 + c] = run; run += v; }
                  if (sg == 31) tot[c] = run; }
                __syncthreads();
                if (tid == 0) { int o = 0; for (int e = 0; e < 8; ++e) { offp[e] = o; o += (tot[e] + tot[8 + e] + 255) & ~255; }
                    if (blockIdx.x == 0) { tileexp[320] = o >> 8; for (int e = 0; e < 8; ++e) { const int t0 = offp[e] >> 8, nt = (tot[e] + tot[8 + e] + 255) >> 8; for (int q = 0; q < nt; ++q) tileexp[t0 + q] = e; } } }
                __syncthreads();
                const float* nw = args.in[I_N2W] + l * D;
                for (int blk = blockIdx.x; blk < ML / 128; blk += G) {
                    u32x4 wnx[2]; xb_load(XB + (size_t)(blk * 128 + wid) * XBP, lane, wnx);
                    for (int rr = wid; rr < 128; rr += 8) { const int r = blk * 128 + rr, bi = r >> 12; float v[16];
                        u32x4 wc[2]; wc[0] = wnx[0]; wc[1] = wnx[1];
                        if (rr + 8 < 128) xb_load(XB + (size_t)(r + 8) * XBP, lane, wnx);
                        norm_fin_b(wc, nw, mod_l + bi * 6144 + 3 * 1024, mod_l + bi * 6144 + 4 * 1024, lane, v);
                        const int* ti = tokinfo + (size_t)r * 4;
#pragma unroll
                        for (int k = 0; k < 2; ++k) { const int e = ti[k], pos = offp[e] + (k == 0 ? 0 : tot[e]) + pre[blk * 16 + k * 8 + e] + ti[2 + k];
                            { unsigned char* ar = A8 + (size_t)pos * 1024 + 8 * lane; *(u32x2*)ar = pack8_f8(v); *(u32x2*)(ar + 512) = pack8_f8(v + 8); }
                            if (lane == 0) tokinfo[(size_t)r * 4 + 2 + k] = pos; } }
                }
            }
            SEAM(pb + 7);
            for (int k = 0; k < 1; ++k) {
                if (EN(12) && IN(pb + 8 + 2 * k)) { PHASE_WS();
                    const int ntl = tileexp[320], t0 = 0, t1 = ntl;
                    pg8::Gemm g{(const bf16_t*)(A8 + (size_t)t0 * 256 * 1024), 512, WMOE, 512}; pg8::GroupedOrder S; S.init(t1 > t0 ? t1 - t0 : 0, 22, G, blockIdx.x, 512); S.tile_exp = tileexp + t0; S.estride = WMOE_E;
                    pg8::EpiSwiglu8 E{(unsigned char*)UB, DFF};
                    pg8::gemm_phase<pg8::EpiSwiglu8, pg8::GroupedOrder, true, true>(lds, g, S, E, wid0);
                }
                SEAM(pb + 8 + 2 * k);
                if (EN(13) && IN(pb + 9 + 2 * k)) { PHASE_WS();
                    const int ntl = tileexp[320], t0 = 0, t1 = ntl;
                    const int nmp = t1 > t0 ? t1 - t0 : 0, nmain = nmp < 256 ? nmp : 256;
                    pg8::Gemm g{UB, DFF / 2, (const bf16_t*)((const unsigned char*)WMOE + (size_t)5632 * 1024), DFF / 2}; pg8::TailSplit<pg8::GroupedOrder> S; S.init(nmain, 4, G, blockIdx.x, DFF / 2); S.tile_exp = tileexp + t0; S.estride = WMOE_E; S.init_ts(nmain, nmp - nmain, 5);
                    pg8::EpiDelta E{ASORT + (size_t)t0 * 256 * D, nullptr, 0, PBY, (size_t)7 * 256 * D, 256 * 256};
                    pg8::gemm_phase<pg8::EpiDelta, pg8::TailSplit<pg8::GroupedOrder>, true, true>(lds, g, S, E, wid0);
                }
                SEAM(pb + 9 + 2 * k);
            }
        }
    }

constexpr int NPHASE = 24;
__global__ void __launch_bounds__(512, 2) mega_fwd(Args args) {
    extern __shared__ __attribute__((aligned(16))) unsigned char lds_raw[];
    LAS unsigned char* lds = (LAS unsigned char*)lds_raw;
    const int G = gridDim.x, NGW = G * 8;
    const int wid0 = __builtin_amdgcn_readfirstlane(threadIdx.x >> 6);
    if (threadIdx.x < 4) ((volatile LAS unsigned*)(lds + LDS_MISC))[threadIdx.x] = 0u;
    __syncthreads();
#if !MK_MULTI
    XcdBarrier bar = xcd_barrier_post((unsigned*)(args.ws + WS_CTL) + CW_BAR, (volatile LAS unsigned*)(lds + LDS_MISC));
    constexpr int lo = 0, hi_ph = 1000;
#else
    XcdBarrier bar; bar.bar = nullptr; bar.x = 0; bar.st = nullptr;
    const int lo = args.ph_lo, hi_ph = args.ph_hi;
#endif
    if (EN(0) && IN(0)) { PHASE_IDS();
        LAS float* scr = (LAS float*)(lds + wid * 4352);
        TrJob jobs[10];
        for (int l = 0; l < 2; ++l) {
            jobs[l * 4 + 0] = TrJob{args.in[I_WIN] + (size_t)l * 1024 * 2992, nullptr, 2992, 1024, 192, 1, Win + (size_t)l * 3072 * 1024, nullptr, 1.f};
            jobs[l * 4 + 1] = TrJob{args.in[I_WOUT] + (size_t)l * 1024 * 1024, nullptr, 1024, 1024, 64, 0, Wout + (size_t)l * 1024 * 1024, nullptr, 1.f};
            jobs[l * 4 + 2] = TrJob{args.in[I_WUQ] + (size_t)l * 512 * 576, nullptr, 576, 512, 36, 2, Wuq + (size_t)l * 768 * 512, args.in[I_QNW] + l * 512, 0.10206207261596577f * LOG2E};
            jobs[l * 4 + 3] = TrJob{args.in[I_WUKV] + (size_t)l * 256 * 768, nullptr, 768, 256, 48, 0, Wukv + (size_t)l * 768 * 256, args.in[I_KVNW] + l * 256, 1.f};
        }
        jobs[8] = TrJob{args.in[I_F1], args.in[I_F3], 2816, 1024, 352, 3, Wf13, nullptr, 1.f};
        jobs[9] = TrJob{args.in[I_F2], nullptr, 1024, 2816, 64, 0, Wf2, nullptr, 1.f};
        int total = 0;
#pragma unroll
        for (int q = 0; q < 10; ++q) total += tr_job_count(jobs[q]);
        { auto resolve = [&](int it, TrItem& T) { int r = it;
#pragma unroll
              for (int q = 0; q < 10; ++q) { const int n = tr_job_count(jobs[q]); if (r >= 0 && r < n) tr_resolve(jobs[q], r, lane, T); r -= n; } };
          tr_run(gw, NGW, total, resolve, scr, lane); }
        for (int item = blockIdx.x; item < 192; item += G) mod_item((LAS char*)lds + 40960, wid0, item, args.in[I_C], args.in[I_CCTX], args.in[I_ADAW], args.in[I_ADAB], modv);
        if (blockIdx.x == G - 1) { const int pos = tid >> 3, jj = tid & 7; const float inv = powf(10000.0f, -(float)jj / 8.0f); const float a = (float)pos * inv; ropet[pos * 8 + jj] = cosf(a); ropet[512 + pos * 8 + jj] = sinf(a); }
    }
    SEAM(0);

    layer_phases<0>(args, lds, G, NGW, bar, lo, hi_ph, wid0);
    layer_phases<1>(args, lds, G, NGW, bar, lo, hi_ph, wid0);
    if (EN(14) && IN(23)) { PHASE_IDS();
        const float* nw = args.in[I_FNW]; const float* g5 = modv + (size_t)9 * 6144 + 5 * 1024;
        auto yslow = [&](int pos, int c, float* y) {
            if (pos < 65536) unpack8(*(const u32x4*)(ASORT + (size_t)pos * D + c), y);
            else { for (int e = 0; e < 8; ++e) y[e] = 0.f;
                for (int p = 0; p < 5; ++p) { float t[8]; unpack8(*(const u32x4*)(PBY + ((size_t)p * 7 * 256 + (pos - 65536)) * D + c), t);
                    for (int e = 0; e < 8; ++e) y[e] += t[e]; } } };
        auto finish = [&](int r, float (&v)[16]) {
            float sq = 0.f;
#pragma unroll
            for (int e = 0; e < 16; ++e) sq += v[e] * v[e];
            const float rs = 1.0f / sqrtf(wave_sum(sq) * (1.0f / D) + EPS);
            float* xr = xout + (size_t)r * D;
#pragma unroll
            for (int j = 0; j < 2; ++j)
#pragma unroll
                for (int h = 0; h < 2; ++h) { const int c = 8 * lane + 512 * j + 4 * h; const f32x4 w = *(const f32x4*)(nw + c);
                    f32x4 o; o.x = v[8 * j + 4 * h] * rs * w.x; o.y = v[8 * j + 4 * h + 1] * rs * w.y; o.z = v[8 * j + 4 * h + 2] * rs * w.z; o.w = v[8 * j + 4 * h + 3] * rs * w.w;
                    *(f32x4*)(xr + c) = o; } };
        auto combine = [&](int r, const u32x4 (&xw)[2], const float (&ya)[16], const float (&yb)[16], float g0, float g1, float (&v)[16]) {
            const float* gp = g5 + (size_t)(r >> 12) * 6144;
            unpack8(xw[0], v); unpack8(xw[1], v + 8);
#pragma unroll
            for (int j = 0; j < 2; ++j)
#pragma unroll
                for (int h = 0; h < 2; ++h) { const int c = 8 * lane + 512 * j + 4 * h; const f32x4 gg = *(const f32x4*)(gp + c);
#pragma unroll
                    for (int q = 0; q < 4; ++q) { const int e = 8 * j + 4 * h + q; v[e] += gg[q] * (ya[e] * g0 + yb[e] * g1); } } };
        auto row_slow = [&](int r) {
            const int p0 = tokinfo[(size_t)r * 4 + 2], p1 = tokinfo[(size_t)r * 4 + 3]; const float g0 = tokg[(size_t)r * 2], g1 = tokg[(size_t)r * 2 + 1];
            u32x4 xw[2]; xb_load(XB + (size_t)r * XBP, lane, xw);
            float ya[16], yb[16], v[16];
            yslow(p0, 8 * lane, ya); yslow(p0, 8 * lane + 512, ya + 8); yslow(p1, 8 * lane, yb); yslow(p1, 8 * lane + 512, yb + 8);
            combine(r, xw, ya, yb, g0, g1, v); finish(r, v); };
        int nA0 = 0, nA1 = 0, nB0 = 0, nB1 = 0; float ngA0 = 0.f, ngA1 = 0.f, ngB0 = 0.f, ngB1 = 0.f;
        auto ld_ti = [&](int rA, int rB) { if (rB < ML) { nA0 = tokinfo[(size_t)rA * 4 + 2]; nA1 = tokinfo[(size_t)rA * 4 + 3]; nB0 = tokinfo[(size_t)rB * 4 + 2]; nB1 = tokinfo[(size_t)rB * 4 + 3];
            ngA0 = tokg[(size_t)rA * 2]; ngA1 = tokg[(size_t)rA * 2 + 1]; ngB0 = tokg[(size_t)rB * 2]; ngB1 = tokg[(size_t)rB * 2 + 1]; } };
        ld_ti(gw, gw + NGW);
        for (int r = gw; r < ML; r += 2 * NGW) { const int rA = r, rB = r + NGW;
            const int pA0 = nA0, pA1 = nA1, pB0 = nB0, pB1 = nB1; const float gA0 = ngA0, gA1 = ngA1, gB0 = ngB0, gB1 = ngB1;
            if (r + 2 * NGW < ML) ld_ti(r + 2 * NGW, r + 3 * NGW);
            if (rB >= ML) { row_slow(rA); continue; }
            if (__builtin_amdgcn_readfirstlane((pA0 | pA1 | pB0 | pB1) >= 65536 ? 1 : 0)) { row_slow(rA); row_slow(rB); continue; }
            u32x4 xa[2], xb2[2], a0[2], a1[2], b0[2], b1[2];
            xb_load(XB + (size_t)rA * XBP, lane, xa); xb_load(XB + (size_t)rB * XBP, lane, xb2);
            xb_load(ASORT + (size_t)pA0 * D, lane, a0); xb_load(ASORT + (size_t)pA1 * D, lane, a1); xb_load(ASORT + (size_t)pB0 * D, lane, b0); xb_load(ASORT + (size_t)pB1 * D, lane, b1);
            float ya[16], yb[16], v[16];
            unpack8(a0[0], ya); unpack8(a0[1], ya + 8); unpack8(a1[0], yb); unpack8(a1[1], yb + 8);
            combine(rA, xa, ya, yb, gA0, gA1, v); finish(rA, v);
            unpack8(b0[0], ya); unpack8(b0[1], ya + 8); unpack8(b1[0], yb); unpack8(b1[1], yb + 8);
            combine(rB, xb2, ya, yb, gB0, gB1, v); finish(rB, v); }
    }
}

extern "C" void kernel_launch(void* const* d_in, const int* in_sizes, int n_in, void* d_out, int out_size, void* d_ws, size_t ws_size, hipStream_t stream) {
    static int grid = 0;
    if (grid == 0) {
        if (n_in != 27 || out_size != ML * D || ws_size < WS_END) { fprintf(stderr, "kernel_launch: unexpected sizes (n_in %d out %d ws %zu need %zu)\n", n_in, out_size, ws_size, (size_t)WS_END); grid = -1; return; }
        int dev = 0, cus = 0;
        if (hipGetDevice(&dev) != hipSuccess || hipDeviceGetAttribute(&cus, hipDeviceAttributeMultiprocessorCount, dev) != hipSuccess) { grid = -1; return; }
        if (hipFuncSetAttribute((const void*)mega_fwd, hipFuncAttributeMaxDynamicSharedMemorySize, LDS_BYTES) != hipSuccess) { fprintf(stderr, "kernel_launch: hipFuncSetAttribute failed\n"); grid = -1; return; }
        int per_cu = 0;
        if (hipOccupancyMaxActiveBlocksPerMultiprocessor(&per_cu, (const void*)mega_fwd, 512, LDS_BYTES) != hipSuccess || per_cu < 1) fprintf(stderr, "kernel_launch: occupancy query says %d\n", per_cu);
        (void)hipGetLastError();
        grid = cus;
    }
    if (grid < 0) return;
    if (hipMemsetAsync((char*)d_ws + WS_CTL, 0, CTL_ZERO_BYTES, stream) != hipSuccess) return;
    Args a{};
    for (int i = 0; i < 27; ++i) a.in[i] = (const float*)d_in[i];
    a.out = (float*)d_out; a.ws = (unsigned char*)d_ws;
#if MK_MULTI
#ifndef MK_DUP0
#define MK_DUP0 -1
#endif
#ifndef MK_DUP1
#define MK_DUP1 -1
#endif
    for (int ph = 0; ph < NPHASE; ++ph) { a.ph_lo = ph; a.ph_hi = ph + 1; const int reps = (ph == MK_DUP0 || ph == MK_DUP1) ? 2 : 1;
        for (int r = 0; r < reps; ++r) hipLaunchKernelGGL(mega_fwd, dim3(grid), dim3(512), LDS_BYTES, stream, a); }
#else
    a.ph_lo = 0; a.ph_hi = NPHASE;
    hipLaunchKernelGGL(mega_fwd, dim3(grid), dim3(512), LDS_BYTES, stream, a);
#endif
}
```
